# Optimizing an MI355X kernel written in HIP

```python
import jax, jax.numpy as jnp
from jax import lax
import numpy as np

D_MODEL = 1024
BATCH = 8
SEQ = 2048
DEPTH = 2
DEC_BATCH = 32
DEC_SEQ = 8
PAST_LEN = 16384
PAGE_SIZE = 128

N_MIXERS = 2
N_ATT_LAYERS = (DEPTH + 1) // 2
N_DN_LAYERS = DEPTH // 2
EPS = 1e-6

N_HEADS = 8
HEAD_DIM = D_MODEL // N_HEADS
N_KV_HEADS = 2
GROUP = N_HEADS // N_KV_HEADS
ATT_WIDTH = N_HEADS * HEAD_DIM
IDX_HEADS = 8
IDX_DIM = 64
TOPK_MAX = 256
Q_BLOCK = 128
ATT_SIZES = (ATT_WIDTH, N_KV_HEADS * HEAD_DIM, N_KV_HEADS * HEAD_DIM, IDX_HEADS * IDX_DIM, IDX_DIM, IDX_HEADS, ATT_WIDTH)
ATT_IN = 2 * ATT_WIDTH + 2 * N_KV_HEADS * HEAD_DIM + IDX_HEADS * IDX_DIM + IDX_DIM + IDX_HEADS

DN_HEADS = 8
DN_DK = 128
DN_DV = 128
DN_WIDTH = DN_HEADS * DN_DV
CONV_W = 4
CONV_DIM = 2 * DN_HEADS * DN_DK + DN_WIDTH
CHUNK = 64
DN_IN = CONV_DIM + DN_WIDTH + 2 * DN_HEADS

kernel_name = 'dsa_gated_deltanet_hybrid_step'


def _rms_norm(x, gain):
    xf = x.astype(jnp.float32)
    y = xf * lax.rsqrt(jnp.mean(xf * xf, axis=-1, keepdims=True) + EPS)
    return (y * gain.astype(jnp.float32)).astype(x.dtype)


def _l2norm(x):
    xf = x.astype(jnp.float32)
    return xf * lax.rsqrt(jnp.sum(xf * xf, axis=-1, keepdims=True) + EPS)


def _split(p, sizes):
    offs, acc = [], 0
    for s in sizes[:-1]:
        acc += s
        offs.append(acc)
    return jnp.split(p, offs, axis=-1)


def _gather_rows(rows, idx):
    return jax.vmap(lambda r, i: r[i])(rows, idx)


def _gated_out(o, gate, w_out):
    return (o * jax.nn.silu(gate)) @ w_out


def _att_project(xn, w_in, q_gain, k_gain, ik_gain):
    B, T, _ = xn.shape
    q, k, v, iq, ik, iw, gate = _split(xn @ w_in, ATT_SIZES)
    q = _rms_norm(q.reshape(B, T, N_HEADS, HEAD_DIM), q_gain) * (HEAD_DIM ** -0.5)
    k = _rms_norm(k.reshape(B, T, N_KV_HEADS, HEAD_DIM), k_gain)
    v = v.reshape(B, T, N_KV_HEADS, HEAD_DIM)
    iq = iq.reshape(B, T, IDX_HEADS, IDX_DIM)
    ik = _rms_norm(ik, ik_gain)
    iw = iw * (IDX_HEADS ** -0.5 * IDX_DIM ** -0.5)
    return q, k, v, iq, ik, iw, gate


def _indexer_topk(iq, iw, ik, q_pos, topk):
    L = ik.shape[1]
    s = jnp.einsum('bthd,bld->bthl', iq.astype(jnp.float32), ik.astype(jnp.float32))
    score = jnp.einsum('bth,bthl->btl', iw.astype(jnp.float32), jax.nn.relu(s))
    admissible = jnp.arange(L)[None, None, :] <= q_pos[None, :, None]
    score = jnp.where(admissible, score, -jnp.inf)
    _, idx = lax.top_k(score, topk)
    return idx, idx <= q_pos[None, :, None]


def _sparse_attend(q, k_sel, v_sel, valid):
    B, T = q.shape[:2]
    qg = q.reshape(B, T, N_KV_HEADS, GROUP, HEAD_DIM).astype(jnp.float32)
    logits = jnp.einsum('btgrd,btkgd->btgrk', qg, k_sel.astype(jnp.float32))
    logits = jnp.where(valid[:, :, None, None, :], logits, -jnp.inf)
    p = jax.nn.softmax(logits, axis=-1)
    o = jnp.einsum('btgrk,btkgd->btgrd', p, v_sel.astype(jnp.float32))
    return o.reshape(B, T, ATT_WIDTH).astype(q.dtype)


def _att_prompt(q, k, v, iq, iw, ik):
    B, S = q.shape[:2]
    nb = S // Q_BLOCK
    topk = min(TOPK_MAX, S // 4)

    def to_blocks(a):
        return jnp.swapaxes(a.reshape(B, nb, Q_BLOCK, *a.shape[2:]), 0, 1)

    def block(args):
        qb, iqb, iwb, pos = args
        idx, valid = _indexer_topk(iqb, iwb, ik, pos, topk)
        return _sparse_attend(qb, _gather_rows(k, idx), _gather_rows(v, idx), valid)

    pos = jnp.arange(S).reshape(nb, Q_BLOCK)
    out = lax.map(block, (to_blocks(q), to_blocks(iq), to_blocks(iw), pos))
    return jnp.swapaxes(out, 0, 1).reshape(B, S, ATT_WIDTH)


def _att_sample(q, k, v, iq, iw, ik, cache_k, cache_v, cache_idx_k, page_table, layer):
    B, T = q.shape[:2]
    past = page_table.shape[1] * PAGE_SIZE
    ik_past = cache_idx_k[page_table][..., layer, :].reshape(B, past, IDX_DIM)
    ik_all = jnp.concatenate([ik_past.astype(ik.dtype), ik], axis=1)
    q_pos = past + jnp.arange(T)
    idx, valid = _indexer_topk(iq, iw, ik_all, q_pos, min(TOPK_MAX, (past + T) // 4))
    in_past = idx < past
    pidx = jnp.minimum(idx, past - 1)
    phys = jax.vmap(lambda pt, pg: pt[pg])(page_table, pidx // PAGE_SIZE)
    off = pidx % PAGE_SIZE
    nidx = jnp.clip(idx - past, 0, T - 1)

    def select(cache, new):
        old = cache[phys, off][:, :, :, layer]
        return jnp.where(in_past[..., None, None], old.astype(new.dtype), _gather_rows(new, nidx))

    return _sparse_attend(q, select(cache_k, k), select(cache_v, v), valid)


def _short_conv(x, buf, w):
    T = x.shape[1]
    xp = jnp.concatenate([buf.astype(x.dtype), x], axis=1)
    y = sum(xp[:, i:i + T] * w[i] for i in range(CONV_W))
    return jax.nn.silu(y), xp[:, T:]


def _gated_delta_chunked(q, k, v, g, beta, S0):
    B, T, H, _ = q.shape
    n = -(-T // CHUNK)
    pad = n * CHUNK - T

    def blocks(a):
        a = jnp.pad(a, [(0, 0), (0, pad)] + [(0, 0)] * (a.ndim - 2))
        return a.reshape(B, n, CHUNK, H, -1).transpose(1, 0, 3, 2, 4)

    qc, kc, vc = blocks(q), blocks(k), blocks(v)
    gc, bc = blocks(g[..., None])[..., 0], blocks(beta[..., None])[..., 0]
    incl = jnp.tril(jnp.ones((CHUNK, CHUNK), bool))
    strict = jnp.tril(jnp.ones((CHUNK, CHUNK), bool), k=-1)
    eye = jnp.eye(CHUNK, dtype=jnp.float32)

    def step(S, inp):
        qb, kb, vb, gb, bb = inp
        gcum = jnp.cumsum(gb, axis=-1)
        diff = gcum[..., :, None] - gcum[..., None, :]
        decay = jnp.exp(jnp.where(incl, diff, -jnp.inf))
        kk = jnp.einsum('bhid,bhjd->bhij', kb, kb)
        a_mat = bb[..., :, None] * kk * jnp.where(strict, decay, 0.0)
        rhs = bb[..., None] * (vb - jnp.exp(gcum)[..., None] * jnp.einsum('bhcd,bhdv->bhcv', kb, S))
        u = lax.linalg.triangular_solve(eye + a_mat, rhs, left_side=True, lower=True, unit_diagonal=True)
        qk = jnp.einsum('bhid,bhjd->bhij', qb, kb) * decay
        o = jnp.exp(gcum)[..., None] * jnp.einsum('bhcd,bhdv->bhcv', qb, S) + jnp.einsum('bhij,bhjv->bhiv', qk, u)
        glast = gcum[..., -1]
        S_new = jnp.exp(glast)[..., None, None] * S + jnp.einsum(
            'bhcd,bhcv->bhdv', kb * jnp.exp(glast[..., None] - gcum)[..., None], u)
        return S_new, o

    S_fin, o = lax.scan(step, S0, (qc, kc, vc, gc, bc))
    o = o.transpose(1, 0, 3, 2, 4).reshape(B, n * CHUNK, H, -1)[:, :T]
    return o, S_fin


def _dn_branch(xn, S0, conv_buf, w_in, conv_w, A_log, dt_bias, o_gain, w_out):
    B, T, _ = xn.shape
    qkv, z, b, a = _split(xn @ w_in, (CONV_DIM, DN_WIDTH, DN_HEADS, DN_HEADS))
    qkv, new_buf = _short_conv(qkv, conv_buf, conv_w)
    q, k, v = _split(qkv, (DN_HEADS * DN_DK, DN_HEADS * DN_DK, DN_WIDTH))
    q = _l2norm(q.reshape(B, T, DN_HEADS, DN_DK)) * (DN_DK ** -0.5)
    k = _l2norm(k.reshape(B, T, DN_HEADS, DN_DK))
    v = v.reshape(B, T, DN_HEADS, DN_DV).astype(jnp.float32)
    beta = jax.nn.sigmoid(b.astype(jnp.float32))
    g = -jnp.exp(A_log.astype(jnp.float32)) * jax.nn.softplus(a.astype(jnp.float32) + dt_bias.astype(jnp.float32))
    o, S_new = _gated_delta_chunked(q, k, v, g, beta, S0.astype(jnp.float32))
    o = _rms_norm(o, o_gain).astype(xn.dtype).reshape(B, T, DN_WIDTH)
    return _gated_out(o, z, w_out), S_new.astype(S0.dtype), new_buf


def setup_inputs(seed: int = 0) -> dict:
    key = jax.random.key(seed)
    ks = jax.random.split(key, 24)
    n_pages = PAST_LEN // PAGE_SIZE
    n_pool = (5 * DEC_BATCH * n_pages) // 4

    def nrm(k, shape, scale=1.0):
        return scale * jax.random.normal(k, shape, jnp.float32)

    page_table = jax.random.permutation(ks[7], n_pool)[: DEC_BATCH * n_pages].reshape(DEC_BATCH, n_pages).astype(jnp.int32)
    dt = jnp.exp(jax.random.uniform(ks[20], (N_DN_LAYERS, DN_HEADS), jnp.float32, np.log(1e-3), np.log(1e-1)))
    return {
        'x_prompt': nrm(ks[0], (BATCH, SEQ, D_MODEL)),
        'x_sample': nrm(ks[1], (DEC_BATCH, DEC_SEQ, D_MODEL)),
        'cache_k': nrm(ks[2], (n_pool, PAGE_SIZE, N_ATT_LAYERS, N_KV_HEADS, HEAD_DIM)),
        'cache_v': nrm(ks[3], (n_pool, PAGE_SIZE, N_ATT_LAYERS, N_KV_HEADS, HEAD_DIM)),
        'cache_idx_k': nrm(ks[4], (n_pool, PAGE_SIZE, N_ATT_LAYERS, IDX_DIM)),
        'state_dn_S': nrm(ks[5], (DEC_BATCH, N_DN_LAYERS, DN_HEADS, DN_DK, DN_DV), 0.1),
        'state_dn_conv': nrm(ks[6], (DEC_BATCH, N_DN_LAYERS, CONV_W - 1, CONV_DIM)),
        'page_table': page_table,
        'att_norm': 1.0 + nrm(ks[8], (N_ATT_LAYERS, D_MODEL), 0.05),
        'att_w_in': nrm(ks[9], (N_ATT_LAYERS, D_MODEL, ATT_IN), D_MODEL ** -0.5),
        'att_q_gain': 1.0 + nrm(ks[10], (N_ATT_LAYERS, HEAD_DIM), 0.05),
        'att_k_gain': 1.0 + nrm(ks[11], (N_ATT_LAYERS, HEAD_DIM), 0.05),
        'att_ik_gain': 1.0 + nrm(ks[12], (N_ATT_LAYERS, IDX_DIM), 0.05),
        'att_w_out': nrm(ks[13], (N_ATT_LAYERS, ATT_WIDTH, D_MODEL), ATT_WIDTH ** -0.5),
        'dn_norm': 1.0 + nrm(ks[14], (N_DN_LAYERS, D_MODEL), 0.05),
        'dn_w_in': nrm(ks[15], (N_DN_LAYERS, D_MODEL, DN_IN), D_MODEL ** -0.5),
        'dn_conv_w': nrm(ks[16], (N_DN_LAYERS, CONV_W, CONV_DIM), CONV_W ** -0.5),
        'dn_A_log': jnp.log(jax.random.uniform(ks[17], (N_DN_LAYERS, DN_HEADS), jnp.float32, 1.0, 16.0)),
        'dn_dt_bias': dt + jnp.log(-jnp.expm1(-dt)),
        'dn_o_gain': 1.0 + nrm(ks[18], (N_DN_LAYERS, DN_DV), 0.05),
        'dn_w_out': nrm(ks[19], (N_DN_LAYERS, DN_WIDTH, D_MODEL), DN_WIDTH ** -0.5),
    }


def reference(x_prompt, x_sample, cache_k, cache_v, cache_idx_k, state_dn_S, state_dn_conv, page_table,
              att_norm, att_w_in, att_q_gain, att_k_gain, att_ik_gain, att_w_out,
              dn_norm, dn_w_in, dn_conv_w, dn_A_log, dn_dt_bias, dn_o_gain, dn_w_out):
    y_p, y_s = x_prompt, x_sample
    kp, vp, ikp, ks_, vs_, iks = [], [], [], [], [], []
    Sp, cp, Ss, cs = [], [], [], []
    for i in range(DEPTH):
        l = i // N_MIXERS
        if i % N_MIXERS == 0:
            xn = _rms_norm(y_p, att_norm[l])
            q, k, v, iq, ik, iw, gate = _att_project(xn, att_w_in[l], att_q_gain[l], att_k_gain[l], att_ik_gain[l])
            y_p = y_p + _gated_out(_att_prompt(q, k, v, iq, iw, ik), gate, att_w_out[l])
            kp.append(k); vp.append(v); ikp.append(ik)
            xn = _rms_norm(y_s, att_norm[l])
            q, k, v, iq, ik, iw, gate = _att_project(xn, att_w_in[l], att_q_gain[l], att_k_gain[l], att_ik_gain[l])
            o = _att_sample(q, k, v, iq, iw, ik, cache_k, cache_v, cache_idx_k, page_table, l)
            y_s = y_s + _gated_out(o, gate, att_w_out[l])
            ks_.append(k); vs_.append(v); iks.append(ik)
        else:
            xn = _rms_norm(y_p, dn_norm[l])
            B = xn.shape[0]
            S0 = jnp.zeros((B, DN_HEADS, DN_DK, DN_DV), xn.dtype)
            buf0 = jnp.zeros((B, CONV_W - 1, CONV_DIM), xn.dtype)
            out, S_new, buf_new = _dn_branch(xn, S0, buf0, dn_w_in[l], dn_conv_w[l], dn_A_log[l], dn_dt_bias[l], dn_o_gain[l], dn_w_out[l])
            y_p = y_p + out
            Sp.append(S_new); cp.append(buf_new)
            xn = _rms_norm(y_s, dn_norm[l])
            out, S_new, buf_new = _dn_branch(xn, state_dn_S[:, l], state_dn_conv[:, l], dn_w_in[l], dn_conv_w[l], dn_A_log[l], dn_dt_bias[l], dn_o_gain[l], dn_w_out[l])
            y_s = y_s + out
            Ss.append(S_new); cs.append(buf_new)
    k_prompt = jnp.stack(kp, axis=2)
    v_prompt = jnp.stack(vp, axis=2)
    idx_k_prompt = jnp.stack(ikp, axis=2)
    k_sample = jnp.stack(ks_, axis=2)
    v_sample = jnp.stack(vs_, axis=2)
    idx_k_sample = jnp.stack(iks, axis=2)
    dn_S_prompt = jnp.stack(Sp, axis=1)
    dn_conv_prompt = jnp.stack(cp, axis=1)
    dn_S_sample = jnp.stack(Ss, axis=1)
    dn_conv_sample = jnp.stack(cs, axis=1)
    return (y_p, y_s, k_prompt, v_prompt, idx_k_prompt, k_sample, v_sample, idx_k_sample,
            dn_S_prompt, dn_conv_prompt, dn_S_sample, dn_conv_sample)
```

```cpp
#include <hip/hip_runtime.h>
#include <cstdio>
#include <cstdint>

namespace nv {
constexpr int D = 1024, NB = 8, SEQ = 2048, MP = NB * SEQ, DB = 32, DS = 8, MS = DB * DS, M = MP + MS;
constexpr int PAST = 16384, PAGE = 128, NPG = PAST / PAGE;
constexpr int NH = 8, HD = 128, NKV = 2, IH = 8, ID = 64, TOPK = 256;
constexpr int ATT_IN = 3144, OQ = 0, OK_ = 1024, OV = 1280, OIQ = 1536, OIK = 2048, OIW = 2112, OG = 2120;
constexpr int DNH = 8, DK = 128, DV = 128, CONV = 3072, DN_IN = 4112, OZ = 3072, OB = 4096, OA = 4104;
constexpr float EPS = 1e-6f;
constexpr size_t O_Y = 0;
constexpr size_t O_KP = (size_t)M * D;
constexpr size_t O_VP = O_KP + (size_t)MP * 256;
constexpr size_t O_IKP = O_VP + (size_t)MP * 256;
constexpr size_t O_KS = O_IKP + (size_t)MP * 64;
constexpr size_t O_VS = O_KS + (size_t)MS * 256;
constexpr size_t O_IKS = O_VS + (size_t)MS * 256;
constexpr size_t O_SP = O_IKS + (size_t)MS * 64;
constexpr size_t O_CP = O_SP + (size_t)NB * 8 * 128 * 128;
constexpr size_t O_SS = O_CP + (size_t)NB * 3 * CONV;
constexpr size_t O_CS = O_SS + (size_t)DB * 8 * 128 * 128;
constexpr size_t O_END = O_CS + (size_t)DB * 3 * CONV;
static_assert(O_END == 32235520, "output size");

__device__ __forceinline__ float* kout(float* out, int m) { return m < MP ? out + O_KP + (size_t)m * 256 : out + O_KS + (size_t)(m - MP) * 256; }
__device__ __forceinline__ float* vout(float* out, int m) { return m < MP ? out + O_VP + (size_t)m * 256 : out + O_VS + (size_t)(m - MP) * 256; }
__device__ __forceinline__ float* ikout(float* out, int m) { return m < MP ? out + O_IKP + (size_t)m * 64 : out + O_IKS + (size_t)(m - MP) * 64; }

__device__ __forceinline__ float wave_sum(float v) {
#pragma unroll
    for (int o = 32; o > 0; o >>= 1) v += __shfl_xor(v, o);
    return v;
}
__device__ __forceinline__ float silu(float x) { return x / (1.0f + __expf(-x)); }

__device__ __forceinline__ float block_sum256(float v, float* sh) {
    v = wave_sum(v);
    __syncthreads();
    if ((threadIdx.x & 63) == 0) sh[threadIdx.x >> 6] = v;
    __syncthreads();
    return sh[0] + sh[1] + sh[2] + sh[3];
}

__global__ __launch_bounds__(256) void k_rmsnorm(const float* X, const float* gain, float* XN) {
    __shared__ float sh[4];
    const int m = blockIdx.x, t = threadIdx.x;
    const float* x = X + (size_t)m * D;
    float v[4]; float ss = 0.f;
#pragma unroll
    for (int i = 0; i < 4; ++i) { v[i] = x[t + 256 * i]; ss += v[i] * v[i]; }
    ss = block_sum256(ss, sh);
    const float r = rsqrtf(ss * (1.0f / D) + EPS);
#pragma unroll
    for (int i = 0; i < 4; ++i) XN[(size_t)m * D + t + 256 * i] = v[i] * r * gain[t + 256 * i];
}

__global__ __launch_bounds__(256) void k_gemm(const float* A, const float* B, float* C, int Mm, int N, int K, const float* R, int ldr, int ldc) {
    __shared__ float As[16][64 + 4];
    __shared__ float Bs[16][64 + 4];
    const int tx = threadIdx.x & 15, ty = threadIdx.x >> 4;
    const int m0 = blockIdx.y * 64, n0 = blockIdx.x * 64;
    float acc[4][4];
#pragma unroll
    for (int i = 0; i < 4; ++i)
#pragma unroll
        for (int j = 0; j < 4; ++j) acc[i][j] = 0.f;
    for (int k0 = 0; k0 < K; k0 += 16) {
#pragma unroll
        for (int i = 0; i < 4; ++i) {
            const int e = threadIdx.x + 256 * i, r = e >> 4, c = e & 15;
            As[c][r] = (m0 + r < Mm) ? A[(size_t)(m0 + r) * K + k0 + c] : 0.f;
        }
#pragma unroll
        for (int i = 0; i < 4; ++i) {
            const int e = threadIdx.x + 256 * i, r = e >> 6, c = e & 63;
            Bs[r][c] = (n0 + c < N) ? B[(size_t)(k0 + r) * N + n0 + c] : 0.f;
        }
        __syncthreads();
#pragma unroll
        for (int kk = 0; kk < 16; ++kk) {
            float a[4], b[4];
#pragma unroll
            for (int i = 0; i < 4; ++i) a[i] = As[kk][ty * 4 + i];
#pragma unroll
            for (int j = 0; j < 4; ++j) b[j] = Bs[kk][tx * 4 + j];
#pragma unroll
            for (int i = 0; i < 4; ++i)
#pragma unroll
                for (int j = 0; j < 4; ++j) acc[i][j] += a[i] * b[j];
        }
        __syncthreads();
    }
#pragma unroll
    for (int i = 0; i < 4; ++i) {
        const int m = m0 + ty * 4 + i;
        if (m >= Mm) continue;
#pragma unroll
        for (int j = 0; j < 4; ++j) {
            const int n = n0 + tx * 4 + j;
            if (n >= N) continue;
            float v = acc[i][j];
            if (R) v += R[(size_t)m * ldr + n];
            C[(size_t)m * ldc + n] = v;
        }
    }
}

__global__ __launch_bounds__(256) void k_att_post(const float* P, const float* qg, const float* kg, const float* ikg, float* QN, float* IW, float* out) {
    const int m = blockIdx.x, t = threadIdx.x, w = t >> 6, l = t & 63;
    const float* p = P + (size_t)m * ATT_IN;
    for (int h = w; h < NH; h += 4) {
        const float a = p[OQ + h * 128 + l], b = p[OQ + h * 128 + 64 + l];
        const float ss = wave_sum(a * a + b * b);
        const float r = rsqrtf(ss * (1.0f / 128) + EPS) * 0.08838834764831845f;
        QN[(size_t)m * D + h * 128 + l] = a * r * qg[l];
        QN[(size_t)m * D + h * 128 + 64 + l] = b * r * qg[64 + l];
    }
    if (w < 2) {
        const int h = w;
        const float a = p[OK_ + h * 128 + l], b = p[OK_ + h * 128 + 64 + l];
        const float ss = wave_sum(a * a + b * b);
        const float r = rsqrtf(ss * (1.0f / 128) + EPS);
        float* ko = kout(out, m);
        ko[h * 128 + l] = a * r * kg[l];
        ko[h * 128 + 64 + l] = b * r * kg[64 + l];
    } else if (w == 2) {
        const float a = p[OIK + l];
        const float ss = wave_sum(a * a);
        const float r = rsqrtf(ss * (1.0f / 64) + EPS);
        ikout(out, m)[l] = a * r * ikg[l];
    } else {
        if (l < 8) IW[(size_t)m * 8 + l] = p[OIW + l] * (0.35355339059327373f * 0.125f);
    }
    vout(out, m)[t] = p[OV + t];
}

__device__ __forceinline__ unsigned f2key(float f) { f += 0.0f; unsigned u = __float_as_uint(f); return (u & 0x80000000u) ? ~u : (u | 0x80000000u); }

__device__ int topk_select(const unsigned* keys, int n, unsigned* mask, int nwords, int* scratch, int* sel) {
    const int t = threadIdx.x;
    for (int i = t; i < nwords; i += 256) mask[i] = 0u;
    __syncthreads();
    int count;
    if (n <= TOPK) {
        for (int i = t; i < n; i += 256) atomicOr(&mask[i >> 5], 1u << (i & 31));
        count = n;
    } else {
        unsigned v = 0u;
        for (int bit = 31; bit >= 0; --bit) {
            const unsigned cand = v | (1u << bit);
            int c = 0;
            for (int i = t; i < n; i += 256) c += (keys[i] >= cand) ? 1 : 0;
            c += __shfl_xor(c, 32); c += __shfl_xor(c, 16); c += __shfl_xor(c, 8); c += __shfl_xor(c, 4); c += __shfl_xor(c, 2); c += __shfl_xor(c, 1);
            __syncthreads();
            if ((t & 63) == 0) scratch[t >> 6] = c;
            __syncthreads();
            const int tot = scratch[0] + scratch[1] + scratch[2] + scratch[3];
            if (tot >= TOPK) v = cand;
        }
        int c = 0;
        for (int i = t; i < n; i += 256) c += (keys[i] > v) ? 1 : 0;
        c += __shfl_xor(c, 32); c += __shfl_xor(c, 16); c += __shfl_xor(c, 8); c += __shfl_xor(c, 4); c += __shfl_xor(c, 2); c += __shfl_xor(c, 1);
        __syncthreads();
        if ((t & 63) == 0) scratch[t >> 6] = c;
        __syncthreads();
        const int ngt = scratch[0] + scratch[1] + scratch[2] + scratch[3];
        const int need = TOPK - ngt;
        for (int i = t; i < n; i += 256) {
            const unsigned k = keys[i];
            bool s = k > v;
            if (k == v) { int rank = 0; for (int j = 0; j < i; ++j) rank += (keys[j] == v) ? 1 : 0; s = rank < need; }
            if (s) atomicOr(&mask[i >> 5], 1u << (i & 31));
        }
        count = TOPK;
    }
    __syncthreads();
    if (t == 0) { int run = 0; for (int i = 0; i < nwords; ++i) { const int pc = __popc(mask[i]); scratch[300 + i] = run; run += pc; } }
    __syncthreads();
    for (int i = t; i < nwords; i += 256) { unsigned wv = mask[i]; int pos = scratch[300 + i]; while (wv) { const int b = __ffs(wv) - 1; wv &= wv - 1; if (pos < TOPK) sel[pos] = i * 32 + b; ++pos; } }
    __syncthreads();
    return count;
}

__global__ __launch_bounds__(256) void k_index_prompt(const float* P, const float* IW, const float* out, int* SEL, int* CNT) {
    __shared__ float iq[512]; __shared__ float iw[8]; __shared__ unsigned keys[2048]; __shared__ unsigned mask[64]; __shared__ int scratch[900]; __shared__ int sel[256];
    const int m = blockIdx.x, b = m / SEQ, tq = m % SEQ, t = threadIdx.x;
    iq[t] = P[(size_t)m * ATT_IN + OIQ + t]; iq[t + 256] = P[(size_t)m * ATT_IN + OIQ + 256 + t];
    if (t < 8) iw[t] = IW[(size_t)m * 8 + t];
    __syncthreads();
    const int n = tq + 1;
    for (int s = t; s < n; s += 256) {
        const float* ik = out + O_IKP + (size_t)(b * SEQ + s) * 64;
        float sc = 0.f;
        float4 kv[16];
#pragma unroll
        for (int e = 0; e < 16; ++e) kv[e] = ((const float4*)ik)[e];
        for (int h = 0; h < 8; ++h) { float d = 0.f;
#pragma unroll
            for (int e = 0; e < 16; ++e) { d += iq[h * 64 + 4 * e] * kv[e].x; d += iq[h * 64 + 4 * e + 1] * kv[e].y; d += iq[h * 64 + 4 * e + 2] * kv[e].z; d += iq[h * 64 + 4 * e + 3] * kv[e].w; }
            sc += iw[h] * fmaxf(d, 0.f); }
        keys[s] = f2key(sc);
    }
    __syncthreads();
    const int c = topk_select(keys, n, mask, 64, scratch, sel);
    SEL[(size_t)m * 256 + t] = t < c ? sel[t] : 0;
    if (t == 0) CNT[m] = c;
}

__global__ __launch_bounds__(256) void k_index_sample(const float* P, const float* IW, const float* out, const float* cache_ik, const int* page_table, unsigned* KEYS, int* SEL, int* CNT) {
    __shared__ float iq[512]; __shared__ float iw[8]; __shared__ unsigned mask[520]; __shared__ int scratch[900]; __shared__ int sel[256];
    const int r = blockIdx.x, b = r / DS, tq = r % DS, m = MP + r, t = threadIdx.x;
    iq[t] = P[(size_t)m * ATT_IN + OIQ + t]; iq[t + 256] = P[(size_t)m * ATT_IN + OIQ + 256 + t];
    if (t < 8) iw[t] = IW[(size_t)m * 8 + t];
    __syncthreads();
    const int n = PAST + tq + 1;
    unsigned* keys = KEYS + (size_t)r * (PAST + DS);
    for (int s = t; s < n; s += 256) {
        const float* ik;
        if (s < PAST) { const int pg = page_table[b * NPG + s / PAGE]; ik = cache_ik + ((size_t)pg * PAGE + (s % PAGE)) * 64; }
        else ik = out + O_IKS + (size_t)(b * DS + (s - PAST)) * 64;
        float sc = 0.f;
        float4 kv[16];
#pragma unroll
        for (int e = 0; e < 16; ++e) kv[e] = ((const float4*)ik)[e];
        for (int h = 0; h < 8; ++h) { float d = 0.f;
#pragma unroll
            for (int e = 0; e < 16; ++e) { d += iq[h * 64 + 4 * e] * kv[e].x; d += iq[h * 64 + 4 * e + 1] * kv[e].y; d += iq[h * 64 + 4 * e + 2] * kv[e].z; d += iq[h * 64 + 4 * e + 3] * kv[e].w; }
            sc += iw[h] * fmaxf(d, 0.f); }
        keys[s] = f2key(sc);
    }
    __threadfence_block();
    __syncthreads();
    const int c = topk_select(keys, n, mask, (PAST + DS + 31) / 32, scratch, sel);
    SEL[(size_t)m * 256 + t] = t < c ? sel[t] : 0;
    if (t == 0) CNT[m] = c;
}

__global__ __launch_bounds__(256) void k_attend(const float* QN, const float* P, const int* SEL, const int* CNT, const float* out, const float* cache_k, const float* cache_v, const int* page_table, float* AO) {
    __shared__ float q[1024]; __shared__ float lg[8][256]; __shared__ int sel[256]; __shared__ float red[8];
    const int m = blockIdx.x, t = threadIdx.x;
    for (int i = t; i < 1024; i += 256) q[i] = QN[(size_t)m * D + i];
    sel[t] = SEL[(size_t)m * 256 + t];
    const int cnt = CNT[m];
    __syncthreads();
    const bool samp = m >= MP; const int b = samp ? (m - MP) / DS : m / SEQ;
    const float* kr = nullptr; const float* vr = nullptr;
    if (t < cnt) {
        const int idx = sel[t];
        if (!samp) { kr = out + O_KP + (size_t)(b * SEQ + idx) * 256; vr = out + O_VP + (size_t)(b * SEQ + idx) * 256; }
        else if (idx < PAST) { const int pg = page_table[b * NPG + idx / PAGE]; const size_t ro = ((size_t)pg * PAGE + (idx % PAGE)) * 256; kr = cache_k + ro; vr = cache_v + ro; }
        else { kr = out + O_KS + (size_t)(b * DS + (idx - PAST)) * 256; vr = out + O_VS + (size_t)(b * DS + (idx - PAST)) * 256; }
        for (int g2 = 0; g2 < 2; ++g2) { float d0 = 0.f, d1 = 0.f, d2 = 0.f, d3 = 0.f; const float4* kk = (const float4*)(kr + g2 * 128); const float* qq = q + g2 * 512;
            for (int e = 0; e < 32; ++e) { const float4 x = kk[e];
                d0 += qq[4 * e] * x.x + qq[4 * e + 1] * x.y + qq[4 * e + 2] * x.z + qq[4 * e + 3] * x.w;
                d1 += qq[128 + 4 * e] * x.x + qq[128 + 4 * e + 1] * x.y + qq[128 + 4 * e + 2] * x.z + qq[128 + 4 * e + 3] * x.w;
                d2 += qq[256 + 4 * e] * x.x + qq[256 + 4 * e + 1] * x.y + qq[256 + 4 * e + 2] * x.z + qq[256 + 4 * e + 3] * x.w;
                d3 += qq[384 + 4 * e] * x.x + qq[384 + 4 * e + 1] * x.y + qq[384 + 4 * e + 2] * x.z + qq[384 + 4 * e + 3] * x.w; }
            lg[g2 * 4][t] = d0; lg[g2 * 4 + 1][t] = d1; lg[g2 * 4 + 2][t] = d2; lg[g2 * 4 + 3][t] = d3; }
    } else { for (int h = 0; h < 8; ++h) lg[h][t] = -INFINITY; }
    __syncthreads();
    const int w = t >> 6, l = t & 63;
    for (int h = w; h < 8; h += 4) {
        float mx = -INFINITY;
        for (int j = l; j < 256; j += 64) mx = fmaxf(mx, lg[h][j]);
#pragma unroll
        for (int o = 32; o > 0; o >>= 1) mx = fmaxf(mx, __shfl_xor(mx, o));
        float s = 0.f;
        for (int j = l; j < 256; j += 64) { const float e = __expf(lg[h][j] - mx); lg[h][j] = e; s += e; }
        s = wave_sum(s);
        if (l == 0) red[h] = 1.0f / s;
    }
    __syncthreads();
    const int h = t >> 5, d0 = (t & 31) * 4, g = h >> 2;
    float o0 = 0.f, o1 = 0.f, o2 = 0.f, o3 = 0.f;
    for (int j = 0; j < cnt; ++j) {
        const int idx = sel[j]; const float* vv;
        if (!samp) vv = out + O_VP + (size_t)(b * SEQ + idx) * 256;
        else if (idx < PAST) { const int pg = page_table[b * NPG + idx / PAGE]; vv = cache_v + ((size_t)pg * PAGE + (idx % PAGE)) * 256; }
        else vv = out + O_VS + (size_t)(b * DS + (idx - PAST)) * 256;
        const float p = lg[h][j];
        const float4 x = *(const float4*)(vv + g * 128 + d0);
        o0 += p * x.x; o1 += p * x.y; o2 += p * x.z; o3 += p * x.w;
    }
    const float rinv = red[h];
    const float* gate = P + (size_t)m * ATT_IN + OG + h * 128 + d0;
    float* ao = AO + (size_t)m * D + h * 128 + d0;
    ao[0] = o0 * rinv * silu(gate[0]); ao[1] = o1 * rinv * silu(gate[1]); ao[2] = o2 * rinv * silu(gate[2]); ao[3] = o3 * rinv * silu(gate[3]);
}

__global__ __launch_bounds__(256) void k_dn_post(const float* P2, const float* conv_w, const float* conv_state, const float* A_log, const float* dt_bias, float* QC, float* KC, float* VC, float* BETA, float* G, float* out) {
    __shared__ float y[CONV];
    const int m = blockIdx.x, t = threadIdx.x;
    const bool samp = m >= MP; const int b = samp ? (m - MP) / DS : m / SEQ; const int tt = samp ? (m - MP) % DS : m % SEQ; const int T = samp ? DS : SEQ;
    for (int c = t; c < CONV; c += 256) {
        float acc = 0.f;
#pragma unroll
        for (int i = 0; i < 4; ++i) {
            const int j = tt + i;
            float xv;
            if (j < 3) xv = samp ? conv_state[((size_t)b * 3 + j) * CONV + c] : 0.f;
            else xv = P2[(size_t)(m - tt + (j - 3)) * DN_IN + c];
            acc += conv_w[i * CONV + c] * xv;
        }
        y[c] = silu(acc);
        if (tt >= T - 3) {
            const int j = tt - (T - 3);
            float* dst = samp ? out + O_CS + ((size_t)b * 3 + j) * CONV : out + O_CP + ((size_t)b * 3 + j) * CONV;
            dst[c] = P2[(size_t)m * DN_IN + c];
        }
    }
    __syncthreads();
    const int w = t >> 6, l = t & 63;
    for (int hh = w; hh < 16; hh += 4) {
        const float a = y[hh * 128 + l], bb = y[hh * 128 + 64 + l];
        const float ss = wave_sum(a * a + bb * bb);
        float r = rsqrtf(ss + EPS);
        if (hh < 8) { r *= 0.08838834764831845f; QC[(size_t)m * D + hh * 128 + l] = a * r; QC[(size_t)m * D + hh * 128 + 64 + l] = bb * r; }
        else { KC[(size_t)m * D + (hh - 8) * 128 + l] = a * r; KC[(size_t)m * D + (hh - 8) * 128 + 64 + l] = bb * r; }
    }
    for (int c = t; c < 1024; c += 256) VC[(size_t)m * D + c] = y[2048 + c];
    if (t < 8) {
        const float bv = P2[(size_t)m * DN_IN + OB + t], av = P2[(size_t)m * DN_IN + OA + t];
        BETA[(size_t)m * 8 + t] = 1.0f / (1.0f + expf(-bv));
        const float x = av + dt_bias[t];
        const float sp = x > 20.f ? x : log1pf(expf(x));
        G[(size_t)m * 8 + t] = -expf(A_log[t]) * sp;
    }
}

__global__ __launch_bounds__(128) void k_dn_scan(const float* QC, const float* KC, const float* VC, const float* BETA, const float* G, const float* S0, float* ORAW, float* out) {
    __shared__ float qs[128]; __shared__ float ks[128];
    const int seq = blockIdx.x >> 3, h = blockIdx.x & 7, v = threadIdx.x;
    const bool samp = seq >= NB; const int b = samp ? seq - NB : seq; const int T = samp ? DS : SEQ; const int m0 = samp ? MP + b * DS : b * SEQ;
    float S[128];
    if (samp) {
#pragma unroll
        for (int d = 0; d < 128; ++d) S[d] = S0[(((size_t)b * 8 + h) * 128 + d) * 128 + v];
    } else {
#pragma unroll
        for (int d = 0; d < 128; ++d) S[d] = 0.f;
    }
    for (int tt = 0; tt < T; ++tt) {
        const int m = m0 + tt;
        __syncthreads();
        qs[v] = QC[(size_t)m * D + h * 128 + v]; ks[v] = KC[(size_t)m * D + h * 128 + v];
        __syncthreads();
        const float vv = VC[(size_t)m * D + h * 128 + v], beta = BETA[(size_t)m * 8 + h], alpha = expf(G[(size_t)m * 8 + h]);
        float kS = 0.f;
#pragma unroll
        for (int d = 0; d < 128; ++d) kS += ks[d] * S[d];
        const float u = beta * (vv - alpha * kS);
        float o = 0.f;
#pragma unroll
        for (int d = 0; d < 128; ++d) { S[d] = alpha * S[d] + ks[d] * u; o += qs[d] * S[d]; }
        ORAW[(size_t)m * D + h * 128 + v] = o;
    }
    float* so = samp ? out + O_SS + ((size_t)b * 8 + h) * 128 * 128 : out + O_SP + ((size_t)b * 8 + h) * 128 * 128;
#pragma unroll
    for (int d = 0; d < 128; ++d) so[(size_t)d * 128 + v] = S[d];
}

__global__ __launch_bounds__(256) void k_dn_gate(const float* ORAW, const float* P2, const float* og, float* AO2) {
    const int m = blockIdx.x, t = threadIdx.x, w = t >> 6, l = t & 63;
    for (int h = w; h < 8; h += 4) {
        const float a = ORAW[(size_t)m * D + h * 128 + l], b = ORAW[(size_t)m * D + h * 128 + 64 + l];
        const float ss = wave_sum(a * a + b * b);
        const float r = rsqrtf(ss * (1.0f / 128) + EPS);
        const float z0 = P2[(size_t)m * DN_IN + OZ + h * 128 + l], z1 = P2[(size_t)m * DN_IN + OZ + h * 128 + 64 + l];
        AO2[(size_t)m * D + h * 128 + l] = a * r * og[l] * silu(z0);
        AO2[(size_t)m * D + h * 128 + 64 + l] = b * r * og[64 + l] * silu(z1);
    }
}
}

extern "C" void kernel_launch(void* const* d_in, const int* in_sizes, int n_in, void* d_out, int out_size, void* d_ws, size_t ws_size, hipStream_t stream) {
    using namespace nv;
    const float* x_prompt = (const float*)d_in[0]; const float* x_sample = (const float*)d_in[1];
    const float* cache_k = (const float*)d_in[2]; const float* cache_v = (const float*)d_in[3]; const float* cache_ik = (const float*)d_in[4];
    const float* state_S = (const float*)d_in[5]; const float* state_conv = (const float*)d_in[6]; const int* page_table = (const int*)d_in[7];
    const float* att_norm = (const float*)d_in[8]; const float* att_w_in = (const float*)d_in[9]; const float* qg = (const float*)d_in[10]; const float* kg = (const float*)d_in[11];
    const float* ikg = (const float*)d_in[12]; const float* att_w_out = (const float*)d_in[13]; const float* dn_norm = (const float*)d_in[14]; const float* dn_w_in = (const float*)d_in[15];
    const float* conv_w = (const float*)d_in[16]; const float* A_log = (const float*)d_in[17]; const float* dt_bias = (const float*)d_in[18]; const float* og = (const float*)d_in[19]; const float* dn_w_out = (const float*)d_in[20];
    float* out = (float*)d_out;
    if (out_size != (int)O_END) fprintf(stderr, "kernel_launch: out_size %d != %zu\n", out_size, (size_t)O_END);
    float* ws = (float*)d_ws; size_t off = 0;
    auto take = [&](size_t n) { float* p = ws + off; off += (n + 63) & ~(size_t)63; return p; };
    float* X = take((size_t)M * D); float* XN = take((size_t)M * D); float* P = take((size_t)M * DN_IN); float* QN = take((size_t)M * D); float* IW = take((size_t)M * 8);
    int* SEL = (int*)take((size_t)M * 256); int* CNT = (int*)take(M); float* AO = take((size_t)M * D); float* Y1 = take((size_t)M * D);
    float* QC = take((size_t)M * D); float* KC = take((size_t)M * D); float* VC = take((size_t)M * D); float* BETA = take((size_t)M * 8); float* G = take((size_t)M * 8); float* ORAW = take((size_t)M * D);
    unsigned* KEYS = (unsigned*)take((size_t)MS * (PAST + DS));
    if (off * 4 > ws_size) { fprintf(stderr, "ws too small\n"); return; }
    hipMemcpyAsync(X, x_prompt, (size_t)MP * D * 4, hipMemcpyDeviceToDevice, stream);
    hipMemcpyAsync(X + (size_t)MP * D, x_sample, (size_t)MS * D * 4, hipMemcpyDeviceToDevice, stream);
    k_rmsnorm<<<M, 256, 0, stream>>>(X, att_norm, XN);
    k_gemm<<<dim3((ATT_IN + 63) / 64, M / 64), 256, 0, stream>>>(XN, att_w_in, P, M, ATT_IN, D, nullptr, 0, ATT_IN);
    k_att_post<<<M, 256, 0, stream>>>(P, qg, kg, ikg, QN, IW, out);
    k_index_prompt<<<MP, 256, 0, stream>>>(P, IW, out, SEL, CNT);
    k_index_sample<<<MS, 256, 0, stream>>>(P, IW, out, cache_ik, page_table, KEYS, SEL, CNT);
    k_attend<<<M, 256, 0, stream>>>(QN, P, SEL, CNT, out, cache_k, cache_v, page_table, AO);
    k_gemm<<<dim3(D / 64, M / 64), 256, 0, stream>>>(AO, att_w_out, Y1, M, D, D, X, D, D);
    k_rmsnorm<<<M, 256, 0, stream>>>(Y1, dn_norm, XN);
    k_gemm<<<dim3((DN_IN + 63) / 64, M / 64), 256, 0, stream>>>(XN, dn_w_in, P, M, DN_IN, D, nullptr, 0, DN_IN);
    k_dn_post<<<M, 256, 0, stream>>>(P, conv_w, state_conv, A_log, dt_bias, QC, KC, VC, BETA, G, out);
    k_dn_scan<<<(NB + DB) * 8, 128, 0, stream>>>(QC, KC, VC, BETA, G, state_S, ORAW, out);
    k_dn_gate<<<M, 256, 0, stream>>>(ORAW, P, og, AO);
    k_gemm<<<dim3(D / 64, M / 64), 256, 0, stream>>>(AO, dn_w_out, out + O_Y, M, D, D, Y1, D, D);
}
```

```cpp
#include <hip/hip_runtime.h>
#include <cstdio>
#include <cstdint>

namespace nv {
#define XB_TMO      128
#define XB_XCNT(j)  (256  + 64 * (j))
#define XB_XSUB(j)  (1280 + 64 * (j))
#define XB_XGEN(j)  (2304 + 64 * (j))
#define XB_TOP      3328
#define XB_TOPGEN   3392
#define XCD_BAR_WORDS 3456
#define XB_SPIN_CAP (1u << 18)
#define LAS __attribute__((address_space(3)))

__device__ __forceinline__ unsigned xb_ld(unsigned* p)              { return __hip_atomic_load(p, __ATOMIC_RELAXED, __HIP_MEMORY_SCOPE_AGENT); }
__device__ __forceinline__ unsigned xb_add(unsigned* p, unsigned v) { return __hip_atomic_fetch_add(p, v, __ATOMIC_RELAXED, __HIP_MEMORY_SCOPE_AGENT); }
__device__ __forceinline__ unsigned xb_xcc_id() { return (unsigned)__builtin_amdgcn_s_getreg((3 << 11) | 20) & 0xFu; }
#define XB_SPIN(cond, bar) do { unsigned _sp = 0; while (cond) { __builtin_amdgcn_s_sleep(1); \
    if ((++_sp & 255u) == 0u) { if (xb_ld(&(bar)[XB_TMO])) break; if (_sp > XB_SPIN_CAP) { atomicAdd(&(bar)[XB_TMO], 1u); break; } } } } while (0)

struct XcdBarrier {
    unsigned* bar; unsigned x;
    volatile LAS unsigned* st;
};

__device__ __forceinline__ XcdBarrier xcd_barrier_post(unsigned* bar, volatile LAS unsigned* st) {
    XcdBarrier b; b.bar = bar; b.x = xb_xcc_id(); b.st = st;
    if (threadIdx.x == 0) (void)xb_add(&bar[XB_XCNT(b.x)], 1u);
    return b;
}
__device__ __forceinline__ void xcd_barrier_complete(unsigned* bar, unsigned x, unsigned& nloc, unsigned& nx) {
    const unsigned G = gridDim.x * gridDim.y * gridDim.z;
    unsigned sum, cnt, mine, sp = 0u;
    for (;;) {
        sum = 0u; cnt = 0u; mine = 0u;
#pragma unroll
        for (unsigned j = 0; j < 16; ++j) { const unsigned c = xb_ld(&bar[XB_XCNT(j)]); sum += c; cnt += (c > 0u) ? 1u : 0u; mine = (j == x) ? c : mine; }
        if (sum == G) break;
        __builtin_amdgcn_s_sleep(1);
        if ((++sp & 255u) == 0u) { if (xb_ld(&bar[XB_TMO])) break; if (sp > XB_SPIN_CAP) { atomicAdd(&bar[XB_TMO], 1u); break; } }
    }
    nloc = mine > 0u ? mine : 1u; nx = cnt > 0u ? cnt : 1u;
}

__device__ __forceinline__ void xcd_barrier(const XcdBarrier& b) {
    asm volatile("s_waitcnt vmcnt(0)" ::: "memory");
    __syncthreads();
    if (threadIdx.x == 0) {
        unsigned* bar = b.bar;
        __builtin_amdgcn_s_waitcnt(0);
        unsigned nloc = b.st[0], nx = b.st[1];
        if (nloc == 0u) { xcd_barrier_complete(bar, b.x, nloc, nx); b.st[0] = nloc; b.st[1] = nx; }
        const unsigned old = xb_add(&bar[XB_XSUB(b.x)], 1u);
        const unsigned gen = old / nloc;
        if (old + 1u == (gen + 1u) * nloc) {
            __builtin_amdgcn_fence(__ATOMIC_RELEASE, "agent");
            asm volatile("s_waitcnt vmcnt(0)" ::: "memory");
            const unsigned og = xb_add(&bar[XB_TOP], 1u);
            const unsigned tg = og / nx;
            if (og + 1u == (tg + 1u) * nx) xb_add(&bar[XB_TOPGEN], 1u);
            else XB_SPIN(xb_ld(&bar[XB_TOPGEN]) == tg, bar);
            __builtin_amdgcn_fence(__ATOMIC_ACQUIRE, "agent");
            xb_add(&bar[XB_XGEN(b.x)], 1u);
            asm volatile("s_waitcnt vmcnt(0)" ::: "memory");
        } else {
            XB_SPIN(xb_ld(&bar[XB_XGEN(b.x)]) == gen, bar);
            __builtin_amdgcn_fence(__ATOMIC_ACQUIRE, "agent");
            asm volatile("s_waitcnt vmcnt(0)" ::: "memory");
        }
    }
    __syncthreads();
}


constexpr int D = 1024, NB = 8, SEQ = 2048, MP = NB * SEQ, DB = 32, DS = 8, MS = DB * DS, M = MP + MS;
constexpr int PAST = 16384, PAGE = 128, NPG = PAST / PAGE;
constexpr int NH = 8, HD = 128, NKV = 2, IH = 8, ID = 64, TOPK = 256;
constexpr int ATT_IN = 3144, OQ = 0, OK_ = 1024, OV = 1280, OIQ = 1536, OIK = 2048, OIW = 2112, OG = 2120;
constexpr int DNH = 8, DK = 128, DV = 128, CONV = 3072, DN_IN = 4112, OZ = 3072, OB = 4096, OA = 4104;
constexpr float EPS = 1e-6f;
constexpr size_t O_Y = 0;
constexpr size_t O_KP = (size_t)M * D;
constexpr size_t O_VP = O_KP + (size_t)MP * 256;
constexpr size_t O_IKP = O_VP + (size_t)MP * 256;
constexpr size_t O_KS = O_IKP + (size_t)MP * 64;
constexpr size_t O_VS = O_KS + (size_t)MS * 256;
constexpr size_t O_IKS = O_VS + (size_t)MS * 256;
constexpr size_t O_SP = O_IKS + (size_t)MS * 64;
constexpr size_t O_CP = O_SP + (size_t)NB * 8 * 128 * 128;
constexpr size_t O_SS = O_CP + (size_t)NB * 3 * CONV;
constexpr size_t O_CS = O_SS + (size_t)DB * 8 * 128 * 128;
constexpr size_t O_END = O_CS + (size_t)DB * 3 * CONV;
static_assert(O_END == 32235520, "output size");

__device__ __forceinline__ float* kout(float* out, int m) { return m < MP ? out + O_KP + (size_t)m * 256 : out + O_KS + (size_t)(m - MP) * 256; }
__device__ __forceinline__ float* vout(float* out, int m) { return m < MP ? out + O_VP + (size_t)m * 256 : out + O_VS + (size_t)(m - MP) * 256; }
__device__ __forceinline__ float* ikout(float* out, int m) { return m < MP ? out + O_IKP + (size_t)m * 64 : out + O_IKS + (size_t)(m - MP) * 64; }

__device__ __forceinline__ float wave_sum(float v) {
#pragma unroll
    for (int o = 32; o > 0; o >>= 1) v += __shfl_xor(v, o);
    return v;
}
__device__ __forceinline__ float silu(float x) { return x / (1.0f + __expf(-x)); }

__device__ __forceinline__ float block_sum256(float v, float* sh) {
    v = wave_sum(v);
    __syncthreads();
    if ((threadIdx.x & 63) == 0) sh[threadIdx.x >> 6] = v;
    __syncthreads();
    return sh[0] + sh[1] + sh[2] + sh[3];
}

__device__ __forceinline__ void p_rmsnorm(const int vb, const float* X, const float* gain, float* XN) {
    __shared__ float sh[4];
    const int m = vb, t = threadIdx.x;
    const float* x = X + (size_t)m * D;
    float v[4]; float ss = 0.f;
#pragma unroll
    for (int i = 0; i < 4; ++i) { v[i] = x[t + 256 * i]; ss += v[i] * v[i]; }
    ss = block_sum256(ss, sh);
    const float r = rsqrtf(ss * (1.0f / D) + EPS);
#pragma unroll
    for (int i = 0; i < 4; ++i) XN[(size_t)m * D + t + 256 * i] = v[i] * r * gain[t + 256 * i];
}

__device__ __forceinline__ void p_gemm(const int vb, const int nbx, const float* A, const float* B, float* C, int Mm, int N, int K, const float* R, int ldr, int ldc) {
    __shared__ float As[16][64 + 4];
    __shared__ float Bs[16][64 + 4];
    const int tx = threadIdx.x & 15, ty = threadIdx.x >> 4;
    const int m0 = (vb / nbx) * 64, n0 = (vb % nbx) * 64;
    float acc[4][4];
#pragma unroll
    for (int i = 0; i < 4; ++i)
#pragma unroll
        for (int j = 0; j < 4; ++j) acc[i][j] = 0.f;
    for (int k0 = 0; k0 < K; k0 += 16) {
#pragma unroll
        for (int i = 0; i < 4; ++i) {
            const int e = threadIdx.x + 256 * i, r = e >> 4, c = e & 15;
            As[c][r] = (m0 + r < Mm) ? A[(size_t)(m0 + r) * K + k0 + c] : 0.f;
        }
#pragma unroll
        for (int i = 0; i < 4; ++i) {
            const int e = threadIdx.x + 256 * i, r = e >> 6, c = e & 63;
            Bs[r][c] = (n0 + c < N) ? B[(size_t)(k0 + r) * N + n0 + c] : 0.f;
        }
        __syncthreads();
#pragma unroll
        for (int kk = 0; kk < 16; ++kk) {
            float a[4], b[4];
#pragma unroll
            for (int i = 0; i < 4; ++i) a[i] = As[kk][ty * 4 + i];
#pragma unroll
            for (int j = 0; j < 4; ++j) b[j] = Bs[kk][tx * 4 + j];
#pragma unroll
            for (int i = 0; i < 4; ++i)
#pragma unroll
                for (int j = 0; j < 4; ++j) acc[i][j] += a[i] * b[j];
        }
        __syncthreads();
    }
#pragma unroll
    for (int i = 0; i < 4; ++i) {
        const int m = m0 + ty * 4 + i;
        if (m >= Mm) continue;
#pragma unroll
        for (int j = 0; j < 4; ++j) {
            const int n = n0 + tx * 4 + j;
            if (n >= N) continue;
            float v = acc[i][j];
            if (R) v += R[(size_t)m * ldr + n];
            C[(size_t)m * ldc + n] = v;
        }
    }
}

__device__ __forceinline__ void p_att_post(const int vb, const float* P, const float* qg, const float* kg, const float* ikg, float* QN, float* IW, float* out) {
    const int m = vb, t = threadIdx.x, w = t >> 6, l = t & 63;
    const float* p = P + (size_t)m * ATT_IN;
    for (int h = w; h < NH; h += 4) {
        const float a = p[OQ + h * 128 + l], b = p[OQ + h * 128 + 64 + l];
        const float ss = wave_sum(a * a + b * b);
        const float r = rsqrtf(ss * (1.0f / 128) + EPS) * 0.08838834764831845f;
        QN[(size_t)m * D + h * 128 + l] = a * r * qg[l];
        QN[(size_t)m * D + h * 128 + 64 + l] = b * r * qg[64 + l];
    }
    if (w < 2) {
        const int h = w;
        const float a = p[OK_ + h * 128 + l], b = p[OK_ + h * 128 + 64 + l];
        const float ss = wave_sum(a * a + b * b);
        const float r = rsqrtf(ss * (1.0f / 128) + EPS);
        float* ko = kout(out, m);
        ko[h * 128 + l] = a * r * kg[l];
        ko[h * 128 + 64 + l] = b * r * kg[64 + l];
    } else if (w == 2) {
        const float a = p[OIK + l];
        const float ss = wave_sum(a * a);
        const float r = rsqrtf(ss * (1.0f / 64) + EPS);
        ikout(out, m)[l] = a * r * ikg[l];
    } else {
        if (l < 8) IW[(size_t)m * 8 + l] = p[OIW + l] * (0.35355339059327373f * 0.125f);
    }
    vout(out, m)[t] = p[OV + t];
}

__device__ __forceinline__ unsigned f2key(float f) { f += 0.0f; unsigned u = __float_as_uint(f); return (u & 0x80000000u) ? ~u : (u | 0x80000000u); }

__device__ int topk_select(const unsigned* keys, int n, unsigned* mask, int nwords, int* scratch, int* sel) {
    const int t = threadIdx.x;
    for (int i = t; i < nwords; i += 256) mask[i] = 0u;
    __syncthreads();
    int count;
    if (n <= TOPK) {
        for (int i = t; i < n; i += 256) atomicOr(&mask[i >> 5], 1u << (i & 31));
        count = n;
    } else {
        unsigned v = 0u;
        for (int bit = 31; bit >= 0; --bit) {
            const unsigned cand = v | (1u << bit);
            int c = 0;
            for (int i = t; i < n; i += 256) c += (keys[i] >= cand) ? 1 : 0;
            c += __shfl_xor(c, 32); c += __shfl_xor(c, 16); c += __shfl_xor(c, 8); c += __shfl_xor(c, 4); c += __shfl_xor(c, 2); c += __shfl_xor(c, 1);
            __syncthreads();
            if ((t & 63) == 0) scratch[t >> 6] = c;
            __syncthreads();
            const int tot = scratch[0] + scratch[1] + scratch[2] + scratch[3];
            if (tot >= TOPK) v = cand;
        }
        int c = 0;
        for (int i = t; i < n; i += 256) c += (keys[i] > v) ? 1 : 0;
        c += __shfl_xor(c, 32); c += __shfl_xor(c, 16); c += __shfl_xor(c, 8); c += __shfl_xor(c, 4); c += __shfl_xor(c, 2); c += __shfl_xor(c, 1);
        __syncthreads();
        if ((t & 63) == 0) scratch[t >> 6] = c;
        __syncthreads();
        const int ngt = scratch[0] + scratch[1] + scratch[2] + scratch[3];
        const int need = TOPK - ngt;
        for (int i = t; i < n; i += 256) {
            const unsigned k = keys[i];
            bool s = k > v;
            if (k == v) { int rank = 0; for (int j = 0; j < i; ++j) rank += (keys[j] == v) ? 1 : 0; s = rank < need; }
            if (s) atomicOr(&mask[i >> 5], 1u << (i & 31));
        }
        count = TOPK;
    }
    __syncthreads();
    if (t == 0) { int run = 0; for (int i = 0; i < nwords; ++i) { const int pc = __popc(mask[i]); scratch[300 + i] = run; run += pc; } }
    __syncthreads();
    for (int i = t; i < nwords; i += 256) { unsigned wv = mask[i]; int pos = scratch[300 + i]; while (wv) { const int b = __ffs(wv) - 1; wv &= wv - 1; if (pos < TOPK) sel[pos] = i * 32 + b; ++pos; } }
    __syncthreads();
    return count;
}

__device__ __forceinline__ void p_index_prompt(const int vb, const float* P, const float* IW, const float* out, int* SEL, int* CNT) {
    __shared__ float iq[512]; __shared__ float iw[8]; __shared__ unsigned keys[2048]; __shared__ unsigned mask[64]; __shared__ int scratch[900]; __shared__ int sel[256];
    const int m = vb, b = m / SEQ, tq = m % SEQ, t = threadIdx.x;
    iq[t] = P[(size_t)m * ATT_IN + OIQ + t]; iq[t + 256] = P[(size_t)m * ATT_IN + OIQ + 256 + t];
    if (t < 8) iw[t] = IW[(size_t)m * 8 + t];
    __syncthreads();
    const int n = tq + 1;
    for (int s = t; s < n; s += 256) {
        const float* ik = out + O_IKP + (size_t)(b * SEQ + s) * 64;
        float sc = 0.f;
        float dd[8];
#pragma unroll
        for (int h = 0; h < 8; ++h) dd[h] = 0.f;
#pragma unroll 2
        for (int e = 0; e < 16; ++e) { const float4 kv = ((const float4*)ik)[e];
#pragma unroll
            for (int h = 0; h < 8; ++h) dd[h] += iq[h * 64 + 4 * e] * kv.x + iq[h * 64 + 4 * e + 1] * kv.y + iq[h * 64 + 4 * e + 2] * kv.z + iq[h * 64 + 4 * e + 3] * kv.w; }
#pragma unroll
        for (int h = 0; h < 8; ++h) sc += iw[h] * fmaxf(dd[h], 0.f);
        keys[s] = f2key(sc);
    }
    __syncthreads();
    const int c = topk_select(keys, n, mask, 64, scratch, sel);
    SEL[(size_t)m * 256 + t] = t < c ? sel[t] : 0;
    if (t == 0) CNT[m] = c;
}

__device__ __forceinline__ void p_index_sample(const int vb, const float* P, const float* IW, const float* out, const float* cache_ik, const int* page_table, unsigned* KEYS, int* SEL, int* CNT) {
    __shared__ float iq[512]; __shared__ float iw[8]; __shared__ unsigned mask[520]; __shared__ int scratch[900]; __shared__ int sel[256];
    const int r = vb, b = r / DS, tq = r % DS, m = MP + r, t = threadIdx.x;
    iq[t] = P[(size_t)m * ATT_IN + OIQ + t]; iq[t + 256] = P[(size_t)m * ATT_IN + OIQ + 256 + t];
    if (t < 8) iw[t] = IW[(size_t)m * 8 + t];
    __syncthreads();
    const int n = PAST + tq + 1;
    unsigned* keys = KEYS + (size_t)r * (PAST + DS);
    for (int s = t; s < n; s += 256) {
        const float* ik;
        if (s < PAST) { const int pg = page_table[b * NPG + s / PAGE]; ik = cache_ik + ((size_t)pg * PAGE + (s % PAGE)) * 64; }
        else ik = out + O_IKS + (size_t)(b * DS + (s - PAST)) * 64;
        float sc = 0.f;
        float dd[8];
#pragma unroll
        for (int h = 0; h < 8; ++h) dd[h] = 0.f;
#pragma unroll 2
        for (int e = 0; e < 16; ++e) { const float4 kv = ((const float4*)ik)[e];
#pragma unroll
            for (int h = 0; h < 8; ++h) dd[h] += iq[h * 64 + 4 * e] * kv.x + iq[h * 64 + 4 * e + 1] * kv.y + iq[h * 64 + 4 * e + 2] * kv.z + iq[h * 64 + 4 * e + 3] * kv.w; }
#pragma unroll
        for (int h = 0; h < 8; ++h) sc += iw[h] * fmaxf(dd[h], 0.f);
        keys[s] = f2key(sc);
    }
    __threadfence_block();
    __syncthreads();
    const int c = topk_select(keys, n, mask, (PAST + DS + 31) / 32, scratch, sel);
    SEL[(size_t)m * 256 + t] = t < c ? sel[t] : 0;
    if (t == 0) CNT[m] = c;
}

__device__ __forceinline__ void p_attend(const int vb, const float* QN, const float* P, const int* SEL, const int* CNT, const float* out, const float* cache_k, const float* cache_v, const int* page_table, float* AO) {
    __shared__ float q[1024]; __shared__ float lg[8][256]; __shared__ int sel[256]; __shared__ float red[8];
    const int m = vb, t = threadIdx.x;
    for (int i = t; i < 1024; i += 256) q[i] = QN[(size_t)m * D + i];
    sel[t] = SEL[(size_t)m * 256 + t];
    const int cnt = CNT[m];
    __syncthreads();
    const bool samp = m >= MP; const int b = samp ? (m - MP) / DS : m / SEQ;
    const float* kr = nullptr; const float* vr = nullptr;
    if (t < cnt) {
        const int idx = sel[t];
        if (!samp) { kr = out + O_KP + (size_t)(b * SEQ + idx) * 256; vr = out + O_VP + (size_t)(b * SEQ + idx) * 256; }
        else if (idx < PAST) { const int pg = page_table[b * NPG + idx / PAGE]; const size_t ro = ((size_t)pg * PAGE + (idx % PAGE)) * 256; kr = cache_k + ro; vr = cache_v + ro; }
        else { kr = out + O_KS + (size_t)(b * DS + (idx - PAST)) * 256; vr = out + O_VS + (size_t)(b * DS + (idx - PAST)) * 256; }
        for (int g2 = 0; g2 < 2; ++g2) { float d0 = 0.f, d1 = 0.f, d2 = 0.f, d3 = 0.f; const float4* kk = (const float4*)(kr + g2 * 128); const float* qq = q + g2 * 512;
            for (int e = 0; e < 32; ++e) { const float4 x = kk[e];
                d0 += qq[4 * e] * x.x + qq[4 * e + 1] * x.y + qq[4 * e + 2] * x.z + qq[4 * e + 3] * x.w;
                d1 += qq[128 + 4 * e] * x.x + qq[128 + 4 * e + 1] * x.y + qq[128 + 4 * e + 2] * x.z + qq[128 + 4 * e + 3] * x.w;
                d2 += qq[256 + 4 * e] * x.x + qq[256 + 4 * e + 1] * x.y + qq[256 + 4 * e + 2] * x.z + qq[256 + 4 * e + 3] * x.w;
                d3 += qq[384 + 4 * e] * x.x + qq[384 + 4 * e + 1] * x.y + qq[384 + 4 * e + 2] * x.z + qq[384 + 4 * e + 3] * x.w; }
            lg[g2 * 4][t] = d0; lg[g2 * 4 + 1][t] = d1; lg[g2 * 4 + 2][t] = d2; lg[g2 * 4 + 3][t] = d3; }
    } else { for (int h = 0; h < 8; ++h) lg[h][t] = -INFINITY; }
    __syncthreads();
    const int w = t >> 6, l = t & 63;
    for (int h = w; h < 8; h += 4) {
        float mx = -INFINITY;
        for (int j = l; j < 256; j += 64) mx = fmaxf(mx, lg[h][j]);
#pragma unroll
        for (int o = 32; o > 0; o >>= 1) mx = fmaxf(mx, __shfl_xor(mx, o));
        float s = 0.f;
        for (int j = l; j < 256; j += 64) { const float e = __expf(lg[h][j] - mx); lg[h][j] = e; s += e; }
        s = wave_sum(s);
        if (l == 0) red[h] = 1.0f / s;
    }
    __syncthreads();
    const int h = t >> 5, d0 = (t & 31) * 4, g = h >> 2;
    float o0 = 0.f, o1 = 0.f, o2 = 0.f, o3 = 0.f;
    for (int j = 0; j < cnt; ++j) {
        const int idx = sel[j]; const float* vv;
        if (!samp) vv = out + O_VP + (size_t)(b * SEQ + idx) * 256;
        else if (idx < PAST) { const int pg = page_table[b * NPG + idx / PAGE]; vv = cache_v + ((size_t)pg * PAGE + (idx % PAGE)) * 256; }
        else vv = out + O_VS + (size_t)(b * DS + (idx - PAST)) * 256;
        const float p = lg[h][j];
        const float4 x = *(const float4*)(vv + g * 128 + d0);
        o0 += p * x.x; o1 += p * x.y; o2 += p * x.z; o3 += p * x.w;
    }
    const float rinv = red[h];
    const float* gate = P + (size_t)m * ATT_IN + OG + h * 128 + d0;
    float* ao = AO + (size_t)m * D + h * 128 + d0;
    ao[0] = o0 * rinv * silu(gate[0]); ao[1] = o1 * rinv * silu(gate[1]); ao[2] = o2 * rinv * silu(gate[2]); ao[3] = o3 * rinv * silu(gate[3]);
}

__device__ __forceinline__ void p_dn_post(const int vb, const float* P2, const float* conv_w, const float* conv_state, const float* A_log, const float* dt_bias, float* QC, float* KC, float* VC, float* BETA, float* G, float* out) {
    __shared__ float y[CONV];
    const int m = vb, t = threadIdx.x;
    const bool samp = m >= MP; const int b = samp ? (m - MP) / DS : m / SEQ; const int tt = samp ? (m - MP) % DS : m % SEQ; const int T = samp ? DS : SEQ;
    for (int c = t; c < CONV; c += 256) {
        float acc = 0.f;
#pragma unroll
        for (int i = 0; i < 4; ++i) {
            const int j = tt + i;
            float xv;
            if (j < 3) xv = samp ? conv_state[((size_t)b * 3 + j) * CONV + c] : 0.f;
            else xv = P2[(size_t)(m - tt + (j - 3)) * DN_IN + c];
            acc += conv_w[i * CONV + c] * xv;
        }
        y[c] = silu(acc);
        if (tt >= T - 3) {
            const int j = tt - (T - 3);
            float* dst = samp ? out + O_CS + ((size_t)b * 3 + j) * CONV : out + O_CP + ((size_t)b * 3 + j) * CONV;
            dst[c] = P2[(size_t)m * DN_IN + c];
        }
    }
    __syncthreads();
    const int w = t >> 6, l = t & 63;
    for (int hh = w; hh < 16; hh += 4) {
        const float a = y[hh * 128 + l], bb = y[hh * 128 + 64 + l];
        const float ss = wave_sum(a * a + bb * bb);
        float r = rsqrtf(ss + EPS);
        if (hh < 8) { r *= 0.08838834764831845f; QC[(size_t)m * D + hh * 128 + l] = a * r; QC[(size_t)m * D + hh * 128 + 64 + l] = bb * r; }
        else { KC[(size_t)m * D + (hh - 8) * 128 + l] = a * r; KC[(size_t)m * D + (hh - 8) * 128 + 64 + l] = bb * r; }
    }
    for (int c = t; c < 1024; c += 256) VC[(size_t)m * D + c] = y[2048 + c];
    if (t < 8) {
        const float bv = P2[(size_t)m * DN_IN + OB + t], av = P2[(size_t)m * DN_IN + OA + t];
        BETA[(size_t)m * 8 + t] = 1.0f / (1.0f + expf(-bv));
        const float x = av + dt_bias[t];
        const float sp = x > 20.f ? x : log1pf(expf(x));
        G[(size_t)m * 8 + t] = -expf(A_log[t]) * sp;
    }
}

__device__ __forceinline__ void p_dn_scan(const int vb, const float* QC, const float* KC, const float* VC, const float* BETA, const float* G, const float* S0, float* ORAW, float* out) {
    __shared__ float qs2[2][128]; __shared__ float ks2[2][128]; float* qs = qs2[threadIdx.x >> 7]; float* ks = ks2[threadIdx.x >> 7];
    const int half = threadIdx.x >> 7, item = vb * 2 + half; const int seq = item >> 3, h = item & 7, v = threadIdx.x & 127;
    const bool samp = seq >= NB; const int b = samp ? seq - NB : seq; const int T = samp ? DS : SEQ; const int m0 = samp ? MP + b * DS : b * SEQ;
    float S[128];
    if (samp) {
#pragma unroll
        for (int d = 0; d < 128; ++d) S[d] = S0[(((size_t)b * 8 + h) * 128 + d) * 128 + v];
    } else {
#pragma unroll
        for (int d = 0; d < 128; ++d) S[d] = 0.f;
    }
    for (int tt = 0; tt < T; ++tt) {
        const int m = m0 + tt;
        __syncthreads();
        qs[v] = QC[(size_t)m * D + h * 128 + v]; ks[v] = KC[(size_t)m * D + h * 128 + v];
        __syncthreads();
        const float vv = VC[(size_t)m * D + h * 128 + v], beta = BETA[(size_t)m * 8 + h], alpha = expf(G[(size_t)m * 8 + h]);
        float kS = 0.f;
#pragma unroll
        for (int d = 0; d < 128; ++d) kS += ks[d] * S[d];
        const float u = beta * (vv - alpha * kS);
        float o = 0.f;
#pragma unroll
        for (int d = 0; d < 128; ++d) { S[d] = alpha * S[d] + ks[d] * u; o += qs[d] * S[d]; }
        ORAW[(size_t)m * D + h * 128 + v] = o;
    }
    float* so = samp ? out + O_SS + ((size_t)b * 8 + h) * 128 * 128 : out + O_SP + ((size_t)b * 8 + h) * 128 * 128;
#pragma unroll
    for (int d = 0; d < 128; ++d) so[(size_t)d * 128 + v] = S[d];
}

__device__ __forceinline__ void p_dn_gate(const int vb, const float* ORAW, const float* P2, const float* og, float* AO2) {
    const int m = vb, t = threadIdx.x, w = t >> 6, l = t & 63;
    for (int h = w; h < 8; h += 4) {
        const float a = ORAW[(size_t)m * D + h * 128 + l], b = ORAW[(size_t)m * D + h * 128 + 64 + l];
        const float ss = wave_sum(a * a + b * b);
        const float r = rsqrtf(ss * (1.0f / 128) + EPS);
        const float z0 = P2[(size_t)m * DN_IN + OZ + h * 128 + l], z1 = P2[(size_t)m * DN_IN + OZ + h * 128 + 64 + l];
        AO2[(size_t)m * D + h * 128 + l] = a * r * og[l] * silu(z0);
        AO2[(size_t)m * D + h * 128 + 64 + l] = b * r * og[64 + l] * silu(z1);
    }
}

struct MArgs {
    const float* x_prompt; const float* x_sample; const float* cache_k; const float* cache_v; const float* cache_ik; const float* state_S; const float* state_conv; const int* page_table;
    const float* att_norm; const float* att_w_in; const float* qg; const float* kg; const float* ikg; const float* att_w_out; const float* dn_norm; const float* dn_w_in;
    const float* conv_w; const float* A_log; const float* dt_bias; const float* og; const float* dn_w_out;
    float* out; unsigned* bar;
    float* X; float* XN; float* P; float* QN; float* IW; int* SEL; int* CNT; float* AO; float* Y1; float* QC; float* KC; float* VC; float* BETA; float* G; float* ORAW; unsigned* KEYS;
};

#define PHASE_LOOP(n, call) do { for (int vb = blockIdx.x; vb < (n); vb += gridDim.x) { call; __syncthreads(); } } while (0)

__global__ void __launch_bounds__(256, 1) mega_naive(MArgs a) {
    __shared__ uint4 xb_words;
    if (threadIdx.x == 0) xb_words = make_uint4(0u, 0u, 0u, 0u);
    __syncthreads();
    XcdBarrier bar = xcd_barrier_post(a.bar, (volatile LAS unsigned*)&xb_words);
    for (int vb = blockIdx.x; vb < M; vb += gridDim.x) {
        const float* src = vb < MP ? a.x_prompt + (size_t)vb * D : a.x_sample + (size_t)(vb - MP) * D;
        for (int i = threadIdx.x; i < D; i += 256) a.X[(size_t)vb * D + i] = src[i];
    }
    xcd_barrier(bar);
    PHASE_LOOP(M, p_rmsnorm(vb, a.X, a.att_norm, a.XN));
    xcd_barrier(bar);
    { const int nbx = (ATT_IN + 63) / 64; PHASE_LOOP(nbx * (M / 64), p_gemm(vb, nbx, a.XN, a.att_w_in, a.P, M, ATT_IN, D, nullptr, 0, ATT_IN)); }
    xcd_barrier(bar);
    PHASE_LOOP(M, p_att_post(vb, a.P, a.qg, a.kg, a.ikg, a.QN, a.IW, a.out));
    xcd_barrier(bar);
    PHASE_LOOP(MP, p_index_prompt(vb, a.P, a.IW, a.out, a.SEL, a.CNT));
    PHASE_LOOP(MS, p_index_sample(vb, a.P, a.IW, a.out, a.cache_ik, a.page_table, a.KEYS, a.SEL, a.CNT));
    xcd_barrier(bar);
    PHASE_LOOP(M, p_attend(vb, a.QN, a.P, a.SEL, a.CNT, a.out, a.cache_k, a.cache_v, a.page_table, a.AO));
    xcd_barrier(bar);
    { const int nbx = D / 64; PHASE_LOOP(nbx * (M / 64), p_gemm(vb, nbx, a.AO, a.att_w_out, a.Y1, M, D, D, a.X, D, D)); }
    xcd_barrier(bar);
    PHASE_LOOP(M, p_rmsnorm(vb, a.Y1, a.dn_norm, a.XN));
    xcd_barrier(bar);
    { const int nbx = (DN_IN + 63) / 64; PHASE_LOOP(nbx * (M / 64), p_gemm(vb, nbx, a.XN, a.dn_w_in, a.P, M, DN_IN, D, nullptr, 0, DN_IN)); }
    xcd_barrier(bar);
    PHASE_LOOP(M, p_dn_post(vb, a.P, a.conv_w, a.state_conv, a.A_log, a.dt_bias, a.QC, a.KC, a.VC, a.BETA, a.G, a.out));
    xcd_barrier(bar);
    PHASE_LOOP((NB + DB) * 8 / 2, p_dn_scan(vb, a.QC, a.KC, a.VC, a.BETA, a.G, a.state_S, a.ORAW, a.out));
    xcd_barrier(bar);
    PHASE_LOOP(M, p_dn_gate(vb, a.ORAW, a.P, a.og, a.AO));
    xcd_barrier(bar);
    { const int nbx = D / 64; PHASE_LOOP(nbx * (M / 64), p_gemm(vb, nbx, a.AO, a.dn_w_out, a.out + O_Y, M, D, D, a.Y1, D, D)); }
}
}

extern "C" void kernel_launch(void* const* d_in, const int* in_sizes, int n_in, void* d_out, int out_size, void* d_ws, size_t ws_size, hipStream_t stream) {
    using namespace nv;
    static int grid = 0;
    if (!grid) {
        int dev = 0, cus = 0, per_cu = 0;
        (void)hipGetDevice(&dev);
        (void)hipDeviceGetAttribute(&cus, hipDeviceAttributeMultiprocessorCount, dev);
        (void)hipOccupancyMaxActiveBlocksPerMultiprocessor(&per_cu, (const void*)mega_naive, 256, 0);
        if (per_cu < 1) per_cu = 1;
        grid = cus * (per_cu < 2 ? per_cu : 2);
        fprintf(stderr, "mega_naive: cus %d per_cu %d grid %d\n", cus, per_cu, grid);
    }
    MArgs a{};
    a.x_prompt = (const float*)d_in[0]; a.x_sample = (const float*)d_in[1]; a.cache_k = (const float*)d_in[2]; a.cache_v = (const float*)d_in[3]; a.cache_ik = (const float*)d_in[4];
    a.state_S = (const float*)d_in[5]; a.state_conv = (const float*)d_in[6]; a.page_table = (const int*)d_in[7];
    a.att_norm = (const float*)d_in[8]; a.att_w_in = (const float*)d_in[9]; a.qg = (const float*)d_in[10]; a.kg = (const float*)d_in[11];
    a.ikg = (const float*)d_in[12]; a.att_w_out = (const float*)d_in[13]; a.dn_norm = (const float*)d_in[14]; a.dn_w_in = (const float*)d_in[15];
    a.conv_w = (const float*)d_in[16]; a.A_log = (const float*)d_in[17]; a.dt_bias = (const float*)d_in[18]; a.og = (const float*)d_in[19]; a.dn_w_out = (const float*)d_in[20];
    a.out = (float*)d_out;
    float* ws = (float*)d_ws; size_t off = 0;
    auto take = [&](size_t n) { float* p = ws + off; off += (n + 63) & ~(size_t)63; return p; };
    a.bar = (unsigned*)take(XCD_BAR_WORDS);
    a.X = take((size_t)M * D); a.XN = take((size_t)M * D); a.P = take((size_t)M * DN_IN); a.QN = take((size_t)M * D); a.IW = take((size_t)M * 8);
    a.SEL = (int*)take((size_t)M * 256); a.CNT = (int*)take(M); a.AO = take((size_t)M * D); a.Y1 = take((size_t)M * D);
    a.QC = take((size_t)M * D); a.KC = take((size_t)M * D); a.VC = take((size_t)M * D); a.BETA = take((size_t)M * 8); a.G = take((size_t)M * 8); a.ORAW = take((size_t)M * D);
    a.KEYS = (unsigned*)take((size_t)MS * (PAST + DS));
    if (off * 4 > ws_size) { fprintf(stderr, "ws too small\n"); return; }
    (void)hipMemsetAsync(a.bar, 0, XCD_BAR_WORDS * sizeof(unsigned), stream);
    hipLaunchKernelGGL(mega_naive, dim3(grid), dim3(256), 0, stream, a);
}
```

```cpp
#include <hip/hip_runtime.h>
#include <cstdio>
#include <cstdint>
#include <cstring>

namespace mk {
typedef unsigned short bf16_t;
constexpr int D = 1024, NB = 8, SEQ = 2048, MP = NB * SEQ, DB = 32, DS = 8, MS = DB * DS, M = MP + MS;
constexpr int PAST = 16384, PAGE = 128, NPG = PAST / PAGE;
constexpr int NH = 8, HD = 128, NKV = 2, IH = 8, ID = 64, TOPK = 256;
constexpr int ATT_IN = 3144, SQ_ = 0, SK_ = 1024, SV_ = 1280, SIQ = 1536, SIK = 2048, SIW = 2112, SG = 2120;
constexpr int DN_IN = 4112;
constexpr int N1P = 3328, CQ = 0, CK = 1024, CV = 1280, CIQ = 1536, CG = 2048, CIK = 3072, CIW = 3136;
constexpr int N3P = 4352, CONV = 3072, CZ = 3072, CB = 4096, CA = 4104;
constexpr float EPS = 1e-6f;
constexpr size_t O_Y = 0;
constexpr size_t O_KP = (size_t)M * D;
constexpr size_t O_VP = O_KP + (size_t)MP * 256;
constexpr size_t O_IKP = O_VP + (size_t)MP * 256;
constexpr size_t O_KS = O_IKP + (size_t)MP * 64;
constexpr size_t O_VS = O_KS + (size_t)MS * 256;
constexpr size_t O_IKS = O_VS + (size_t)MS * 256;
constexpr size_t O_SP = O_IKS + (size_t)MS * 64;
constexpr size_t O_CP = O_SP + (size_t)NB * 8 * 128 * 128;
constexpr size_t O_SS = O_CP + (size_t)NB * 3 * CONV;
constexpr size_t O_CS = O_SS + (size_t)DB * 8 * 128 * 128;
constexpr size_t O_END = O_CS + (size_t)DB * 3 * CONV;
static_assert(O_END == 32235520, "output size");

__device__ __forceinline__ float* kout(float* out, int m) { return m < MP ? out + O_KP + (size_t)m * 256 : out + O_KS + (size_t)(m - MP) * 256; }
__device__ __forceinline__ float* vout(float* out, int m) { return m < MP ? out + O_VP + (size_t)m * 256 : out + O_VS + (size_t)(m - MP) * 256; }
__device__ __forceinline__ float* ikout(float* out, int m) { return m < MP ? out + O_IKP + (size_t)m * 64 : out + O_IKS + (size_t)(m - MP) * 64; }
__device__ __forceinline__ const float* xrow(const float* xp, const float* xs, int m) { return m < MP ? xp + (size_t)m * D : xs + (size_t)(m - MP) * D; }

__device__ __forceinline__ int ltid() { int t = threadIdx.x; asm volatile("" : "+v"(t)); return t; }
typedef float f32x2_t __attribute__((ext_vector_type(2)));
typedef unsigned u32x4_t __attribute__((ext_vector_type(4)));
typedef float f32x4_t __attribute__((ext_vector_type(4)));
typedef float f32x2_t __attribute__((ext_vector_type(2)));
__device__ __forceinline__ float4 ldnt4(const float* p) { const f32x4_t v = __builtin_nontemporal_load((const f32x4_t*)p); return make_float4(v.x, v.y, v.z, v.w); }
__device__ __forceinline__ float ldnt1(const float* p) { return __builtin_nontemporal_load(p); }
__device__ __forceinline__ void stnt1(float* p, float a) { __builtin_nontemporal_store(a, p); }
__device__ __forceinline__ void stnt2(float* p, float a, float b) { const f32x2_t v = {a, b}; __builtin_nontemporal_store(v, (f32x2_t*)p); }
typedef short bf16x8 __attribute__((ext_vector_type(8)));
typedef float f32x16 __attribute__((ext_vector_type(16)));
typedef __bf16 bf16x2_t __attribute__((ext_vector_type(2)));
__device__ __forceinline__ unsigned cvtpk_native(float lo, float hi) { f32x2_t v = {lo, hi}; return __builtin_bit_cast(unsigned, __builtin_convertvector(v, bf16x2_t)); }
__device__ __forceinline__ void lds_barrier() { asm volatile("s_waitcnt lgkmcnt(0)" ::: "memory"); __builtin_amdgcn_s_barrier(); asm volatile("" ::: "memory"); }
__device__ __forceinline__ float bf2f(bf16_t b) { return __uint_as_float(((unsigned)b) << 16); }
__device__ __forceinline__ bf16_t f2bf(float f) { unsigned u = __float_as_uint(f); u += 0x7FFFu + ((u >> 16) & 1u); return (bf16_t)(u >> 16); }
__device__ __forceinline__ unsigned pk2bf(float lo, float hi) { return (unsigned)f2bf(lo) | ((unsigned)f2bf(hi) << 16); }
template <int N> __device__ __forceinline__ void wave_sum_n(float (&v)[N]) {
#pragma unroll
    for (int i = 0; i < N; ++i) v[i] += __int_as_float(__builtin_amdgcn_update_dpp(0, __float_as_int(v[i]), 0xB1, 0xF, 0xF, false));
#pragma unroll
    for (int i = 0; i < N; ++i) v[i] += __int_as_float(__builtin_amdgcn_update_dpp(0, __float_as_int(v[i]), 0x4E, 0xF, 0xF, false));
#pragma unroll
    for (int i = 0; i < N; ++i) v[i] += __int_as_float(__builtin_amdgcn_update_dpp(0, __float_as_int(v[i]), 0x124, 0xF, 0xF, false));
#pragma unroll
    for (int i = 0; i < N; ++i) v[i] += __int_as_float(__builtin_amdgcn_update_dpp(0, __float_as_int(v[i]), 0x128, 0xF, 0xF, false));
#pragma unroll
    for (int i = 0; i < N; ++i) v[i] += __shfl_xor(v[i], 16);
#pragma unroll
    for (int i = 0; i < N; ++i) v[i] += __shfl_xor(v[i], 32);
}
__device__ __forceinline__ float wave_sum(float v) { float a[1] = {v}; wave_sum_n<1>(a); return a[0]; }
__device__ __forceinline__ float silu(float x) { return x / (1.0f + __expf(-x)); }
}

namespace pg8 {
#define PG8_LAS __attribute__((address_space(3)))
typedef unsigned short bf16_t;
typedef short bf16x8 __attribute__((ext_vector_type(8)));
typedef float f32x4 __attribute__((ext_vector_type(4)));
typedef unsigned u32x4 __attribute__((ext_vector_type(4)));
constexpr int BM = 256, BK = 64, HALF = 128, HTB = HALF * BK * 2  , STAGE_BYTES = 8 * HTB, NXCD = 8, WGM = 8;

__host__ __device__ __forceinline__ int lds_byte(int r, int c) { const int st = (r >> 4) * 2 + (c >> 5), rr = r & 15, cc = c & 31, ob = rr * 64 + cc * 2; return st * 1024 + (ob ^ (((ob >> 9) & 1) << 5)); }
__host__ __device__ __forceinline__ void stage_rc(int b, int& R, int& C) { const int st = b / 1024, sb = b % 1024, swz = sb ^ (((sb >> 9) & 1) << 5); R = (st >> 1) * 16 + swz / 64; C = (st & 1) * 32 + (swz % 64) / 2; }
__host__ __device__ __forceinline__ int perm32(int rho) { const int n = rho >> 4, i = rho & 15; return 8 * (i >> 2) + 4 * n + (i & 3); }

struct Unit { int pm, pn; };
struct Gemm { const bf16_t* A; const bf16_t* Bt; int M, N, K, pad_; };

struct StaticOrder {
    int nM, nN, nwg, G, c;
    __host__ __device__ void init(int M, int N, int G_, int c_) { nM = M / BM; nN = N / BM; nwg = nM * nN; G = G_; c = c_; }
    __host__ __device__ bool next(int i, Unit& u) const {
        const long L = (long)i * G + c; if (L >= nwg) return false;
        int wgid = (int)L; { const int q = nwg / NXCD, r = nwg % NXCD, xcd = wgid % NXCD, off = wgid / NXCD; wgid = (xcd < r ? xcd * (q + 1) : r * (q + 1) + (xcd - r) * q) + off; }
        const int nig = WGM * nN, gid = wgid / nig, fm = gid * WGM, gsz = (nM - fm) < WGM ? (nM - fm) : WGM;
        u.pm = fm + ((wgid % nig) % gsz); u.pn = (wgid % nig) / gsz; return true;
    }
    __device__ __forceinline__ void a_ready(const Unit&) const {}
    __device__ __forceinline__ void done(const Unit&) const {}
};
struct CountedOrder : StaticOrder {
    const unsigned* ready; unsigned need; unsigned* tmo;
    __device__ __forceinline__ void a_ready(const Unit& u) const {
        if (mk::ltid() < 64) {
            const unsigned long long t0 = __builtin_amdgcn_s_memrealtime(); unsigned polls = 0;
            while ((unsigned)__builtin_amdgcn_readfirstlane(__hip_atomic_load(ready + 64 * u.pm, __ATOMIC_RELAXED, __HIP_MEMORY_SCOPE_AGENT)) < need) {
                if ((++polls & 255u) == 0u && __builtin_amdgcn_readfirstlane(__hip_atomic_load(tmo, __ATOMIC_RELAXED, __HIP_MEMORY_SCOPE_AGENT)) != 0u) break;
                if (__builtin_amdgcn_s_memrealtime() - t0 > 2000000ull) {
                    if (mk::ltid() == 0) { unsigned expect = 0u; __hip_atomic_compare_exchange_strong(tmo + 1, &expect, 0x600u | (unsigned)(u.pm & 0xff), __ATOMIC_RELAXED, __ATOMIC_RELAXED, __HIP_MEMORY_SCOPE_AGENT); __hip_atomic_store(tmo, 1u, __ATOMIC_RELAXED, __HIP_MEMORY_SCOPE_AGENT); }
                    break; }
                __builtin_amdgcn_s_sleep(2); }
            __builtin_amdgcn_fence(__ATOMIC_ACQUIRE, "agent");
            asm volatile("s_waitcnt vmcnt(0)" ::: "memory");
        }
#if !defined(BROKEN_HOOK_NO_BARRIER)
        asm volatile("" ::: "memory"); __builtin_amdgcn_s_barrier(); asm volatile("" ::: "memory");
#endif
    }
};

__device__ __forceinline__ unsigned cvt_pk_bf16(float lo, float hi) { return mk::cvtpk_native(lo, hi); }
typedef float f32x2 __attribute__((ext_vector_type(2)));
__device__ __forceinline__ f32x2 gelu_pk(f32x2 v) {
    const f32x2 av = __builtin_elementwise_abs(v), d = av * 0.2316418882f + 1.0f;
    f32x2 t; t.x = __builtin_amdgcn_rcpf(d.x); t.y = __builtin_amdgcn_rcpf(d.y);
    f32x2 q = t * 0.5307027145f + (-0.7265760135f); q = q * t + 0.7107068705f; q = q * t + (-0.142248368f); q = q * t + 0.127414796f; q = q * t;
    const f32x2 s = (v * v) * (-0.72134752044f);
    f32x2 e; e.x = __builtin_amdgcn_exp2f(s.x); e.y = __builtin_amdgcn_exp2f(s.y);
    const f32x2 m = v * (q * e), r = v - m;
    f32x2 o; o.x = v.x < 0.f ? m.x : r.x; o.y = v.y < 0.f ? m.y : r.y; return o;
}

struct EpiF32 {
    static constexpr bool PERM = false, AFTER_DRAIN = false;
    float* C; int ldc; const float* bias;
    __device__ __forceinline__ void operator()(const f32x4 (&acc)[2][2][4][2], const Unit& u, int wr, int wc, int fr, int fq) const {
        const int row0 = u.pm * BM + wr * 64 + fr, col0 = u.pn * BM + wc * 32 + 4 * fq;
        f32x4 bv[2][2];
#pragma unroll
        for (int bj = 0; bj < 2; ++bj)
#pragma unroll
            for (int n = 0; n < 2; ++n) bv[bj][n] = bias ? *(const f32x4*)(bias + col0 + bj * HALF + n * 16) : (f32x4){0.f, 0.f, 0.f, 0.f};
#pragma unroll
        for (int ai = 0; ai < 2; ++ai)
#pragma unroll
            for (int m = 0; m < 4; ++m) { float* rowp = C + (size_t)(row0 + ai * HALF + m * 16) * ldc + col0;
#pragma unroll
                for (int bj = 0; bj < 2; ++bj)
#pragma unroll
                    for (int n = 0; n < 2; ++n) *(f32x4*)(rowp + bj * HALF + n * 16) = acc[ai][bj][m][n] + bv[bj][n]; }
    }
};
template <int ACT  > struct EpiBf16 {
    static constexpr bool PERM = true, AFTER_DRAIN = false;
    bf16_t* O; int ldc; const float* bias; int split_cols; size_t split_stride;
    __device__ __forceinline__ void operator()(const f32x4 (&acc)[2][2][4][2], const Unit& u, int wr, int wc, int fr, int fq) const {
        const int row0 = u.pm * BM + wr * 64 + fr; int colt = u.pn * BM; bf16_t* base = O;
        if (split_cols) { const int t = colt / split_cols; base += (size_t)t * split_stride; colt -= t * split_cols; }
        const int col0 = colt + wc * 32 + 8 * fq, bcol0 = u.pn * BM + wc * 32 + 8 * fq;
        f32x4 bv[2][2];
#pragma unroll
        for (int bj = 0; bj < 2; ++bj)
#pragma unroll
            for (int n = 0; n < 2; ++n) bv[bj][n] = bias ? *(const f32x4*)(bias + bcol0 + bj * HALF + 4 * n) : (f32x4){0.f, 0.f, 0.f, 0.f};
#pragma unroll
        for (int ai = 0; ai < 2; ++ai)
#pragma unroll
            for (int m = 0; m < 4; ++m) { bf16_t* rowp = base + (size_t)(row0 + ai * HALF + m * 16) * ldc + col0;
#pragma unroll
                for (int bj = 0; bj < 2; ++bj) { f32x4 v0 = acc[ai][bj][m][0] + bv[bj][0], v1 = acc[ai][bj][m][1] + bv[bj][1];
                    if (ACT == 1) { f32x2 a = gelu_pk((f32x2){v0[0], v0[1]}), b = gelu_pk((f32x2){v0[2], v0[3]}), c = gelu_pk((f32x2){v1[0], v1[1]}), d = gelu_pk((f32x2){v1[2], v1[3]});
                        v0 = (f32x4){a.x, a.y, b.x, b.y}; v1 = (f32x4){c.x, c.y, d.x, d.y}; }
                    if (ACT == 2) {
#pragma unroll
                        for (int j = 0; j < 4; ++j) { v0[j] = 0.5f * v0[j] * (1.0f + erff(v0[j] * 0.70710678f)); v1[j] = 0.5f * v1[j] * (1.0f + erff(v1[j] * 0.70710678f)); } }
                    u32x4 w; w.x = cvt_pk_bf16(v0[0], v0[1]); w.y = cvt_pk_bf16(v0[2], v0[3]); w.z = cvt_pk_bf16(v1[0], v1[1]); w.w = cvt_pk_bf16(v1[2], v1[3]);
                    *(u32x4*)(rowp + bj * HALF) = w; } }
    }
};

template <class Epi, class Sched, bool STAMP = false>
__device__ __forceinline__ void gemm_phase(PG8_LAS unsigned char* lds, const Gemm g, const Sched& S, const Epi& E, unsigned long long* stamps) {
    const int tid = mk::ltid(), wid = __builtin_amdgcn_readfirstlane(tid >> 6), lane = tid & 63, wr = wid >> 2, wc = wid & 3, fr = lane & 15, fq = lane >> 4;
    const int K = g.K, nt = K / BK;
    int ts_lo = 0, ts_hi = 0, nts = 0; const unsigned long long rt_entry = STAMP ? (unsigned long long)wall_clock64() : 0ull;
#define PG8_STAMP() do { if (STAMP && wid == 0 && nts < 64) { const unsigned long long _c = (unsigned long long)clock64(); \
        ts_lo = (lane == nts) ? (int)(unsigned)_c : ts_lo; ts_hi = (lane == nts) ? (int)(unsigned)(_c >> 32) : ts_hi; ++nts; } } while (0)
    PG8_STAMP();
    unsigned voffA[2], voffB[2];
#pragma unroll
    for (int i = 0; i < 2; ++i) { int R, C; stage_rc(tid * 16 + i * 8192, R, C); const int Rb = Epi::PERM ? ((R & ~31) + perm32(R & 31)) : R;
        voffA[i] = (unsigned)(R * K + C) * 2u; voffB[i] = (unsigned)(Rb * K + C) * 2u; }
    const size_t kstep = (size_t)(BK * 2);
    const size_t hstep = (size_t)HALF * K * 2;
    const size_t tstep = 2 * hstep;
    const unsigned ldsw = (unsigned)wid * 1024u;
    const int aoff = lds_byte(wr * 64 + fr, fq * 8), boff = lds_byte(wc * 32 + fr, fq * 8);
#define PG8_SA(b, h) (((b) * 2 + (h)) * HTB)
#define PG8_SB(b, h) ((4 + (b) * 2 + (h)) * HTB)
#define PG8_STAGE(bufoff, gbase, voff) do { _Pragma("unroll") for (int _i = 0; _i < 2; ++_i) \
        __builtin_amdgcn_global_load_lds((const unsigned*)((const char*)(gbase) + (voff)[_i]), (PG8_LAS unsigned*)(lds + (bufoff) + ldsw + _i * 8192), 16, 0, 0); } while (0)
#define PG8_LDA(dst, b, h) do { _Pragma("unroll") for (int m = 0; m < 4; ++m) _Pragma("unroll") for (int k = 0; k < 2; ++k) dst[m][k] = *(const PG8_LAS bf16x8*)(lds + PG8_SA(b, h) + aoff + m * 2048 + k * 1024); } while (0)
#define PG8_LDB(dst, b, h) do { _Pragma("unroll") for (int n = 0; n < 2; ++n) _Pragma("unroll") for (int k = 0; k < 2; ++k) dst[n][k] = *(const PG8_LAS bf16x8*)(lds + PG8_SB(b, h) + boff + n * 2048 + k * 1024); } while (0)
#define PG8_MMA(ai, bj, At, Bt) do { __builtin_amdgcn_s_setprio(1); _Pragma("unroll") for (int m = 0; m < 4; ++m) _Pragma("unroll") for (int n = 0; n < 2; ++n) _Pragma("unroll") for (int k = 0; k < 2; ++k) \
        acc[ai][bj][m][n] = __builtin_amdgcn_mfma_f32_16x16x32_bf16(Bt[n][k], At[m][k], acc[ai][bj][m][n], 0, 0, 0); __builtin_amdgcn_s_setprio(0); } while (0)
#define PG8_WAIT_V(n) asm volatile("s_waitcnt vmcnt(" #n ")" ::: "memory")
#define PG8_WAIT_L(n) asm volatile("s_waitcnt lgkmcnt(" #n ")" ::: "memory")
#define PG8_BAR __builtin_amdgcn_s_barrier()
#define PG8_SCHED __builtin_amdgcn_sched_barrier(0)
    Unit cur, nxt; int ui = 0;
    if (!S.next(0, cur)) return;
    f32x4 acc[2][2][4][2];
#pragma unroll
    for (int a = 0; a < 2; ++a)
#pragma unroll
        for (int b = 0; b < 2; ++b)
#pragma unroll
            for (int m = 0; m < 4; ++m)
#pragma unroll
                for (int n = 0; n < 2; ++n) acc[a][b][m][n] = (f32x4){0.f, 0.f, 0.f, 0.f};
    bf16x8 At[4][2], B0[2][2], B1[2][2];
    const char* cA = (const char*)g.A + (size_t)cur.pm * tstep; const char* cB = (const char*)g.Bt + (size_t)cur.pn * tstep;
    S.a_ready(cur);
    PG8_STAGE(PG8_SB(0, 0), cB, voffB); PG8_STAGE(PG8_SA(0, 0), cA, voffA); PG8_STAGE(PG8_SB(0, 1), cB + hstep, voffB); PG8_STAGE(PG8_SA(0, 1), cA + hstep, voffA);
    if (wr == 1) PG8_BAR;
    PG8_WAIT_V(4); PG8_BAR;
    PG8_STAGE(PG8_SB(1, 0), cB + kstep, voffB); PG8_STAGE(PG8_SA(1, 0), cA + kstep, voffA); PG8_STAGE(PG8_SB(1, 1), cB + hstep + kstep, voffB);
    PG8_WAIT_V(6); PG8_BAR;
    PG8_STAMP();
    for (;;) {
        const bool has_next = S.next(ui + 1, nxt);
        const char* nA = has_next ? (const char*)g.A + (size_t)nxt.pm * tstep : cA; const char* nB = has_next ? (const char*)g.Bt + (size_t)nxt.pn * tstep : cB;
        for (int t = 0; t < nt; t += 2) {
            const bool last = (t == nt - 2);
            const char* a1 = cA + (size_t)(t + 1) * kstep;
            const char* a2 = last ? nA : cA + (size_t)(t + 2) * kstep; const char* b2 = last ? nB : cB + (size_t)(t + 2) * kstep;
            const char* a3 = a2 + kstep; const char* b3 = b2 + kstep;
            if (last && has_next) S.a_ready(nxt);
            PG8_LDB(B0, 0, 0); PG8_SCHED; PG8_LDA(At, 0, 0); PG8_STAGE(PG8_SA(1, 1), a1 + hstep, voffA);
            PG8_WAIT_L(8); PG8_BAR; PG8_WAIT_L(0); PG8_MMA(0, 0, At, B0); PG8_BAR; PG8_SCHED;
            PG8_LDB(B1, 0, 1); PG8_STAGE(PG8_SB(0, 0), b2, voffB);
            PG8_BAR; PG8_WAIT_L(0); PG8_MMA(0, 1, At, B1); PG8_BAR;
            PG8_LDA(At, 0, 1); PG8_STAGE(PG8_SA(0, 0), a2, voffA);
            PG8_BAR; PG8_WAIT_L(0); PG8_MMA(1, 0, At, B0); PG8_BAR; PG8_SCHED;
            PG8_STAGE(PG8_SB(0, 1), b2 + hstep, voffB);
            PG8_WAIT_V(6); PG8_BAR; PG8_MMA(1, 1, At, B1); PG8_BAR;
            PG8_LDB(B0, 1, 0); PG8_SCHED; PG8_LDA(At, 1, 0); PG8_STAGE(PG8_SA(0, 1), a2 + hstep, voffA);
            PG8_WAIT_L(8); PG8_BAR; PG8_WAIT_L(0); PG8_MMA(0, 0, At, B0); PG8_BAR; PG8_SCHED;
            PG8_LDB(B1, 1, 1); PG8_STAGE(PG8_SB(1, 0), b3, voffB);
            PG8_BAR; PG8_WAIT_L(0); PG8_MMA(0, 1, At, B1); PG8_BAR;
            PG8_LDA(At, 1, 1); PG8_STAGE(PG8_SA(1, 0), a3, voffA);
            PG8_BAR; PG8_WAIT_L(0); PG8_MMA(1, 0, At, B0); PG8_BAR; PG8_SCHED;
            PG8_STAGE(PG8_SB(1, 1), b3 + hstep, voffB);
            PG8_WAIT_V(6); PG8_BAR; PG8_MMA(1, 1, At, B1); PG8_BAR;
        }
        PG8_STAMP();
        if constexpr (!Epi::AFTER_DRAIN) { E(acc, cur, wr, wc, fr, fq); S.done(cur); }
        PG8_STAMP();
        if (!has_next) break;
#pragma unroll
        for (int a = 0; a < 2; ++a)
#pragma unroll
            for (int b = 0; b < 2; ++b)
#pragma unroll
                for (int m = 0; m < 4; ++m)
#pragma unroll
                    for (int n = 0; n < 2; ++n) acc[a][b][m][n] = (f32x4){0.f, 0.f, 0.f, 0.f};
        cur = nxt; cA = nA; cB = nB; ++ui;
    }
    PG8_WAIT_V(0);
    if (wr == 0) PG8_BAR;
    PG8_BAR;
    if constexpr (Epi::AFTER_DRAIN) { E.fused(acc, cur, wr, wc, fr, fq, lds, wid, lane); S.done(cur); }
    PG8_STAMP();
    if (STAMP && wid == 0) { stamps[lane] = lane < nts ? (((unsigned long long)(unsigned)ts_hi << 32) | (unsigned)ts_lo) : 0ull;
        if (lane == 62) stamps[62] = rt_entry; if (lane == 63) stamps[63] = (unsigned long long)wall_clock64(); }
#undef PG8_STAMP
#undef PG8_SA
#undef PG8_SB
#undef PG8_STAGE
#undef PG8_LDA
#undef PG8_LDB
#undef PG8_MMA
#undef PG8_WAIT_V
#undef PG8_WAIT_L
#undef PG8_BAR
#undef PG8_SCHED
}
}

#define XB_TMO      128
#define XB_XCNT(j)  (256  + 64 * (j))
#define XB_XSUB(j)  (1280 + 64 * (j))
#define XB_XGEN(j)  (2304 + 64 * (j))
#define XB_TOP      3328
#define XB_TOPGEN   3392
#define XCD_BAR_WORDS 3456
#define XB_SPIN_CAP (1u << 18)
#define LAS __attribute__((address_space(3)))

__device__ __forceinline__ unsigned xb_ld(unsigned* p)              { return __hip_atomic_load(p, __ATOMIC_RELAXED, __HIP_MEMORY_SCOPE_AGENT); }
__device__ __forceinline__ unsigned xb_add(unsigned* p, unsigned v) { return __hip_atomic_fetch_add(p, v, __ATOMIC_RELAXED, __HIP_MEMORY_SCOPE_AGENT); }
__device__ __forceinline__ unsigned xb_xcc_id() { return (unsigned)__builtin_amdgcn_s_getreg((3 << 11) | 20) & 0xFu; }
#define XB_SPIN(cond, bar) do { unsigned _sp = 0; while (cond) { __builtin_amdgcn_s_sleep(1); \
    if ((++_sp & 255u) == 0u) { if (xb_ld(&(bar)[XB_TMO])) break; if (_sp > XB_SPIN_CAP) { atomicAdd(&(bar)[XB_TMO], 1u); break; } } } } while (0)

struct XcdBarrier {
    unsigned* bar; unsigned x;
    volatile LAS unsigned* st;
};

__device__ __forceinline__ XcdBarrier xcd_barrier_post(unsigned* bar, volatile LAS unsigned* st) {
    XcdBarrier b; b.bar = bar; b.x = xb_xcc_id(); b.st = st;
    if (threadIdx.x == 0) (void)xb_add(&bar[XB_XCNT(b.x)], 1u);
    return b;
}
__device__ __forceinline__ void xcd_barrier_complete(unsigned* bar, unsigned x, unsigned& nloc, unsigned& nx) {
    const unsigned G = gridDim.x * gridDim.y * gridDim.z;
    unsigned sum, cnt, mine, sp = 0u;
    for (;;) {
        sum = 0u; cnt = 0u; mine = 0u;
#pragma unroll
        for (unsigned j = 0; j < 16; ++j) { const unsigned c = xb_ld(&bar[XB_XCNT(j)]); sum += c; cnt += (c > 0u) ? 1u : 0u; mine = (j == x) ? c : mine; }
        if (sum == G) break;
        __builtin_amdgcn_s_sleep(1);
        if ((++sp & 255u) == 0u) { if (xb_ld(&bar[XB_TMO])) break; if (sp > XB_SPIN_CAP) { atomicAdd(&bar[XB_TMO], 1u); break; } }
    }
    nloc = mine > 0u ? mine : 1u; nx = cnt > 0u ? cnt : 1u;
}

__device__ __forceinline__ void xcd_barrier(const XcdBarrier& b) {
    asm volatile("s_waitcnt vmcnt(0)" ::: "memory");
    __syncthreads();
    if (threadIdx.x == 0) {
        unsigned* bar = b.bar;
        __builtin_amdgcn_s_waitcnt(0);
        unsigned nloc = b.st[0], nx = b.st[1];
        if (nloc == 0u) { xcd_barrier_complete(bar, b.x, nloc, nx); b.st[0] = nloc; b.st[1] = nx; }
        const unsigned old = xb_add(&bar[XB_XSUB(b.x)], 1u);
        const unsigned gen = old / nloc;
        if (old + 1u == (gen + 1u) * nloc) {
            __builtin_amdgcn_fence(__ATOMIC_RELEASE, "agent");
            asm volatile("s_waitcnt vmcnt(0)" ::: "memory");
            const unsigned og = xb_add(&bar[XB_TOP], 1u);
            const unsigned tg = og / nx;
            if (og + 1u == (tg + 1u) * nx) xb_add(&bar[XB_TOPGEN], 1u);
            else XB_SPIN(xb_ld(&bar[XB_TOPGEN]) == tg, bar);
            __builtin_amdgcn_fence(__ATOMIC_ACQUIRE, "agent");
            xb_add(&bar[XB_XGEN(b.x)], 1u);
            asm volatile("s_waitcnt vmcnt(0)" ::: "memory");
        } else {
            XB_SPIN(xb_ld(&bar[XB_XGEN(b.x)]) == gen, bar);
            __builtin_amdgcn_fence(__ATOMIC_ACQUIRE, "agent");
            asm volatile("s_waitcnt vmcnt(0)" ::: "memory");
        }
    }
    __syncthreads();
}


namespace mk {
#define LAS3 __attribute__((address_space(3)))
__device__ __forceinline__ int src_col1(int n) { if (n < 2048) return n; if (n < 3072) return SG + (n - 2048); if (n < 3136) return SIK + (n - 3072); if (n < 3144) return SIW + (n - 3136); return -1; }
__device__ __forceinline__ int src_col3(int n) { return n < DN_IN ? n : -1; }
__device__ __forceinline__ int src_colid(int n) { return n; }

template <int MAP> __device__ __forceinline__ void wconv_load(float (&v)[8], const float* W, int ldw, const float* gain, int n0, int k0) {
    const int tid = mk::ltid();
#pragma unroll
    for (int i = 0; i < 8; ++i) {
        const int e = tid + 512 * i, kk = e >> 6, nn = e & 63, n = n0 + nn;
        const int sc = MAP == 1 ? src_col1(n) : (MAP == 3 ? src_col3(n) : src_colid(n));
        float x = 0.f;
        if (sc >= 0) { x = W[(size_t)(k0 + kk) * ldw + sc]; if (gain) x *= gain[k0 + kk]; }
        v[i] = x;
    }
}
template <int MAP> __device__ __forceinline__ void wconv_all(float* tile, const float* W, int ldw, const float* gain, bf16_t* Wt, int K, int NP, int bid, int nblk) {
    const int ntn = NP / 64, ntk = K / 64, total = ntn * ntk, tid = mk::ltid();
    float v[8], vn[8];
    int t = bid;
    if (t < total) wconv_load<MAP>(v, W, ldw, gain, (t % ntn) * 64, (t / ntn) * 64);
    for (; t < total; t += nblk) {
        const int tn = t + nblk, n0 = (t % ntn) * 64, k0 = (t / ntn) * 64;
        if (tn < total) wconv_load<MAP>(vn, W, ldw, gain, (tn % ntn) * 64, (tn / ntn) * 64);
#pragma unroll
        for (int i = 0; i < 8; ++i) { const int e = tid + 512 * i; tile[(e >> 6) * 65 + (e & 63)] = v[i]; }
        __syncthreads();
#pragma unroll
        for (int i = 0; i < 4; ++i) {
            const int e = tid + 512 * i, nn = e >> 5, kk = (e & 31) * 2;
            *(unsigned*)(Wt + (size_t)(n0 + nn) * K + k0 + kk) = pk2bf(tile[kk * 65 + nn], tile[(kk + 1) * 65 + nn]);
        }
        __syncthreads();
#pragma unroll
        for (int i = 0; i < 8; ++i) v[i] = vn[i];
    }
}
template <int MAP> __device__ __forceinline__ void wconv_waves(const float* W, int ldw, const float* gain, bf16_t* Wt, int K, int NP, int wv, int nwv) {
    const int l = mk::ltid() & 63, n = l & 31, kh = l >> 5;
    const int nun = NP / 32, nuk = K / 64;
    for (int u = wv; u < nun * nuk; u += nwv) {
        const int n0 = (u % nun) * 32, k0 = (u / nun) * 64 + 32 * kh;
        const int sc = MAP == 1 ? src_col1(n0 + n) : (MAP == 3 ? src_col3(n0 + n) : src_colid(n0 + n));
        float x[32];
#pragma unroll
        for (int i = 0; i < 32; ++i) x[i] = sc >= 0 ? W[(size_t)(k0 + i) * ldw + sc] : 0.f;
        if (gain) {
#pragma unroll
            for (int i = 0; i < 32; ++i) x[i] *= gain[k0 + i];
        }
        uint4* dst = (uint4*)(Wt + (size_t)(n0 + n) * K + k0);
#pragma unroll
        for (int q = 0; q < 4; ++q) dst[q] = make_uint4(cvtpk_native(x[8 * q], x[8 * q + 1]), cvtpk_native(x[8 * q + 2], x[8 * q + 3]), cvtpk_native(x[8 * q + 4], x[8 * q + 5]), cvtpk_native(x[8 * q + 6], x[8 * q + 7]));
    }
}
__device__ __forceinline__ void xnorm_load(const float* x, float4 (&v)[4]) { const int lane = mk::ltid() & 63;
#pragma unroll
    for (int i = 0; i < 4; ++i) v[i] = ldnt4(x + 4 * (lane + 64 * i)); }
__device__ __forceinline__ void xnorm_finish(const float4 (&v)[4], bf16_t* xa, float* inv) {
    const int lane = mk::ltid() & 63;
    float ss = 0.f;
#pragma unroll
    for (int i = 0; i < 4; ++i) ss += v[i].x * v[i].x + v[i].y * v[i].y + v[i].z * v[i].z + v[i].w * v[i].w;
    ss = wave_sum(ss);
    const float ms = ss * (1.0f / D) + EPS, r = rsqrtf(ms);
    if (lane == 0) *inv = ms * r;
#pragma unroll
    for (int i = 0; i < 4; ++i) { uint2 w; w.x = pk2bf(v[i].x * r, v[i].y * r); w.y = pk2bf(v[i].z * r, v[i].w * r); ((uint2*)xa)[lane + 64 * i] = w; }
}

using pg8::f32x4; using pg8::u32x4; using pg8::Unit; using pg8::BM; using pg8::HALF;
struct EpiF32Res {
    static constexpr bool PERM = false, AFTER_DRAIN = false;
    float* C; const float* R0; const float* R1; bf16_t* XB; float* SS; int ld; int pad_;
    __device__ __forceinline__ void operator()(const f32x4 (&acc)[2][2][4][2], const Unit& u, int wr, int wc, int fr, int fq) const {
        const int row0 = u.pm * BM + wr * 64 + fr, col0 = u.pn * BM + wc * 32 + 4 * fq;
        const float* Rb = (u.pm * BM < MP) ? R0 : R1 - (size_t)MP * ld;
#pragma unroll
        for (int ai = 0; ai < 2; ++ai)
#pragma unroll
            for (int m = 0; m < 4; ++m) { const size_t ro = (size_t)(row0 + ai * HALF + m * 16) * ld + col0;
                float ss = 0.f;
#pragma unroll
                for (int bj = 0; bj < 2; ++bj)
#pragma unroll
                    for (int n = 0; n < 2; ++n) { const f32x4 v = acc[ai][bj][m][n] + *(const f32x4*)(Rb + ro + bj * HALF + n * 16);
                        if (C) *(f32x4*)(C + ro + bj * HALF + n * 16) = v;
                        if (XB) { *(uint2*)(XB + ro + bj * HALF + n * 16) = make_uint2(cvtpk_native(v[0], v[1]), cvtpk_native(v[2], v[3])); ss += (v[0] * v[0] + v[1] * v[1]) + (v[2] * v[2] + v[3] * v[3]); } }
                if (XB) { ss += __shfl_xor(ss, 16); ss += __shfl_xor(ss, 32); if (fq == 0) atomicAdd(SS + row0 + ai * HALF + m * 16, ss); }
            }
    }
};
struct EpiY1 {
    static constexpr bool PERM = false, AFTER_DRAIN = false;
    bf16_t* XB; const float* INV; float* SS; int ld; int pad_;
    __device__ __forceinline__ void operator()(const f32x4 (&acc)[2][2][4][2], const Unit& u, int wr, int wc, int fr, int fq) const {
        const int row0 = u.pm * BM + wr * 64 + fr, col0 = u.pn * BM + wc * 32 + 4 * fq;
#pragma unroll
        for (int ai = 0; ai < 2; ++ai)
#pragma unroll
            for (int m = 0; m < 4; ++m) { const int row = row0 + ai * HALF + m * 16; const size_t ro = (size_t)row * ld + col0;
                const float inv = INV[row];
                float ss = 0.f;
#pragma unroll
                for (int bj = 0; bj < 2; ++bj)
#pragma unroll
                    for (int n = 0; n < 2; ++n) { uint2* xp = (uint2*)(XB + ro + bj * HALF + n * 16); const uint2 rb = *xp;
                        f32x4 v = acc[ai][bj][m][n];
                        v[0] = fmaf(__uint_as_float(rb.x << 16), inv, v[0]); v[1] = fmaf(__uint_as_float(rb.x & 0xFFFF0000u), inv, v[1]);
                        v[2] = fmaf(__uint_as_float(rb.y << 16), inv, v[2]); v[3] = fmaf(__uint_as_float(rb.y & 0xFFFF0000u), inv, v[3]);
                        *xp = make_uint2(cvtpk_native(v[0], v[1]), cvtpk_native(v[2], v[3])); ss += (v[0] * v[0] + v[1] * v[1]) + (v[2] * v[2] + v[3] * v[3]); }
                ss += __shfl_xor(ss, 16); ss += __shfl_xor(ss, 32); if (fq == 0) atomicAdd(SS + row, ss);
            }
    }
};
struct EpiF32ResBf {
    static constexpr bool PERM = false, AFTER_DRAIN = false;
    float* C; const bf16_t* RB; int ld; int pad_;
    __device__ __forceinline__ void operator()(const f32x4 (&acc)[2][2][4][2], const Unit& u, int wr, int wc, int fr, int fq) const {
        const int row0 = u.pm * BM + wr * 64 + fr, col0 = u.pn * BM + wc * 32 + 4 * fq;
#pragma unroll
        for (int ai = 0; ai < 2; ++ai)
#pragma unroll
            for (int m = 0; m < 4; ++m) { const size_t ro = (size_t)(row0 + ai * HALF + m * 16) * ld + col0;
#pragma unroll
                for (int bj = 0; bj < 2; ++bj)
#pragma unroll
                    for (int n = 0; n < 2; ++n) { const uint2 rb = *(const uint2*)(RB + ro + bj * HALF + n * 16);
                        f32x4 v = acc[ai][bj][m][n];
                        v[0] += __uint_as_float(rb.x << 16); v[1] += __uint_as_float(rb.x & 0xFFFF0000u); v[2] += __uint_as_float(rb.y << 16); v[3] += __uint_as_float(rb.y & 0xFFFF0000u);
                        *(f32x4*)(C + ro + bj * HALF + n * 16) = v; }
            }
    }
};
struct EpiBf16Tail {
    static constexpr bool PERM = true, AFTER_DRAIN = false;
    bf16_t* O; int ldc; int ntile_bf; float* BA; const float* SS;
    float* QSS;
    __device__ __forceinline__ void operator()(const f32x4 (&acc)[2][2][4][2], const Unit& u, int wr, int wc, int fr, int fq) const {
        const int row0 = u.pm * BM + wr * 64 + fr;
        float rs[2][4];
#pragma unroll
        for (int ai = 0; ai < 2; ++ai)
#pragma unroll
            for (int m = 0; m < 4; ++m) rs[ai][m] = SS ? rsqrtf(SS[row0 + ai * HALF + m * 16] * (1.0f / D) + EPS) : 1.0f;
        if (u.pn >= ntile_bf) {
            if (wc == 0 && fq < 2) {
#pragma unroll
                for (int ai = 0; ai < 2; ++ai)
#pragma unroll
                    for (int m = 0; m < 4; ++m) { float* rp = BA + (size_t)(row0 + ai * HALF + m * 16) * 16 + 8 * fq;
                        *(f32x4*)(rp) = acc[ai][0][m][0] * rs[ai][m]; *(f32x4*)(rp + 4) = acc[ai][0][m][1] * rs[ai][m]; }
            }
            return;
        }
        const int col0 = u.pn * BM + wc * 32 + 8 * fq;
        const bool qsum = QSS != nullptr && u.pn < 4;
#pragma unroll
        for (int ai = 0; ai < 2; ++ai)
#pragma unroll
            for (int m = 0; m < 4; ++m) { bf16_t* rowp = O + (size_t)(row0 + ai * HALF + m * 16) * ldc + col0;
#pragma unroll
                for (int bj = 0; bj < 2; ++bj) { const f32x4 v0 = acc[ai][bj][m][0] * rs[ai][m], v1 = acc[ai][bj][m][1] * rs[ai][m];
                    u32x4 w; w.x = pg8::cvt_pk_bf16(v0[0], v0[1]); w.y = pg8::cvt_pk_bf16(v0[2], v0[3]); w.z = pg8::cvt_pk_bf16(v1[0], v1[1]); w.w = pg8::cvt_pk_bf16(v1[2], v1[3]);
                    *(u32x4*)(rowp + bj * HALF) = w;
                    if (qsum) { float ss = ((v0[0] * v0[0] + v0[1] * v0[1]) + (v0[2] * v0[2] + v0[3] * v0[3])) + ((v1[0] * v1[0] + v1[1] * v1[1]) + (v1[2] * v1[2] + v1[3] * v1[3]));
                        ss += __shfl_xor(ss, 16); ss += __shfl_xor(ss, 32);
                        if (fq == 0) atomicAdd(QSS + (size_t)(row0 + ai * HALF + m * 16) * 8 + 2 * u.pn + bj, ss); } } }
    }
};
}
namespace mk {
template <int NJ, class P, class F> __device__ __forceinline__ void gemm_small_unit(char* lds, const bf16_t* A, const bf16_t* Bt, int row0, int col0, P&& pre, F&& emit) {
    const int tid = ltid(), w = __builtin_amdgcn_readfirstlane(tid >> 6), l = tid & 63, r = l & 31, hh = l >> 5;
    const bf16_t* ap = A + (size_t)(row0 + r) * D + 128 * w + 8 * hh;
    const bf16_t* bp = Bt + (size_t)(col0 + r) * D + 128 * w + 8 * hh;
    bf16x8 af[8], bfr[NJ][8];
#pragma unroll
    for (int s = 0; s < 8; ++s) { af[s] = *(const bf16x8*)(ap + 16 * s);
#pragma unroll
        for (int j = 0; j < NJ; ++j) bfr[j][s] = *(const bf16x8*)(bp + (size_t)(32 * j) * D + 16 * s); }
    float rsd[NJ][2];
#pragma unroll
    for (int j = 0; j < NJ; ++j)
#pragma unroll
        for (int e = 0; e < 2; ++e) { const int q = 2 * w + e; rsd[j][e] = pre(row0 + (q & 3) + 8 * (q >> 2) + 4 * hh, col0 + 32 * j + r); }
    f32x16 acc[NJ];
#pragma unroll
    for (int j = 0; j < NJ; ++j) acc[j] = f32x16{};
#pragma unroll
    for (int s = 0; s < 8; ++s)
#pragma unroll
        for (int j = 0; j < NJ; ++j) acc[j] = __builtin_amdgcn_mfma_f32_32x32x16_bf16(af[s], bfr[j][s], acc[j], 0, 0, 0);
    float* part = (float*)lds;
#pragma unroll
    for (int j = 0; j < NJ; ++j)
#pragma unroll
        for (int q = 0; q < 16; ++q) part[((w * NJ + j) * 16 + q) * 64 + l] = acc[j][q];
    __syncthreads();
#pragma unroll
    for (int j = 0; j < NJ; ++j)
#pragma unroll
        for (int e = 0; e < 2; ++e) {
            const int q = 2 * w + e;
            float v = 0.f;
#pragma unroll
            for (int ww = 0; ww < 8; ++ww) v += part[((ww * NJ + j) * 16 + q) * 64 + l];
            emit(row0 + (q & 3) + 8 * (q >> 2) + 4 * hh, col0 + 32 * j + r, v, rsd[j][e]);
        }
    __syncthreads();
}
}

namespace mk {

struct AttPostRegs { unsigned k[2], v[2]; bf16_t ik, iw; };
__device__ __forceinline__ void att_post_load(int m, const bf16_t* P1, AttPostRegs& R) {
    const int l = mk::ltid() & 63;
    const unsigned* p = (const unsigned*)(P1 + (size_t)m * N1P);
#pragma unroll
    for (int h = 0; h < 2; ++h) { R.k[h] = p[(CK >> 1) + h * 64 + l]; R.v[h] = p[(CV >> 1) + h * 64 + l]; }
    R.ik = P1[(size_t)m * N1P + CIK + l]; R.iw = P1[(size_t)m * N1P + CIW + (l & 7)];
}
__device__ __forceinline__ void att_post_finish(int m, const AttPostRegs& R, const float* qg, const float* kg, const float* ikg, bf16_t* KB, bf16_t* IKB, float* IW, float* out) {
    const int l = mk::ltid() & 63;
    const float g0 = qg[2 * l], g1 = qg[2 * l + 1];
    {
        const float k0 = kg[2 * l], k1 = kg[2 * l + 1];
        float* ko = kout(out, m); unsigned* kb = (unsigned*)(KB + (size_t)m * 256);
        float ka[2], kb2[2], ss[3];
#pragma unroll
        for (int h = 0; h < 2; ++h) { ka[h] = __uint_as_float(R.k[h] << 16); kb2[h] = __uint_as_float(R.k[h] & 0xFFFF0000u); ss[h] = ka[h] * ka[h] + kb2[h] * kb2[h]; }
        const float ia = bf2f(R.ik); ss[2] = ia * ia;
        wave_sum_n<3>(ss);
#pragma unroll
        for (int h = 0; h < 2; ++h) {
            const float r = rsqrtf(ss[h] * (1.0f / 128) + EPS);
            const float x = ka[h] * r * k0, y = kb2[h] * r * k1;
            *(float2*)(ko + h * 128 + 2 * l) = make_float2(x, y);
            kb[h * 64 + l] = pk2bf(x * g0, y * g1);
        }
        float* vo = vout(out, m);
#pragma unroll
        for (int h = 0; h < 2; ++h) *(float2*)(vo + h * 128 + 2 * l) = make_float2(__uint_as_float(R.v[h] << 16), __uint_as_float(R.v[h] & 0xFFFF0000u));
        const float ri = rsqrtf(ss[2] * (1.0f / 64) + EPS);
        const float xi = ia * ri * ikg[l];
        ikout(out, m)[l] = xi;
        IKB[(size_t)m * 64 + l] = f2bf(xi);
        if (l < 8) IW[(size_t)m * 8 + l] = bf2f(R.iw) * (0.35355339059327373f * 0.125f);
    }
}
__device__ __forceinline__ void att_post_rows(int gw, int nw, const bf16_t* P1, const float* qg, const float* kg, const float* ikg, bf16_t* KB, bf16_t* IKB, float* IW, float* out) {
    AttPostRegs R0, R1, R2;
    int m = gw;
    if (m < M) att_post_load(m, P1, R0);
    if (m + nw < M) att_post_load(m + nw, P1, R1);
    for (; m < M; m += 3 * nw) {
        if (m + 2 * nw < M) att_post_load(m + 2 * nw, P1, R2);
        att_post_finish(m, R0, qg, kg, ikg, KB, IKB, IW, out);
        if (m + nw < M) { if (m + 3 * nw < M) att_post_load(m + 3 * nw, P1, R0);
            att_post_finish(m + nw, R1, qg, kg, ikg, KB, IKB, IW, out); }
        if (m + 2 * nw < M) { if (m + 4 * nw < M) att_post_load(m + 4 * nw, P1, R1);
            att_post_finish(m + 2 * nw, R2, qg, kg, ikg, KB, IKB, IW, out); }
    }
}
}

namespace ix {
using mk::bf16_t; using mk::bf16x8; using mk::f32x16;
constexpr int TOPK = mk::TOPK;
constexpr float NEGINF = -__builtin_inff();
__device__ __forceinline__ float key2f(unsigned k) { return (k & 0x80000000u) ? __uint_as_float(k & 0x7FFFFFFFu) : __uint_as_float(~k); }

__device__ __forceinline__ void tile_partial(const bf16x8 (&af)[4], const bf16x8 (&bfr)[4], const float (&w)[16], float (&p)[4]) {
    f32x16 acc = {};
#pragma unroll
    for (int s = 0; s < 4; ++s) acc = __builtin_amdgcn_mfma_f32_32x32x16_bf16(af[s], bfr[s], acc, 0, 0, 0);
#pragma unroll
    for (int T = 0; T < 4; ++T) {
        float x = w[4 * T] * fmaxf(acc[4 * T], 0.f);
        x = fmaf(w[4 * T + 1], fmaxf(acc[4 * T + 1], 0.f), x);
        x = fmaf(w[4 * T + 2], fmaxf(acc[4 * T + 2], 0.f), x);
        x = fmaf(w[4 * T + 3], fmaxf(acc[4 * T + 3], 0.f), x);
        p[T] = x;
    }
}
__device__ __forceinline__ float pair_combine(float pa, float pb) {
    auto rr = __builtin_amdgcn_permlane32_swap(__float_as_uint(pa), __float_as_uint(pb), false, false);
    return __uint_as_float(rr[0]) + __uint_as_float(rr[1]);
}
__device__ __forceinline__ void load_af_w(const bf16_t* P1, const float* IW, int m0, int r, int hh, bf16x8 (&af)[4], float (&w)[16]) {
    const bf16_t* ap = P1 + (size_t)(m0 + (r >> 3)) * mk::N1P + mk::CIQ + (r & 7) * 64 + 8 * hh;
#pragma unroll
    for (int s = 0; s < 4; ++s) af[s] = *(const bf16x8*)(ap + 16 * s);
#pragma unroll
    for (int i = 0; i < 16; ++i) w[i] = IW[(size_t)(m0 + (i >> 2)) * 8 + (i & 3) + 4 * hh];
}

template <int NA, int NR, int MI = 0, class F> __device__ __forceinline__ void topk_select(const float (&sc)[NA], F&& emit) {
    unsigned lo = 0x007FFFFFu, hi = 0xFF800001u;
    float tau = NEGINF; bool exact = false;
    auto count_ge = [&](float tf) __attribute__((always_inline)) -> int {
        int c = 0;
#pragma unroll
        for (int k0 = 0; k0 < NR; k0 += 8) {
            unsigned long long bm[8];
#pragma unroll
            for (int q = 0; q < 8; ++q) bm[q] = (k0 + q < NR) ? __builtin_amdgcn_ballot_w64(sc[k0 + q < NR ? k0 + q : 0] >= tf) : 0ull;
            __builtin_amdgcn_sched_barrier(0);
#pragma unroll
            for (int q = 0; q < 8; ++q) c += __builtin_popcountll(bm[q]);
            __builtin_amdgcn_sched_barrier(0);
        }
        return c;
    };
    if (MI) {
        float mx = sc[0];
#pragma unroll
        for (int k = 1; k < NR; ++k) mx = fmaxf(mx, sc[k]);
        mx = fmaxf(mx, __int_as_float(__builtin_amdgcn_update_dpp(0, __float_as_int(mx), 0xB1, 0xF, 0xF, false)));
        mx = fmaxf(mx, __int_as_float(__builtin_amdgcn_update_dpp(0, __float_as_int(mx), 0x4E, 0xF, 0xF, false)));
        mx = fmaxf(mx, __int_as_float(__builtin_amdgcn_update_dpp(0, __float_as_int(mx), 0x124, 0xF, 0xF, false)));
        mx = fmaxf(mx, __int_as_float(__builtin_amdgcn_update_dpp(0, __float_as_int(mx), 0x128, 0xF, 0xF, false)));
        const int mi = __float_as_int(mx);
        const float m4 = fmaxf(fmaxf(__int_as_float(__builtin_amdgcn_readlane(mi, 0)), __int_as_float(__builtin_amdgcn_readlane(mi, 16))),
                               fmaxf(__int_as_float(__builtin_amdgcn_readlane(mi, 32)), __int_as_float(__builtin_amdgcn_readlane(mi, 48))));
        if (m4 > 1e-30f) {
            hi = (__float_as_uint(m4) | 0x80000000u) + 1u;
            const float tf = m4 * 0.0625f; const unsigned kf = __float_as_uint(tf) | 0x80000000u;
            const int c = count_ge(tf);
            if (c >= TOPK) { lo = kf; tau = tf; if (c == TOPK) { exact = true; hi = lo + 1u; } } else hi = kf;
        }
    }
    while (hi - lo > 1u) {
        const unsigned mid = lo + ((hi - lo) >> 1);
        const float tf = key2f(mid);
        const int c = count_ge(tf);
        if (c >= TOPK) { lo = mid; tau = tf; if (c == TOPK) { exact = true; break; } } else hi = mid;
    }
    if (exact) {
#pragma unroll
        for (int k = 0; k < NA; ++k) emit(k, k < NR ? __builtin_amdgcn_ballot_w64(sc[k] >= tau) : 0ull);
        return;
    }
    int cgt = 0;
#pragma unroll
    for (int k = 0; k < NR; ++k) cgt += __builtin_popcountll(__builtin_amdgcn_ballot_w64(sc[k] > tau));
    int need = TOPK - cgt;
#pragma unroll
    for (int k = 0; k < NA; ++k) {
        unsigned long long bm = 0ull;
        if (k < NR) {
            const unsigned long long gt = __builtin_amdgcn_ballot_w64(sc[k] > tau);
            unsigned long long eq = __builtin_amdgcn_ballot_w64(sc[k] == tau);
            int pc = __builtin_popcountll(eq);
            while (pc > need) { eq &= ~(1ull << (63 - __builtin_clzll(eq))); --pc; }
            need -= pc;
            bm = gt | eq;
        }
        emit(k, bm);
    }
}

__device__ __forceinline__ void index_prompt_block(int b, int gi, char* lds, const bf16_t* P1, const bf16_t* IKB, const float* IW, unsigned* MASK) {
    const int tid = mk::ltid(), w = __builtin_amdgcn_readfirstlane(tid >> 6), l = tid & 63, r = l & 31, hh = l >> 5;
    const int t0 = 32 * gi + 4 * w, m0 = b * mk::SEQ + t0;
    if (gi < 8) {
#pragma unroll
        for (int T = 0; T < 4; ++T) { const int nb = t0 + T + 1 - 32 * l; MASK[(size_t)(m0 + T) * 64 + l] = nb >= 32 ? 0xFFFFFFFFu : (nb <= 0 ? 0u : ((1u << nb) - 1u)); }
        return;
    }
    bf16x8 af[4]; float wt[16];
    load_af_w(P1, IW, m0, r, hh, af, wt);
    const int JP = (32 * gi + 31) / 64 + 1;
    const int skey = tid >> 3, sch = tid & 7;
    const bf16_t* gsrc = IKB + (size_t)(b * mk::SEQ + skey) * 64 + 8 * sch;
    const int sdst = (skey * 8 + (sch ^ ((skey >> 1) & 7))) * 16;
    const int rd0 = r * 128 + ((hh ^ ((r >> 1) & 1)) << 4), rda = ((r >> 1) & 6) << 4;
#define RDO(s) (rd0 + ((32 * (s)) ^ rda))
    float sc[4][32];
    uint4 stA, stB = make_uint4(0u, 0u, 0u, 0u);
    stA = *(const uint4*)gsrc;
    if (1 < JP) stB = *(const uint4*)(gsrc + (size_t)1 * 64 * 64);
    *(uint4*)(lds + sdst) = stA;
    __syncthreads();
#pragma unroll
    for (int jp = 0; jp < 32; ++jp) {
        if (jp < JP) {
            if (jp + 2 < JP) { if (jp & 1) stB = *(const uint4*)(gsrc + (size_t)(jp + 2) * 64 * 64); else stA = *(const uint4*)(gsrc + (size_t)(jp + 2) * 64 * 64); }
            const char* buf = lds + (jp & 1) * 8192;
            if (jp * 64 <= t0 + 3) {
                float pa[4], pb[4];
                { bf16x8 bfr[4];
#pragma unroll
                  for (int s = 0; s < 4; ++s) bfr[s] = *(const bf16x8*)(buf + RDO(s));
                  tile_partial(af, bfr, wt, pa); }
                { bf16x8 bfr[4];
#pragma unroll
                  for (int s = 0; s < 4; ++s) bfr[s] = *(const bf16x8*)(buf + RDO(s) + 4096);
                  tile_partial(af, bfr, wt, pb); }
#pragma unroll
                for (int T = 0; T < 4; ++T) {
                    float s = pair_combine(pa[T], pb[T]);
                    if (jp * 64 + 63 > t0) { if (jp * 64 + l > t0 + T) s = NEGINF; }
                    sc[T][jp] = s;
                }
            } else {
#pragma unroll
                for (int T = 0; T < 4; ++T) sc[T][jp] = NEGINF;
            }
            if (jp + 1 < JP) *(uint4*)(lds + ((jp + 1) & 1) * 8192 + sdst) = ((jp + 1) & 1) ? stB : stA;
            mk::lds_barrier();
        } else {
#pragma unroll
            for (int T = 0; T < 4; ++T) sc[T][jp] = NEGINF;
        }
    }
#define IX_SELECT(T) do { \
        unsigned wv = 0u; \
        auto put = [&](int k, unsigned long long bm) { const unsigned mine = (l & 1) ? (unsigned)(bm >> 32) : (unsigned)bm; wv = ((l >> 1) == k) ? mine : wv; }; \
        const int nreg = (t0 + (T)) / 64 + 1;                                    \
        if (nreg <= 8) topk_select<32, 8, 1>(sc[T], put); else if (nreg <= 16) topk_select<32, 16, 1>(sc[T], put); else if (nreg <= 24) topk_select<32, 24, 1>(sc[T], put); else topk_select<32, 32, 1>(sc[T], put); \
        MASK[(size_t)(m0 + (T)) * 64 + l] = wv; \
    } while (0)
    IX_SELECT(0); IX_SELECT(1); IX_SELECT(2); IX_SELECT(3);
#undef IX_SELECT
}

constexpr int SCR_BYTES = 8 * 2048 * 4, SCX_OFF = SCR_BYTES;
__device__ __forceinline__ void index_sample_block(int b, int kc, char* lds, const bf16_t* P1, const bf16_t* IKB, const float* IW, const float* cache_ik, const int* page_table, float* CS, int* CI) {
    const int tid = mk::ltid(), w = __builtin_amdgcn_readfirstlane(tid >> 6), l = tid & 63, r = l & 31, hh = l >> 5;
    const int m0 = mk::MP + b * mk::DS;
    float* scr = (float*)lds; float* scx = (float*)(lds + SCX_OFF);
    bf16x8 afA[4], afB[4]; float wtA[16], wtB[16];
    load_af_w(P1, IW, m0, r, hh, afA, wtA);
    load_af_w(P1, IW, m0 + 4, r, hh, afB, wtB);
    const int kbase = 2048 * kc + 256 * w;
    const int pg0 = __builtin_amdgcn_readfirstlane(page_table[b * mk::NPG + (kbase >> 7)]), pg1 = __builtin_amdgcn_readfirstlane(page_table[b * mk::NPG + (kbase >> 7) + 1]);
    const float* kp0 = cache_ik + ((size_t)pg0 * mk::PAGE + r) * 64 + 8 * hh;
    const float* kp1 = cache_ik + ((size_t)pg1 * mk::PAGE + r) * 64 + 8 * hh;
    float4 ring[3][8];
#define SI_LOAD(slot, tl_) do { const float* p_ = (((tl_) >> 2) ? kp1 : kp0) + ((tl_) & 3) * 32 * 64; _Pragma("unroll") for (int s = 0; s < 4; ++s) { ring[slot][2 * s] = *(const float4*)(p_ + 16 * s); ring[slot][2 * s + 1] = *(const float4*)(p_ + 16 * s + 4); } } while (0)
    SI_LOAD(0, 0); SI_LOAD(1, 1); SI_LOAD(2, 2);
    float pA[4] = {0.f, 0.f, 0.f, 0.f}, pB[4] = {0.f, 0.f, 0.f, 0.f};
#pragma unroll
    for (int tl = 0; tl < 8; ++tl) {
        bf16x8 bfr[4];
#pragma unroll
        for (int s = 0; s < 4; ++s) { const float4 x = ring[tl % 3][2 * s], y = ring[tl % 3][2 * s + 1];
            mk::u32x4_t u = {mk::cvtpk_native(x.x, x.y), mk::cvtpk_native(x.z, x.w), mk::cvtpk_native(y.x, y.y), mk::cvtpk_native(y.z, y.w)}; bfr[s] = *reinterpret_cast<bf16x8*>(&u); }
        if (tl + 3 < 8) SI_LOAD(tl % 3, tl + 3);
        float qa[4], qb[4];
        tile_partial(afA, bfr, wtA, qa);
        tile_partial(afB, bfr, wtB, qb);
        if (tl & 1) {
#pragma unroll
            for (int T = 0; T < 4; ++T) { scr[T * 2048 + 256 * w + 32 * (tl - 1) + l] = pair_combine(pA[T], qa[T]); scr[(4 + T) * 2048 + 256 * w + 32 * (tl - 1) + l] = pair_combine(pB[T], qb[T]); }
        } else {
#pragma unroll
            for (int T = 0; T < 4; ++T) { pA[T] = qa[T]; pB[T] = qb[T]; }
        }
    }
#undef SI_LOAD
    if (kc == 7 && w < 2) {
        bf16x8 bfr[4];
#pragma unroll
        for (int s = 0; s < 4; ++s) { bfr[s] = bf16x8{}; if (r < mk::DS) bfr[s] = *(const bf16x8*)(IKB + (size_t)(mk::MP + b * mk::DS + r) * 64 + 16 * s + 8 * hh); }
        float p[4];
        if (w == 0) tile_partial(afA, bfr, wtA, p); else tile_partial(afB, bfr, wtB, p);
#pragma unroll
        for (int T = 0; T < 4; ++T) { const float s = pair_combine(p[T], p[T]); if (l < mk::DS) scx[(4 * w + T) * 8 + l] = (l <= 4 * w + T) ? s : NEGINF; }
    }
    __syncthreads();
    {
        const int tok = w;
        float sc[33];
#pragma unroll
        for (int k = 0; k < 32; ++k) sc[k] = scr[tok * 2048 + 64 * k + l];
        sc[32] = (kc == 7 && l < mk::DS) ? scx[tok * 8 + l] : NEGINF;
        float* cs = CS + ((size_t)(b * mk::DS + tok) * 8 + kc) * TOPK; int* ci = CI + ((size_t)(b * mk::DS + tok) * 8 + kc) * TOPK;
        int run = 0;
        topk_select<33, 33>(sc, [&](int k, unsigned long long bm) {
            const bool mine = (bm >> l) & 1ull;
            const int pos = run + __builtin_popcountll(bm & ((1ull << l) - 1ull));
            if (mine) { cs[pos] = sc[k]; ci[pos] = (k < 32) ? 2048 * kc + 64 * k + l : mk::PAST + l; }
            run += __builtin_popcountll(bm);
        });
    }
    __syncthreads();
}

__device__ __forceinline__ void merge_sample_row(int r, const float* CS, const int* CI, const int* page_table, int* rowi) {
    const int l = mk::ltid() & 63, b = r / mk::DS;
    float sc[32];
    const float* cs = CS + (size_t)r * 8 * TOPK; const int* ci = CI + (size_t)r * 8 * TOPK;
#pragma unroll
    for (int k = 0; k < 32; ++k) sc[k] = cs[64 * k + l];
    int run = 0;
    topk_select<32, 32>(sc, [&](int k, unsigned long long bm) {
        const bool mine = (bm >> l) & 1ull;
        const int pos = run + __builtin_popcountll(bm & ((1ull << l) - 1ull));
        if (mine) { const int idx = ci[64 * k + l];
            rowi[pos] = idx < mk::PAST ? page_table[b * mk::NPG + idx / mk::PAGE] * mk::PAGE + (idx % mk::PAGE) : -(b * mk::DS + (idx - mk::PAST)) - 1; }
        run += __builtin_popcountll(bm);
    });
}
}

namespace dsa {
using mk::bf16_t;
typedef short bf16x8 __attribute__((ext_vector_type(8)));
typedef short s16x4 __attribute__((ext_vector_type(4)));
typedef float f32x16 __attribute__((ext_vector_type(16)));
typedef float f32x4 __attribute__((ext_vector_type(4)));
typedef unsigned u32x4 __attribute__((ext_vector_type(4)));
constexpr float SCALE = 0.08838834764831845f;
constexpr float THR = 8.f;
constexpr int NW = 8, QBLK = 32, KVBLK = 64, HDIM = 128;
constexpr int SHM_V = KVBLK * HDIM * 2, SHM_K = KVBLK * HDIM * 2;
constexpr int LDS_BYTES = 2 * SHM_V + 2 * SHM_K + NW * 64 * 4;

#define KSWZ(row, colB) ((row) * 256 + ((colB) ^ (((row) & 7) << 4)))
#define SBAR() __builtin_amdgcn_sched_barrier(0)
__device__ __forceinline__ int v_st(int k, int c) { const int kk = (k & ~0xC) | ((k & 4) << 1) | ((k & 8) >> 1); return ((kk >> 3) * 4 + (c >> 5)) * 512 + ((kk & 7) * 32 + (c & 31)) * 2; }
__device__ __forceinline__ int v_rd_base(int lane) { return ((lane & 3) << 3) | (((lane >> 2) & 3) << 6) | (((lane >> 4) & 1) << 5) | (((lane >> 5) & 1) << 8); }
constexpr int v_rd_off(int d0, int ks, int half) { return d0 * 512 + ks * 4096 + half * 2048; }
__device__ __forceinline__ int crow(int r, int hi) { return (r & 3) + 8 * (r >> 2) + 4 * hi; }
__device__ __forceinline__ unsigned cvtpk(float lo, float hi) { return mk::cvtpk_native(lo, hi); }

__device__ __forceinline__ void partialSM(f32x16& p0, f32x16& p1, float& m_reg, float& mn, float& alpha) {
    float pmax = p0[0]; for (int r = 1; r < 16; ++r) pmax = fmaxf(pmax, p0[r]); for (int r = 0; r < 16; ++r) pmax = fmaxf(pmax, p1[r]);
    { auto rr = __builtin_amdgcn_permlane32_swap(__float_as_uint(pmax), __float_as_uint(pmax), false, false);
      pmax = fmaxf(__uint_as_float(rr[0]), __uint_as_float(rr[1])); }
    constexpr float C2 = 1.4426950408889634f * SCALE;
    if (__builtin_expect(__all((pmax - m_reg) * SCALE <= THR), 1)) { mn = m_reg; alpha = 1.f; }
    else { mn = fmaxf(m_reg, pmax); alpha = __builtin_amdgcn_exp2f((m_reg - mn) * C2); m_reg = mn; }
    const float mnL = -mn * C2;
    for (int r = 0; r < 16; ++r) p0[r] = fmaf(p0[r], C2, mnL); for (int r = 0; r < 16; ++r) p1[r] = fmaf(p1[r], C2, mnL);
    for (int r = 0; r < 16; ++r) p0[r] = __builtin_amdgcn_exp2f(p0[r]);
}
__device__ __forceinline__ void finishSM(f32x16& p0, f32x16& p1, float alpha, float& l_reg, uint2 mw, int hi, bf16x8& pa0, bf16x8& pa1, bf16x8& pa2, bf16x8& pa3) {
    for (int r = 0; r < 16; ++r) p1[r] = __builtin_amdgcn_exp2f(p1[r]);
    const int w0 = (int)(mw.x >> (4 * hi)), w1 = (int)(mw.y >> (4 * hi));
#pragma unroll
    for (int r = 0; r < 16; ++r) {
        const int c = (r & 3) + 8 * (r >> 2);
        int b0 = __builtin_amdgcn_sbfe(w0, c, 1), b1 = __builtin_amdgcn_sbfe(w1, c, 1);
        asm volatile("" : "+v"(b0), "+v"(b1));
        p0[r] = __uint_as_float(__float_as_uint(p0[r]) & (unsigned)b0);
        p1[r] = __uint_as_float(__float_as_uint(p1[r]) & (unsigned)b1);
    }
    float ps = 0; for (int r = 0; r < 16; ++r) ps += p0[r]; for (int r = 0; r < 16; ++r) ps += p1[r];
    { auto rr = __builtin_amdgcn_permlane32_swap(__float_as_uint(ps), __float_as_uint(ps), false, false);
      ps = __uint_as_float(rr[0]) + __uint_as_float(rr[1]); }
    l_reg = l_reg * alpha + ps;
#define PK4(P, B_, OUT) do { unsigned a0 = cvtpk(P[B_+0], P[B_+1]), a1 = cvtpk(P[B_+2], P[B_+3]);                          \
        unsigned b0 = cvtpk(P[B_+4], P[B_+5]), b1 = cvtpk(P[B_+6], P[B_+7]);                                             \
        auto r0 = __builtin_amdgcn_permlane32_swap(a0, b0, false, false); auto r1 = __builtin_amdgcn_permlane32_swap(a1, b1, false, false); \
        u32x4 w = {r0[0], r1[0], r0[1], r1[1]}; OUT = *reinterpret_cast<bf16x8*>(&w); } while (0)
    PK4(p0, 0, pa0); PK4(p0, 8, pa1); PK4(p1, 0, pa2); PK4(p1, 8, pa3);
#undef PK4
}
template <int KB>
__device__ __forceinline__ void qkt(f32x16& p0, f32x16& p1, const char* K_lds, int r32, int hi, const bf16x8* qr) {
    p0 = f32x16{}; p1 = f32x16{};
    const char* kb[4];
#pragma unroll
    for (int dd = 0; dd < 4; ++dd) kb[dd] = K_lds + KB * SHM_K + KSWZ(r32, (dd * 16 + hi * 8) * 2);
#pragma unroll
    for (int d0 = 0; d0 < 8; ++d0) { const char* a = kb[d0 & 3] + (d0 >> 2) * 128;
        bf16x8 b0 = *reinterpret_cast<const bf16x8*>(a);
        bf16x8 b1 = *reinterpret_cast<const bf16x8*>(a + 32 * 256);
        p0 = __builtin_amdgcn_mfma_f32_32x32x16_bf16(b0, qr[d0], p0, 0, 0, 0);
        p1 = __builtin_amdgcn_mfma_f32_32x32x16_bf16(b1, qr[d0], p1, 0, 0, 0); }
}
template <int VB>
__device__ __forceinline__ void pv_tile(f32x16* o, int vb0, bf16x8 pa0, bf16x8 pa1, bf16x8 pa2, bf16x8 pa3) {
#define TRRD(dst, off) asm volatile("ds_read_b64_tr_b16 %0, %1 offset:%2" : "=&v"(dst) : "v"(vb0), "i"(off) : "memory")
#define PV_D0(d0) do { s16x4 l0, l1, l2, l3, h0, h1, h2, h3; constexpr int b_ = VB * SHM_V + v_rd_off(d0, 0, 0);   \
        TRRD(l0, b_); TRRD(h0, b_ + 2048); TRRD(l1, b_ + 4096); TRRD(h1, b_ + 6144); TRRD(l2, b_ + 8192); TRRD(h2, b_ + 10240); TRRD(l3, b_ + 12288); TRRD(h3, b_ + 14336); \
        asm volatile("s_waitcnt lgkmcnt(0)" ::: "memory"); SBAR();   \
        o[d0] = __builtin_amdgcn_mfma_f32_32x32x16_bf16(pa0, (bf16x8){l0[0], l0[1], l0[2], l0[3], h0[0], h0[1], h0[2], h0[3]}, o[d0], 0, 0, 0);   \
        o[d0] = __builtin_amdgcn_mfma_f32_32x32x16_bf16(pa1, (bf16x8){l1[0], l1[1], l1[2], l1[3], h1[0], h1[1], h1[2], h1[3]}, o[d0], 0, 0, 0);   \
        o[d0] = __builtin_amdgcn_mfma_f32_32x32x16_bf16(pa2, (bf16x8){l2[0], l2[1], l2[2], l2[3], h2[0], h2[1], h2[2], h2[3]}, o[d0], 0, 0, 0);   \
        o[d0] = __builtin_amdgcn_mfma_f32_32x32x16_bf16(pa3, (bf16x8){l3[0], l3[1], l3[2], l3[3], h3[0], h3[1], h3[2], h3[3]}, o[d0], 0, 0, 0); } while (0)
    PV_D0(0); PV_D0(1); PV_D0(2); PV_D0(3);
#undef PV_D0
#undef TRRD
}

struct Tensors { const float* QSS; const bf16_t* KB; const bf16_t* P1; const unsigned* MASK; bf16_t* AO; };
struct Blk { int b, g, qc; };
struct Seam { bf16x8 qr[8]; bf16x8 st_v0, st_v1, st_k0, st_k1; float qss; };
__device__ __forceinline__ const bf16_t* q_row(const Tensors& T, const Blk& k, int wid, int r32) { return T.P1 + (size_t)(k.b * mk::SEQ + k.qc * 64 + (wid & 1) * 32 + r32) * mk::N1P + mk::CQ + (4 * k.g + (wid >> 1)) * 128; }
__device__ __forceinline__ const float* qss_ptr(const Tensors& T, const Blk& k, int wid, int r32) { return T.QSS + (size_t)(k.b * mk::SEQ + k.qc * 64 + (wid & 1) * 32 + r32) * 8 + (4 * k.g + (wid >> 1)); }
__device__ __forceinline__ const bf16_t* k_row(const Tensors& T, const Blk& k, int key) { return T.KB + (size_t)(k.b * mk::SEQ + key) * 256 + k.g * 128; }
__device__ __forceinline__ const bf16_t* v_row(const Tensors& T, const Blk& k, int key) { return T.P1 + (size_t)(k.b * mk::SEQ + key) * mk::N1P + mk::CV + k.g * 128; }

#define VMW() asm volatile("s_waitcnt vmcnt(0)" ::: "memory")
#define VMWN(n) asm volatile("s_waitcnt vmcnt(%0)" :: "i"(n) : "memory")
#define SLOAD_H(blk, k0) do { S.st_v0 = *(const bf16x8*)(v_row(T, blk, (k0) + sr) + sc); S.st_v1 = *(const bf16x8*)(v_row(T, blk, (k0) + 32 + sr) + sc);   \
                              S.st_k0 = *(const bf16x8*)(k_row(T, blk, (k0) + sr) + sc); S.st_k1 = *(const bf16x8*)(k_row(T, blk, (k0) + 32 + sr) + sc); } while (0)
#define SWRITE_HK(bf) do { *(bf16x8*)(K_lds + (bf) * SHM_K + kws) = S.st_k0; *(bf16x8*)(K_lds + (bf) * SHM_K + kws + 32 * 256) = S.st_k1; } while (0)
#define SWRITE_HV(bf) do { *(bf16x8*)(V_lds + (bf) * SHM_V + vst0) = S.st_v0; *(bf16x8*)(V_lds + (bf) * SHM_V + vst0 + VST1) = S.st_v1; } while (0)
#define SWRITE_H(bf) do { SWRITE_HV(bf); SWRITE_HK(bf); } while (0)

__device__ __forceinline__ void dsa_prime(const Tensors& T, const Blk& cur, char* lds, Seam& S) {
    const int tid = mk::ltid(), wid = __builtin_amdgcn_readfirstlane(tid >> 6), lane = tid & 63, r32 = lane & 31, hi = lane >> 5;
    const int sr = tid >> 4, sc = (tid & 15) * 8, kws = KSWZ(sr, sc * 2); char* K_lds = lds + 2 * SHM_V;
    const bf16_t* qp = q_row(T, cur, wid, r32) + hi * 8;
    for (int d0 = 0; d0 < 8; ++d0) S.qr[d0] = *(const bf16x8*)(qp + d0 * 16);
    S.qss = *qss_ptr(T, cur, wid, r32);
    SLOAD_H(cur, 0); VMW(); SWRITE_HK(0);
    __syncthreads();
}
__device__ __forceinline__ void dsa_block(const Tensors& T, const Blk& cur, const Blk& nxt, char* lds, Seam& S) {
    const int tid = mk::ltid(), wid = __builtin_amdgcn_readfirstlane(tid >> 6), lane = tid & 63, r32 = lane & 31, hi = lane >> 5;
    const int NT = cur.qc + 1;
    char* V_lds = lds; char* K_lds = lds + 2 * SHM_V;
    float* ws = (float*)(lds + 2 * SHM_V + 2 * SHM_K) + wid * 64; float* li_l = ws, * al_l = ws + 32;
    float m_reg = -1e30f, l_reg = 0; f32x16 o[4] = {};
    const int sr = tid >> 4, sc = (tid & 15) * 8, vst0 = v_st(sr, sc), kws = KSWZ(sr, sc * 2);
    constexpr int VST1 = 8192;
    const int vb0 = (int)(uintptr_t)V_lds + v_rd_base(lane);
    const int qtok = cur.b * mk::SEQ + cur.qc * 64 + (wid & 1) * 32;
    const int moff = (qtok + r32) * 64;
#define LDMASK(t) (*(const uint2*)(T.MASK + (moff + 2 * (t))))
#define RESC(a) do { if (__any((a) < 1.f)) { if (hi == 0) al_l[r32] = (a); asm volatile("s_waitcnt lgkmcnt(0)" ::: "memory");              \
                     for (int d_ = 0; d_ < 4; ++d_) for (int r = 0; r < 16; ++r) o[d_][r] *= al_l[crow(r, hi)]; } } while (0)
#define KBASE(t) ((t) * KVBLK)
    constexpr int NQL = 9;
#define SEAM_K0() do { VMWN(NQL); SWRITE_HK(0); SBAR(); } while (0)
    f32x16 pA0, pA1, pB0, pB1; float mnA, mnB, alA, alB; bf16x8 pa0, pa1, pa2, pa3; uint2 mcur;
    {
        const float rs = rsqrtf(S.qss * (1.0f / 128) + mk::EPS);
#pragma unroll
        for (int d0 = 0; d0 < 8; ++d0) { u32x4 u = *reinterpret_cast<u32x4*>(&S.qr[d0]);
#pragma unroll
            for (int e = 0; e < 4; ++e) u[e] = cvtpk(__uint_as_float(u[e] << 16) * rs, __uint_as_float(u[e] & 0xFFFF0000u) * rs);
            S.qr[d0] = *reinterpret_cast<bf16x8*>(&u); }
    }
    SWRITE_HV(0); SBAR();
    if (NT > 1) { SLOAD_H(cur, KBASE(1)); }
    SBAR(); qkt<0>(pA0, pA1, K_lds, r32, hi, S.qr); mcur = LDMASK(0);
    partialSM(pA0, pA1, m_reg, mnA, alA);
    if (NT > 1) { VMW(); SWRITE_H(1); }
    __syncthreads();
#define HALF_STEP(PX0, PX1, mnX, alX, PY0, PY1, alY, t, KB, VB, SB) do {                                             \
        SBAR(); qkt<KB>(PX0, PX1, K_lds, r32, hi, S.qr);                                                                       \
        finishSM(PY0, PY1, alY, l_reg, mcur, hi, pa0, pa1, pa2, pa3); mcur = LDMASK(t); SBAR();                                                   \
        if ((t) + 1 < NT) { SLOAD_H(cur, KBASE((t) + 1)); SBAR(); }                                                           \
        pv_tile<VB>(o, vb0, pa0, pa1, pa2, pa3); partialSM(PX0, PX1, m_reg, mnX, alX);                                        \
        __syncthreads();                                                                                                      \
        if ((t) + 1 < NT) { VMW(); SWRITE_H(SB); }                                                                            \
        RESC(alX); __syncthreads(); } while (0)
    for (int t = 1; t + 1 < NT; t += 2) {
        HALF_STEP(pB0, pB1, mnB, alB, pA0, pA1, alA, t, 1, 0, 0);
        HALF_STEP(pA0, pA1, mnA, alA, pB0, pB1, alB, t + 1, 0, 1, 1);
    }
    const bool even = (NT & 1) == 0;
    if (even) { SBAR(); qkt<1>(pB0, pB1, K_lds, r32, hi, S.qr); SBAR(); }
    SLOAD_H(nxt, 0); SBAR();
    { const bf16_t* qp = q_row(T, nxt, wid, r32) + hi * 8;
#pragma unroll
      for (int d0 = 0; d0 < 8; ++d0) S.qr[d0] = *(const bf16x8*)(qp + d0 * 16);
      S.qss = *qss_ptr(T, nxt, wid, r32); }
    SBAR();
    finishSM(pA0, pA1, alA, l_reg, mcur, hi, pa0, pa1, pa2, pa3); if (even) mcur = LDMASK(NT - 1); SBAR();
    pv_tile<0>(o, vb0, pa0, pa1, pa2, pa3);
    if (even) { partialSM(pB0, pB1, m_reg, mnB, alB); __syncthreads(); RESC(alB);
        finishSM(pB0, pB1, alB, l_reg, mcur, hi, pa0, pa1, pa2, pa3); SBAR(); pv_tile<1>(o, vb0, pa0, pa1, pa2, pa3); }
    SBAR(); SEAM_K0();
    if (hi == 0) li_l[r32] = l_reg; asm volatile("s_waitcnt lgkmcnt(0)" ::: "memory");
    { const int le = mk::ltid() & 63, re = le & 31, he = le >> 5;
      const int hq = 4 * cur.g + (wid >> 1);
#pragma unroll
      for (int r = 0; r < 16; ++r) { const int orow = crow(r, he); const size_t tok = (size_t)(qtok + orow);
        const float rl = __builtin_amdgcn_rcpf(li_l[orow]);
        const bf16_t* gp = T.P1 + tok * mk::N1P + mk::CG + hq * 128 + re;
        bf16_t* op = T.AO + tok * mk::D + hq * 128 + re;
#pragma unroll
        for (int d0 = 0; d0 < 4; ++d0) { const float gt = mk::bf2f(gp[d0 * 32]);
            const float v = o[d0][r] * rl * (gt * __builtin_amdgcn_rcpf(1.0f + __builtin_amdgcn_exp2f(-1.4426950408889634f * gt)));
            const float vn = __int_as_float(__builtin_amdgcn_update_dpp(0, __float_as_int(v), 0xB1, 0xF, 0xF, false));
            if ((re & 1) == 0) *(unsigned*)(op + d0 * 32) = cvtpk(v, vn); } } }
    __syncthreads();
#undef LDMASK
#undef RESC
#undef KBASE
#undef SEAM_K0
#undef HALF_STEP
}
#undef VMW
#undef VMWN
#undef SLOAD_H
#undef SWRITE_HK
#undef SWRITE_HV
#undef SWRITE_H

__device__ __forceinline__ void attn_prompt_phase(const Tensors& T, char* lds, int bid, int nblk) {
    constexpr int NITEM = 256;
    if (bid >= NITEM) return;
    int id = bid, pass = 0;
    Blk cur{id & 7, (id >> 3) & 1, 31 - (id >> 4)};
    Seam S;
    dsa_prime(T, cur, lds, S);
    for (;;) {
        const bool more_pass = pass == 0, more_item = id + nblk < NITEM, last = !more_pass && !more_item;
        int idn = id, passn = pass + 1;
        if (!more_pass) { passn = 0; idn = more_item ? id + nblk : id; }
        Blk nxt = cur;
        if (!last) { nxt.b = idn & 7; nxt.g = (idn >> 3) & 1; nxt.qc = passn ? (idn >> 4) : 31 - (idn >> 4); }
        dsa_block(T, cur, nxt, lds, S);
        if (last) break;
        cur = nxt; id = idn; pass = passn;
    }
}
}

namespace dn {
using mk::bf16_t;
typedef short bf16x8 __attribute__((ext_vector_type(8)));
typedef float f32x16 __attribute__((ext_vector_type(16)));
constexpr int NITEM = mk::NB * 8 * 32;
constexpr size_t IT_W = 0, IT_QD = 16384, IT_KDT = 32768, IT_U0T = 49152, IT_QKD = 65536, IT_BYTES = 73728;
constexpr int L_KR = 0, L_QR = 17408, L_KT = 34816, L_VT = 53248, L_AM = 71680, L_TW = 89088, L_TU = 98304, L_SC = 107520, L_END = 108032;
constexpr int RS = 272;
constexpr int TS = 144;
constexpr int L_SK = 108032, L_SU = L_SK + 128 * 144, L_SEND = L_SU + 128 * 136, L_SW = L_AM;
static_assert(L_SEND <= 147456 - 16, "pre-phase LDS map");

__device__ __forceinline__ int crow(int r, int hi) { return (r & 3) + 8 * (r >> 2) + 4 * hi; }
__device__ __forceinline__ unsigned cvtpk(float lo, float hi) { return mk::cvtpk_native(lo, hi); }
__device__ __forceinline__ float silu_f(float x) { return x * __builtin_amdgcn_rcpf(1.0f + __builtin_amdgcn_exp2f(-1.4426950408889634f * x)); }
__device__ __forceinline__ float quad_sum(float v) {
    v += __int_as_float(__builtin_amdgcn_update_dpp(0, __float_as_int(v), 0xB1, 0xF, 0xF, false));
    v += __int_as_float(__builtin_amdgcn_update_dpp(0, __float_as_int(v), 0x4E, 0xF, 0xF, false));
    return v;
}

struct PreArgs { const bf16_t* P2; const float* BA; const float* conv_w; const float* A_log; const float* dt_bias; unsigned char* CH; float* EG; float* out; };

struct PreRaw { unsigned x[3][11]; float wc[3][4][2]; float bv, av; };
__device__ __forceinline__ void pre_load(const PreArgs& a, int item, PreRaw& R) {
    const int tid = mk::ltid(), w = __builtin_amdgcn_readfirstlane(tid >> 6), l = tid & 63;
    const int c = item & 31, h = (item >> 5) & 7, b = item >> 8;
    const int m0 = b * mk::SEQ + c * 64;
    R.bv = a.BA[(size_t)(m0 + l) * 16 + h]; R.av = a.BA[(size_t)(m0 + l) * 16 + 8 + h];
#pragma unroll
    for (int part = 0; part < 3; ++part) {
        const int colb = part * 1024 + h * 128 + 2 * l;
#pragma unroll
        for (int i = 0; i < 4; ++i) { const float2 t = *(const float2*)(a.conv_w + (size_t)i * mk::CONV + colb); R.wc[part][i][0] = t.x; R.wc[part][i][1] = t.y; }
#pragma unroll
        for (int k = 0; k < 11; ++k) {
            const int rl = 8 * w + k - 3;
            unsigned u = 0u;
            if (rl >= 0 || c > 0) u = __builtin_nontemporal_load((const unsigned*)(a.P2 + (size_t)(m0 + rl) * mk::N3P + colb));
            R.x[part][k] = u;
        }
    }
}
__device__ __forceinline__ void pre_item(const PreArgs& a, int item, int next, char* lds, PreRaw& R) {
    const int tid = mk::ltid(), w = __builtin_amdgcn_readfirstlane(tid >> 6), l = tid & 63, r32 = l & 31, hh = l >> 5;
    const int c = item & 31, h = (item >> 5) & 7, b = item >> 8;
    const int m0 = b * mk::SEQ + c * 64;
    unsigned char* ch = a.CH + (size_t)item * IT_BYTES;
    float* sc_beta = (float*)(lds + L_SC); float* sc_gc = sc_beta + 64;
    float beta_l, gc_l;
    {
        const float bv = R.bv, av = R.av;
        beta_l = __builtin_amdgcn_rcpf(1.0f + __expf(-bv));
        const float x = av + a.dt_bias[h];
        const float sp = x > 20.f ? x : log1pf(__expf(x));
        float g = -__expf(a.A_log[h]) * sp;
#pragma unroll
        for (int o = 1; o < 64; o <<= 1) { const float t = __shfl_up(g, o); if (l >= o) g += t; }
        gc_l = g;
    }
    const float gc_last = __shfl(gc_l, 63);
    if (w == 0) { sc_beta[l] = beta_l; sc_gc[l] = gc_l; if (l == 0) a.EG[item] = __expf(gc_last); }
    {
        float sq[8][2], sk[8][2], sv[8][2];
#pragma unroll
        for (int part = 0; part < 3; ++part) {
            const int colb = part * 1024 + h * 128 + 2 * l;
            float wc[4][2];
#pragma unroll
            for (int i = 0; i < 4; ++i) { wc[i][0] = R.wc[part][i][0]; wc[i][1] = R.wc[part][i][1]; }
            float x[11][2];
#pragma unroll
            for (int k = 0; k < 11; ++k) { const unsigned u = R.x[part][k]; x[k][0] = __uint_as_float(u << 16); x[k][1] = __uint_as_float(u & 0xFFFF0000u); }
            if (c == 31 && w == 7) {
#pragma unroll
                for (int j = 0; j < 3; ++j) *(float2*)(a.out + mk::O_CP + ((size_t)b * 3 + j) * mk::CONV + colb) = make_float2(x[8 + j][0], x[8 + j][1]);
            }
#pragma unroll
            for (int rr = 0; rr < 8; ++rr) {
#pragma unroll
                for (int e = 0; e < 2; ++e) {
                    float y = wc[0][e] * x[rr][e]; y = fmaf(wc[1][e], x[rr + 1][e], y); y = fmaf(wc[2][e], x[rr + 2][e], y); y = fmaf(wc[3][e], x[rr + 3][e], y);
                    const float s = silu_f(y);
                    if (part == 0) sq[rr][e] = s; else if (part == 1) sk[rr][e] = s; else sv[rr][e] = s;
                }
            }
        }
        if (next >= 0) pre_load(a, next, R);
        float nq[8], nk[8];
#pragma unroll
        for (int rr = 0; rr < 8; ++rr) { nq[rr] = sq[rr][0] * sq[rr][0] + sq[rr][1] * sq[rr][1]; nk[rr] = sk[rr][0] * sk[rr][0] + sk[rr][1] * sk[rr][1]; }
        mk::wave_sum_n<8>(nq); mk::wave_sum_n<8>(nk);
        unsigned ktp[2][4], vtp[2][4], kdp[2][4];
#pragma unroll
        for (int rr = 0; rr < 8; ++rr) {
            const int i = 8 * w + rr;
            const float rq = rsqrtf(nq[rr] + mk::EPS) * 0.08838834764831845f;
            const float rk = rsqrtf(nk[rr] + mk::EPS);
            const float gci = __shfl(gc_l, i);
            const float eg = __expf(gci), egl = __expf(gc_last - gci);
            const float q0 = sq[rr][0] * rq, q1 = sq[rr][1] * rq, k0 = sk[rr][0] * rk, k1 = sk[rr][1] * rk;
            *(unsigned*)(lds + L_QR + i * RS + 4 * l) = cvtpk(q0, q1);
            *(unsigned*)(lds + L_KR + i * RS + 4 * l) = cvtpk(k0, k1);
            *(unsigned*)(ch + IT_QD + (size_t)i * 256 + 4 * l) = cvtpk(q0 * eg, q1 * eg);
            if ((rr & 1) == 0) { sq[rr][0] = k0; sq[rr][1] = k1; }
            else {
                ktp[0][rr >> 1] = cvtpk(sq[rr - 1][0], k0); ktp[1][rr >> 1] = cvtpk(sq[rr - 1][1], k1);
                vtp[0][rr >> 1] = cvtpk(sv[rr - 1][0], sv[rr][0]); vtp[1][rr >> 1] = cvtpk(sv[rr - 1][1], sv[rr][1]);
                const float gcp = __shfl(gc_l, i - 1); const float eglp = __expf(gc_last - gcp);
                kdp[0][rr >> 1] = cvtpk(sq[rr - 1][0] * eglp, k0 * egl); kdp[1][rr >> 1] = cvtpk(sq[rr - 1][1] * eglp, k1 * egl);
            }
        }
#pragma unroll
        for (int e = 0; e < 2; ++e) {
            *(uint4*)(lds + L_KT + (2 * l + e) * TS + 16 * w) = make_uint4(ktp[e][0], ktp[e][1], ktp[e][2], ktp[e][3]);
            *(uint4*)(lds + L_VT + (2 * l + e) * TS + 16 * w) = make_uint4(vtp[e][0], vtp[e][1], vtp[e][2], vtp[e][3]);
            *(uint4*)(lds + L_SK + (2 * l + e) * 144 + 16 * w) = make_uint4(kdp[e][0], kdp[e][1], kdp[e][2], kdp[e][3]);
        }
    }
    mk::lds_barrier();
#pragma unroll
    for (int j = 0; j < 2; ++j) { const int pc = tid + 512 * j;
        *(uint4*)(ch + IT_KDT + (size_t)16 * pc) = *(const uint4*)(lds + L_SK + (pc >> 3) * 144 + 16 * (pc & 7)); }
    if (w < 6) {
        const int kind = w >= 3, tix = kind ? w - 3 : w, ti = tix > 0, tj = tix > 1;
        const char* ap = lds + (kind ? L_QR : L_KR) + (32 * ti + r32) * RS + 16 * hh;
        const char* bp = lds + L_KR + (32 * tj + r32) * RS + 16 * hh;
        f32x16 acc = {};
#pragma unroll
        for (int s = 0; s < 8; ++s) acc = __builtin_amdgcn_mfma_f32_32x32x16_bf16(*(const bf16x8*)(ap + 32 * s), *(const bf16x8*)(bp + 32 * s), acc, 0, 0, 0);
        const int j = 32 * tj + r32; const float gcj = sc_gc[j];
#pragma unroll
        for (int r = 0; r < 16; ++r) {
            const int i = 32 * ti + crow(r, hh);
            const float dec = __expf(sc_gc[i] - gcj);
            if (!kind) { const float v = (i > j) ? sc_beta[i] * acc[r] * dec : 0.f; *(float*)(lds + L_AM + i * RS + 4 * j) = v; }
            else { const float v = (i >= j) ? acc[r] * dec : 0.f; const float vn = __shfl_xor(v, 1);
                   if ((r32 & 1) == 0) *(unsigned*)(ch + IT_QKD + (size_t)i * 128 + 2 * j) = cvtpk(v, vn); }
        }
    } else if (w == 6) {
#pragma unroll
        for (int k = 0; k < 16; ++k) { const int e = l + 64 * k; *(float*)(lds + L_AM + (e >> 5) * RS + 4 * (32 + (e & 31))) = 0.f; }
    }
    mk::lds_barrier();
    constexpr int L_T1T = L_KR, L_TBR = L_KR + 2560, L_P3T = L_KR + 5120;
    if (w < 2) {
        const int blk = w, ccl = l >> 1, q = l & 1, cc = 32 * blk + ccl;
        float x[16];
#pragma unroll
        for (int k = 0; k < 16; ++k) x[k] = 0.f;
        const char* arow = lds + L_AM + (32 * blk) * RS + 4 * (32 * blk) + 16 * q;
#pragma unroll
        for (int ib = 0; ib < 8; ++ib) {
            const int i0 = 4 * ib, aS = ib >> 1, qS = ib & 1;
            float p[4] = {0.f, 0.f, 0.f, 0.f};
#pragma unroll
            for (int rr = 0; rr < 4; ++rr)
#pragma unroll
                for (int a4 = 0; a4 <= aS; ++a4) { const float4 av = *(const float4*)(arow + (i0 + rr) * RS + 32 * a4);
                    p[rr] = fmaf(av.x, x[4 * a4], p[rr]); p[rr] = fmaf(av.y, x[4 * a4 + 1], p[rr]); p[rr] = fmaf(av.z, x[4 * a4 + 2], p[rr]); p[rr] = fmaf(av.w, x[4 * a4 + 3], p[rr]); }
#pragma unroll
            for (int rr = 0; rr < 4; ++rr) p[rr] += __int_as_float(__builtin_amdgcn_update_dpp(0, __float_as_int(p[rr]), 0xB1, 0xF, 0xF, false));
            const char* rb = lds + L_AM + (32 * blk + i0) * RS + 4 * (32 * blk + i0);
            const float4 r1 = *(const float4*)(rb + RS), r2 = *(const float4*)(rb + 2 * RS), r3 = *(const float4*)(rb + 3 * RS);
            const float x0 = ((i0 == ccl) ? 1.f : 0.f) - p[0];
            const float x1 = ((i0 + 1 == ccl) ? 1.f : 0.f) - p[1] - r1.x * x0;
            const float x2 = ((i0 + 2 == ccl) ? 1.f : 0.f) - p[2] - r2.x * x0 - r2.y * x1;
            const float x3 = ((i0 + 3 == ccl) ? 1.f : 0.f) - p[3] - r3.x * x0 - r3.y * x1 - r3.z * x2;
            if (q == qS) { x[4 * aS] = x0; x[4 * aS + 1] = x1; x[4 * aS + 2] = x2; x[4 * aS + 3] = x3; }
        }
        const float bc = sc_beta[cc], bw = bc * __expf(sc_gc[cc]);
#pragma unroll
        for (int k = 0; k < 16; ++k) { const int j = 8 * (k >> 2) + 4 * q + (k & 3);
            *(bf16_t*)(lds + L_TW + (32 * blk + j) * TS + 2 * cc) = mk::f2bf(x[k] * bw);
            *(bf16_t*)(lds + L_TU + (32 * blk + j) * TS + 2 * cc) = mk::f2bf(x[k] * bc);
            if (blk == 1) *(bf16_t*)(lds + L_TBR + j * 80 + 2 * ccl) = mk::f2bf(x[k]); }
        if (blk == 0) {
#pragma unroll
            for (int a4 = 0; a4 < 4; ++a4) *(uint2*)(lds + L_T1T + ccl * 80 + 2 * (8 * a4 + 4 * q)) = make_uint2(cvtpk(x[4 * a4], x[4 * a4 + 1]), cvtpk(x[4 * a4 + 2], x[4 * a4 + 3]));
        }
    }
    mk::lds_barrier();
    if (w == 0) {
        f32x16 a3 = {};
#pragma unroll
        for (int s = 0; s < 2; ++s) {
            const float4 f0 = *(const float4*)(lds + L_AM + (32 + r32) * RS + 4 * (16 * s + 8 * hh)), f1 = *(const float4*)(lds + L_AM + (32 + r32) * RS + 4 * (16 * s + 8 * hh) + 16);
            mk::u32x4_t au_ = {cvtpk(f0.x, f0.y), cvtpk(f0.z, f0.w), cvtpk(f1.x, f1.y), cvtpk(f1.z, f1.w)};
            a3 = __builtin_amdgcn_mfma_f32_32x32x16_bf16(*reinterpret_cast<bf16x8*>(&au_), *(const bf16x8*)(lds + L_T1T + r32 * 80 + 2 * (16 * s + 8 * hh)), a3, 0, 0, 0);
        }
#pragma unroll
        for (int g = 0; g < 4; ++g) *(uint2*)(lds + L_P3T + r32 * 80 + 2 * (8 * g + 4 * hh)) = make_uint2(cvtpk(a3[4 * g], a3[4 * g + 1]), cvtpk(a3[4 * g + 2], a3[4 * g + 3]));
        asm volatile("s_waitcnt lgkmcnt(0)" ::: "memory");
        f32x16 a4 = {};
#pragma unroll
        for (int s = 0; s < 2; ++s)
            a4 = __builtin_amdgcn_mfma_f32_32x32x16_bf16(*(const bf16x8*)(lds + L_TBR + r32 * 80 + 2 * (16 * s + 8 * hh)), *(const bf16x8*)(lds + L_P3T + r32 * 80 + 2 * (16 * s + 8 * hh)), a4, 0, 0, 0);
        const float bc = sc_beta[r32], bw = bc * __expf(sc_gc[r32]);
#pragma unroll
        for (int r = 0; r < 16; ++r) { const int i = 32 + crow(r, hh);
            *(bf16_t*)(lds + L_TW + i * TS + 2 * r32) = mk::f2bf(-a4[r] * bw);
            *(bf16_t*)(lds + L_TU + i * TS + 2 * r32) = mk::f2bf(-a4[r] * bc); }
    }
    mk::lds_barrier();
    {
        const int it = w >> 2, dt = w & 3, ns = it ? 4 : 2;
        f32x16 aw = {}, au = {};
        const char* kt = lds + L_KT + (32 * dt + r32) * TS + 16 * hh;
        const char* vt = lds + L_VT + (32 * dt + r32) * TS + 16 * hh;
        const char* tw = lds + L_TW + (32 * it + r32) * TS + 16 * hh;
        const char* tu = lds + L_TU + (32 * it + r32) * TS + 16 * hh;
#pragma unroll
        for (int s = 0; s < 4; ++s) if (s < ns) {
            aw = __builtin_amdgcn_mfma_f32_32x32x16_bf16(*(const bf16x8*)(kt + 32 * s), *(const bf16x8*)(tw + 32 * s), aw, 0, 0, 0);
            au = __builtin_amdgcn_mfma_f32_32x32x16_bf16(*(const bf16x8*)(tu + 32 * s), *(const bf16x8*)(vt + 32 * s), au, 0, 0, 0);
        }
#pragma unroll
        for (int g = 0; g < 4; ++g) {
            *(uint2*)(lds + L_SW + (32 * it + r32) * RS + 2 * (32 * dt + 8 * g + 4 * hh)) = make_uint2(cvtpk(aw[4 * g], aw[4 * g + 1]), cvtpk(aw[4 * g + 2], aw[4 * g + 3]));
            *(uint2*)(lds + L_SU + (32 * dt + r32) * 136 + 2 * (32 * it + 8 * g + 4 * hh)) = make_uint2(cvtpk(au[4 * g], au[4 * g + 1]), cvtpk(au[4 * g + 2], au[4 * g + 3]));
        }
    }
    mk::lds_barrier();
#pragma unroll
    for (int j = 0; j < 2; ++j) { const int pc = tid + 512 * j;
        *(uint4*)(ch + IT_W + (size_t)16 * pc) = *(const uint4*)(lds + L_SW + (pc >> 4) * RS + 16 * (pc & 15)); }
#pragma unroll
    for (int j = 0; j < 4; ++j) { const int pc = tid + 512 * j;
        *(uint2*)(ch + IT_U0T + (size_t)8 * pc) = *(const uint2*)(lds + L_SU + (pc >> 4) * 136 + 8 * (pc & 15)); }
}

constexpr int SL_ST = 0, SL_UT = 8704, SL_END = 8704 + 4608;
struct ScanArgs { const unsigned char* CH; const float* EG; bf16_t* ORAW; float* out; };

__device__ __forceinline__ void scan_item(const ScanArgs& a, int bh, int sl, char* lds) {
    const int tid = mk::ltid(), w = __builtin_amdgcn_readfirstlane(tid >> 6), l = tid & 63, r32 = l & 31, hh = l >> 5;
    const int b = bh >> 3, h = bh & 7;
    const unsigned char* chb = a.CH + (size_t)bh * 32 * IT_BYTES;
    for (int k = tid; k < SL_END / 4; k += 512) ((unsigned*)lds)[k] = 0u;
    __syncthreads();
    const char* stp = lds + SL_ST + r32 * RS + 16 * hh;
    const char* utp = lds + SL_UT + r32 * TS + 16 * hh;
    if (w < 2) {
        const int tt = w;
        bf16x8 wf[4][8]; uint2 u0[4][4];
#define LD_W(dst, dstu, cix) do { const unsigned char* cb = chb + (size_t)(cix) * IT_BYTES; \
        _Pragma("unroll") for (int s = 0; s < 8; ++s) dst[s] = *(const bf16x8*)(cb + IT_W + (size_t)(32 * tt + r32) * 256 + 32 * s + 16 * hh); \
        _Pragma("unroll") for (int g = 0; g < 4; ++g) dstu[g] = *(const uint2*)(cb + IT_U0T + (size_t)(32 * sl + r32) * 128 + 2 * (32 * tt + 8 * g + 4 * hh)); } while (0)
        LD_W(wf[0], u0[0], 0); LD_W(wf[1], u0[1], 1); LD_W(wf[2], u0[2], 2);
        for (int c0 = 0; c0 < 32; c0 += 4) {
#pragma unroll
            for (int k = 0; k < 4; ++k) {
                const int c = c0 + k;
                if (c + 3 < 32) LD_W(wf[(k + 3) & 3], u0[(k + 3) & 3], c + 3);
                f32x16 acc = {};
#pragma unroll
                for (int s = 0; s < 8; ++s) acc = __builtin_amdgcn_mfma_f32_32x32x16_bf16(wf[k][s], *(const bf16x8*)(stp + 32 * s), acc, 0, 0, 0);
#pragma unroll
                for (int g = 0; g < 4; ++g) {
                    const float a0 = __uint_as_float(u0[k][g].x << 16) - acc[4 * g], a1 = __uint_as_float(u0[k][g].x & 0xFFFF0000u) - acc[4 * g + 1];
                    const float a2 = __uint_as_float(u0[k][g].y << 16) - acc[4 * g + 2], a3 = __uint_as_float(u0[k][g].y & 0xFFFF0000u) - acc[4 * g + 3];
                    *(uint2*)(lds + SL_UT + r32 * TS + 2 * (32 * tt + 8 * g + 4 * hh)) = make_uint2(cvtpk(a0, a1), cvtpk(a2, a3));
                }
                mk::lds_barrier();
                mk::lds_barrier();
            }
        }
#undef LD_W
    } else if (w < 4) {
        const int tt = w - 2;
        bf16x8 qf[4][8], pf[4][4];
#pragma unroll
        for (int k = 0; k < 4; ++k)
#pragma unroll
            for (int s = 0; s < 4; ++s) pf[k][s] = bf16x8{};
#define LD_Q(dq, dp, cix) do { const unsigned char* cb = chb + (size_t)(cix) * IT_BYTES; \
        _Pragma("unroll") for (int s = 0; s < 8; ++s) dq[s] = *(const bf16x8*)(cb + IT_QD + (size_t)(32 * tt + r32) * 256 + 32 * s + 16 * hh); \
        _Pragma("unroll") for (int s = 0; s < 4; ++s) if (s < 2 * (tt + 1)) dp[s] = *(const bf16x8*)(cb + IT_QKD + (size_t)(32 * tt + r32) * 128 + 32 * s + 16 * hh); } while (0)
        LD_Q(qf[0], pf[0], 0); LD_Q(qf[1], pf[1], 1); LD_Q(qf[2], pf[2], 2);
        const size_t orow0 = (size_t)(b * mk::SEQ + 32 * tt) * mk::D + h * 128 + 32 * sl + r32;
        for (int c0 = 0; c0 < 32; c0 += 4) {
#pragma unroll
            for (int k = 0; k < 4; ++k) {
                const int c = c0 + k;
                if (c + 3 < 32) LD_Q(qf[(k + 3) & 3], pf[(k + 3) & 3], c + 3);
                f32x16 acc = {};
#pragma unroll
                for (int s = 0; s < 8; ++s) acc = __builtin_amdgcn_mfma_f32_32x32x16_bf16(qf[k][s], *(const bf16x8*)(stp + 32 * s), acc, 0, 0, 0);
                mk::lds_barrier();
#pragma unroll
                for (int s = 0; s < 4; ++s) if (s < 2 * (tt + 1)) acc = __builtin_amdgcn_mfma_f32_32x32x16_bf16(pf[k][s], *(const bf16x8*)(utp + 32 * s), acc, 0, 0, 0);
#pragma unroll
                for (int r = 0; r < 16; ++r) { const float v = acc[r]; const float vn = __shfl_xor(v, 1);
                    if ((r32 & 1) == 0) *(unsigned*)(a.ORAW + orow0 + (size_t)(64 * c + crow(r, hh)) * mk::D) = cvtpk(v, vn); }
                mk::lds_barrier();
            }
        }
#undef LD_Q
    } else {
        const int dt = w - 4;
        bf16x8 kf[4][4]; float eg[4];
#define LD_S(dk_, deg, cix) do { const unsigned char* cb = chb + (size_t)(cix) * IT_BYTES; \
        _Pragma("unroll") for (int s = 0; s < 4; ++s) dk_[s] = *(const bf16x8*)(cb + IT_KDT + (size_t)(32 * dt + r32) * 128 + 32 * s + 16 * hh); \
        deg = a.EG[bh * 32 + (cix)]; } while (0)
        LD_S(kf[0], eg[0], 0); LD_S(kf[1], eg[1], 1); LD_S(kf[2], eg[2], 2);
        f32x16 S = {};
        for (int c0 = 0; c0 < 32; c0 += 4) {
#pragma unroll
            for (int k = 0; k < 4; ++k) {
                const int c = c0 + k;
                if (c + 3 < 32) LD_S(kf[(k + 3) & 3], eg[(k + 3) & 3], c + 3);
#pragma unroll
                for (int r = 0; r < 16; ++r) S[r] *= eg[k];
                mk::lds_barrier();
#pragma unroll
                for (int s = 0; s < 4; ++s) S = __builtin_amdgcn_mfma_f32_32x32x16_bf16(kf[k][s], *(const bf16x8*)(utp + 32 * s), S, 0, 0, 0);
#pragma unroll
                for (int g = 0; g < 4; ++g)
                    *(uint2*)(lds + SL_ST + r32 * RS + 2 * (32 * dt + 8 * g + 4 * hh)) = make_uint2(cvtpk(S[4 * g], S[4 * g + 1]), cvtpk(S[4 * g + 2], S[4 * g + 3]));
                mk::lds_barrier();
            }
        }
#undef LD_S
        float* so = a.out + mk::O_SP + ((size_t)bh * 128) * 128 + 32 * sl + r32;
#pragma unroll
        for (int r = 0; r < 16; ++r) so[(size_t)(32 * dt + crow(r, hh)) * 128] = S[r];
    }
    __syncthreads();
}
}

namespace mk {
__device__ __forceinline__ unsigned f2key(float f) { f += 0.0f; unsigned u = __float_as_uint(f); return (u & 0x80000000u) ? ~u : (u | 0x80000000u); }
__device__ __forceinline__ int block_sum_i512(int c, int* red) {
    c += __shfl_xor(c, 32); c += __shfl_xor(c, 16); c += __shfl_xor(c, 8); c += __shfl_xor(c, 4); c += __shfl_xor(c, 2); c += __shfl_xor(c, 1);
    __syncthreads();
    if ((mk::ltid() & 63) == 0) red[mk::ltid() >> 6] = c;
    __syncthreads();
    return red[0] + red[1] + red[2] + red[3] + red[4] + red[5] + red[6] + red[7];
}
__device__ __forceinline__ void attend_sample_row(int r, char* lds, const float* QSS, const float* qg, const bf16_t* P1, const float* CS, const int* CI, const float* out, const float* cache_k, const float* cache_v, const int* page_table, bf16_t* AO) {
    float* lg = (float*)lds;
    int* rowi = (int*)(lg + 2048);
    int* pt = rowi + 256;
    float* red = (float*)(pt + 128);
    bf16_t* qs = (bf16_t*)(red + 64);
    float* part = (float*)(qs + 1024);
    const int m = MP + r, b = r / DS, t = mk::ltid(), w = __builtin_amdgcn_readfirstlane(t >> 6), l = t & 63;
    {
        const unsigned u = ((const unsigned*)(P1 + (size_t)m * N1P + CQ))[t];
        const float rs = rsqrtf(QSS[(size_t)m * 8 + (t >> 6)] * (1.0f / 128) + EPS);
        ((unsigned*)qs)[t] = pk2bf(__uint_as_float(u << 16) * rs * qg[(2 * t) & 127], __uint_as_float(u & 0xFFFF0000u) * rs * qg[(2 * t + 1) & 127]);
    }
    if (t >= 64 && t < 64 + NPG) pt[t - 64] = page_table[b * NPG + t - 64];
    if (w == 0) {
        float sc[32]; int ci[32];
        const float* cs = CS + (size_t)r * 8 * ix::TOPK; const int* cip = CI + (size_t)r * 8 * ix::TOPK;
#pragma unroll
        for (int k = 0; k < 32; ++k) { sc[k] = cs[64 * k + l]; ci[k] = cip[64 * k + l]; }
        __syncthreads();
        int run = 0;
        ix::topk_select<32, 32>(sc, [&](int k, unsigned long long bm) {
            const bool mine = (bm >> l) & 1ull;
            const int pos = run + __builtin_popcountll(bm & ((1ull << l) - 1ull));
            if (mine) { const int idx = ci[k]; rowi[pos] = idx < PAST ? pt[idx >> 7] * PAGE + (idx & (PAGE - 1)) : -(b * DS + (idx - PAST)) - 1; }
            run += __builtin_popcountll(bm);
        });
    } else __syncthreads();
    __syncthreads();
    const int rr = l & 31, hh = l >> 5;
    f32x16 acc0 = {}, acc1 = {};
    {
        const int ri = rowi[32 * w + rr];
        const float* kr = (ri >= 0 ? cache_k + (size_t)ri * 256 : out + O_KS + (size_t)(-ri - 1) * 256) + 8 * hh;
        float4 kf[2][8][2];
#pragma unroll
        for (int g = 0; g < 2; ++g)
#pragma unroll
            for (int s = 0; s < 8; ++s) { kf[g][s][0] = *(const float4*)(kr + g * 128 + 16 * s); kf[g][s][1] = *(const float4*)(kr + g * 128 + 16 * s + 4); }
        const bf16_t* qa = qs + (rr & 3) * 128 + 8 * hh;
#pragma unroll
        for (int s = 0; s < 8; ++s) {
            bf16x8 a0 = *(const bf16x8*)(qa + 16 * s), a1 = *(const bf16x8*)(qa + 512 + 16 * s);
            if (rr >= 4) { a0 = bf16x8{}; a1 = bf16x8{}; }
            { const float4 x = kf[0][s][0], y = kf[0][s][1];
              u32x4_t u = {cvtpk_native(x.x, x.y), cvtpk_native(x.z, x.w), cvtpk_native(y.x, y.y), cvtpk_native(y.z, y.w)};
              acc0 = __builtin_amdgcn_mfma_f32_32x32x16_bf16(a0, *reinterpret_cast<bf16x8*>(&u), acc0, 0, 0, 0); }
            { const float4 x = kf[1][s][0], y = kf[1][s][1];
              u32x4_t u = {cvtpk_native(x.x, x.y), cvtpk_native(x.z, x.w), cvtpk_native(y.x, y.y), cvtpk_native(y.z, y.w)};
              acc1 = __builtin_amdgcn_mfma_f32_32x32x16_bf16(a1, *reinterpret_cast<bf16x8*>(&u), acc1, 0, 0, 0); }
        }
    }
    __builtin_amdgcn_sched_barrier(0);
    float4 vf[32];
#pragma unroll
    for (int jj = 0; jj < 32; ++jj) { const int ri = rowi[32 * w + jj];
        vf[jj] = *(const float4*)((ri >= 0 ? cache_v + (size_t)ri * 256 : out + O_VS + (size_t)(-ri - 1) * 256) + 4 * l); }
    if (hh == 0) {
        *(float4*)(lg + (32 * w + rr) * 8) = make_float4(acc0[0] * 0.08838834764831845f, acc0[1] * 0.08838834764831845f, acc0[2] * 0.08838834764831845f, acc0[3] * 0.08838834764831845f);
        *(float4*)(lg + (32 * w + rr) * 8 + 4) = make_float4(acc1[0] * 0.08838834764831845f, acc1[1] * 0.08838834764831845f, acc1[2] * 0.08838834764831845f, acc1[3] * 0.08838834764831845f);
    }
    mk::lds_barrier();
    {
        float x[4], mx = -INFINITY;
#pragma unroll
        for (int i = 0; i < 4; ++i) { x[i] = lg[(l + 64 * i) * 8 + w]; mx = fmaxf(mx, x[i]); }
#pragma unroll
        for (int o = 32; o > 0; o >>= 1) mx = fmaxf(mx, __shfl_xor(mx, o));
        float s = 0.f;
#pragma unroll
        for (int i = 0; i < 4; ++i) { x[i] = __expf(x[i] - mx); s += x[i]; lg[(l + 64 * i) * 8 + w] = x[i]; }
        s = wave_sum(s);
        if (l == 0) red[w] = 1.0f / s;
    }
    mk::lds_barrier();
    {
        float4 o0 = make_float4(0.f, 0.f, 0.f, 0.f), o1 = o0, o2 = o0, o3 = o0;
#pragma unroll
        for (int jj = 0; jj < 32; ++jj) {
            const float4 p4 = *(const float4*)(lg + (32 * w + jj) * 8 + 4 * hh); const float4 v = vf[jj];
            o0.x = fmaf(p4.x, v.x, o0.x); o0.y = fmaf(p4.x, v.y, o0.y); o0.z = fmaf(p4.x, v.z, o0.z); o0.w = fmaf(p4.x, v.w, o0.w);
            o1.x = fmaf(p4.y, v.x, o1.x); o1.y = fmaf(p4.y, v.y, o1.y); o1.z = fmaf(p4.y, v.z, o1.z); o1.w = fmaf(p4.y, v.w, o1.w);
            o2.x = fmaf(p4.z, v.x, o2.x); o2.y = fmaf(p4.z, v.y, o2.y); o2.z = fmaf(p4.z, v.z, o2.z); o2.w = fmaf(p4.z, v.w, o2.w);
            o3.x = fmaf(p4.w, v.x, o3.x); o3.y = fmaf(p4.w, v.y, o3.y); o3.z = fmaf(p4.w, v.z, o3.z); o3.w = fmaf(p4.w, v.w, o3.w);
        }
        float* pp = part + w * 1024 + (4 * hh) * 128 + 4 * rr;
        *(float4*)(pp) = o0; *(float4*)(pp + 128) = o1; *(float4*)(pp + 256) = o2; *(float4*)(pp + 384) = o3;
    }
    __syncthreads();
    {
        const int c0 = 2 * t, h = c0 >> 7;
        float o0 = 0.f, o1 = 0.f;
#pragma unroll
        for (int ww = 0; ww < 8; ++ww) { const float2 x = *(const float2*)(part + ww * 1024 + c0); o0 += x.x; o1 += x.y; }
        const float rinv = red[h];
        const bf16_t* gate = P1 + (size_t)m * N1P + CG + c0;
        *(unsigned*)(AO + (size_t)m * D + c0) = pk2bf(o0 * rinv * silu(bf2f(gate[0])), o1 * rinv * silu(bf2f(gate[1])));
    }
    __syncthreads();
}

__device__ __forceinline__ void dn_post_row(int m, char* lds, const bf16_t* P2, const float* BA, const float* conv_w, const float* conv_state, const float* A_log, const float* dt_bias,
                                            float* QC, float* KC, float* VC, float* BETA, float* G, float* out) {
    float* y = (float*)lds;
    const int t = mk::ltid();
    const int b = (m - MP) / DS, tt = (m - MP) % DS;
    {
        float xv[6][4], wv[6][4];
#pragma unroll
        for (int k = 0; k < 6; ++k) { const int c = t + 512 * k;
#pragma unroll
            for (int i = 0; i < 4; ++i) { const int j = tt + i;
                xv[k][i] = (j < 3) ? conv_state[((size_t)b * 3 + j) * CONV + c] : bf2f(P2[(size_t)(m - tt + (j - 3)) * N3P + c]);
                wv[k][i] = conv_w[i * CONV + c]; } }
#pragma unroll
        for (int k = 0; k < 6; ++k) { const int c = t + 512 * k;
            float acc = wv[k][0] * xv[k][0]; acc += wv[k][1] * xv[k][1]; acc += wv[k][2] * xv[k][2]; acc += wv[k][3] * xv[k][3];
            y[c] = silu(acc);
            if (tt >= DS - 3) out[O_CS + ((size_t)b * 3 + (tt - (DS - 3))) * CONV + c] = xv[k][3]; }
    }
    __syncthreads();
    const int w = t >> 6, l = t & 63;
    for (int hh = w; hh < 16; hh += 8) {
        const float a = y[hh * 128 + l], bb = y[hh * 128 + 64 + l];
        const float ss = wave_sum(a * a + bb * bb);
        float r = rsqrtf(ss + EPS);
        if (hh < 8) { r *= 0.08838834764831845f; QC[(size_t)m * D + hh * 128 + l] = a * r; QC[(size_t)m * D + hh * 128 + 64 + l] = bb * r; }
        else { KC[(size_t)m * D + (hh - 8) * 128 + l] = a * r; KC[(size_t)m * D + (hh - 8) * 128 + 64 + l] = bb * r; }
    }
    for (int c = t; c < 1024; c += 512) VC[(size_t)m * D + c] = y[2048 + c];
    if (t < 8) {
        const float bv = BA[(size_t)m * 16 + t], av = BA[(size_t)m * 16 + 8 + t];
        BETA[(size_t)m * 8 + t] = 1.0f / (1.0f + expf(-bv));
        const float x = av + dt_bias[t];
        const float sp = x > 20.f ? x : log1pf(expf(x));
        G[(size_t)m * 8 + t] = -expf(A_log[t]) * sp;
    }
    __syncthreads();
}

__device__ __forceinline__ void dn_scan_sample(int it, char* lds, const float* QC, const float* KC, const float* VC, const float* BETA, const float* G, const float* S0, bf16_t* ORAW, float* out) {
    const int t = mk::ltid(), v = t & 127, hq = __builtin_amdgcn_readfirstlane(t >> 7);
    float* qs = (float*)lds; float* ks = qs + DS * 128; float* ex = ks + DS * 128;
    const int b = it >> 3, h = it & 7, m0 = MP + b * DS;
    float S[32], vv[DS], beta[DS], alpha[DS];
    const float* sp = S0 + (((size_t)b * 8 + h) * 128 + hq * 32) * 128 + v;
#pragma unroll
    for (int d = 0; d < 32; ++d) S[d] = ldnt1(sp + (size_t)d * 128);
#pragma unroll
    for (int j = 0; j < 2; ++j) { const int tt = hq + 4 * j;
        qs[tt * 128 + v] = QC[(size_t)(m0 + tt) * D + h * 128 + v]; ks[tt * 128 + v] = KC[(size_t)(m0 + tt) * D + h * 128 + v]; }
#pragma unroll
    for (int tt = 0; tt < DS; ++tt) { vv[tt] = VC[(size_t)(m0 + tt) * D + h * 128 + v]; beta[tt] = BETA[(size_t)(m0 + tt) * 8 + h]; alpha[tt] = expf(G[(size_t)(m0 + tt) * 8 + h]); }
    __syncthreads();
#pragma unroll
    for (int tt = 0; tt < DS; ++tt) {
        const float4* k4 = (const float4*)(ks + tt * 128 + hq * 32); const float4* q4 = (const float4*)(qs + tt * 128 + hq * 32);
        float kS = 0.f;
#pragma unroll
        for (int d = 0; d < 8; ++d) { const float4 kk = k4[d]; kS = fmaf(kk.x, S[4 * d], kS); kS = fmaf(kk.y, S[4 * d + 1], kS); kS = fmaf(kk.z, S[4 * d + 2], kS); kS = fmaf(kk.w, S[4 * d + 3], kS); }
        ex[hq * 128 + v] = kS;
        mk::lds_barrier();
        const float u = beta[tt] * (vv[tt] - alpha[tt] * ((ex[v] + ex[128 + v]) + (ex[256 + v] + ex[384 + v])));
        float o = 0.f;
#pragma unroll
        for (int d = 0; d < 8; ++d) { const float4 kk = k4[d], qq = q4[d];
            S[4 * d] = fmaf(alpha[tt], S[4 * d], kk.x * u); o = fmaf(qq.x, S[4 * d], o);
            S[4 * d + 1] = fmaf(alpha[tt], S[4 * d + 1], kk.y * u); o = fmaf(qq.y, S[4 * d + 1], o);
            S[4 * d + 2] = fmaf(alpha[tt], S[4 * d + 2], kk.z * u); o = fmaf(qq.z, S[4 * d + 2], o);
            S[4 * d + 3] = fmaf(alpha[tt], S[4 * d + 3], kk.w * u); o = fmaf(qq.w, S[4 * d + 3], o); }
        ex[512 + hq * 128 + v] = o;
        mk::lds_barrier();
        if (hq == 0) ORAW[(size_t)(m0 + tt) * D + h * 128 + v] = f2bf((ex[512 + v] + ex[512 + 128 + v]) + (ex[512 + 256 + v] + ex[512 + 384 + v]));
    }
    float* so_ = out + O_SS + (((size_t)b * 8 + h) * 128 + hq * 32) * 128 + v;
#pragma unroll
    for (int d = 0; d < 32; ++d) so_[(size_t)d * 128] = S[d];
    __syncthreads();
}

struct GateRegs { unsigned o[8], z[8]; };
__device__ __forceinline__ void dn_gate_load(int m, const bf16_t* ORAW, const bf16_t* P2, GateRegs& R) {
    const int l = mk::ltid() & 63;
#pragma unroll
    for (int h = 0; h < 8; ++h) { R.o[h] = *(const unsigned*)(ORAW + (size_t)m * D + h * 128 + 2 * l); R.z[h] = *(const unsigned*)(P2 + (size_t)m * N3P + CZ + h * 128 + 2 * l); }
}
__device__ __forceinline__ void dn_gate_finish(int m, const GateRegs& R, const float* og, bf16_t* AO2) {
    const int l = mk::ltid() & 63;
    const float g0 = og[2 * l], g1 = og[2 * l + 1];
    float oa[8], ob[8], ss[8];
#pragma unroll
    for (int h = 0; h < 8; ++h) { oa[h] = __uint_as_float(R.o[h] << 16); ob[h] = __uint_as_float(R.o[h] & 0xFFFF0000u); ss[h] = oa[h] * oa[h] + ob[h] * ob[h]; }
    wave_sum_n<8>(ss);
#pragma unroll
    for (int h = 0; h < 8; ++h) {
        const float r = rsqrtf(ss[h] * (1.0f / 128) + EPS);
        const float z0 = __uint_as_float(R.z[h] << 16), z1 = __uint_as_float(R.z[h] & 0xFFFF0000u);
        *(unsigned*)(AO2 + (size_t)m * D + h * 128 + 2 * l) = pk2bf(oa[h] * r * g0 * silu(z0), ob[h] * r * g1 * silu(z1));
    }
}
__device__ __forceinline__ int dn_gate_rowmap(int j) { return j < MS ? MP + j : ((j - MS) & (NB - 1)) * SEQ + (SEQ - 1 - ((j - MS) >> 3)); }
__device__ __forceinline__ void dn_gate_rows(int gw, int nw, const bf16_t* ORAW, const bf16_t* P2, const float* og, bf16_t* AO2) {
    GateRegs R0, R1, R2;
    int m = gw;
#define RM(j) dn_gate_rowmap(j)
    if (m < M) dn_gate_load(RM(m), ORAW, P2, R0);
    if (m + nw < M) dn_gate_load(RM(m + nw), ORAW, P2, R1);
    for (; m < M; m += 3 * nw) {
        if (m + 2 * nw < M) dn_gate_load(RM(m + 2 * nw), ORAW, P2, R2);
        dn_gate_finish(RM(m), R0, og, AO2);
        if (m + nw < M) { if (m + 3 * nw < M) dn_gate_load(RM(m + 3 * nw), ORAW, P2, R0); dn_gate_finish(RM(m + nw), R1, og, AO2); }
        if (m + 2 * nw < M) { if (m + 4 * nw < M) dn_gate_load(RM(m + 4 * nw), ORAW, P2, R1); dn_gate_finish(RM(m + 2 * nw), R2, og, AO2); }
    }
#undef RM
}
}

namespace mk {
constexpr size_t al256(size_t x) { return (x + 255) & ~(size_t)255; }
constexpr size_t W_BAR = 0, W_WT1 = al256(W_BAR + (size_t)12 * XCD_BAR_WORDS * 4), W_WT2 = al256(W_WT1 + (size_t)N1P * D * 2), W_WT3 = al256(W_WT2 + (size_t)D * D * 2), W_WT4 = al256(W_WT3 + (size_t)N3P * D * 2),
    W_XA = al256(W_WT4 + (size_t)D * D * 2), W_P1 = al256(W_XA + (size_t)M * D * 2), W_P2 = al256(W_P1 + (size_t)M * N1P * 2), W_AO = al256(W_P2 + (size_t)M * N3P * 2), W_QN = al256(W_AO + (size_t)M * D * 2),
    W_KB = al256(W_QN + (size_t)M * D * 2), W_IKB = al256(W_KB + (size_t)M * 256 * 2), W_BA = al256(W_IKB + (size_t)M * 64 * 2), W_IW = al256(W_BA + (size_t)M * 16 * 4), W_Y1 = al256(W_IW + (size_t)M * 8 * 4),
    W_QC = al256(W_Y1 + (size_t)M * D * 4), W_KC = al256(W_QC + (size_t)M * D * 4), W_VC = al256(W_KC + (size_t)M * D * 4), W_BETA = al256(W_VC + (size_t)M * D * 4), W_G = al256(W_BETA + (size_t)M * 8 * 4),
    W_ORAW = al256(W_G + (size_t)M * 8 * 4), W_CH = al256(W_ORAW + (size_t)M * D * 2), W_EG = al256(W_CH + (size_t)dn::NITEM * dn::IT_BYTES), W_CS = al256(W_EG + (size_t)dn::NITEM * 4), W_CI = al256(W_CS + (size_t)MS * 8 * 256 * 4), W_MASK = al256(W_CI + (size_t)MS * 8 * 256 * 4), W_SS = al256(W_MASK + (size_t)MP * 64 * 4), W_END = al256(W_SS + (size_t)M * 4);
struct WsMap {
    unsigned char* base;
#define WSP(name, T, off) __device__ __forceinline__ T* name() const { return (T*)(base + (off)); }
    WSP(bar, unsigned, W_BAR) WSP(Wt1, bf16_t, W_WT1) WSP(Wt2, bf16_t, W_WT2) WSP(Wt3, bf16_t, W_WT3) WSP(Wt4, bf16_t, W_WT4) WSP(XA, bf16_t, W_XA) WSP(P1, bf16_t, W_P1) WSP(P2, bf16_t, W_P2)
    WSP(AO, bf16_t, W_AO) WSP(QNb, bf16_t, W_QN) WSP(KB, bf16_t, W_KB) WSP(IKB, bf16_t, W_IKB) WSP(BA, float, W_BA) WSP(IW, float, W_IW) WSP(Y1, float, W_Y1) WSP(QC, float, W_QC) WSP(KC, float, W_KC)
    WSP(VC, float, W_VC) WSP(BETA, float, W_BETA) WSP(G, float, W_G) WSP(ORAW, bf16_t, W_ORAW) WSP(CH, unsigned char, W_CH) WSP(EG, float, W_EG) WSP(CS, float, W_CS) WSP(CI, int, W_CI) WSP(SS, float, W_SS) WSP(MASK, unsigned, W_MASK)
#undef WSP
};
struct Params {
    const float *x_prompt, *x_sample, *cache_k, *cache_v, *cache_ik, *state_S, *state_conv; const int* page_table;
    const float *att_norm, *att_w_in, *qg, *kg, *ikg, *att_w_out, *dn_norm, *dn_w_in, *conv_w, *A_log, *dt_bias, *og, *dn_w_out;
    float* out; WsMap w; int ph_lo, ph_hi, li, pad_;
};
constexpr int LDS_TOTAL = 147456;
constexpr int NPHASE = 12;
#ifndef MK_NLAUNCH
#define MK_NLAUNCH 1
#endif

__global__ void __launch_bounds__(512, 2) mega(Params p) {
    extern __shared__ __attribute__((aligned(16))) unsigned char lds[];
    const int bid = blockIdx.x, nblk = gridDim.x;
#define wave (mk::ltid() >> 6)
    uint4* xbw = (uint4*)(lds + LDS_TOTAL - 16);
    if (threadIdx.x == 0) *xbw = make_uint4(0u, 0u, 0u, 0u);
    __syncthreads();
    XcdBarrier bar = xcd_barrier_post(p.w.bar() + (size_t)p.li * XCD_BAR_WORDS, (volatile LAS unsigned*)xbw);
    const int lo = p.ph_lo, hi = p.ph_hi;
#define IN(k) (lo <= (k) && (k) < hi)
#define SEAM(k) do { if (IN(k) && IN((k) + 1)) xcd_barrier(bar); } while (0)
    const WsMap& w = p.w;
    if (IN(0)) {
        float* tile = (float*)lds;
        { float* qss = (float*)w.QNb(); for (int i = bid * 512 + mk::ltid(); i < M * 8; i += nblk * 512) qss[i] = 0.f; }
        wconv_waves<1>(p.att_w_in, ATT_IN, p.att_norm, w.Wt1(), D, N1P, bid * 8 + wave, nblk * 8);
        wconv_waves<0>(p.att_w_out, D, nullptr, w.Wt2(), D, D, (bid * 8 + wave + 1664) % (nblk * 8), nblk * 8);
        { const int gw = bid * 8 + wave, nw = nblk * 8;
          if (nw >= 2048) { float4 v[9][4];
#pragma unroll
              for (int k = 0; k < 9; ++k) { const int m = gw + k * nw; if (m < M) xnorm_load(xrow(p.x_prompt, p.x_sample, m), v[k]); }
#pragma unroll
              for (int k = 0; k < 9; ++k) { const int m = gw + k * nw; if (m < M) xnorm_finish(v[k], w.XA() + (size_t)m * D, w.Y1() + m); } }
          else { float4 v[4]; for (int m = gw; m < M; m += nw) { xnorm_load(xrow(p.x_prompt, p.x_sample, m), v); xnorm_finish(v, w.XA() + (size_t)m * D, w.Y1() + m); } } }
    }
    SEAM(0);
    if (IN(1)) { pg8::Gemm g{w.XA(), w.Wt1(), M, N1P, D, 0}; EpiBf16Tail E{w.P1(), N1P, N1P / 256, nullptr, nullptr, (float*)w.QNb()}; pg8::StaticOrder S; S.init(M, N1P, nblk, bid);
        pg8::gemm_phase<EpiBf16Tail, pg8::StaticOrder, false>((PG8_LAS unsigned char*)lds, g, S, E, nullptr);
        { const int nfull = (M / 256) * (N1P / 256), last = nfull - (nfull / nblk) * nblk;
          const int nidle = nblk - last, me = bid - last;
          if (nidle > 0 && me >= 0) { float* tile = (float*)lds;
              wconv_all<3>(tile, p.dn_w_in, DN_IN, p.dn_norm, w.Wt3(), D, N3P, me, nidle);
              wconv_all<0>(tile, p.dn_w_out, D, nullptr, w.Wt4(), D, D, me, nidle); }
          else if (nidle <= 0) { float* tile = (float*)lds; wconv_all<3>(tile, p.dn_w_in, DN_IN, p.dn_norm, w.Wt3(), D, N3P, bid, nblk); wconv_all<0>(tile, p.dn_w_out, D, nullptr, w.Wt4(), D, D, bid, nblk); } }
    }
    SEAM(1);
    if (IN(2)) { for (int i = bid * 512 + mk::ltid(); i < M; i += nblk * 512) w.SS()[i] = 0.f;
        att_post_rows(bid * 8 + wave, nblk * 8, w.P1(), p.qg, p.kg, p.ikg, w.KB(), w.IKB(), w.IW(), p.out); }
    SEAM(2);
    if (IN(3)) {
        const bool sfirst = (bid >> 3) & 1;
        if (sfirst) { for (int id = bid; id < 256; id += nblk) ix::index_sample_block(id >> 3, id & 7, (char*)lds, w.P1(), w.IKB(), w.IW(), p.cache_ik, p.page_table, w.CS(), w.CI()); }
        for (int id = bid; id < 256; id += nblk) { const int b = id & 7, pr = id >> 3;
            ix::index_prompt_block(b, 63 - pr, (char*)lds, w.P1(), w.IKB(), w.IW(), w.MASK());
            __syncthreads();
            ix::index_prompt_block(b, pr, (char*)lds, w.P1(), w.IKB(), w.IW(), w.MASK());
            __syncthreads(); }
        if (!sfirst) { for (int id = bid; id < 256; id += nblk) ix::index_sample_block(id >> 3, id & 7, (char*)lds, w.P1(), w.IKB(), w.IW(), p.cache_ik, p.page_table, w.CS(), w.CI()); }
    }
    SEAM(3);
    if (IN(4)) {
        dsa::Tensors T{(const float*)w.QNb(), w.KB(), w.P1(), w.MASK(), w.AO()};
        const bool sfirst = (bid >> 3) & 1;
        if (sfirst) { for (int r = bid; r < MS; r += nblk) attend_sample_row(r, (char*)lds, (const float*)w.QNb(), p.qg, w.P1(), w.CS(), w.CI(), p.out, p.cache_k, p.cache_v, p.page_table, w.AO()); }
        dsa::attn_prompt_phase(T, (char*)lds, bid, nblk);
        __syncthreads();
        if (!sfirst) { for (int r = bid; r < MS; r += nblk) attend_sample_row(r, (char*)lds, (const float*)w.QNb(), p.qg, w.P1(), w.CS(), w.CI(), p.out, p.cache_k, p.cache_v, p.page_table, w.AO()); }
    }
    SEAM(4);
    if (IN(5)) {
        { const float* INV = w.Y1(); bf16_t* XB = w.XA(); float* SS = w.SS();
          for (int u = bid; u < 256; u += nblk) gemm_small_unit<1>((char*)lds, w.AO(), w.Wt2(), MP + 32 * (u >> 5), 32 * (u & 31), [&](int r_, int c_) { return bf2f(XB[(size_t)r_ * D + c_]) * INV[r_]; }, [&](int r_, int c_, float v, float res) {
              const float y = v + res; XB[(size_t)r_ * D + c_] = f2bf(y);
              float ss = y * y; ss += __shfl_xor(ss, 1); ss += __shfl_xor(ss, 2); ss += __shfl_xor(ss, 4); ss += __shfl_xor(ss, 8); ss += __shfl_xor(ss, 16);
              if ((ltid() & 31) == 0) atomicAdd(SS + r_, ss); }); }
        pg8::Gemm g{w.AO(), w.Wt2(), MP, D, D, 0}; EpiY1 E{w.XA(), w.Y1(), w.SS(), D, 0}; pg8::StaticOrder S; S.init(MP, D, nblk, bid);
        pg8::gemm_phase<EpiY1, pg8::StaticOrder, false>((PG8_LAS unsigned char*)lds, g, S, E, nullptr); }
    SEAM(5);
    if (IN(7)) { pg8::Gemm g{w.XA(), w.Wt3(), M, N3P, D, 0}; EpiBf16Tail E{w.P2(), N3P, 16, w.BA(), w.SS(), nullptr}; pg8::StaticOrder S; S.init(M, N3P, nblk, bid);
        pg8::gemm_phase<EpiBf16Tail, pg8::StaticOrder, false>((PG8_LAS unsigned char*)lds, g, S, E, nullptr); }
    SEAM(7);
    if (IN(8)) {
        dn::PreArgs pa{w.P2(), w.BA(), p.conv_w, p.A_log, p.dt_bias, w.CH(), w.EG(), p.out};
        { dn::PreRaw R;
          if (nblk == 256) {
              const int bh = bid & 63, cq = bid >> 6;
              dn::pre_load(pa, bh * 32 + 31 - cq, R);
              for (int k = 0; k < 8; ++k) dn::pre_item(pa, bh * 32 + 31 - (4 * k + cq), k + 1 < 8 ? bh * 32 + 31 - (4 * (k + 1) + cq) : -1, (char*)lds, R);
          } else {
              int item = bid;
              if (item < dn::NITEM) dn::pre_load(pa, item, R);
              for (; item < dn::NITEM; item += nblk) dn::pre_item(pa, item, item + nblk < dn::NITEM ? item + nblk : -1, (char*)lds, R);
          }
          __syncthreads(); }
        for (int m = MP + bid; m < M; m += nblk) dn_post_row(m, (char*)lds, w.P2(), w.BA(), p.conv_w, p.state_conv, p.A_log, p.dt_bias, w.QC(), w.KC(), w.VC(), w.BETA(), w.G(), p.out);
    }
    SEAM(8);
    if (IN(9)) {
        dn::ScanArgs sa{w.CH(), w.EG(), w.ORAW(), p.out};
        for (int it = bid; it < 256; it += nblk) { const int xcd = it & 7, slot = it >> 3; dn::scan_item(sa, xcd * 8 + (slot >> 2), slot & 3, (char*)lds); }
        for (int it = bid; it < DB * 8; it += nblk) dn_scan_sample(it, (char*)lds, w.QC(), w.KC(), w.VC(), w.BETA(), w.G(), p.state_S, w.ORAW(), p.out);
    }
    SEAM(9);
    if (IN(10)) { dn_gate_rows(bid * 8 + wave, nblk * 8, w.ORAW(), w.P2(), p.og, w.AO()); }
    SEAM(10);
    if (IN(11)) {
        { float* yo = p.out + O_Y; const bf16_t* Y1b = w.XA();
          for (int u = bid; u < 256; u += nblk) gemm_small_unit<1>((char*)lds, w.AO(), w.Wt4(), MP + 32 * (u >> 5), 32 * (u & 31), [&](int r_, int c_) { return bf2f(Y1b[(size_t)r_ * D + c_]); }, [&](int r_, int c_, float v, float res) { yo[(size_t)r_ * D + c_] = v + res; }); }
        pg8::Gemm g{w.AO(), w.Wt4(), MP, D, D, 0}; EpiF32ResBf E{p.out + O_Y, w.XA(), D, 0}; pg8::StaticOrder S; S.init(MP, D, nblk, bid);
        pg8::gemm_phase<EpiF32ResBf, pg8::StaticOrder, false>((PG8_LAS unsigned char*)lds, g, S, E, nullptr); }
#undef IN
#undef SEAM
}
}

extern "C" void kernel_launch(void* const* d_in, const int* in_sizes, int n_in, void* d_out, int out_size, void* d_ws, size_t ws_size, hipStream_t stream) {
    using namespace mk;
    static int grid = 0;
    if (!grid) {
        int dev = 0, cus = 0, per_cu = 0;
        (void)hipGetDevice(&dev);
        (void)hipDeviceGetAttribute(&cus, hipDeviceAttributeMultiprocessorCount, dev);
        (void)hipFuncSetAttribute((const void*)mega, hipFuncAttributeMaxDynamicSharedMemorySize, LDS_TOTAL);
        (void)hipOccupancyMaxActiveBlocksPerMultiprocessor(&per_cu, (const void*)mega, 512, LDS_TOTAL);
        (void)hipGetLastError();
        grid = cus > 0 ? cus : 256;
        fprintf(stderr, "mega: cus %d occupancy %d grid %d\n", cus, per_cu, grid);
    }
    Params p; memset(&p, 0, sizeof(p));
    p.x_prompt = (const float*)d_in[0]; p.x_sample = (const float*)d_in[1]; p.cache_k = (const float*)d_in[2]; p.cache_v = (const float*)d_in[3]; p.cache_ik = (const float*)d_in[4];
    p.state_S = (const float*)d_in[5]; p.state_conv = (const float*)d_in[6]; p.page_table = (const int*)d_in[7];
    p.att_norm = (const float*)d_in[8]; p.att_w_in = (const float*)d_in[9]; p.qg = (const float*)d_in[10]; p.kg = (const float*)d_in[11];
    p.ikg = (const float*)d_in[12]; p.att_w_out = (const float*)d_in[13]; p.dn_norm = (const float*)d_in[14]; p.dn_w_in = (const float*)d_in[15];
    p.conv_w = (const float*)d_in[16]; p.A_log = (const float*)d_in[17]; p.dt_bias = (const float*)d_in[18]; p.og = (const float*)d_in[19]; p.dn_w_out = (const float*)d_in[20];
    p.out = (float*)d_out;
    p.w.base = (unsigned char*)d_ws;
    if (W_END > ws_size) { fprintf(stderr, "ws too small\n"); return; }
    (void)hipMemsetAsync(d_ws, 0, (size_t)NPHASE * XCD_BAR_WORDS * 4, stream);
    constexpr int NL = MK_NLAUNCH;
    for (int li = 0; li < NL; ++li) {
        p.ph_lo = (NL == 1) ? 0 : li; p.ph_hi = (NL == 1) ? NPHASE : li + 1; p.li = li;
        hipLaunchKernelGGL(mega, dim3(grid), dim3(512), LDS_TOTAL, stream, p);
    }
}
```

```cpp
#include <hip/hip_runtime.h>
#include <cstdio>
#include <cstdint>
#include <cstring>

namespace mk {
typedef unsigned short bf16_t;
constexpr int D = 1024, NB = 8, SEQ = 2048, MP = NB * SEQ, DB = 32, DS = 8, MS = DB * DS, M = MP + MS;
constexpr int PAST = 16384, PAGE = 128, NPG = PAST / PAGE;
constexpr int NH = 8, HD = 128, NKV = 2, IH = 8, ID = 64, TOPK = 256;
constexpr int ATT_IN = 3144, SQ_ = 0, SK_ = 1024, SV_ = 1280, SIQ = 1536, SIK = 2048, SIW = 2112, SG = 2120;
constexpr int DN_IN = 4112;
constexpr int N1P = 3328, CQ = 0, CK = 1024, CV = 1280, CIQ = 1536, CG = 2048, CIK = 3072, CIW = 3136;
constexpr int N3P = 4352, CONV = 3072, CZ = 3072, CB = 4096, CA = 4104;
constexpr float EPS = 1e-6f;
constexpr size_t O_Y = 0;
constexpr size_t O_KP = (size_t)M * D;
constexpr size_t O_VP = O_KP + (size_t)MP * 256;
constexpr size_t O_IKP = O_VP + (size_t)MP * 256;
constexpr size_t O_KS = O_IKP + (size_t)MP * 64;
constexpr size_t O_VS = O_KS + (size_t)MS * 256;
constexpr size_t O_IKS = O_VS + (size_t)MS * 256;
constexpr size_t O_SP = O_IKS + (size_t)MS * 64;
constexpr size_t O_CP = O_SP + (size_t)NB * 8 * 128 * 128;
constexpr size_t O_SS = O_CP + (size_t)NB * 3 * CONV;
constexpr size_t O_CS = O_SS + (size_t)DB * 8 * 128 * 128;
constexpr size_t O_END = O_CS + (size_t)DB * 3 * CONV;
static_assert(O_END == 32235520, "output size");

__device__ __forceinline__ float* kout(float* out, int m) { return m < MP ? out + O_KP + (size_t)m * 256 : out + O_KS + (size_t)(m - MP) * 256; }
__device__ __forceinline__ float* vout(float* out, int m) { return m < MP ? out + O_VP + (size_t)m * 256 : out + O_VS + (size_t)(m - MP) * 256; }
__device__ __forceinline__ float* ikout(float* out, int m) { return m < MP ? out + O_IKP + (size_t)m * 64 : out + O_IKS + (size_t)(m - MP) * 64; }
__device__ __forceinline__ const float* xrow(const float* xp, const float* xs, int m) { return m < MP ? xp + (size_t)m * D : xs + (size_t)(m - MP) * D; }

__device__ __forceinline__ int ltid() { int t = threadIdx.x; asm volatile("" : "+v"(t)); return t; }
typedef float f32x2_t __attribute__((ext_vector_type(2)));
typedef unsigned u32x4_t __attribute__((ext_vector_type(4)));
typedef float f32x4_t __attribute__((ext_vector_type(4)));
typedef float f32x2_t __attribute__((ext_vector_type(2)));
__device__ __forceinline__ float4 ldnt4(const float* p) { const f32x4_t v = __builtin_nontemporal_load((const f32x4_t*)p); return make_float4(v.x, v.y, v.z, v.w); }
__device__ __forceinline__ float ldnt1(const float* p) { return __builtin_nontemporal_load(p); }
__device__ __forceinline__ void stnt1(float* p, float a) { __builtin_nontemporal_store(a, p); }
__device__ __forceinline__ void stnt2(float* p, float a, float b) { const f32x2_t v = {a, b}; __builtin_nontemporal_store(v, (f32x2_t*)p); }
typedef short bf16x8 __attribute__((ext_vector_type(8)));
typedef float f32x16 __attribute__((ext_vector_type(16)));
typedef __bf16 bf16x2_t __attribute__((ext_vector_type(2)));
__device__ __forceinline__ unsigned cvtpk_native(float lo, float hi) { f32x2_t v = {lo, hi}; return __builtin_bit_cast(unsigned, __builtin_convertvector(v, bf16x2_t)); }
__device__ __forceinline__ void lds_barrier() { asm volatile("s_waitcnt lgkmcnt(0)" ::: "memory"); __builtin_amdgcn_s_barrier(); asm volatile("" ::: "memory"); }
__device__ __forceinline__ float bf2f(bf16_t b) { return __uint_as_float(((unsigned)b) << 16); }
__device__ __forceinline__ bf16_t f2bf(float f) { unsigned u = __float_as_uint(f); u += 0x7FFFu + ((u >> 16) & 1u); return (bf16_t)(u >> 16); }
__device__ __forceinline__ unsigned pk2bf(float lo, float hi) { return (unsigned)f2bf(lo) | ((unsigned)f2bf(hi) << 16); }
template <int N> __device__ __forceinline__ void wave_sum_n(float (&v)[N]) {
#pragma unroll
    for (int i = 0; i < N; ++i) v[i] += __int_as_float(__builtin_amdgcn_update_dpp(0, __float_as_int(v[i]), 0xB1, 0xF, 0xF, false));
#pragma unroll
    for (int i = 0; i < N; ++i) v[i] += __int_as_float(__builtin_amdgcn_update_dpp(0, __float_as_int(v[i]), 0x4E, 0xF, 0xF, false));
#pragma unroll
    for (int i = 0; i < N; ++i) v[i] += __int_as_float(__builtin_amdgcn_update_dpp(0, __float_as_int(v[i]), 0x124, 0xF, 0xF, false));
#pragma unroll
    for (int i = 0; i < N; ++i) v[i] += __int_as_float(__builtin_amdgcn_update_dpp(0, __float_as_int(v[i]), 0x128, 0xF, 0xF, false));
#pragma unroll
    for (int i = 0; i < N; ++i) v[i] += __shfl_xor(v[i], 16);
#pragma unroll
    for (int i = 0; i < N; ++i) v[i] += __shfl_xor(v[i], 32);
}
__device__ __forceinline__ float wave_sum(float v) { float a[1] = {v}; wave_sum_n<1>(a); return a[0]; }
__device__ __forceinline__ float silu(float x) { return x / (1.0f + __expf(-x)); }
}

namespace pg8 {
#define PG8_LAS __attribute__((address_space(3)))
typedef unsigned short bf16_t;
typedef short bf16x8 __attribute__((ext_vector_type(8)));
typedef float f32x4 __attribute__((ext_vector_type(4)));
typedef unsigned u32x4 __attribute__((ext_vector_type(4)));
constexpr int BM = 256, BK = 64, HALF = 128, HTB = HALF * BK * 2  , STAGE_BYTES = 8 * HTB, NXCD = 8, WGM = 8;

__host__ __device__ __forceinline__ int lds_byte(int r, int c) { const int st = (r >> 4) * 2 + (c >> 5), rr = r & 15, cc = c & 31, ob = rr * 64 + cc * 2; return st * 1024 + (ob ^ (((ob >> 9) & 1) << 5)); }
__host__ __device__ __forceinline__ void stage_rc(int b, int& R, int& C) { const int st = b / 1024, sb = b % 1024, swz = sb ^ (((sb >> 9) & 1) << 5); R = (st >> 1) * 16 + swz / 64; C = (st & 1) * 32 + (swz % 64) / 2; }
__host__ __device__ __forceinline__ int perm32(int rho) { const int n = rho >> 4, i = rho & 15; return 8 * (i >> 2) + 4 * n + (i & 3); }

struct Unit { int pm, pn; };
struct Gemm { const bf16_t* A; const bf16_t* Bt; int M, N, K, pad_; };

struct StaticOrder {
    int nM, nN, nwg, G, c;
    __host__ __device__ void init(int M, int N, int G_, int c_) { nM = M / BM; nN = N / BM; nwg = nM * nN; G = G_; c = c_; }
    __host__ __device__ bool next(int i, Unit& u) const {
        const long L = (long)i * G + c; if (L >= nwg) return false;
        int wgid = (int)L; { const int q = nwg / NXCD, r = nwg % NXCD, xcd = wgid % NXCD, off = wgid / NXCD; wgid = (xcd < r ? xcd * (q + 1) : r * (q + 1) + (xcd - r) * q) + off; }
        const int nig = WGM * nN, gid = wgid / nig, fm = gid * WGM, gsz = (nM - fm) < WGM ? (nM - fm) : WGM;
        u.pm = fm + ((wgid % nig) % gsz); u.pn = (wgid % nig) / gsz; return true;
    }
    __device__ __forceinline__ void a_ready(const Unit&) const {}
    __device__ __forceinline__ void done(const Unit&) const {}
};
struct CountedOrder : StaticOrder {
    const unsigned* ready; unsigned need; unsigned* tmo;
    __device__ __forceinline__ void a_ready(const Unit& u) const {
        if (mk::ltid() < 64) {
            const unsigned long long t0 = __builtin_amdgcn_s_memrealtime(); unsigned polls = 0;
            while ((unsigned)__builtin_amdgcn_readfirstlane(__hip_atomic_load(ready + 64 * u.pm, __ATOMIC_RELAXED, __HIP_MEMORY_SCOPE_AGENT)) < need) {
                if ((++polls & 255u) == 0u && __builtin_amdgcn_readfirstlane(__hip_atomic_load(tmo, __ATOMIC_RELAXED, __HIP_MEMORY_SCOPE_AGENT)) != 0u) break;
                if (__builtin_amdgcn_s_memrealtime() - t0 > 2000000ull) {
                    if (mk::ltid() == 0) { unsigned expect = 0u; __hip_atomic_compare_exchange_strong(tmo + 1, &expect, 0x600u | (unsigned)(u.pm & 0xff), __ATOMIC_RELAXED, __ATOMIC_RELAXED, __HIP_MEMORY_SCOPE_AGENT); __hip_atomic_store(tmo, 1u, __ATOMIC_RELAXED, __HIP_MEMORY_SCOPE_AGENT); }
                    break; }
                __builtin_amdgcn_s_sleep(2); }
            __builtin_amdgcn_fence(__ATOMIC_ACQUIRE, "agent");
            asm volatile("s_waitcnt vmcnt(0)" ::: "memory");
        }
#if !defined(BROKEN_HOOK_NO_BARRIER)
        asm volatile("" ::: "memory"); __builtin_amdgcn_s_barrier(); asm volatile("" ::: "memory");
#endif
    }
};

__device__ __forceinline__ unsigned cvt_pk_bf16(float lo, float hi) { return mk::cvtpk_native(lo, hi); }
typedef float f32x2 __attribute__((ext_vector_type(2)));
__device__ __forceinline__ f32x2 gelu_pk(f32x2 v) {
    const f32x2 av = __builtin_elementwise_abs(v), d = av * 0.2316418882f + 1.0f;
    f32x2 t; t.x = __builtin_amdgcn_rcpf(d.x); t.y = __builtin_amdgcn_rcpf(d.y);
    f32x2 q = t * 0.5307027145f + (-0.7265760135f); q = q * t + 0.7107068705f; q = q * t + (-0.142248368f); q = q * t + 0.127414796f; q = q * t;
    const f32x2 s = (v * v) * (-0.72134752044f);
    f32x2 e; e.x = __builtin_amdgcn_exp2f(s.x); e.y = __builtin_amdgcn_exp2f(s.y);
    const f32x2 m = v * (q * e), r = v - m;
    f32x2 o; o.x = v.x < 0.f ? m.x : r.x; o.y = v.y < 0.f ? m.y : r.y; return o;
}

struct EpiF32 {
    static constexpr bool PERM = false, AFTER_DRAIN = false;
    float* C; int ldc; const float* bias;
    __device__ __forceinline__ void operator()(const f32x4 (&acc)[2][2][4][2], const Unit& u, int wr, int wc, int fr, int fq) const {
        const int row0 = u.pm * BM + wr * 64 + fr, col0 = u.pn * BM + wc * 32 + 4 * fq;
        f32x4 bv[2][2];
#pragma unroll
        for (int bj = 0; bj < 2; ++bj)
#pragma unroll
            for (int n = 0; n < 2; ++n) bv[bj][n] = bias ? *(const f32x4*)(bias + col0 + bj * HALF + n * 16) : (f32x4){0.f, 0.f, 0.f, 0.f};
#pragma unroll
        for (int ai = 0; ai < 2; ++ai)
#pragma unroll
            for (int m = 0; m < 4; ++m) { float* rowp = C + (size_t)(row0 + ai * HALF + m * 16) * ldc + col0;
#pragma unroll
                for (int bj = 0; bj < 2; ++bj)
#pragma unroll
                    for (int n = 0; n < 2; ++n) *(f32x4*)(rowp + bj * HALF + n * 16) = acc[ai][bj][m][n] + bv[bj][n]; }
    }
};
template <int ACT  > struct EpiBf16 {
    static constexpr bool PERM = true, AFTER_DRAIN = false;
    bf16_t* O; int ldc; const float* bias; int split_cols; size_t split_stride;
    __device__ __forceinline__ void operator()(const f32x4 (&acc)[2][2][4][2], const Unit& u, int wr, int wc, int fr, int fq) const {
        const int row0 = u.pm * BM + wr * 64 + fr; int colt = u.pn * BM; bf16_t* base = O;
        if (split_cols) { const int t = colt / split_cols; base += (size_t)t * split_stride; colt -= t * split_cols; }
        const int col0 = colt + wc * 32 + 8 * fq, bcol0 = u.pn * BM + wc * 32 + 8 * fq;
        f32x4 bv[2][2];
#pragma unroll
        for (int bj = 0; bj < 2; ++bj)
#pragma unroll
            for (int n = 0; n < 2; ++n) bv[bj][n] = bias ? *(const f32x4*)(bias + bcol0 + bj * HALF + 4 * n) : (f32x4){0.f, 0.f, 0.f, 0.f};
#pragma unroll
        for (int ai = 0; ai < 2; ++ai)
#pragma unroll
            for (int m = 0; m < 4; ++m) { bf16_t* rowp = base + (size_t)(row0 + ai * HALF + m * 16) * ldc + col0;
#pragma unroll
                for (int bj = 0; bj < 2; ++bj) { f32x4 v0 = acc[ai][bj][m][0] + bv[bj][0], v1 = acc[ai][bj][m][1] + bv[bj][1];
                    if (ACT == 1) { f32x2 a = gelu_pk((f32x2){v0[0], v0[1]}), b = gelu_pk((f32x2){v0[2], v0[3]}), c = gelu_pk((f32x2){v1[0], v1[1]}), d = gelu_pk((f32x2){v1[2], v1[3]});
                        v0 = (f32x4){a.x, a.y, b.x, b.y}; v1 = (f32x4){c.x, c.y, d.x, d.y}; }
                    if (ACT == 2) {
#pragma unroll
                        for (int j = 0; j < 4; ++j) { v0[j] = 0.5f * v0[j] * (1.0f + erff(v0[j] * 0.70710678f)); v1[j] = 0.5f * v1[j] * (1.0f + erff(v1[j] * 0.70710678f)); } }
                    u32x4 w; w.x = cvt_pk_bf16(v0[0], v0[1]); w.y = cvt_pk_bf16(v0[2], v0[3]); w.z = cvt_pk_bf16(v1[0], v1[1]); w.w = cvt_pk_bf16(v1[2], v1[3]);
                    *(u32x4*)(rowp + bj * HALF) = w; } }
    }
};

template <class Epi, class Sched, bool STAMP = false>
__device__ __forceinline__ void gemm_phase(PG8_LAS unsigned char* lds, const Gemm g, const Sched& S, const Epi& E, unsigned long long* stamps) {
    const int tid = mk::ltid(), wid = __builtin_amdgcn_readfirstlane(tid >> 6), lane = tid & 63, wr = wid >> 2, wc = wid & 3, fr = lane & 15, fq = lane >> 4;
    const int K = g.K, nt = K / BK;
    int ts_lo = 0, ts_hi = 0, nts = 0; const unsigned long long rt_entry = STAMP ? (unsigned long long)wall_clock64() : 0ull;
#define PG8_STAMP() do { if (STAMP && wid == 0 && nts < 64) { const unsigned long long _c = (unsigned long long)clock64(); \
        ts_lo = (lane == nts) ? (int)(unsigned)_c : ts_lo; ts_hi = (lane == nts) ? (int)(unsigned)(_c >> 32) : ts_hi; ++nts; } } while (0)
    PG8_STAMP();
    unsigned voffA[2], voffB[2];
#pragma unroll
    for (int i = 0; i < 2; ++i) { int R, C; stage_rc(tid * 16 + i * 8192, R, C); const int Rb = Epi::PERM ? ((R & ~31) + perm32(R & 31)) : R;
        voffA[i] = (unsigned)(R * K + C) * 2u; voffB[i] = (unsigned)(Rb * K + C) * 2u; }
    const size_t kstep = (size_t)(BK * 2);
    const size_t hstep = (size_t)HALF * K * 2;
    const size_t tstep = 2 * hstep;
    const unsigned ldsw = (unsigned)wid * 1024u;
    const int aoff = lds_byte(wr * 64 + fr, fq * 8), boff = lds_byte(wc * 32 + fr, fq * 8);
#define PG8_SA(b, h) (((b) * 2 + (h)) * HTB)
#define PG8_SB(b, h) ((4 + (b) * 2 + (h)) * HTB)
#define PG8_STAGE(bufoff, gbase, voff) do { _Pragma("unroll") for (int _i = 0; _i < 2; ++_i) \
        __builtin_amdgcn_global_load_lds((const unsigned*)((const char*)(gbase) + (voff)[_i]), (PG8_LAS unsigned*)(lds + (bufoff) + ldsw + _i * 8192), 16, 0, 0); } while (0)
#define PG8_LDA(dst, b, h) do { _Pragma("unroll") for (int m = 0; m < 4; ++m) _Pragma("unroll") for (int k = 0; k < 2; ++k) dst[m][k] = *(const PG8_LAS bf16x8*)(lds + PG8_SA(b, h) + aoff + m * 2048 + k * 1024); } while (0)
#define PG8_LDB(dst, b, h) do { _Pragma("unroll") for (int n = 0; n < 2; ++n) _Pragma("unroll") for (int k = 0; k < 2; ++k) dst[n][k] = *(const PG8_LAS bf16x8*)(lds + PG8_SB(b, h) + boff + n * 2048 + k * 1024); } while (0)
#define PG8_MMA(ai, bj, At, Bt) do { __builtin_amdgcn_s_setprio(1); _Pragma("unroll") for (int m = 0; m < 4; ++m) _Pragma("unroll") for (int n = 0; n < 2; ++n) _Pragma("unroll") for (int k = 0; k < 2; ++k) \
        acc[ai][bj][m][n] = __builtin_amdgcn_mfma_f32_16x16x32_bf16(Bt[n][k], At[m][k], acc[ai][bj][m][n], 0, 0, 0); __builtin_amdgcn_s_setprio(0); } while (0)
#define PG8_WAIT_V(n) asm volatile("s_waitcnt vmcnt(" #n ")" ::: "memory")
#define PG8_WAIT_L(n) asm volatile("s_waitcnt lgkmcnt(" #n ")" ::: "memory")
#define PG8_BAR __builtin_amdgcn_s_barrier()
#define PG8_SCHED __builtin_amdgcn_sched_barrier(0)
    Unit cur, nxt; int ui = 0;
    if (!S.next(0, cur)) return;
    f32x4 acc[2][2][4][2];
#pragma unroll
    for (int a = 0; a < 2; ++a)
#pragma unroll
        for (int b = 0; b < 2; ++b)
#pragma unroll
            for (int m = 0; m < 4; ++m)
#pragma unroll
                for (int n = 0; n < 2; ++n) acc[a][b][m][n] = (f32x4){0.f, 0.f, 0.f, 0.f};
    bf16x8 At[4][2], B0[2][2], B1[2][2];
    const char* cA = (const char*)g.A + (size_t)cur.pm * tstep; const char* cB = (const char*)g.Bt + (size_t)cur.pn * tstep;
    S.a_ready(cur);
    PG8_STAGE(PG8_SB(0, 0), cB, voffB); PG8_STAGE(PG8_SA(0, 0), cA, voffA); PG8_STAGE(PG8_SB(0, 1), cB + hstep, voffB); PG8_STAGE(PG8_SA(0, 1), cA + hstep, voffA);
    if (wr == 1) PG8_BAR;
    PG8_WAIT_V(4); PG8_BAR;
    PG8_STAGE(PG8_SB(1, 0), cB + kstep, voffB); PG8_STAGE(PG8_SA(1, 0), cA + kstep, voffA); PG8_STAGE(PG8_SB(1, 1), cB + hstep + kstep, voffB);
    PG8_WAIT_V(6); PG8_BAR;
    PG8_STAMP();
    for (;;) {
        const bool has_next = S.next(ui + 1, nxt);
        const char* nA = has_next ? (const char*)g.A + (size_t)nxt.pm * tstep : cA; const char* nB = has_next ? (const char*)g.Bt + (size_t)nxt.pn * tstep : cB;
        for (int t = 0; t < nt; t += 2) {
            const bool last = (t == nt - 2);
            const char* a1 = cA + (size_t)(t + 1) * kstep;
            const char* a2 = last ? nA : cA + (size_t)(t + 2) * kstep; const char* b2 = last ? nB : cB + (size_t)(t + 2) * kstep;
            const char* a3 = a2 + kstep; const char* b3 = b2 + kstep;
            if (last && has_next) S.a_ready(nxt);
            PG8_LDB(B0, 0, 0); PG8_SCHED; PG8_LDA(At, 0, 0); PG8_STAGE(PG8_SA(1, 1), a1 + hstep, voffA);
            PG8_WAIT_L(8); PG8_BAR; PG8_WAIT_L(0); PG8_MMA(0, 0, At, B0); PG8_BAR; PG8_SCHED;
            PG8_LDB(B1, 0, 1); PG8_STAGE(PG8_SB(0, 0), b2, voffB);
            PG8_BAR; PG8_WAIT_L(0); PG8_MMA(0, 1, At, B1); PG8_BAR;
            PG8_LDA(At, 0, 1); PG8_STAGE(PG8_SA(0, 0), a2, voffA);
            PG8_BAR; PG8_WAIT_L(0); PG8_MMA(1, 0, At, B0); PG8_BAR; PG8_SCHED;
            PG8_STAGE(PG8_SB(0, 1), b2 + hstep, voffB);
            PG8_WAIT_V(6); PG8_BAR; PG8_MMA(1, 1, At, B1); PG8_BAR;
            PG8_LDB(B0, 1, 0); PG8_SCHED; PG8_LDA(At, 1, 0); PG8_STAGE(PG8_SA(0, 1), a2 + hstep, voffA);
            PG8_WAIT_L(8); PG8_BAR; PG8_WAIT_L(0); PG8_MMA(0, 0, At, B0); PG8_BAR; PG8_SCHED;
            PG8_LDB(B1, 1, 1); PG8_STAGE(PG8_SB(1, 0), b3, voffB);
            PG8_BAR; PG8_WAIT_L(0); PG8_MMA(0, 1, At, B1); PG8_BAR;
            PG8_LDA(At, 1, 1); PG8_STAGE(PG8_SA(1, 0), a3, voffA);
            PG8_BAR; PG8_WAIT_L(0); PG8_MMA(1, 0, At, B0); PG8_BAR; PG8_SCHED;
            PG8_STAGE(PG8_SB(1, 1), b3 + hstep, voffB);
            PG8_WAIT_V(6); PG8_BAR; PG8_MMA(1, 1, At, B1); PG8_BAR;
        }
        PG8_STAMP();
        if constexpr (!Epi::AFTER_DRAIN) { E(acc, cur, wr, wc, fr, fq); S.done(cur); }
        PG8_STAMP();
        if (!has_next) break;
#pragma unroll
        for (int a = 0; a < 2; ++a)
#pragma unroll
            for (int b = 0; b < 2; ++b)
#pragma unroll
                for (int m = 0; m < 4; ++m)
#pragma unroll
                    for (int n = 0; n < 2; ++n) acc[a][b][m][n] = (f32x4){0.f, 0.f, 0.f, 0.f};
        cur = nxt; cA = nA; cB = nB; ++ui;
    }
    PG8_WAIT_V(0);
    if (wr == 0) PG8_BAR;
    PG8_BAR;
    if constexpr (Epi::AFTER_DRAIN) { E.fused(acc, cur, wr, wc, fr, fq, lds, wid, lane); S.done(cur); }
    PG8_STAMP();
    if (STAMP && wid == 0) { stamps[lane] = lane < nts ? (((unsigned long long)(unsigned)ts_hi << 32) | (unsigned)ts_lo) : 0ull;
        if (lane == 62) stamps[62] = rt_entry; if (lane == 63) stamps[63] = (unsigned long long)wall_clock64(); }
#undef PG8_STAMP
#undef PG8_SA
#undef PG8_SB
#undef PG8_STAGE
#undef PG8_LDA
#undef PG8_LDB
#undef PG8_MMA
#undef PG8_WAIT_V
#undef PG8_WAIT_L
#undef PG8_BAR
#undef PG8_SCHED
}
}

#define XB_TMO      128
#define XB_XCNT(j)  (256  + 64 * (j))
#define XB_XSUB(j)  (1280 + 64 * (j))
#define XB_XGEN(j)  (2304 + 64 * (j))
#define XB_TOP      3328
#define XB_TOPGEN   3392
#define XCD_BAR_WORDS 3456
#define XB_SPIN_CAP (1u << 18)
#define LAS __attribute__((address_space(3)))

__device__ __forceinline__ unsigned xb_ld(unsigned* p)              { return __hip_atomic_load(p, __ATOMIC_RELAXED, __HIP_MEMORY_SCOPE_AGENT); }
__device__ __forceinline__ unsigned xb_add(unsigned* p, unsigned v) { return __hip_atomic_fetch_add(p, v, __ATOMIC_RELAXED, __HIP_MEMORY_SCOPE_AGENT); }
__device__ __forceinline__ unsigned xb_xcc_id() { return (unsigned)__builtin_amdgcn_s_getreg((3 << 11) | 20) & 0xFu; }
#define XB_SPIN(cond, bar) do { unsigned _sp = 0; while (cond) { __builtin_amdgcn_s_sleep(1); \
    if ((++_sp & 255u) == 0u) { if (xb_ld(&(bar)[XB_TMO])) break; if (_sp > XB_SPIN_CAP) { atomicAdd(&(bar)[XB_TMO], 1u); break; } } } } while (0)

struct XcdBarrier {
    unsigned* bar; unsigned x;
    volatile LAS unsigned* st;
};

__device__ __forceinline__ XcdBarrier xcd_barrier_post(unsigned* bar, volatile LAS unsigned* st) {
    XcdBarrier b; b.bar = bar; b.x = xb_xcc_id(); b.st = st;
    if (threadIdx.x == 0) (void)xb_add(&bar[XB_XCNT(b.x)], 1u);
    return b;
}
__device__ __forceinline__ void xcd_barrier_complete(unsigned* bar, unsigned x, unsigned& nloc, unsigned& nx) {
    const unsigned G = gridDim.x * gridDim.y * gridDim.z;
    unsigned sum, cnt, mine, sp = 0u;
    for (;;) {
        sum = 0u; cnt = 0u; mine = 0u;
#pragma unroll
        for (unsigned j = 0; j < 16; ++j) { const unsigned c = xb_ld(&bar[XB_XCNT(j)]); sum += c; cnt += (c > 0u) ? 1u : 0u; mine = (j == x) ? c : mine; }
        if (sum == G) break;
        __builtin_amdgcn_s_sleep(1);
        if ((++sp & 255u) == 0u) { if (xb_ld(&bar[XB_TMO])) break; if (sp > XB_SPIN_CAP) { atomicAdd(&bar[XB_TMO], 1u); break; } }
    }
    nloc = mine > 0u ? mine : 1u; nx = cnt > 0u ? cnt : 1u;
}

__device__ __forceinline__ void xcd_barrier(const XcdBarrier& b) {
    asm volatile("s_waitcnt vmcnt(0)" ::: "memory");
    __syncthreads();
    if (threadIdx.x == 0) {
        unsigned* bar = b.bar;
        __builtin_amdgcn_s_waitcnt(0);
        unsigned nloc = b.st[0], nx = b.st[1];
        if (nloc == 0u) { xcd_barrier_complete(bar, b.x, nloc, nx); b.st[0] = nloc; b.st[1] = nx; }
        const unsigned old = xb_add(&bar[XB_XSUB(b.x)], 1u);
        const unsigned gen = old / nloc;
        if (old + 1u == (gen + 1u) * nloc) {
            __builtin_amdgcn_fence(__ATOMIC_RELEASE, "agent");
            asm volatile("s_waitcnt vmcnt(0)" ::: "memory");
            const unsigned og = xb_add(&bar[XB_TOP], 1u);
            const unsigned tg = og / nx;
            if (og + 1u == (tg + 1u) * nx) xb_add(&bar[XB_TOPGEN], 1u);
            else XB_SPIN(xb_ld(&bar[XB_TOPGEN]) == tg, bar);
            __builtin_amdgcn_fence(__ATOMIC_ACQUIRE, "agent");
            xb_add(&bar[XB_XGEN(b.x)], 1u);
            asm volatile("s_waitcnt vmcnt(0)" ::: "memory");
        } else {
            XB_SPIN(xb_ld(&bar[XB_XGEN(b.x)]) == gen, bar);
            __builtin_amdgcn_fence(__ATOMIC_ACQUIRE, "agent");
            asm volatile("s_waitcnt vmcnt(0)" ::: "memory");
        }
    }
    __syncthreads();
}


namespace mk {
#define LAS3 __attribute__((address_space(3)))
__device__ __forceinline__ int src_col1(int n) { if (n < 2048) return n; if (n < 3072) return SG + (n - 2048); if (n < 3136) return SIK + (n - 3072); if (n < 3144) return SIW + (n - 3136); return -1; }
__device__ __forceinline__ int src_col3(int n) { return n < DN_IN ? n : -1; }
__device__ __forceinline__ int src_colid(int n) { return n; }

template <int MAP> __device__ __forceinline__ void wconv_load(float (&v)[8], const float* W, int ldw, const float* gain, int n0, int k0) {
    const int tid = mk::ltid();
#pragma unroll
    for (int i = 0; i < 8; ++i) {
        const int e = tid + 512 * i, kk = e >> 6, nn = e & 63, n = n0 + nn;
        const int sc = MAP == 1 ? src_col1(n) : (MAP == 3 ? src_col3(n) : src_colid(n));
        float x = 0.f;
        if (sc >= 0) { x = W[(size_t)(k0 + kk) * ldw + sc]; if (gain) x *= gain[k0 + kk]; }
        v[i] = x;
    }
}
template <int MAP> __device__ __forceinline__ void wconv_all(float* tile, const float* W, int ldw, const float* gain, bf16_t* Wt, int K, int NP, int bid, int nblk) {
    const int ntn = NP / 64, ntk = K / 64, total = ntn * ntk, tid = mk::ltid();
    float v[8], vn[8];
    int t = bid;
    if (t < total) wconv_load<MAP>(v, W, ldw, gain, (t % ntn) * 64, (t / ntn) * 64);
    for (; t < total; t += nblk) {
        const int tn = t + nblk, n0 = (t % ntn) * 64, k0 = (t / ntn) * 64;
        if (tn < total) wconv_load<MAP>(vn, W, ldw, gain, (tn % ntn) * 64, (tn / ntn) * 64);
#pragma unroll
        for (int i = 0; i < 8; ++i) { const int e = tid + 512 * i; tile[(e >> 6) * 65 + (e & 63)] = v[i]; }
        __syncthreads();
#pragma unroll
        for (int i = 0; i < 4; ++i) {
            const int e = tid + 512 * i, nn = e >> 5, kk = (e & 31) * 2;
            *(unsigned*)(Wt + (size_t)(n0 + nn) * K + k0 + kk) = pk2bf(tile[kk * 65 + nn], tile[(kk + 1) * 65 + nn]);
        }
        __syncthreads();
#pragma unroll
        for (int i = 0; i < 8; ++i) v[i] = vn[i];
    }
}
template <int MAP> __device__ __forceinline__ void wconv_waves(const float* W, int ldw, const float* gain, bf16_t* Wt, int K, int NP, int wv, int nwv) {
    const int l = mk::ltid() & 63, n = l & 31, kh = l >> 5;
    const int nun = NP / 32, nuk = K / 64;
    for (int u = wv; u < nun * nuk; u += nwv) {
        const int n0 = (u % nun) * 32, k0 = (u / nun) * 64 + 32 * kh;
        const int sc = MAP == 1 ? src_col1(n0 + n) : (MAP == 3 ? src_col3(n0 + n) : src_colid(n0 + n));
        float x[32];
#pragma unroll
        for (int i = 0; i < 32; ++i) x[i] = sc >= 0 ? W[(size_t)(k0 + i) * ldw + sc] : 0.f;
        if (gain) {
#pragma unroll
            for (int i = 0; i < 32; ++i) x[i] *= gain[k0 + i];
        }
        uint4* dst = (uint4*)(Wt + (size_t)(n0 + n) * K + k0);
#pragma unroll
        for (int q = 0; q < 4; ++q) dst[q] = make_uint4(cvtpk_native(x[8 * q], x[8 * q + 1]), cvtpk_native(x[8 * q + 2], x[8 * q + 3]), cvtpk_native(x[8 * q + 4], x[8 * q + 5]), cvtpk_native(x[8 * q + 6], x[8 * q + 7]));
    }
}
__device__ __forceinline__ void xnorm_load(const float* x, float4 (&v)[4]) { const int lane = mk::ltid() & 63;
#pragma unroll
    for (int i = 0; i < 4; ++i) v[i] = ldnt4(x + 4 * (lane + 64 * i)); }
__device__ __forceinline__ void xnorm_finish(const float4 (&v)[4], bf16_t* xa, float* inv) {
    const int lane = mk::ltid() & 63;
    float ss = 0.f;
#pragma unroll
    for (int i = 0; i < 4; ++i) ss += v[i].x * v[i].x + v[i].y * v[i].y + v[i].z * v[i].z + v[i].w * v[i].w;
    ss = wave_sum(ss);
    const float ms = ss * (1.0f / D) + EPS, r = rsqrtf(ms);
    if (lane == 0) *inv = ms * r;
#pragma unroll
    for (int i = 0; i < 4; ++i) { uint2 w; w.x = pk2bf(v[i].x * r, v[i].y * r); w.y = pk2bf(v[i].z * r, v[i].w * r); ((uint2*)xa)[lane + 64 * i] = w; }
}

using pg8::f32x4; using pg8::u32x4; using pg8::Unit; using pg8::BM; using pg8::HALF;
struct EpiF32Res {
    static constexpr bool PERM = false, AFTER_DRAIN = false;
    float* C; const float* R0; const float* R1; bf16_t* XB; float* SS; int ld; int pad_;
    __device__ __forceinline__ void operator()(const f32x4 (&acc)[2][2][4][2], const Unit& u, int wr, int wc, int fr, int fq) const {
        const int row0 = u.pm * BM + wr * 64 + fr, col0 = u.pn * BM + wc * 32 + 4 * fq;
        const float* Rb = (u.pm * BM < MP) ? R0 : R1 - (size_t)MP * ld;
#pragma unroll
        for (int ai = 0; ai < 2; ++ai)
#pragma unroll
            for (int m = 0; m < 4; ++m) { const size_t ro = (size_t)(row0 + ai * HALF + m * 16) * ld + col0;
                float ss = 0.f;
#pragma unroll
                for (int bj = 0; bj < 2; ++bj)
#pragma unroll
                    for (int n = 0; n < 2; ++n) { const f32x4 v = acc[ai][bj][m][n] + *(const f32x4*)(Rb + ro + bj * HALF + n * 16);
                        if (C) *(f32x4*)(C + ro + bj * HALF + n * 16) = v;
                        if (XB) { *(uint2*)(XB + ro + bj * HALF + n * 16) = make_uint2(cvtpk_native(v[0], v[1]), cvtpk_native(v[2], v[3])); ss += (v[0] * v[0] + v[1] * v[1]) + (v[2] * v[2] + v[3] * v[3]); } }
                if (XB) { ss += __shfl_xor(ss, 16); ss += __shfl_xor(ss, 32); if (fq == 0) atomicAdd(SS + row0 + ai * HALF + m * 16, ss); }
            }
    }
};
struct EpiY1 {
    static constexpr bool PERM = false, AFTER_DRAIN = false;
    bf16_t* XB; const float* INV; float* SS; int ld; int pad_;
    __device__ __forceinline__ void operator()(const f32x4 (&acc)[2][2][4][2], const Unit& u, int wr, int wc, int fr, int fq) const {
        const int row0 = u.pm * BM + wr * 64 + fr, col0 = u.pn * BM + wc * 32 + 4 * fq;
#pragma unroll
        for (int ai = 0; ai < 2; ++ai)
#pragma unroll
            for (int m = 0; m < 4; ++m) { const int row = row0 + ai * HALF + m * 16; const size_t ro = (size_t)row * ld + col0;
                const float inv = INV[row];
                float ss = 0.f;
#pragma unroll
                for (int bj = 0; bj < 2; ++bj)
#pragma unroll
                    for (int n = 0; n < 2; ++n) { uint2* xp = (uint2*)(XB + ro + bj * HALF + n * 16); const uint2 rb = *xp;
                        f32x4 v = acc[ai][bj][m][n];
                        v[0] = fmaf(__uint_as_float(rb.x << 16), inv, v[0]); v[1] = fmaf(__uint_as_float(rb.x & 0xFFFF0000u), inv, v[1]);
                        v[2] = fmaf(__uint_as_float(rb.y << 16), inv, v[2]); v[3] = fmaf(__uint_as_float(rb.y & 0xFFFF0000u), inv, v[3]);
                        *xp = make_uint2(cvtpk_native(v[0], v[1]), cvtpk_native(v[2], v[3])); ss += (v[0] * v[0] + v[1] * v[1]) + (v[2] * v[2] + v[3] * v[3]); }
                ss += __shfl_xor(ss, 16); ss += __shfl_xor(ss, 32); if (fq == 0) atomicAdd(SS + row, ss);
            }
    }
};
struct EpiF32ResBf {
    static constexpr bool PERM = false, AFTER_DRAIN = false;
    float* C; const bf16_t* RB; int ld; int pad_;
    __device__ __forceinline__ void operator()(const f32x4 (&acc)[2][2][4][2], const Unit& u, int wr, int wc, int fr, int fq) const {
        const int row0 = u.pm * BM + wr * 64 + fr, col0 = u.pn * BM + wc * 32 + 4 * fq;
#pragma unroll
        for (int ai = 0; ai < 2; ++ai)
#pragma unroll
            for (int m = 0; m < 4; ++m) { const size_t ro = (size_t)(row0 + ai * HALF + m * 16) * ld + col0;
#pragma unroll
                for (int bj = 0; bj < 2; ++bj)
#pragma unroll
                    for (int n = 0; n < 2; ++n) { const uint2 rb = *(const uint2*)(RB + ro + bj * HALF + n * 16);
                        f32x4 v = acc[ai][bj][m][n];
                        v[0] += __uint_as_float(rb.x << 16); v[1] += __uint_as_float(rb.x & 0xFFFF0000u); v[2] += __uint_as_float(rb.y << 16); v[3] += __uint_as_float(rb.y & 0xFFFF0000u);
                        *(f32x4*)(C + ro + bj * HALF + n * 16) = v; }
            }
    }
};
struct EpiBf16Tail {
    static constexpr bool PERM = true, AFTER_DRAIN = false;
    bf16_t* O; int ldc; int ntile_bf; float* BA; const float* SS;
    float* QSS;
    __device__ __forceinline__ void operator()(const f32x4 (&acc)[2][2][4][2], const Unit& u, int wr, int wc, int fr, int fq) const {
        const int row0 = u.pm * BM + wr * 64 + fr;
        float rs[2][4];
#pragma unroll
        for (int ai = 0; ai < 2; ++ai)
#pragma unroll
            for (int m = 0; m < 4; ++m) rs[ai][m] = SS ? rsqrtf(SS[row0 + ai * HALF + m * 16] * (1.0f / D) + EPS) : 1.0f;
        if (u.pn >= ntile_bf) {
            if (wc == 0 && fq < 2) {
#pragma unroll
                for (int ai = 0; ai < 2; ++ai)
#pragma unroll
                    for (int m = 0; m < 4; ++m) { float* rp = BA + (size_t)(row0 + ai * HALF + m * 16) * 16 + 8 * fq;
                        *(f32x4*)(rp) = acc[ai][0][m][0] * rs[ai][m]; *(f32x4*)(rp + 4) = acc[ai][0][m][1] * rs[ai][m]; }
            }
            return;
        }
        const int col0 = u.pn * BM + wc * 32 + 8 * fq;
        const bool qsum = QSS != nullptr && u.pn < 4;
#pragma unroll
        for (int ai = 0; ai < 2; ++ai)
#pragma unroll
            for (int m = 0; m < 4; ++m) { bf16_t* rowp = O + (size_t)(row0 + ai * HALF + m * 16) * ldc + col0;
#pragma unroll
                for (int bj = 0; bj < 2; ++bj) { const f32x4 v0 = acc[ai][bj][m][0] * rs[ai][m], v1 = acc[ai][bj][m][1] * rs[ai][m];
                    u32x4 w; w.x = pg8::cvt_pk_bf16(v0[0], v0[1]); w.y = pg8::cvt_pk_bf16(v0[2], v0[3]); w.z = pg8::cvt_pk_bf16(v1[0], v1[1]); w.w = pg8::cvt_pk_bf16(v1[2], v1[3]);
                    *(u32x4*)(rowp + bj * HALF) = w;
                    if (qsum) { float ss = ((v0[0] * v0[0] + v0[1] * v0[1]) + (v0[2] * v0[2] + v0[3] * v0[3])) + ((v1[0] * v1[0] + v1[1] * v1[1]) + (v1[2] * v1[2] + v1[3] * v1[3]));
                        ss += __shfl_xor(ss, 16); ss += __shfl_xor(ss, 32);
                        if (fq == 0) atomicAdd(QSS + (size_t)(row0 + ai * HALF + m * 16) * 8 + 2 * u.pn + bj, ss); } } }
    }
};
}
namespace mk {
template <int NJ, class P, class F> __device__ __forceinline__ void gemm_small_unit(char* lds, const bf16_t* A, const bf16_t* Bt, int row0, int col0, P&& pre, F&& emit) {
    const int tid = ltid(), w = __builtin_amdgcn_readfirstlane(tid >> 6), l = tid & 63, r = l & 31, hh = l >> 5;
    const bf16_t* ap = A + (size_t)(row0 + r) * D + 128 * w + 8 * hh;
    const bf16_t* bp = Bt + (size_t)(col0 + r) * D + 128 * w + 8 * hh;
    bf16x8 af[8], bfr[NJ][8];
#pragma unroll
    for (int s = 0; s < 8; ++s) { af[s] = *(const bf16x8*)(ap + 16 * s);
#pragma unroll
        for (int j = 0; j < NJ; ++j) bfr[j][s] = *(const bf16x8*)(bp + (size_t)(32 * j) * D + 16 * s); }
    float rsd[NJ][2];
#pragma unroll
    for (int j = 0; j < NJ; ++j)
#pragma unroll
        for (int e = 0; e < 2; ++e) { const int q = 2 * w + e; rsd[j][e] = pre(row0 + (q & 3) + 8 * (q >> 2) + 4 * hh, col0 + 32 * j + r); }
    f32x16 acc[NJ];
#pragma unroll
    for (int j = 0; j < NJ; ++j) acc[j] = f32x16{};
#pragma unroll
    for (int s = 0; s < 8; ++s)
#pragma unroll
        for (int j = 0; j < NJ; ++j) acc[j] = __builtin_amdgcn_mfma_f32_32x32x16_bf16(af[s], bfr[j][s], acc[j], 0, 0, 0);
    float* part = (float*)lds;
#pragma unroll
    for (int j = 0; j < NJ; ++j)
#pragma unroll
        for (int q = 0; q < 16; ++q) part[((w * NJ + j) * 16 + q) * 64 + l] = acc[j][q];
    __syncthreads();
#pragma unroll
    for (int j = 0; j < NJ; ++j)
#pragma unroll
        for (int e = 0; e < 2; ++e) {
            const int q = 2 * w + e;
            float v = 0.f;
#pragma unroll
            for (int ww = 0; ww < 8; ++ww) v += part[((ww * NJ + j) * 16 + q) * 64 + l];
            emit(row0 + (q & 3) + 8 * (q >> 2) + 4 * hh, col0 + 32 * j + r, v, rsd[j][e]);
        }
    __syncthreads();
}
}

namespace mk {

struct AttPostRegs { unsigned k[2], v[2]; bf16_t ik, iw; };
__device__ __forceinline__ void att_post_load(int m, const bf16_t* P1, AttPostRegs& R) {
    const int l = mk::ltid() & 63;
    const unsigned* p = (const unsigned*)(P1 + (size_t)m * N1P);
#pragma unroll
    for (int h = 0; h < 2; ++h) { R.k[h] = p[(CK >> 1) + h * 64 + l]; R.v[h] = p[(CV >> 1) + h * 64 + l]; }
    R.ik = P1[(size_t)m * N1P + CIK + l]; R.iw = P1[(size_t)m * N1P + CIW + (l & 7)];
}
__device__ __forceinline__ void att_post_finish(int m, const AttPostRegs& R, const float* qg, const float* kg, const float* ikg, bf16_t* KB, bf16_t* IKB, float* IW, float* out) {
    const int l = mk::ltid() & 63;
    const float g0 = qg[2 * l], g1 = qg[2 * l + 1];
    {
        const float k0 = kg[2 * l], k1 = kg[2 * l + 1];
        float* ko = kout(out, m); unsigned* kb = (unsigned*)(KB + (size_t)m * 256);
        float ka[2], kb2[2], ss[3];
#pragma unroll
        for (int h = 0; h < 2; ++h) { ka[h] = __uint_as_float(R.k[h] << 16); kb2[h] = __uint_as_float(R.k[h] & 0xFFFF0000u); ss[h] = ka[h] * ka[h] + kb2[h] * kb2[h]; }
        const float ia = bf2f(R.ik); ss[2] = ia * ia;
        wave_sum_n<3>(ss);
#pragma unroll
        for (int h = 0; h < 2; ++h) {
            const float r = rsqrtf(ss[h] * (1.0f / 128) + EPS);
            const float x = ka[h] * r * k0, y = kb2[h] * r * k1;
            *(float2*)(ko + h * 128 + 2 * l) = make_float2(x, y);
            kb[h * 64 + l] = pk2bf(x * g0, y * g1);
        }
        float* vo = vout(out, m);
#pragma unroll
        for (int h = 0; h < 2; ++h) *(float2*)(vo + h * 128 + 2 * l) = make_float2(__uint_as_float(R.v[h] << 16), __uint_as_float(R.v[h] & 0xFFFF0000u));
        const float ri = rsqrtf(ss[2] * (1.0f / 64) + EPS);
        const float xi = ia * ri * ikg[l];
        ikout(out, m)[l] = xi;
        IKB[(size_t)m * 64 + l] = f2bf(xi);
        if (l < 8) IW[(size_t)m * 8 + l] = bf2f(R.iw) * (0.35355339059327373f * 0.125f);
    }
}
__device__ __forceinline__ void att_post_rows(int gw, int nw, const bf16_t* P1, const float* qg, const float* kg, const float* ikg, bf16_t* KB, bf16_t* IKB, float* IW, float* out) {
    AttPostRegs R0, R1, R2;
    int m = gw;
    if (m < M) att_post_load(m, P1, R0);
    if (m + nw < M) att_post_load(m + nw, P1, R1);
    for (; m < M; m += 3 * nw) {
        if (m + 2 * nw < M) att_post_load(m + 2 * nw, P1, R2);
        att_post_finish(m, R0, qg, kg, ikg, KB, IKB, IW, out);
        if (m + nw < M) { if (m + 3 * nw < M) att_post_load(m + 3 * nw, P1, R0);
            att_post_finish(m + nw, R1, qg, kg, ikg, KB, IKB, IW, out); }
        if (m + 2 * nw < M) { if (m + 4 * nw < M) att_post_load(m + 4 * nw, P1, R1);
            att_post_finish(m + 2 * nw, R2, qg, kg, ikg, KB, IKB, IW, out); }
    }
}
}

namespace ix {
using mk::bf16_t; using mk::bf16x8; using mk::f32x16;
constexpr int TOPK = mk::TOPK;
constexpr float NEGINF = -__builtin_inff();
__device__ __forceinline__ float key2f(unsigned k) { return (k & 0x80000000u) ? __uint_as_float(k & 0x7FFFFFFFu) : __uint_as_float(~k); }

__device__ __forceinline__ void tile_partial(const bf16x8 (&af)[4], const bf16x8 (&bfr)[4], const float (&w)[16], float (&p)[4]) {
    f32x16 acc = {};
#pragma unroll
    for (int s = 0; s < 4; ++s) acc = __builtin_amdgcn_mfma_f32_32x32x16_bf16(af[s], bfr[s], acc, 0, 0, 0);
#pragma unroll
    for (int T = 0; T < 4; ++T) {
        float x = w[4 * T] * fmaxf(acc[4 * T], 0.f);
        x = fmaf(w[4 * T + 1], fmaxf(acc[4 * T + 1], 0.f), x);
        x = fmaf(w[4 * T + 2], fmaxf(acc[4 * T + 2], 0.f), x);
        x = fmaf(w[4 * T + 3], fmaxf(acc[4 * T + 3], 0.f), x);
        p[T] = x;
    }
}
__device__ __forceinline__ float pair_combine(float pa, float pb) {
    auto rr = __builtin_amdgcn_permlane32_swap(__float_as_uint(pa), __float_as_uint(pb), false, false);
    return __uint_as_float(rr[0]) + __uint_as_float(rr[1]);
}
__device__ __forceinline__ void load_af_w(const bf16_t* P1, const float* IW, int m0, int r, int hh, bf16x8 (&af)[4], float (&w)[16]) {
    const bf16_t* ap = P1 + (size_t)(m0 + (r >> 3)) * mk::N1P + mk::CIQ + (r & 7) * 64 + 8 * hh;
#pragma unroll
    for (int s = 0; s < 4; ++s) af[s] = *(const bf16x8*)(ap + 16 * s);
#pragma unroll
    for (int i = 0; i < 16; ++i) w[i] = IW[(size_t)(m0 + (i >> 2)) * 8 + (i & 3) + 4 * hh];
}

template <int NA, int NR, int MI = 0, class F> __device__ __forceinline__ void topk_select(const float (&sc)[NA], F&& emit) {
    unsigned lo = 0x007FFFFFu, hi = 0xFF800001u;
    float tau = NEGINF; bool exact = false;
    auto count_ge = [&](float tf) __attribute__((always_inline)) -> int {
        int c = 0;
#pragma unroll
        for (int k0 = 0; k0 < NR; k0 += 8) {
            unsigned long long bm[8];
#pragma unroll
            for (int q = 0; q < 8; ++q) bm[q] = (k0 + q < NR) ? __builtin_amdgcn_ballot_w64(sc[k0 + q < NR ? k0 + q : 0] >= tf) : 0ull;
            __builtin_amdgcn_sched_barrier(0);
#pragma unroll
            for (int q = 0; q < 8; ++q) c += __builtin_popcountll(bm[q]);
            __builtin_amdgcn_sched_barrier(0);
        }
        return c;
    };
    if (MI) {
        float mx = sc[0];
#pragma unroll
        for (int k = 1; k < NR; ++k) mx = fmaxf(mx, sc[k]);
        mx = fmaxf(mx, __int_as_float(__builtin_amdgcn_update_dpp(0, __float_as_int(mx), 0xB1, 0xF, 0xF, false)));
        mx = fmaxf(mx, __int_as_float(__builtin_amdgcn_update_dpp(0, __float_as_int(mx), 0x4E, 0xF, 0xF, false)));
        mx = fmaxf(mx, __int_as_float(__builtin_amdgcn_update_dpp(0, __float_as_int(mx), 0x124, 0xF, 0xF, false)));
        mx = fmaxf(mx, __int_as_float(__builtin_amdgcn_update_dpp(0, __float_as_int(mx), 0x128, 0xF, 0xF, false)));
        const int mi = __float_as_int(mx);
        const float m4 = fmaxf(fmaxf(__int_as_float(__builtin_amdgcn_readlane(mi, 0)), __int_as_float(__builtin_amdgcn_readlane(mi, 16))),
                               fmaxf(__int_as_float(__builtin_amdgcn_readlane(mi, 32)), __int_as_float(__builtin_amdgcn_readlane(mi, 48))));
        if (m4 > 1e-30f) {
            hi = (__float_as_uint(m4) | 0x80000000u) + 1u;
            const float tf = m4 * 0.0625f; const unsigned kf = __float_as_uint(tf) | 0x80000000u;
            const int c = count_ge(tf);
            if (c >= TOPK) { lo = kf; tau = tf; if (c == TOPK) { exact = true; hi = lo + 1u; } } else hi = kf;
        }
    }
    while (hi - lo > 1u) {
        const unsigned mid = lo + ((hi - lo) >> 1);
        const float tf = key2f(mid);
        const int c = count_ge(tf);
        if (c >= TOPK) { lo = mid; tau = tf; if (c == TOPK) { exact = true; break; } } else hi = mid;
    }
    if (exact) {
#pragma unroll
        for (int k = 0; k < NA; ++k) emit(k, k < NR ? __builtin_amdgcn_ballot_w64(sc[k] >= tau) : 0ull);
        return;
    }
    int cgt = 0;
#pragma unroll
    for (int k = 0; k < NR; ++k) cgt += __builtin_popcountll(__builtin_amdgcn_ballot_w64(sc[k] > tau));
    int need = TOPK - cgt;
#pragma unroll
    for (int k = 0; k < NA; ++k) {
        unsigned long long bm = 0ull;
        if (k < NR) {
            const unsigned long long gt = __builtin_amdgcn_ballot_w64(sc[k] > tau);
            unsigned long long eq = __builtin_amdgcn_ballot_w64(sc[k] == tau);
            int pc = __builtin_popcountll(eq);
            while (pc > need) { eq &= ~(1ull << (63 - __builtin_clzll(eq))); --pc; }
            need -= pc;
            bm = gt | eq;
        }
        emit(k, bm);
    }
}

__device__ __forceinline__ void index_prompt_block(int b, int gi, char* lds, const bf16_t* P1, const bf16_t* IKB, const float* IW, unsigned* MASK) {
    const int tid = mk::ltid(), w = __builtin_amdgcn_readfirstlane(tid >> 6), l = tid & 63, r = l & 31, hh = l >> 5;
    const int t0 = 32 * gi + 4 * w, m0 = b * mk::SEQ + t0;
    if (gi < 8) {
#pragma unroll
        for (int T = 0; T < 4; ++T) { const int nb = t0 + T + 1 - 32 * l; MASK[(size_t)(m0 + T) * 64 + l] = nb >= 32 ? 0xFFFFFFFFu : (nb <= 0 ? 0u : ((1u << nb) - 1u)); }
        return;
    }
    bf16x8 af[4]; float wt[16];
    load_af_w(P1, IW, m0, r, hh, af, wt);
    const int JP = (32 * gi + 31) / 64 + 1;
    const int skey = tid >> 3, sch = tid & 7;
    const bf16_t* gsrc = IKB + (size_t)(b * mk::SEQ + skey) * 64 + 8 * sch;
    const int sdst = (skey * 8 + (sch ^ ((skey >> 1) & 7))) * 16;
    const int rd0 = r * 128 + ((hh ^ ((r >> 1) & 1)) << 4), rda = ((r >> 1) & 6) << 4;
#define RDO(s) (rd0 + ((32 * (s)) ^ rda))
    float sc[4][32];
    uint4 stA, stB = make_uint4(0u, 0u, 0u, 0u);
    stA = *(const uint4*)gsrc;
    if (1 < JP) stB = *(const uint4*)(gsrc + (size_t)1 * 64 * 64);
    *(uint4*)(lds + sdst) = stA;
    __syncthreads();
#pragma unroll
    for (int jp = 0; jp < 32; ++jp) {
        if (jp < JP) {
            if (jp + 2 < JP) { if (jp & 1) stB = *(const uint4*)(gsrc + (size_t)(jp + 2) * 64 * 64); else stA = *(const uint4*)(gsrc + (size_t)(jp + 2) * 64 * 64); }
            const char* buf = lds + (jp & 1) * 8192;
            if (jp * 64 <= t0 + 3) {
                float pa[4], pb[4];
                { bf16x8 bfr[4];
#pragma unroll
                  for (int s = 0; s < 4; ++s) bfr[s] = *(const bf16x8*)(buf + RDO(s));
                  tile_partial(af, bfr, wt, pa); }
                { bf16x8 bfr[4];
#pragma unroll
                  for (int s = 0; s < 4; ++s) bfr[s] = *(const bf16x8*)(buf + RDO(s) + 4096);
                  tile_partial(af, bfr, wt, pb); }
#pragma unroll
                for (int T = 0; T < 4; ++T) {
                    float s = pair_combine(pa[T], pb[T]);
                    if (jp * 64 + 63 > t0) { if (jp * 64 + l > t0 + T) s = NEGINF; }
                    sc[T][jp] = s;
                }
            } else {
#pragma unroll
                for (int T = 0; T < 4; ++T) sc[T][jp] = NEGINF;
            }
            if (jp + 1 < JP) *(uint4*)(lds + ((jp + 1) & 1) * 8192 + sdst) = ((jp + 1) & 1) ? stB : stA;
            mk::lds_barrier();
        } else {
#pragma unroll
            for (int T = 0; T < 4; ++T) sc[T][jp] = NEGINF;
        }
    }
#define IX_SELECT(T) do { \
        unsigned wv = 0u; \
        auto put = [&](int k, unsigned long long bm) { const unsigned mine = (l & 1) ? (unsigned)(bm >> 32) : (unsigned)bm; wv = ((l >> 1) == k) ? mine : wv; }; \
        const int nreg = (t0 + (T)) / 64 + 1;                                    \
        if (nreg <= 8) topk_select<32, 8, 1>(sc[T], put); else if (nreg <= 16) topk_select<32, 16, 1>(sc[T], put); else if (nreg <= 24) topk_select<32, 24, 1>(sc[T], put); else topk_select<32, 32, 1>(sc[T], put); \
        MASK[(size_t)(m0 + (T)) * 64 + l] = wv; \
    } while (0)
    IX_SELECT(0); IX_SELECT(1); IX_SELECT(2); IX_SELECT(3);
#undef IX_SELECT
}

constexpr int SCR_BYTES = 8 * 2048 * 4, SCX_OFF = SCR_BYTES;
__device__ __forceinline__ void index_sample_block(int b, int kc, char* lds, const bf16_t* P1, const bf16_t* IKB, const float* IW, const float* cache_ik, const int* page_table, float* CS, int* CI) {
    const int tid = mk::ltid(), w = __builtin_amdgcn_readfirstlane(tid >> 6), l = tid & 63, r = l & 31, hh = l >> 5;
    const int m0 = mk::MP + b * mk::DS;
    float* scr = (float*)lds; float* scx = (float*)(lds + SCX_OFF);
    bf16x8 afA[4], afB[4]; float wtA[16], wtB[16];
    load_af_w(P1, IW, m0, r, hh, afA, wtA);
    load_af_w(P1, IW, m0 + 4, r, hh, afB, wtB);
    const int kbase = 2048 * kc + 256 * w;
    const int pg0 = __builtin_amdgcn_readfirstlane(page_table[b * mk::NPG + (kbase >> 7)]), pg1 = __builtin_amdgcn_readfirstlane(page_table[b * mk::NPG + (kbase >> 7) + 1]);
    const float* kp0 = cache_ik + ((size_t)pg0 * mk::PAGE + r) * 64 + 8 * hh;
    const float* kp1 = cache_ik + ((size_t)pg1 * mk::PAGE + r) * 64 + 8 * hh;
    float4 ring[3][8];
#define SI_LOAD(slot, tl_) do { const float* p_ = (((tl_) >> 2) ? kp1 : kp0) + ((tl_) & 3) * 32 * 64; _Pragma("unroll") for (int s = 0; s < 4; ++s) { ring[slot][2 * s] = *(const float4*)(p_ + 16 * s); ring[slot][2 * s + 1] = *(const float4*)(p_ + 16 * s + 4); } } while (0)
    SI_LOAD(0, 0); SI_LOAD(1, 1); SI_LOAD(2, 2);
    float pA[4] = {0.f, 0.f, 0.f, 0.f}, pB[4] = {0.f, 0.f, 0.f, 0.f};
#pragma unroll
    for (int tl = 0; tl < 8; ++tl) {
        bf16x8 bfr[4];
#pragma unroll
        for (int s = 0; s < 4; ++s) { const float4 x = ring[tl % 3][2 * s], y = ring[tl % 3][2 * s + 1];
            mk::u32x4_t u = {mk::cvtpk_native(x.x, x.y), mk::cvtpk_native(x.z, x.w), mk::cvtpk_native(y.x, y.y), mk::cvtpk_native(y.z, y.w)}; bfr[s] = *reinterpret_cast<bf16x8*>(&u); }
        if (tl + 3 < 8) SI_LOAD(tl % 3, tl + 3);
        float qa[4], qb[4];
        tile_partial(afA, bfr, wtA, qa);
        tile_partial(afB, bfr, wtB, qb);
        if (tl & 1) {
#pragma unroll
            for (int T = 0; T < 4; ++T) { scr[T * 2048 + 256 * w + 32 * (tl - 1) + l] = pair_combine(pA[T], qa[T]); scr[(4 + T) * 2048 + 256 * w + 32 * (tl - 1) + l] = pair_combine(pB[T], qb[T]); }
        } else {
#pragma unroll
            for (int T = 0; T < 4; ++T) { pA[T] = qa[T]; pB[T] = qb[T]; }
        }
    }
#undef SI_LOAD
    if (kc == 7 && w < 2) {
        bf16x8 bfr[4];
#pragma unroll
        for (int s = 0; s < 4; ++s) { bfr[s] = bf16x8{}; if (r < mk::DS) bfr[s] = *(const bf16x8*)(IKB + (size_t)(mk::MP + b * mk::DS + r) * 64 + 16 * s + 8 * hh); }
        float p[4];
        if (w == 0) tile_partial(afA, bfr, wtA, p); else tile_partial(afB, bfr, wtB, p);
#pragma unroll
        for (int T = 0; T < 4; ++T) { const float s = pair_combine(p[T], p[T]); if (l < mk::DS) scx[(4 * w + T) * 8 + l] = (l <= 4 * w + T) ? s : NEGINF; }
    }
    __syncthreads();
    {
        const int tok = w;
        float sc[33];
#pragma unroll
        for (int k = 0; k < 32; ++k) sc[k] = scr[tok * 2048 + 64 * k + l];
        sc[32] = (kc == 7 && l < mk::DS) ? scx[tok * 8 + l] : NEGINF;
        float* cs = CS + ((size_t)(b * mk::DS + tok) * 8 + kc) * TOPK; int* ci = CI + ((size_t)(b * mk::DS + tok) * 8 + kc) * TOPK;
        int run = 0;
        topk_select<33, 33>(sc, [&](int k, unsigned long long bm) {
            const bool mine = (bm >> l) & 1ull;
            const int pos = run + __builtin_popcountll(bm & ((1ull << l) - 1ull));
            if (mine) { cs[pos] = sc[k]; ci[pos] = (k < 32) ? 2048 * kc + 64 * k + l : mk::PAST + l; }
            run += __builtin_popcountll(bm);
        });
    }
    __syncthreads();
}

__device__ __forceinline__ void merge_sample_row(int r, const float* CS, const int* CI, const int* page_table, int* rowi) {
    const int l = mk::ltid() & 63, b = r / mk::DS;
    float sc[32];
    const float* cs = CS + (size_t)r * 8 * TOPK; const int* ci = CI + (size_t)r * 8 * TOPK;
#pragma unroll
    for (int k = 0; k < 32; ++k) sc[k] = cs[64 * k + l];
    int run = 0;
    topk_select<32, 32>(sc, [&](int k, unsigned long long bm) {
        const bool mine = (bm >> l) & 1ull;
        const int pos = run + __builtin_popcountll(bm & ((1ull << l) - 1ull));
        if (mine) { const int idx = ci[64 * k + l];
            rowi[pos] = idx < mk::PAST ? page_table[b * mk::NPG + idx / mk::PAGE] * mk::PAGE + (idx % mk::PAGE) : -(b * mk::DS + (idx - mk::PAST)) - 1; }
        run += __builtin_popcountll(bm);
    });
}
}

namespace dsa {
using mk::bf16_t;
typedef short bf16x8 __attribute__((ext_vector_type(8)));
typedef short s16x4 __attribute__((ext_vector_type(4)));
typedef float f32x16 __attribute__((ext_vector_type(16)));
typedef float f32x4 __attribute__((ext_vector_type(4)));
typedef unsigned u32x4 __attribute__((ext_vector_type(4)));
constexpr float SCALE = 0.08838834764831845f;
constexpr float THR = 8.f;
constexpr int NW = 8, QBLK = 32, KVBLK = 64, HDIM = 128;
constexpr int SHM_V = KVBLK * HDIM * 2, SHM_K = KVBLK * HDIM * 2;
constexpr int LDS_BYTES = 2 * SHM_V + 2 * SHM_K + NW * 64 * 4;

#define KSWZ(row, colB) ((row) * 256 + ((colB) ^ (((row) & 7) << 4)))
#define SBAR() __builtin_amdgcn_sched_barrier(0)
__device__ __forceinline__ int v_st(int k, int c) { const int kk = (k & ~0xC) | ((k & 4) << 1) | ((k & 8) >> 1); return ((kk >> 3) * 4 + (c >> 5)) * 512 + ((kk & 7) * 32 + (c & 31)) * 2; }
__device__ __forceinline__ int v_rd_base(int lane) { return ((lane & 3) << 3) | (((lane >> 2) & 3) << 6) | (((lane >> 4) & 1) << 5) | (((lane >> 5) & 1) << 8); }
constexpr int v_rd_off(int d0, int ks, int half) { return d0 * 512 + ks * 4096 + half * 2048; }
__device__ __forceinline__ int crow(int r, int hi) { return (r & 3) + 8 * (r >> 2) + 4 * hi; }
__device__ __forceinline__ unsigned cvtpk(float lo, float hi) { return mk::cvtpk_native(lo, hi); }

__device__ __forceinline__ void partialSM(f32x16& p0, f32x16& p1, float& m_reg, float& mn, float& alpha) {
    float pmax = p0[0]; for (int r = 1; r < 16; ++r) pmax = fmaxf(pmax, p0[r]); for (int r = 0; r < 16; ++r) pmax = fmaxf(pmax, p1[r]);
    { auto rr = __builtin_amdgcn_permlane32_swap(__float_as_uint(pmax), __float_as_uint(pmax), false, false);
      pmax = fmaxf(__uint_as_float(rr[0]), __uint_as_float(rr[1])); }
    constexpr float C2 = 1.4426950408889634f * SCALE;
    if (__builtin_expect(__all((pmax - m_reg) * SCALE <= THR), 1)) { mn = m_reg; alpha = 1.f; }
    else { mn = fmaxf(m_reg, pmax); alpha = __builtin_amdgcn_exp2f((m_reg - mn) * C2); m_reg = mn; }
    const float mnL = -mn * C2;
    for (int r = 0; r < 16; ++r) p0[r] = fmaf(p0[r], C2, mnL); for (int r = 0; r < 16; ++r) p1[r] = fmaf(p1[r], C2, mnL);
    for (int r = 0; r < 16; ++r) p0[r] = __builtin_amdgcn_exp2f(p0[r]);
}
__device__ __forceinline__ void finishSM(f32x16& p0, f32x16& p1, float alpha, float& l_reg, uint2 mw, int hi, bf16x8& pa0, bf16x8& pa1, bf16x8& pa2, bf16x8& pa3) {
    for (int r = 0; r < 16; ++r) p1[r] = __builtin_amdgcn_exp2f(p1[r]);
    const int w0 = (int)(mw.x >> (4 * hi)), w1 = (int)(mw.y >> (4 * hi));
#pragma unroll
    for (int r = 0; r < 16; ++r) {
        const int c = (r & 3) + 8 * (r >> 2);
        int b0 = __builtin_amdgcn_sbfe(w0, c, 1), b1 = __builtin_amdgcn_sbfe(w1, c, 1);
        asm volatile("" : "+v"(b0), "+v"(b1));
        p0[r] = __uint_as_float(__float_as_uint(p0[r]) & (unsigned)b0);
        p1[r] = __uint_as_float(__float_as_uint(p1[r]) & (unsigned)b1);
    }
    float ps = 0; for (int r = 0; r < 16; ++r) ps += p0[r]; for (int r = 0; r < 16; ++r) ps += p1[r];
    { auto rr = __builtin_amdgcn_permlane32_swap(__float_as_uint(ps), __float_as_uint(ps), false, false);
      ps = __uint_as_float(rr[0]) + __uint_as_float(rr[1]); }
    l_reg = l_reg * alpha + ps;
#define PK4(P, B_, OUT) do { unsigned a0 = cvtpk(P[B_+0], P[B_+1]), a1 = cvtpk(P[B_+2], P[B_+3]);                          \
        unsigned b0 = cvtpk(P[B_+4], P[B_+5]), b1 = cvtpk(P[B_+6], P[B_+7]);                                             \
        auto r0 = __builtin_amdgcn_permlane32_swap(a0, b0, false, false); auto r1 = __builtin_amdgcn_permlane32_swap(a1, b1, false, false); \
        u32x4 w = {r0[0], r1[0], r0[1], r1[1]}; OUT = *reinterpret_cast<bf16x8*>(&w); } while (0)
    PK4(p0, 0, pa0); PK4(p0, 8, pa1); PK4(p1, 0, pa2); PK4(p1, 8, pa3);
#undef PK4
}
template <int KB>
__device__ __forceinline__ void qkt(f32x16& p0, f32x16& p1, const char* K_lds, int r32, int hi, const bf16x8* qr) {
    p0 = f32x16{}; p1 = f32x16{};
    const char* kb[4];
#pragma unroll
    for (int dd = 0; dd < 4; ++dd) kb[dd] = K_lds + KB * SHM_K + KSWZ(r32, (dd * 16 + hi * 8) * 2);
#pragma unroll
    for (int d0 = 0; d0 < 8; ++d0) { const char* a = kb[d0 & 3] + (d0 >> 2) * 128;
        bf16x8 b0 = *reinterpret_cast<const bf16x8*>(a);
        bf16x8 b1 = *reinterpret_cast<const bf16x8*>(a + 32 * 256);
        p0 = __builtin_amdgcn_mfma_f32_32x32x16_bf16(b0, qr[d0], p0, 0, 0, 0);
        p1 = __builtin_amdgcn_mfma_f32_32x32x16_bf16(b1, qr[d0], p1, 0, 0, 0); }
}
template <int VB>
__device__ __forceinline__ void pv_tile(f32x16* o, int vb0, bf16x8 pa0, bf16x8 pa1, bf16x8 pa2, bf16x8 pa3) {
#define TRRD(dst, off) asm volatile("ds_read_b64_tr_b16 %0, %1 offset:%2" : "=&v"(dst) : "v"(vb0), "i"(off) : "memory")
#define PV_D0(d0) do { s16x4 l0, l1, l2, l3, h0, h1, h2, h3; constexpr int b_ = VB * SHM_V + v_rd_off(d0, 0, 0);   \
        TRRD(l0, b_); TRRD(h0, b_ + 2048); TRRD(l1, b_ + 4096); TRRD(h1, b_ + 6144); TRRD(l2, b_ + 8192); TRRD(h2, b_ + 10240); TRRD(l3, b_ + 12288); TRRD(h3, b_ + 14336); \
        asm volatile("s_waitcnt lgkmcnt(0)" ::: "memory"); SBAR();   \
        o[d0] = __builtin_amdgcn_mfma_f32_32x32x16_bf16(pa0, (bf16x8){l0[0], l0[1], l0[2], l0[3], h0[0], h0[1], h0[2], h0[3]}, o[d0], 0, 0, 0);   \
        o[d0] = __builtin_amdgcn_mfma_f32_32x32x16_bf16(pa1, (bf16x8){l1[0], l1[1], l1[2], l1[3], h1[0], h1[1], h1[2], h1[3]}, o[d0], 0, 0, 0);   \
        o[d0] = __builtin_amdgcn_mfma_f32_32x32x16_bf16(pa2, (bf16x8){l2[0], l2[1], l2[2], l2[3], h2[0], h2[1], h2[2], h2[3]}, o[d0], 0, 0, 0);   \
        o[d0] = __builtin_amdgcn_mfma_f32_32x32x16_bf16(pa3, (bf16x8){l3[0], l3[1], l3[2], l3[3], h3[0], h3[1], h3[2], h3[3]}, o[d0], 0, 0, 0); } while (0)
    PV_D0(0); PV_D0(1); PV_D0(2); PV_D0(3);
#undef PV_D0
#undef TRRD
}

struct Tensors { const float* QSS; const bf16_t* KB; const bf16_t* P1; const unsigned* MASK; bf16_t* AO; };
struct Blk { int b, g, qc; };
struct Seam { bf16x8 qr[8]; bf16x8 st_v0, st_v1, st_k0, st_k1; float qss; };
__device__ __forceinline__ const bf16_t* q_row(const Tensors& T, const Blk& k, int wid, int r32) { return T.P1 + (size_t)(k.b * mk::SEQ + k.qc * 64 + (wid & 1) * 32 + r32) * mk::N1P + mk::CQ + (4 * k.g + (wid >> 1)) * 128; }
__device__ __forceinline__ const float* qss_ptr(const Tensors& T, const Blk& k, int wid, int r32) { return T.QSS + (size_t)(k.b * mk::SEQ + k.qc * 64 + (wid & 1) * 32 + r32) * 8 + (4 * k.g + (wid >> 1)); }
__device__ __forceinline__ const bf16_t* k_row(const Tensors& T, const Blk& k, int key) { return T.KB + (size_t)(k.b * mk::SEQ + key) * 256 + k.g * 128; }
__device__ __forceinline__ const bf16_t* v_row(const Tensors& T, const Blk& k, int key) { return T.P1 + (size_t)(k.b * mk::SEQ + key) * mk::N1P + mk::CV + k.g * 128; }

#define VMW() asm volatile("s_waitcnt vmcnt(0)" ::: "memory")
#define VMWN(n) asm volatile("s_waitcnt vmcnt(%0)" :: "i"(n) : "memory")
#define SLOAD_H(blk, k0) do { S.st_v0 = *(const bf16x8*)(v_row(T, blk, (k0) + sr) + sc); S.st_v1 = *(const bf16x8*)(v_row(T, blk, (k0) + 32 + sr) + sc);   \
                              S.st_k0 = *(const bf16x8*)(k_row(T, blk, (k0) + sr) + sc); S.st_k1 = *(const bf16x8*)(k_row(T, blk, (k0) + 32 + sr) + sc); } while (0)
#define SWRITE_HK(bf) do { *(bf16x8*)(K_lds + (bf) * SHM_K + kws) = S.st_k0; *(bf16x8*)(K_lds + (bf) * SHM_K + kws + 32 * 256) = S.st_k1; } while (0)
#define SWRITE_HV(bf) do { *(bf16x8*)(V_lds + (bf) * SHM_V + vst0) = S.st_v0; *(bf16x8*)(V_lds + (bf) * SHM_V + vst0 + VST1) = S.st_v1; } while (0)
#define SWRITE_H(bf) do { SWRITE_HV(bf); SWRITE_HK(bf); } while (0)

__device__ __forceinline__ void dsa_prime(const Tensors& T, const Blk& cur, char* lds, Seam& S) {
    const int tid = mk::ltid(), wid = __builtin_amdgcn_readfirstlane(tid >> 6), lane = tid & 63, r32 = lane & 31, hi = lane >> 5;
    const int sr = tid >> 4, sc = (tid & 15) * 8, kws = KSWZ(sr, sc * 2); char* K_lds = lds + 2 * SHM_V;
    const bf16_t* qp = q_row(T, cur, wid, r32) + hi * 8;
    for (int d0 = 0; d0 < 8; ++d0) S.qr[d0] = *(const bf16x8*)(qp + d0 * 16);
    S.qss = *qss_ptr(T, cur, wid, r32);
    SLOAD_H(cur, 0); VMW(); SWRITE_HK(0);
    __syncthreads();
}
__device__ __forceinline__ void dsa_block(const Tensors& T, const Blk& cur, const Blk& nxt, char* lds, Seam& S) {
    const int tid = mk::ltid(), wid = __builtin_amdgcn_readfirstlane(tid >> 6), lane = tid & 63, r32 = lane & 31, hi = lane >> 5;
    const int NT = cur.qc + 1;
    char* V_lds = lds; char* K_lds = lds + 2 * SHM_V;
    float* ws = (float*)(lds + 2 * SHM_V + 2 * SHM_K) + wid * 64; float* li_l = ws, * al_l = ws + 32;
    float m_reg = -1e30f, l_reg = 0; f32x16 o[4] = {};
    const int sr = tid >> 4, sc = (tid & 15) * 8, vst0 = v_st(sr, sc), kws = KSWZ(sr, sc * 2);
    constexpr int VST1 = 8192;
    const int vb0 = (int)(uintptr_t)V_lds + v_rd_base(lane);
    const int qtok = cur.b * mk::SEQ + cur.qc * 64 + (wid & 1) * 32;
    const int moff = (qtok + r32) * 64;
#define LDMASK(t) (*(const uint2*)(T.MASK + (moff + 2 * (t))))
#define RESC(a) do { if (__any((a) < 1.f)) { if (hi == 0) al_l[r32] = (a); asm volatile("s_waitcnt lgkmcnt(0)" ::: "memory");              \
                     for (int d_ = 0; d_ < 4; ++d_) for (int r = 0; r < 16; ++r) o[d_][r] *= al_l[crow(r, hi)]; } } while (0)
#define KBASE(t) ((t) * KVBLK)
    constexpr int NQL = 9;
#define SEAM_K0() do { VMWN(NQL); SWRITE_HK(0); SBAR(); } while (0)
    f32x16 pA0, pA1, pB0, pB1; float mnA, mnB, alA, alB; bf16x8 pa0, pa1, pa2, pa3; uint2 mcur;
    {
        const float rs = rsqrtf(S.qss * (1.0f / 128) + mk::EPS);
#pragma unroll
        for (int d0 = 0; d0 < 8; ++d0) { u32x4 u = *reinterpret_cast<u32x4*>(&S.qr[d0]);
#pragma unroll
            for (int e = 0; e < 4; ++e) u[e] = cvtpk(__uint_as_float(u[e] << 16) * rs, __uint_as_float(u[e] & 0xFFFF0000u) * rs);
            S.qr[d0] = *reinterpret_cast<bf16x8*>(&u); }
    }
    SWRITE_HV(0); SBAR();
    if (NT > 1) { SLOAD_H(cur, KBASE(1)); }
    SBAR(); qkt<0>(pA0, pA1, K_lds, r32, hi, S.qr); mcur = LDMASK(0);
    partialSM(pA0, pA1, m_reg, mnA, alA);
    if (NT > 1) { VMW(); SWRITE_H(1); }
    __syncthreads();
#define HALF_STEP(PX0, PX1, mnX, alX, PY0, PY1, alY, t, KB, VB, SB) do {                                             \
        SBAR(); qkt<KB>(PX0, PX1, K_lds, r32, hi, S.qr);                                                                       \
        finishSM(PY0, PY1, alY, l_reg, mcur, hi, pa0, pa1, pa2, pa3); mcur = LDMASK(t); SBAR();                                                   \
        if ((t) + 1 < NT) { SLOAD_H(cur, KBASE((t) + 1)); SBAR(); }                                                           \
        pv_tile<VB>(o, vb0, pa0, pa1, pa2, pa3); partialSM(PX0, PX1, m_reg, mnX, alX);                                        \
        __syncthreads();                                                                                                      \
        if ((t) + 1 < NT) { VMW(); SWRITE_H(SB); }                                                                            \
        RESC(alX); __syncthreads(); } while (0)
    for (int t = 1; t + 1 < NT; t += 2) {
        HALF_STEP(pB0, pB1, mnB, alB, pA0, pA1, alA, t, 1, 0, 0);
        HALF_STEP(pA0, pA1, mnA, alA, pB0, pB1, alB, t + 1, 0, 1, 1);
    }
    const bool even = (NT & 1) == 0;
    if (even) { SBAR(); qkt<1>(pB0, pB1, K_lds, r32, hi, S.qr); SBAR(); }
    SLOAD_H(nxt, 0); SBAR();
    { const bf16_t* qp = q_row(T, nxt, wid, r32) + hi * 8;
#pragma unroll
      for (int d0 = 0; d0 < 8; ++d0) S.qr[d0] = *(const bf16x8*)(qp + d0 * 16);
      S.qss = *qss_ptr(T, nxt, wid, r32); }
    SBAR();
    finishSM(pA0, pA1, alA, l_reg, mcur, hi, pa0, pa1, pa2, pa3); if (even) mcur = LDMASK(NT - 1); SBAR();
    pv_tile<0>(o, vb0, pa0, pa1, pa2, pa3);
    if (even) { partialSM(pB0, pB1, m_reg, mnB, alB); __syncthreads(); RESC(alB);
        finishSM(pB0, pB1, alB, l_reg, mcur, hi, pa0, pa1, pa2, pa3); SBAR(); pv_tile<1>(o, vb0, pa0, pa1, pa2, pa3); }
    SBAR(); SEAM_K0();
    if (hi == 0) li_l[r32] = l_reg; asm volatile("s_waitcnt lgkmcnt(0)" ::: "memory");
    { const int le = mk::ltid() & 63, re = le & 31, he = le >> 5;
      const int hq = 4 * cur.g + (wid >> 1);
#pragma unroll
      for (int r = 0; r < 16; ++r) { const int orow = crow(r, he); const size_t tok = (size_t)(qtok + orow);
        const float rl = __builtin_amdgcn_rcpf(li_l[orow]);
        const bf16_t* gp = T.P1 + tok * mk::N1P + mk::CG + hq * 128 + re;
        bf16_t* op = T.AO + tok * mk::D + hq * 128 + re;
#pragma unroll
        for (int d0 = 0; d0 < 4; ++d0) { const float gt = mk::bf2f(gp[d0 * 32]);
            const float v = o[d0][r] * rl * (gt * __builtin_amdgcn_rcpf(1.0f + __builtin_amdgcn_exp2f(-1.4426950408889634f * gt)));
            const float vn = __int_as_float(__builtin_amdgcn_update_dpp(0, __float_as_int(v), 0xB1, 0xF, 0xF, false));
            if ((re & 1) == 0) *(unsigned*)(op + d0 * 32) = cvtpk(v, vn); } } }
    __syncthreads();
#undef LDMASK
#undef RESC
#undef KBASE
#undef SEAM_K0
#undef HALF_STEP
}
#undef VMW
#undef VMWN
#undef SLOAD_H
#undef SWRITE_HK
#undef SWRITE_HV
#undef SWRITE_H

__device__ __forceinline__ void attn_prompt_phase(const Tensors& T, char* lds, int bid, int nblk) {
    constexpr int NITEM = 256;
    if (bid >= NITEM) return;
    int id = bid, pass = 0;
    Blk cur{id & 7, (id >> 3) & 1, 31 - (id >> 4)};
    Seam S;
    dsa_prime(T, cur, lds, S);
    for (;;) {
        const bool more_pass = pass == 0, more_item = id + nblk < NITEM, last = !more_pass && !more_item;
        int idn = id, passn = pass + 1;
        if (!more_pass) { passn = 0; idn = more_item ? id + nblk : id; }
        Blk nxt = cur;
        if (!last) { nxt.b = idn & 7; nxt.g = (idn >> 3) & 1; nxt.qc = passn ? (idn >> 4) : 31 - (idn >> 4); }
        dsa_block(T, cur, nxt, lds, S);
        if (last) break;
        cur = nxt; id = idn; pass = passn;
    }
}
}

namespace dn {
using mk::bf16_t;
typedef short bf16x8 __attribute__((ext_vector_type(8)));
typedef float f32x16 __attribute__((ext_vector_type(16)));
constexpr int NITEM = mk::NB * 8 * 32;
constexpr size_t IT_W = 0, IT_QD = 16384, IT_KDT = 32768, IT_U0T = 49152, IT_QKD = 65536, IT_BYTES = 73728;
constexpr int L_KR = 0, L_QR = 17408, L_KT = 34816, L_VT = 53248, L_AM = 71680, L_TW = 89088, L_TU = 98304, L_SC = 107520, L_END = 108032;
constexpr int RS = 272;
constexpr int TS = 144;
constexpr int L_SK = 108032, L_SU = L_SK + 128 * 144, L_SEND = L_SU + 128 * 136, L_SW = L_AM;
static_assert(L_SEND <= 147456 - 16, "pre-phase LDS map");

__device__ __forceinline__ int crow(int r, int hi) { return (r & 3) + 8 * (r >> 2) + 4 * hi; }
__device__ __forceinline__ unsigned cvtpk(float lo, float hi) { return mk::cvtpk_native(lo, hi); }
__device__ __forceinline__ float silu_f(float x) { return x * __builtin_amdgcn_rcpf(1.0f + __builtin_amdgcn_exp2f(-1.4426950408889634f * x)); }
__device__ __forceinline__ float quad_sum(float v) {
    v += __int_as_float(__builtin_amdgcn_update_dpp(0, __float_as_int(v), 0xB1, 0xF, 0xF, false));
    v += __int_as_float(__builtin_amdgcn_update_dpp(0, __float_as_int(v), 0x4E, 0xF, 0xF, false));
    return v;
}

struct PreArgs { const bf16_t* P2; const float* BA; const float* conv_w; const float* A_log; const float* dt_bias; unsigned char* CH; float* EG; float* out; };

struct PreRaw { unsigned x[3][11]; float wc[3][4][2]; float bv, av; };
__device__ __forceinline__ void pre_load(const PreArgs& a, int item, PreRaw& R) {
    const int tid = mk::ltid(), w = __builtin_amdgcn_readfirstlane(tid >> 6), l = tid & 63;
    const int c = item & 31, h = (item >> 5) & 7, b = item >> 8;
    const int m0 = b * mk::SEQ + c * 64;
    R.bv = a.BA[(size_t)(m0 + l) * 16 + h]; R.av = a.BA[(size_t)(m0 + l) * 16 + 8 + h];
#pragma unroll
    for (int part = 0; part < 3; ++part) {
        const int colb = part * 1024 + h * 128 + 2 * l;
#pragma unroll
        for (int i = 0; i < 4; ++i) { const float2 t = *(const float2*)(a.conv_w + (size_t)i * mk::CONV + colb); R.wc[part][i][0] = t.x; R.wc[part][i][1] = t.y; }
#pragma unroll
        for (int k = 0; k < 11; ++k) {
            const int rl = 8 * w + k - 3;
            unsigned u = 0u;
            if (rl >= 0 || c > 0) u = __builtin_nontemporal_load((const unsigned*)(a.P2 + (size_t)(m0 + rl) * mk::N3P + colb));
            R.x[part][k] = u;
        }
    }
}
__device__ __forceinline__ void pre_item(const PreArgs& a, int item, int next, char* lds, PreRaw& R) {
    const int tid = mk::ltid(), w = __builtin_amdgcn_readfirstlane(tid >> 6), l = tid & 63, r32 = l & 31, hh = l >> 5;
    const int c = item & 31, h = (item >> 5) & 7, b = item >> 8;
    const int m0 = b * mk::SEQ + c * 64;
    unsigned char* ch = a.CH + (size_t)item * IT_BYTES;
    float* sc_beta = (float*)(lds + L_SC); float* sc_gc = sc_beta + 64;
    float beta_l, gc_l;
    {
        const float bv = R.bv, av = R.av;
        beta_l = __builtin_amdgcn_rcpf(1.0f + __expf(-bv));
        const float x = av + a.dt_bias[h];
        const float sp = x > 20.f ? x : log1pf(__expf(x));
        float g = -__expf(a.A_log[h]) * sp;
#pragma unroll
        for (int o = 1; o < 64; o <<= 1) { const float t = __shfl_up(g, o); if (l >= o) g += t; }
        gc_l = g;
    }
    const float gc_last = __shfl(gc_l, 63);
    if (w == 0) { sc_beta[l] = beta_l; sc_gc[l] = gc_l; if (l == 0) a.EG[item] = __expf(gc_last); }
    {
        float sq[8][2], sk[8][2], sv[8][2];
#pragma unroll
        for (int part = 0; part < 3; ++part) {
            const int colb = part * 1024 + h * 128 + 2 * l;
            float wc[4][2];
#pragma unroll
            for (int i = 0; i < 4; ++i) { wc[i][0] = R.wc[part][i][0]; wc[i][1] = R.wc[part][i][1]; }
            float x[11][2];
#pragma unroll
            for (int k = 0; k < 11; ++k) { const unsigned u = R.x[part][k]; x[k][0] = __uint_as_float(u << 16); x[k][1] = __uint_as_float(u & 0xFFFF0000u); }
            if (c == 31 && w == 7) {
#pragma unroll
                for (int j = 0; j < 3; ++j) *(float2*)(a.out + mk::O_CP + ((size_t)b * 3 + j) * mk::CONV + colb) = make_float2(x[8 + j][0], x[8 + j][1]);
            }
#pragma unroll
            for (int rr = 0; rr < 8; ++rr) {
#pragma unroll
                for (int e = 0; e < 2; ++e) {
                    float y = wc[0][e] * x[rr][e]; y = fmaf(wc[1][e], x[rr + 1][e], y); y = fmaf(wc[2][e], x[rr + 2][e], y); y = fmaf(wc[3][e], x[rr + 3][e], y);
                    const float s = silu_f(y);
                    if (part == 0) sq[rr][e] = s; else if (part == 1) sk[rr][e] = s; else sv[rr][e] = s;
                }
            }
        }
        if (next >= 0) pre_load(a, next, R);
        float nq[8], nk[8];
#pragma unroll
        for (int rr = 0; rr < 8; ++rr) { nq[rr] = sq[rr][0] * sq[rr][0] + sq[rr][1] * sq[rr][1]; nk[rr] = sk[rr][0] * sk[rr][0] + sk[rr][1] * sk[rr][1]; }
        mk::wave_sum_n<8>(nq); mk::wave_sum_n<8>(nk);
        unsigned ktp[2][4], vtp[2][4], kdp[2][4];
#pragma unroll
        for (int rr = 0; rr < 8; ++rr) {
            const int i = 8 * w + rr;
            const float rq = rsqrtf(nq[rr] + mk::EPS) * 0.08838834764831845f;
            const float rk = rsqrtf(nk[rr] + mk::EPS);
            const float gci = __shfl(gc_l, i);
            const float eg = __expf(gci), egl = __expf(gc_last - gci);
            const float q0 = sq[rr][0] * rq, q1 = sq[rr][1] * rq, k0 = sk[rr][0] * rk, k1 = sk[rr][1] * rk;
            *(unsigned*)(lds + L_QR + i * RS + 4 * l) = cvtpk(q0, q1);
            *(unsigned*)(lds + L_KR + i * RS + 4 * l) = cvtpk(k0, k1);
            *(unsigned*)(ch + IT_QD + (size_t)i * 256 + 4 * l) = cvtpk(q0 * eg, q1 * eg);
            if ((rr & 1) == 0) { sq[rr][0] = k0; sq[rr][1] = k1; }
            else {
                ktp[0][rr >> 1] = cvtpk(sq[rr - 1][0], k0); ktp[1][rr >> 1] = cvtpk(sq[rr - 1][1], k1);
                vtp[0][rr >> 1] = cvtpk(sv[rr - 1][0], sv[rr][0]); vtp[1][rr >> 1] = cvtpk(sv[rr - 1][1], sv[rr][1]);
                const float gcp = __shfl(gc_l, i - 1); const float eglp = __expf(gc_last - gcp);
                kdp[0][rr >> 1] = cvtpk(sq[rr - 1][0] * eglp, k0 * egl); kdp[1][rr >> 1] = cvtpk(sq[rr - 1][1] * eglp, k1 * egl);
            }
        }
#pragma unroll
        for (int e = 0; e < 2; ++e) {
            *(uint4*)(lds + L_KT + (2 * l + e) * TS + 16 * w) = make_uint4(ktp[e][0], ktp[e][1], ktp[e][2], ktp[e][3]);
            *(uint4*)(lds + L_VT + (2 * l + e) * TS + 16 * w) = make_uint4(vtp[e][0], vtp[e][1], vtp[e][2], vtp[e][3]);
            *(uint4*)(lds + L_SK + (2 * l + e) * 144 + 16 * w) = make_uint4(kdp[e][0], kdp[e][1], kdp[e][2], kdp[e][3]);
        }
    }
    mk::lds_barrier();
#pragma unroll
    for (int j = 0; j < 2; ++j) { const int pc = tid + 512 * j;
        *(uint4*)(ch + IT_KDT + (size_t)16 * pc) = *(const uint4*)(lds + L_SK + (pc >> 3) * 144 + 16 * (pc & 7)); }
    if (w < 6) {
        const int kind = w >= 3, tix = kind ? w - 3 : w, ti = tix > 0, tj = tix > 1;
        const char* ap = lds + (kind ? L_QR : L_KR) + (32 * ti + r32) * RS + 16 * hh;
        const char* bp = lds + L_KR + (32 * tj + r32) * RS + 16 * hh;
        f32x16 acc = {};
#pragma unroll
        for (int s = 0; s < 8; ++s) acc = __builtin_amdgcn_mfma_f32_32x32x16_bf16(*(const bf16x8*)(ap + 32 * s), *(const bf16x8*)(bp + 32 * s), acc, 0, 0, 0);
        const int j = 32 * tj + r32; const float gcj = sc_gc[j];
#pragma unroll
        for (int r = 0; r < 16; ++r) {
            const int i = 32 * ti + crow(r, hh);
            const float dec = __expf(sc_gc[i] - gcj);
            if (!kind) { const float v = (i > j) ? sc_beta[i] * acc[r] * dec : 0.f; *(float*)(lds + L_AM + i * RS + 4 * j) = v; }
            else { const float v = (i >= j) ? acc[r] * dec : 0.f; const float vn = __shfl_xor(v, 1);
                   if ((r32 & 1) == 0) *(unsigned*)(ch + IT_QKD + (size_t)i * 128 + 2 * j) = cvtpk(v, vn); }
        }
    } else if (w == 6) {
#pragma unroll
        for (int k = 0; k < 16; ++k) { const int e = l + 64 * k; *(float*)(lds + L_AM + (e >> 5) * RS + 4 * (32 + (e & 31))) = 0.f; }
    }
    mk::lds_barrier();
    constexpr int L_T1T = L_KR, L_TBR = L_KR + 2560, L_P3T = L_KR + 5120;
    if (w < 2) {
        const int blk = w, ccl = l >> 1, q = l & 1, cc = 32 * blk + ccl;
        float x[16];
#pragma unroll
        for (int k = 0; k < 16; ++k) x[k] = 0.f;
        const char* arow = lds + L_AM + (32 * blk) * RS + 4 * (32 * blk) + 16 * q;
#pragma unroll
        for (int ib = 0; ib < 8; ++ib) {
            const int i0 = 4 * ib, aS = ib >> 1, qS = ib & 1;
            float p[4] = {0.f, 0.f, 0.f, 0.f};
#pragma unroll
            for (int rr = 0; rr < 4; ++rr)
#pragma unroll
                for (int a4 = 0; a4 <= aS; ++a4) { const float4 av = *(const float4*)(arow + (i0 + rr) * RS + 32 * a4);
                    p[rr] = fmaf(av.x, x[4 * a4], p[rr]); p[rr] = fmaf(av.y, x[4 * a4 + 1], p[rr]); p[rr] = fmaf(av.z, x[4 * a4 + 2], p[rr]); p[rr] = fmaf(av.w, x[4 * a4 + 3], p[rr]); }
#pragma unroll
            for (int rr = 0; rr < 4; ++rr) p[rr] += __int_as_float(__builtin_amdgcn_update_dpp(0, __float_as_int(p[rr]), 0xB1, 0xF, 0xF, false));
            const char* rb = lds + L_AM + (32 * blk + i0) * RS + 4 * (32 * blk + i0);
            const float4 r1 = *(const float4*)(rb + RS), r2 = *(const float4*)(rb + 2 * RS), r3 = *(const float4*)(rb + 3 * RS);
            const float x0 = ((i0 == ccl) ? 1.f : 0.f) - p[0];
            const float x1 = ((i0 + 1 == ccl) ? 1.f : 0.f) - p[1] - r1.x * x0;
            const float x2 = ((i0 + 2 == ccl) ? 1.f : 0.f) - p[2] - r2.x * x0 - r2.y * x1;
            const float x3 = ((i0 + 3 == ccl) ? 1.f : 0.f) - p[3] - r3.x * x0 - r3.y * x1 - r3.z * x2;
            if (q == qS) { x[4 * aS] = x0; x[4 * aS + 1] = x1; x[4 * aS + 2] = x2; x[4 * aS + 3] = x3; }
        }
        const float bc = sc_beta[cc], bw = bc * __expf(sc_gc[cc]);
#pragma unroll
        for (int k = 0; k < 16; ++k) { const int j = 8 * (k >> 2) + 4 * q + (k & 3);
            *(bf16_t*)(lds + L_TW + (32 * blk + j) * TS + 2 * cc) = mk::f2bf(x[k] * bw);
            *(bf16_t*)(lds + L_TU + (32 * blk + j) * TS + 2 * cc) = mk::f2bf(x[k] * bc);
            if (blk == 1) *(bf16_t*)(lds + L_TBR + j * 80 + 2 * ccl) = mk::f2bf(x[k]); }
        if (blk == 0) {
#pragma unroll
            for (int a4 = 0; a4 < 4; ++a4) *(uint2*)(lds + L_T1T + ccl * 80 + 2 * (8 * a4 + 4 * q)) = make_uint2(cvtpk(x[4 * a4], x[4 * a4 + 1]), cvtpk(x[4 * a4 + 2], x[4 * a4 + 3]));
        }
    }
    mk::lds_barrier();
    if (w == 0) {
        f32x16 a3 = {};
#pragma unroll
        for (int s = 0; s < 2; ++s) {
            const float4 f0 = *(const float4*)(lds + L_AM + (32 + r32) * RS + 4 * (16 * s + 8 * hh)), f1 = *(const float4*)(lds + L_AM + (32 + r32) * RS + 4 * (16 * s + 8 * hh) + 16);
            mk::u32x4_t au_ = {cvtpk(f0.x, f0.y), cvtpk(f0.z, f0.w), cvtpk(f1.x, f1.y), cvtpk(f1.z, f1.w)};
            a3 = __builtin_amdgcn_mfma_f32_32x32x16_bf16(*reinterpret_cast<bf16x8*>(&au_), *(const bf16x8*)(lds + L_T1T + r32 * 80 + 2 * (16 * s + 8 * hh)), a3, 0, 0, 0);
        }
#pragma unroll
        for (int g = 0; g < 4; ++g) *(uint2*)(lds + L_P3T + r32 * 80 + 2 * (8 * g + 4 * hh)) = make_uint2(cvtpk(a3[4 * g], a3[4 * g + 1]), cvtpk(a3[4 * g + 2], a3[4 * g + 3]));
        asm volatile("s_waitcnt lgkmcnt(0)" ::: "memory");
        f32x16 a4 = {};
#pragma unroll
        for (int s = 0; s < 2; ++s)
            a4 = __builtin_amdgcn_mfma_f32_32x32x16_bf16(*(const bf16x8*)(lds + L_TBR + r32 * 80 + 2 * (16 * s + 8 * hh)), *(const bf16x8*)(lds + L_P3T + r32 * 80 + 2 * (16 * s + 8 * hh)), a4, 0, 0, 0);
        const float bc = sc_beta[r32], bw = bc * __expf(sc_gc[r32]);
#pragma unroll
        for (int r = 0; r < 16; ++r) { const int i = 32 + crow(r, hh);
            *(bf16_t*)(lds + L_TW + i * TS + 2 * r32) = mk::f2bf(-a4[r] * bw);
            *(bf16_t*)(lds + L_TU + i * TS + 2 * r32) = mk::f2bf(-a4[r] * bc); }
    }
    mk::lds_barrier();
    {
        const int it = w >> 2, dt = w & 3, ns = it ? 4 : 2;
        f32x16 aw = {}, au = {};
        const char* kt = lds + L_KT + (32 * dt + r32) * TS + 16 * hh;
        const char* vt = lds + L_VT + (32 * dt + r32) * TS + 16 * hh;
        const char* tw = lds + L_TW + (32 * it + r32) * TS + 16 * hh;
        const char* tu = lds + L_TU + (32 * it + r32) * TS + 16 * hh;
#pragma unroll
        for (int s = 0; s < 4; ++s) if (s < ns) {
            aw = __builtin_amdgcn_mfma_f32_32x32x16_bf16(*(const bf16x8*)(kt + 32 * s), *(const bf16x8*)(tw + 32 * s), aw, 0, 0, 0);
            au = __builtin_amdgcn_mfma_f32_32x32x16_bf16(*(const bf16x8*)(tu + 32 * s), *(const bf16x8*)(vt + 32 * s), au, 0, 0, 0);
        }
#pragma unroll
        for (int g = 0; g < 4; ++g) {
            *(uint2*)(lds + L_SW + (32 * it + r32) * RS + 2 * (32 * dt + 8 * g + 4 * hh)) = make_uint2(cvtpk(aw[4 * g], aw[4 * g + 1]), cvtpk(aw[4 * g + 2], aw[4 * g + 3]));
            *(uint2*)(lds + L_SU + (32 * dt + r32) * 136 + 2 * (32 * it + 8 * g + 4 * hh)) = make_uint2(cvtpk(au[4 * g], au[4 * g + 1]), cvtpk(au[4 * g + 2], au[4 * g + 3]));
        }
    }
    mk::lds_barrier();
#pragma unroll
    for (int j = 0; j < 2; ++j) { const int pc = tid + 512 * j;
        *(uint4*)(ch + IT_W + (size_t)16 * pc) = *(const uint4*)(lds + L_SW + (pc >> 4) * RS + 16 * (pc & 15)); }
#pragma unroll
    for (int j = 0; j < 4; ++j) { const int pc = tid + 512 * j;
        *(uint2*)(ch + IT_U0T + (size_t)8 * pc) = *(const uint2*)(lds + L_SU + (pc >> 4) * 136 + 8 * (pc & 15)); }
}

constexpr int SL_ST = 0, SL_UT = 8704, SL_END = 8704 + 4608;
struct ScanArgs { const unsigned char* CH; const float* EG; bf16_t* ORAW; float* out; };

__device__ __forceinline__ void scan_item(const ScanArgs& a, int bh, int sl, char* lds) {
    const int tid = mk::ltid(), w = __builtin_amdgcn_readfirstlane(tid >> 6), l = tid & 63, r32 = l & 31, hh = l >> 5;
    const int b = bh >> 3, h = bh & 7;
    const unsigned char* chb = a.CH + (size_t)bh * 32 * IT_BYTES;
    for (int k = tid; k < SL_END / 4; k += 512) ((unsigned*)lds)[k] = 0u;
    __syncthreads();
    const char* stp = lds + SL_ST + r32 * RS + 16 * hh;
    const char* utp = lds + SL_UT + r32 * TS + 16 * hh;
    if (w < 2) {
        const int tt = w;
        bf16x8 wf[4][8]; uint2 u0[4][4];
#define LD_W(dst, dstu, cix) do { const unsigned char* cb = chb + (size_t)(cix) * IT_BYTES; \
        _Pragma("unroll") for (int s = 0; s < 8; ++s) dst[s] = *(const bf16x8*)(cb + IT_W + (size_t)(32 * tt + r32) * 256 + 32 * s + 16 * hh); \
        _Pragma("unroll") for (int g = 0; g < 4; ++g) dstu[g] = *(const uint2*)(cb + IT_U0T + (size_t)(32 * sl + r32) * 128 + 2 * (32 * tt + 8 * g + 4 * hh)); } while (0)
        LD_W(wf[0], u0[0], 0); LD_W(wf[1], u0[1], 1); LD_W(wf[2], u0[2], 2);
        for (int c0 = 0; c0 < 32; c0 += 4) {
#pragma unroll
            for (int k = 0; k < 4; ++k) {
                const int c = c0 + k;
                if (c + 3 < 32) LD_W(wf[(k + 3) & 3], u0[(k + 3) & 3], c + 3);
                f32x16 acc = {};
#pragma unroll
                for (int s = 0; s < 8; ++s) acc = __builtin_amdgcn_mfma_f32_32x32x16_bf16(wf[k][s], *(const bf16x8*)(stp + 32 * s), acc, 0, 0, 0);
#pragma unroll
                for (int g = 0; g < 4; ++g) {
                    const float a0 = __uint_as_float(u0[k][g].x << 16) - acc[4 * g], a1 = __uint_as_float(u0[k][g].x & 0xFFFF0000u) - acc[4 * g + 1];
                    const float a2 = __uint_as_float(u0[k][g].y << 16) - acc[4 * g + 2], a3 = __uint_as_float(u0[k][g].y & 0xFFFF0000u) - acc[4 * g + 3];
                    *(uint2*)(lds + SL_UT + r32 * TS + 2 * (32 * tt + 8 * g + 4 * hh)) = make_uint2(cvtpk(a0, a1), cvtpk(a2, a3));
                }
                mk::lds_barrier();
                mk::lds_barrier();
            }
        }
#undef LD_W
    } else if (w < 4) {
        const int tt = w - 2;
        bf16x8 qf[4][8], pf[4][4];
#pragma unroll
        for (int k = 0; k < 4; ++k)
#pragma unroll
            for (int s = 0; s < 4; ++s) pf[k][s] = bf16x8{};
#define LD_Q(dq, dp, cix) do { const unsigned char* cb = chb + (size_t)(cix) * IT_BYTES; \
        _Pragma("unroll") for (int s = 0; s < 8; ++s) dq[s] = *(const bf16x8*)(cb + IT_QD + (size_t)(32 * tt + r32) * 256 + 32 * s + 16 * hh); \
        _Pragma("unroll") for (int s = 0; s < 4; ++s) if (s < 2 * (tt + 1)) dp[s] = *(const bf16x8*)(cb + IT_QKD + (size_t)(32 * tt + r32) * 128 + 32 * s + 16 * hh); } while (0)
        LD_Q(qf[0], pf[0], 0); LD_Q(qf[1], pf[1], 1); LD_Q(qf[2], pf[2], 2);
        const size_t orow0 = (size_t)(b * mk::SEQ + 32 * tt) * mk::D + h * 128 + 32 * sl + r32;
        for (int c0 = 0; c0 < 32; c0 += 4) {
#pragma unroll
            for (int k = 0; k < 4; ++k) {
                const int c = c0 + k;
                if (c + 3 < 32) LD_Q(qf[(k + 3) & 3], pf[(k + 3) & 3], c + 3);
                f32x16 acc = {};
#pragma unroll
                for (int s = 0; s < 8; ++s) acc = __builtin_amdgcn_mfma_f32_32x32x16_bf16(qf[k][s], *(const bf16x8*)(stp + 32 * s), acc, 0, 0, 0);
                mk::lds_barrier();
#pragma unroll
                for (int s = 0; s < 4; ++s) if (s < 2 * (tt + 1)) acc = __builtin_amdgcn_mfma_f32_32x32x16_bf16(pf[k][s], *(const bf16x8*)(utp + 32 * s), acc, 0, 0, 0);
#pragma unroll
                for (int r = 0; r < 16; ++r) { const float v = acc[r]; const float vn = __shfl_xor(v, 1);
                    if ((r32 & 1) == 0) *(unsigned*)(a.ORAW + orow0 + (size_t)(64 * c + crow(r, hh)) * mk::D) = cvtpk(v, vn); }
                mk::lds_barrier();
            }
        }
#undef LD_Q
    } else {
        const int dt = w - 4;
        bf16x8 kf[4][4]; float eg[4];
#define LD_S(dk_, deg, cix) do { const unsigned char* cb = chb + (size_t)(cix) * IT_BYTES; \
        _Pragma("unroll") for (int s = 0; s < 4; ++s) dk_[s] = *(const bf16x8*)(cb + IT_KDT + (size_t)(32 * dt + r32) * 128 + 32 * s + 16 * hh); \
        deg = a.EG[bh * 32 + (cix)]; } while (0)
        LD_S(kf[0], eg[0], 0); LD_S(kf[1], eg[1], 1); LD_S(kf[2], eg[2], 2);
        f32x16 S = {};
        for (int c0 = 0; c0 < 32; c0 += 4) {
#pragma unroll
            for (int k = 0; k < 4; ++k) {
                const int c = c0 + k;
                if (c + 3 < 32) LD_S(kf[(k + 3) & 3], eg[(k + 3) & 3], c + 3);
#pragma unroll
                for (int r = 0; r < 16; ++r) S[r] *= eg[k];
                mk::lds_barrier();
#pragma unroll
                for (int s = 0; s < 4; ++s) S = __builtin_amdgcn_mfma_f32_32x32x16_bf16(kf[k][s], *(const bf16x8*)(utp + 32 * s), S, 0, 0, 0);
#pragma unroll
                for (int g = 0; g < 4; ++g)
                    *(uint2*)(lds + SL_ST + r32 * RS + 2 * (32 * dt + 8 * g + 4 * hh)) = make_uint2(cvtpk(S[4 * g], S[4 * g + 1]), cvtpk(S[4 * g + 2], S[4 * g + 3]));
                mk::lds_barrier();
            }
        }
#undef LD_S
        float* so = a.out + mk::O_SP + ((size_t)bh * 128) * 128 + 32 * sl + r32;
#pragma unroll
        for (int r = 0; r < 16; ++r) so[(size_t)(32 * dt + crow(r, hh)) * 128] = S[r];
    }
    __syncthreads();
}
}

namespace mk {
__device__ __forceinline__ unsigned f2key(float f) { f += 0.0f; unsigned u = __float_as_uint(f); return (u & 0x80000000u) ? ~u : (u | 0x80000000u); }
__device__ __forceinline__ int block_sum_i512(int c, int* red) {
    c += __shfl_xor(c, 32); c += __shfl_xor(c, 16); c += __shfl_xor(c, 8); c += __shfl_xor(c, 4); c += __shfl_xor(c, 2); c += __shfl_xor(c, 1);
    __syncthreads();
    if ((mk::ltid() & 63) == 0) red[mk::ltid() >> 6] = c;
    __syncthreads();
    return red[0] + red[1] + red[2] + red[3] + red[4] + red[5] + red[6] + red[7];
}
__device__ __forceinline__ void attend_sample_row(int r, char* lds, const float* QSS, const float* qg, const bf16_t* P1, const float* CS, const int* CI, const float* out, const float* cache_k, const float* cache_v, const int* page_table, bf16_t* AO) {
    float* lg = (float*)lds;
    int* rowi = (int*)(lg + 2048);
    int* pt = rowi + 256;
    float* red = (float*)(pt + 128);
    bf16_t* qs = (bf16_t*)(red + 64);
    float* part = (float*)(qs + 1024);
    const int m = MP + r, b = r / DS, t = mk::ltid(), w = __builtin_amdgcn_readfirstlane(t >> 6), l = t & 63;
    {
        const unsigned u = ((const unsigned*)(P1 + (size_t)m * N1P + CQ))[t];
        const float rs = rsqrtf(QSS[(size_t)m * 8 + (t >> 6)] * (1.0f / 128) + EPS);
        ((unsigned*)qs)[t] = pk2bf(__uint_as_float(u << 16) * rs * qg[(2 * t) & 127], __uint_as_float(u & 0xFFFF0000u) * rs * qg[(2 * t + 1) & 127]);
    }
    if (t >= 64 && t < 64 + NPG) pt[t - 64] = page_table[b * NPG + t - 64];
    if (w == 0) {
        float sc[32]; int ci[32];
        const float* cs = CS + (size_t)r * 8 * ix::TOPK; const int* cip = CI + (size_t)r * 8 * ix::TOPK;
#pragma unroll
        for (int k = 0; k < 32; ++k) { sc[k] = cs[64 * k + l]; ci[k] = cip[64 * k + l]; }
        __syncthreads();
        int run = 0;
        ix::topk_select<32, 32>(sc, [&](int k, unsigned long long bm) {
            const bool mine = (bm >> l) & 1ull;
            const int pos = run + __builtin_popcountll(bm & ((1ull << l) - 1ull));
            if (mine) { const int idx = ci[k]; rowi[pos] = idx < PAST ? pt[idx >> 7] * PAGE + (idx & (PAGE - 1)) : -(b * DS + (idx - PAST)) - 1; }
            run += __builtin_popcountll(bm);
        });
    } else __syncthreads();
    __syncthreads();
    const int rr = l & 31, hh = l >> 5;
    f32x16 acc0 = {}, acc1 = {};
    {
        const int ri = rowi[32 * w + rr];
        const float* kr = (ri >= 0 ? cache_k + (size_t)ri * 256 : out + O_KS + (size_t)(-ri - 1) * 256) + 8 * hh;
        float4 kf[2][8][2];
#pragma unroll
        for (int g = 0; g < 2; ++g)
#pragma unroll
            for (int s = 0; s < 8; ++s) { kf[g][s][0] = *(const float4*)(kr + g * 128 + 16 * s); kf[g][s][1] = *(const float4*)(kr + g * 128 + 16 * s + 4); }
        const bf16_t* qa = qs + (rr & 3) * 128 + 8 * hh;
#pragma unroll
        for (int s = 0; s < 8; ++s) {
            bf16x8 a0 = *(const bf16x8*)(qa + 16 * s), a1 = *(const bf16x8*)(qa + 512 + 16 * s);
            if (rr >= 4) { a0 = bf16x8{}; a1 = bf16x8{}; }
            { const float4 x = kf[0][s][0], y = kf[0][s][1];
              u32x4_t u = {cvtpk_native(x.x, x.y), cvtpk_native(x.z, x.w), cvtpk_native(y.x, y.y), cvtpk_native(y.z, y.w)};
              acc0 = __builtin_amdgcn_mfma_f32_32x32x16_bf16(a0, *reinterpret_cast<bf16x8*>(&u), acc0, 0, 0, 0); }
            { const float4 x = kf[1][s][0], y = kf[1][s][1];
              u32x4_t u = {cvtpk_native(x.x, x.y), cvtpk_native(x.z, x.w), cvtpk_native(y.x, y.y), cvtpk_native(y.z, y.w)};
              acc1 = __builtin_amdgcn_mfma_f32_32x32x16_bf16(a1, *reinterpret_cast<bf16x8*>(&u), acc1, 0, 0, 0); }
        }
    }
    __builtin_amdgcn_sched_barrier(0);
    float4 vf[32];
#pragma unroll
    for (int jj = 0; jj < 32; ++jj) { const int ri = rowi[32 * w + jj];
        vf[jj] = *(const float4*)((ri >= 0 ? cache_v + (size_t)ri * 256 : out + O_VS + (size_t)(-ri - 1) * 256) + 4 * l); }
    if (hh == 0) {
        *(float4*)(lg + (32 * w + rr) * 8) = make_float4(acc0[0] * 0.08838834764831845f, acc0[1] * 0.08838834764831845f, acc0[2] * 0.08838834764831845f, acc0[3] * 0.08838834764831845f);
        *(float4*)(lg + (32 * w + rr) * 8 + 4) = make_float4(acc1[0] * 0.08838834764831845f, acc1[1] * 0.08838834764831845f, acc1[2] * 0.08838834764831845f, acc1[3] * 0.08838834764831845f);
    }
    mk::lds_barrier();
    {
        float x[4], mx = -INFINITY;
#pragma unroll
        for (int i = 0; i < 4; ++i) { x[i] = lg[(l + 64 * i) * 8 + w]; mx = fmaxf(mx, x[i]); }
#pragma unroll
        for (int o = 32; o > 0; o >>= 1) mx = fmaxf(mx, __shfl_xor(mx, o));
        float s = 0.f;
#pragma unroll
        for (int i = 0; i < 4; ++i) { x[i] = __expf(x[i] - mx); s += x[i]; lg[(l + 64 * i) * 8 + w] = x[i]; }
        s = wave_sum(s);
        if (l == 0) red[w] = 1.0f / s;
    }
    mk::lds_barrier();
    {
        float4 o0 = make_float4(0.f, 0.f, 0.f, 0.f), o1 = o0, o2 = o0, o3 = o0;
#pragma unroll
        for (int jj = 0; jj < 32; ++jj) {
            const float4 p4 = *(const float4*)(lg + (32 * w + jj) * 8 + 4 * hh); const float4 v = vf[jj];
            o0.x = fmaf(p4.x, v.x, o0.x); o0.y = fmaf(p4.x, v.y, o0.y); o0.z = fmaf(p4.x, v.z, o0.z); o0.w = fmaf(p4.x, v.w, o0.w);
            o1.x = fmaf(p4.y, v.x, o1.x); o1.y = fmaf(p4.y, v.y, o1.y); o1.z = fmaf(p4.y, v.z, o1.z); o1.w = fmaf(p4.y, v.w, o1.w);
            o2.x = fmaf(p4.z, v.x, o2.x); o2.y = fmaf(p4.z, v.y, o2.y); o2.z = fmaf(p4.z, v.z, o2.z); o2.w = fmaf(p4.z, v.w, o2.w);
            o3.x = fmaf(p4.w, v.x, o3.x); o3.y = fmaf(p4.w, v.y, o3.y); o3.z = fmaf(p4.w, v.z, o3.z); o3.w = fmaf(p4.w, v.w, o3.w);
        }
        float* pp = part + w * 1024 + (4 * hh) * 128 + 4 * rr;
        *(float4*)(pp) = o0; *(float4*)(pp + 128) = o1; *(float4*)(pp + 256) = o2; *(float4*)(pp + 384) = o3;
    }
    __syncthreads();
    {
        const int c0 = 2 * t, h = c0 >> 7;
        float o0 = 0.f, o1 = 0.f;
#pragma unroll
        for (int ww = 0; ww < 8; ++ww) { const float2 x = *(const float2*)(part + ww * 1024 + c0); o0 += x.x; o1 += x.y; }
        const float rinv = red[h];
        const bf16_t* gate = P1 + (size_t)m * N1P + CG + c0;
        *(unsigned*)(AO + (size_t)m * D + c0) = pk2bf(o0 * rinv * silu(bf2f(gate[0])), o1 * rinv * silu(bf2f(gate[1])));
    }
    __syncthreads();
}

__device__ __forceinline__ void dn_post_row(int m, char* lds, const bf16_t* P2, const float* BA, const float* conv_w, const float* conv_state, const float* A_log, const float* dt_bias,
                                            float* QC, float* KC, float* VC, float* BETA, float* G, float* out) {
    float* y = (float*)lds;
    const int t = mk::ltid();
    const int b = (m - MP) / DS, tt = (m - MP) % DS;
    {
        float xv[6][4], wv[6][4];
#pragma unroll
        for (int k = 0; k < 6; ++k) { const int c = t + 512 * k;
#pragma unroll
            for (int i = 0; i < 4; ++i) { const int j = tt + i;
                xv[k][i] = (j < 3) ? conv_state[((size_t)b * 3 + j) * CONV + c] : bf2f(P2[(size_t)(m - tt + (j - 3)) * N3P + c]);
                wv[k][i] = conv_w[i * CONV + c]; } }
#pragma unroll
        for (int k = 0; k < 6; ++k) { const int c = t + 512 * k;
            float acc = wv[k][0] * xv[k][0]; acc += wv[k][1] * xv[k][1]; acc += wv[k][2] * xv[k][2]; acc += wv[k][3] * xv[k][3];
            y[c] = silu(acc);
            if (tt >= DS - 3) out[O_CS + ((size_t)b * 3 + (tt - (DS - 3))) * CONV + c] = xv[k][3]; }
    }
    __syncthreads();
    const int w = t >> 6, l = t & 63;
    for (int hh = w; hh < 16; hh += 8) {
        const float a = y[hh * 128 + l], bb = y[hh * 128 + 64 + l];
        const float ss = wave_sum(a * a + bb * bb);
        float r = rsqrtf(ss + EPS);
        if (hh < 8) { r *= 0.08838834764831845f; QC[(size_t)m * D + hh * 128 + l] = a * r; QC[(size_t)m * D + hh * 128 + 64 + l] = bb * r; }
        else { KC[(size_t)m * D + (hh - 8) * 128 + l] = a * r; KC[(size_t)m * D + (hh - 8) * 128 + 64 + l] = bb * r; }
    }
    for (int c = t; c < 1024; c += 512) VC[(size_t)m * D + c] = y[2048 + c];
    if (t < 8) {
        const float bv = BA[(size_t)m * 16 + t], av = BA[(size_t)m * 16 + 8 + t];
        BETA[(size_t)m * 8 + t] = 1.0f / (1.0f + expf(-bv));
        const float x = av + dt_bias[t];
        const float sp = x > 20.f ? x : log1pf(expf(x));
        G[(size_t)m * 8 + t] = -expf(A_log[t]) * sp;
    }
    __syncthreads();
}

__device__ __forceinline__ void dn_scan_sample(int it, char* lds, const float* QC, const float* KC, const float* VC, const float* BETA, const float* G, const float* S0, bf16_t* ORAW, float* out) {
    const int t = mk::ltid(), v = t & 127, hq = __builtin_amdgcn_readfirstlane(t >> 7);
    float* qs = (float*)lds; float* ks = qs + DS * 128; float* ex = ks + DS * 128;
    const int b = it >> 3, h = it & 7, m0 = MP + b * DS;
    float S[32], vv[DS], beta[DS], alpha[DS];
    const float* sp = S0 + (((size_t)b * 8 + h) * 128 + hq * 32) * 128 + v;
#pragma unroll
    for (int d = 0; d < 32; ++d) S[d] = ldnt1(sp + (size_t)d * 128);
#pragma unroll
    for (int j = 0; j < 2; ++j) { const int tt = hq + 4 * j;
        qs[tt * 128 + v] = QC[(size_t)(m0 + tt) * D + h * 128 + v]; ks[tt * 128 + v] = KC[(size_t)(m0 + tt) * D + h * 128 + v]; }
#pragma unroll
    for (int tt = 0; tt < DS; ++tt) { vv[tt] = VC[(size_t)(m0 + tt) * D + h * 128 + v]; beta[tt] = BETA[(size_t)(m0 + tt) * 8 + h]; alpha[tt] = expf(G[(size_t)(m0 + tt) * 8 + h]); }
    __syncthreads();
#pragma unroll
    for (int tt = 0; tt < DS; ++tt) {
        const float4* k4 = (const float4*)(ks + tt * 128 + hq * 32); const float4* q4 = (const float4*)(qs + tt * 128 + hq * 32);
        float kS = 0.f;
#pragma unroll
        for (int d = 0; d < 8; ++d) { const float4 kk = k4[d]; kS = fmaf(kk.x, S[4 * d], kS); kS = fmaf(kk.y, S[4 * d + 1], kS); kS = fmaf(kk.z, S[4 * d + 2], kS); kS = fmaf(kk.w, S[4 * d + 3], kS); }
        ex[hq * 128 + v] = kS;
        mk::lds_barrier();
        const float u = beta[tt] * (vv[tt] - alpha[tt] * ((ex[v] + ex[128 + v]) + (ex[256 + v] + ex[384 + v])));
        float o = 0.f;
#pragma unroll
        for (int d = 0; d < 8; ++d) { const float4 kk = k4[d], qq = q4[d];
            S[4 * d] = fmaf(alpha[tt], S[4 * d], kk.x * u); o = fmaf(qq.x, S[4 * d], o);
            S[4 * d + 1] = fmaf(alpha[tt], S[4 * d + 1], kk.y * u); o = fmaf(qq.y, S[4 * d + 1], o);
            S[4 * d + 2] = fmaf(alpha[tt], S[4 * d + 2], kk.z * u); o = fmaf(qq.z, S[4 * d + 2], o);
            S[4 * d + 3] = fmaf(alpha[tt], S[4 * d + 3], kk.w * u); o = fmaf(qq.w, S[4 * d + 3], o); }
        ex[512 + hq * 128 + v] = o;
        mk::lds_barrier();
        if (hq == 0) ORAW[(size_t)(m0 + tt) * D + h * 128 + v] = f2bf((ex[512 + v] + ex[512 + 128 + v]) + (ex[512 + 256 + v] + ex[512 + 384 + v]));
    }
    float* so_ = out + O_SS + (((size_t)b * 8 + h) * 128 + hq * 32) * 128 + v;
#pragma unroll
    for (int d = 0; d < 32; ++d) so_[(size_t)d * 128] = S[d];
    __syncthreads();
}

struct GateRegs { unsigned o[8], z[8]; };
__device__ __forceinline__ void dn_gate_load(int m, const bf16_t* ORAW, const bf16_t* P2, GateRegs& R) {
    const int l = mk::ltid() & 63;
#pragma unroll
    for (int h = 0; h < 8; ++h) { R.o[h] = *(const unsigned*)(ORAW + (size_t)m * D + h * 128 + 2 * l); R.z[h] = __builtin_nontemporal_load((const unsigned*)(P2 + (size_t)m * N3P + CZ + h * 128 + 2 * l)); }
}
__device__ __forceinline__ void dn_gate_finish(int m, const GateRegs& R, const float* og, bf16_t* AO2) {
    const int l = mk::ltid() & 63;
    const float g0 = og[2 * l], g1 = og[2 * l + 1];
    float oa[8], ob[8], ss[8];
#pragma unroll
    for (int h = 0; h < 8; ++h) { oa[h] = __uint_as_float(R.o[h] << 16); ob[h] = __uint_as_float(R.o[h] & 0xFFFF0000u); ss[h] = oa[h] * oa[h] + ob[h] * ob[h]; }
    wave_sum_n<8>(ss);
#pragma unroll
    for (int h = 0; h < 8; ++h) {
        const float r = rsqrtf(ss[h] * (1.0f / 128) + EPS);
        const float z0 = __uint_as_float(R.z[h] << 16), z1 = __uint_as_float(R.z[h] & 0xFFFF0000u);
        *(unsigned*)(AO2 + (size_t)m * D + h * 128 + 2 * l) = pk2bf(oa[h] * r * g0 * silu(z0), ob[h] * r * g1 * silu(z1));
    }
}
__device__ __forceinline__ int dn_gate_rowmap(int j) { return j < MS ? MP + j : ((j - MS) & (NB - 1)) * SEQ + (SEQ - 1 - ((j - MS) >> 3)); }
__device__ __forceinline__ void dn_gate_rows(int gw, int nw, const bf16_t* ORAW, const bf16_t* P2, const float* og, bf16_t* AO2) {
    GateRegs R0, R1, R2;
    int m = gw;
#define RM(j) dn_gate_rowmap(j)
    if (m < M) dn_gate_load(RM(m), ORAW, P2, R0);
    if (m + nw < M) dn_gate_load(RM(m + nw), ORAW, P2, R1);
    for (; m < M; m += 3 * nw) {
        if (m + 2 * nw < M) dn_gate_load(RM(m + 2 * nw), ORAW, P2, R2);
        dn_gate_finish(RM(m), R0, og, AO2);
        if (m + nw < M) { if (m + 3 * nw < M) dn_gate_load(RM(m + 3 * nw), ORAW, P2, R0); dn_gate_finish(RM(m + nw), R1, og, AO2); }
        if (m + 2 * nw < M) { if (m + 4 * nw < M) dn_gate_load(RM(m + 4 * nw), ORAW, P2, R1); dn_gate_finish(RM(m + 2 * nw), R2, og, AO2); }
    }
#undef RM
}
}

namespace mk {
constexpr size_t al256(size_t x) { return (x + 255) & ~(size_t)255; }
constexpr size_t W_BAR = 0, W_WT1 = al256(W_BAR + (size_t)12 * XCD_BAR_WORDS * 4), W_WT2 = al256(W_WT1 + (size_t)N1P * D * 2), W_WT3 = al256(W_WT2 + (size_t)D * D * 2), W_WT4 = al256(W_WT3 + (size_t)N3P * D * 2),
    W_XA = al256(W_WT4 + (size_t)D * D * 2), W_P1 = al256(W_XA + (size_t)M * D * 2), W_P2 = al256(W_P1 + (size_t)M * N1P * 2), W_AO = al256(W_P2 + (size_t)M * N3P * 2), W_QN = al256(W_AO + (size_t)M * D * 2),
    W_KB = al256(W_QN + (size_t)M * D * 2), W_IKB = al256(W_KB + (size_t)M * 256 * 2), W_BA = al256(W_IKB + (size_t)M * 64 * 2), W_IW = al256(W_BA + (size_t)M * 16 * 4), W_Y1 = al256(W_IW + (size_t)M * 8 * 4),
    W_QC = al256(W_Y1 + (size_t)M * D * 4), W_KC = al256(W_QC + (size_t)M * D * 4), W_VC = al256(W_KC + (size_t)M * D * 4), W_BETA = al256(W_VC + (size_t)M * D * 4), W_G = al256(W_BETA + (size_t)M * 8 * 4),
    W_ORAW = al256(W_G + (size_t)M * 8 * 4), W_CH = al256(W_ORAW + (size_t)M * D * 2), W_EG = al256(W_CH + (size_t)dn::NITEM * dn::IT_BYTES), W_CS = al256(W_EG + (size_t)dn::NITEM * 4), W_CI = al256(W_CS + (size_t)MS * 8 * 256 * 4), W_MASK = al256(W_CI + (size_t)MS * 8 * 256 * 4), W_SS = al256(W_MASK + (size_t)MP * 64 * 4), W_END = al256(W_SS + (size_t)M * 4);
struct WsMap {
    unsigned char* base;
#define WSP(name, T, off) __device__ __forceinline__ T* name() const { return (T*)(base + (off)); }
    WSP(bar, unsigned, W_BAR) WSP(Wt1, bf16_t, W_WT1) WSP(Wt2, bf16_t, W_WT2) WSP(Wt3, bf16_t, W_WT3) WSP(Wt4, bf16_t, W_WT4) WSP(XA, bf16_t, W_XA) WSP(P1, bf16_t, W_P1) WSP(P2, bf16_t, W_P2)
    WSP(AO, bf16_t, W_AO) WSP(QNb, bf16_t, W_QN) WSP(KB, bf16_t, W_KB) WSP(IKB, bf16_t, W_IKB) WSP(BA, float, W_BA) WSP(IW, float, W_IW) WSP(Y1, float, W_Y1) WSP(QC, float, W_QC) WSP(KC, float, W_KC)
    WSP(VC, float, W_VC) WSP(BETA, float, W_BETA) WSP(G, float, W_G) WSP(ORAW, bf16_t, W_ORAW) WSP(CH, unsigned char, W_CH) WSP(EG, float, W_EG) WSP(CS, float, W_CS) WSP(CI, int, W_CI) WSP(SS, float, W_SS) WSP(MASK, unsigned, W_MASK)
#undef WSP
};
struct Params {
    const float *x_prompt, *x_sample, *cache_k, *cache_v, *cache_ik, *state_S, *state_conv; const int* page_table;
    const float *att_norm, *att_w_in, *qg, *kg, *ikg, *att_w_out, *dn_norm, *dn_w_in, *conv_w, *A_log, *dt_bias, *og, *dn_w_out;
    float* out; WsMap w; int ph_lo, ph_hi, li, pad_;
};
constexpr int LDS_TOTAL = 147456;
constexpr int NPHASE = 12;
#ifndef MK_NLAUNCH
#define MK_NLAUNCH 1
#endif

__global__ void __launch_bounds__(512, 2) mega(Params p) {
    extern __shared__ __attribute__((aligned(16))) unsigned char lds[];
    const int bid = blockIdx.x, nblk = gridDim.x;
#define wave (mk::ltid() >> 6)
    uint4* xbw = (uint4*)(lds + LDS_TOTAL - 16);
    if (threadIdx.x == 0) *xbw = make_uint4(0u, 0u, 0u, 0u);
    __syncthreads();
    XcdBarrier bar = xcd_barrier_post(p.w.bar() + (size_t)p.li * XCD_BAR_WORDS, (volatile LAS unsigned*)xbw);
    const int lo = p.ph_lo, hi = p.ph_hi;
#define IN(k) (lo <= (k) && (k) < hi)
#define SEAM(k) do { if (IN(k) && IN((k) + 1)) xcd_barrier(bar); } while (0)
    const WsMap& w = p.w;
    if (IN(0)) {
        float* tile = (float*)lds;
        { float* qss = (float*)w.QNb(); for (int i = bid * 512 + mk::ltid(); i < M * 8; i += nblk * 512) qss[i] = 0.f; }
        wconv_waves<1>(p.att_w_in, ATT_IN, p.att_norm, w.Wt1(), D, N1P, bid * 8 + wave, nblk * 8);
        wconv_waves<0>(p.att_w_out, D, nullptr, w.Wt2(), D, D, (bid * 8 + wave + 1664) % (nblk * 8), nblk * 8);
        { const int gw = bid * 8 + wave, nw = nblk * 8;
          if (nw >= 2048) { float4 v[9][4];
#pragma unroll
              for (int k = 0; k < 9; ++k) { const int m = gw + k * nw; if (m < M) xnorm_load(xrow(p.x_prompt, p.x_sample, m), v[k]); }
#pragma unroll
              for (int k = 0; k < 9; ++k) { const int m = gw + k * nw; if (m < M) xnorm_finish(v[k], w.XA() + (size_t)m * D, w.Y1() + m); } }
          else { float4 v[4]; for (int m = gw; m < M; m += nw) { xnorm_load(xrow(p.x_prompt, p.x_sample, m), v); xnorm_finish(v, w.XA() + (size_t)m * D, w.Y1() + m); } } }
    }
    SEAM(0);
    if (IN(1)) { pg8::Gemm g{w.XA(), w.Wt1(), M, N1P, D, 0}; EpiBf16Tail E{w.P1(), N1P, N1P / 256, nullptr, nullptr, (float*)w.QNb()}; pg8::StaticOrder S; S.init(M, N1P, nblk, bid);
        pg8::gemm_phase<EpiBf16Tail, pg8::StaticOrder, false>((PG8_LAS unsigned char*)lds, g, S, E, nullptr);
        { const int nfull = (M / 256) * (N1P / 256), last = nfull - (nfull / nblk) * nblk;
          const int nidle = nblk - last, me = bid - last;
          if (nidle > 0 && me >= 0) { float* tile = (float*)lds;
              wconv_all<3>(tile, p.dn_w_in, DN_IN, p.dn_norm, w.Wt3(), D, N3P, me, nidle);
              wconv_all<0>(tile, p.dn_w_out, D, nullptr, w.Wt4(), D, D, me, nidle); }
          else if (nidle <= 0) { float* tile = (float*)lds; wconv_all<3>(tile, p.dn_w_in, DN_IN, p.dn_norm, w.Wt3(), D, N3P, bid, nblk); wconv_all<0>(tile, p.dn_w_out, D, nullptr, w.Wt4(), D, D, bid, nblk); } }
    }
    SEAM(1);
    if (IN(2)) { for (int i = bid * 512 + mk::ltid(); i < M; i += nblk * 512) w.SS()[i] = 0.f;
        att_post_rows(bid * 8 + wave, nblk * 8, w.P1(), p.qg, p.kg, p.ikg, w.KB(), w.IKB(), w.IW(), p.out); }
    SEAM(2);
    if (IN(3)) {
        const bool sfirst = (bid >> 3) & 1;
        if (sfirst) { for (int id = bid; id < 256; id += nblk) ix::index_sample_block(id >> 3, id & 7, (char*)lds, w.P1(), w.IKB(), w.IW(), p.cache_ik, p.page_table, w.CS(), w.CI()); }
        for (int id = bid; id < 256; id += nblk) { const int b = id & 7, pr = id >> 3;
#pragma nounroll
            for (int k = 0; k < 2; ++k) {
                ix::index_prompt_block(b, k ? pr : 63 - pr, (char*)lds, w.P1(), w.IKB(), w.IW(), w.MASK());
                __syncthreads(); } }
        if (!sfirst) { for (int id = bid; id < 256; id += nblk) ix::index_sample_block(id >> 3, id & 7, (char*)lds, w.P1(), w.IKB(), w.IW(), p.cache_ik, p.page_table, w.CS(), w.CI()); }
    }
    SEAM(3);
    if (IN(4)) {
        dsa::Tensors T{(const float*)w.QNb(), w.KB(), w.P1(), w.MASK(), w.AO()};
        const bool sfirst = (bid >> 3) & 1;
        if (sfirst) { for (int r = bid; r < MS; r += nblk) attend_sample_row(r, (char*)lds, (const float*)w.QNb(), p.qg, w.P1(), w.CS(), w.CI(), p.out, p.cache_k, p.cache_v, p.page_table, w.AO()); }
        dsa::attn_prompt_phase(T, (char*)lds, bid, nblk);
        __syncthreads();
        if (!sfirst) { for (int r = bid; r < MS; r += nblk) attend_sample_row(r, (char*)lds, (const float*)w.QNb(), p.qg, w.P1(), w.CS(), w.CI(), p.out, p.cache_k, p.cache_v, p.page_table, w.AO()); }
    }
    SEAM(4);
    if (IN(5)) {
        { const float* INV = w.Y1(); bf16_t* XB = w.XA(); float* SS = w.SS();
          for (int u = bid; u < 256; u += nblk) gemm_small_unit<1>((char*)lds, w.AO(), w.Wt2(), MP + 32 * (u >> 5), 32 * (u & 31), [&](int r_, int c_) { return bf2f(XB[(size_t)r_ * D + c_]) * INV[r_]; }, [&](int r_, int c_, float v, float res) {
              const float y = v + res; XB[(size_t)r_ * D + c_] = f2bf(y);
              float ss = y * y; ss += __shfl_xor(ss, 1); ss += __shfl_xor(ss, 2); ss += __shfl_xor(ss, 4); ss += __shfl_xor(ss, 8); ss += __shfl_xor(ss, 16);
              if ((ltid() & 31) == 0) atomicAdd(SS + r_, ss); }); }
        pg8::Gemm g{w.AO(), w.Wt2(), MP, D, D, 0}; EpiY1 E{w.XA(), w.Y1(), w.SS(), D, 0}; pg8::StaticOrder S; S.init(MP, D, nblk, bid);
        pg8::gemm_phase<EpiY1, pg8::StaticOrder, false>((PG8_LAS unsigned char*)lds, g, S, E, nullptr); }
    SEAM(5);
    if (IN(7)) { pg8::Gemm g{w.XA(), w.Wt3(), M, N3P, D, 0}; EpiBf16Tail E{w.P2(), N3P, 16, w.BA(), w.SS(), nullptr}; pg8::StaticOrder S; S.init(M, N3P, nblk, bid);
        pg8::gemm_phase<EpiBf16Tail, pg8::StaticOrder, false>((PG8_LAS unsigned char*)lds, g, S, E, nullptr); }
    SEAM(7);
    if (IN(8)) {
        dn::PreArgs pa{w.P2(), w.BA(), p.conv_w, p.A_log, p.dt_bias, w.CH(), w.EG(), p.out};
        { dn::PreRaw R;
          if (nblk == 256) {
              const int bh = bid & 63, cq = bid >> 6;
              dn::pre_load(pa, bh * 32 + 31 - cq, R);
              for (int k = 0; k < 8; ++k) dn::pre_item(pa, bh * 32 + 31 - (4 * k + cq), k + 1 < 8 ? bh * 32 + 31 - (4 * (k + 1) + cq) : -1, (char*)lds, R);
          } else {
              int item = bid;
              if (item < dn::NITEM) dn::pre_load(pa, item, R);
              for (; item < dn::NITEM; item += nblk) dn::pre_item(pa, item, item + nblk < dn::NITEM ? item + nblk : -1, (char*)lds, R);
          }
          __syncthreads(); }
        for (int m = MP + bid; m < M; m += nblk) dn_post_row(m, (char*)lds, w.P2(), w.BA(), p.conv_w, p.state_conv, p.A_log, p.dt_bias, w.QC(), w.KC(), w.VC(), w.BETA(), w.G(), p.out);
    }
    SEAM(8);
    if (IN(9)) {
        dn::ScanArgs sa{w.CH(), w.EG(), w.ORAW(), p.out};
        for (int it = bid; it < 256; it += nblk) { const int xcd = it & 7, slot = it >> 3; dn::scan_item(sa, xcd * 8 + (slot >> 2), slot & 3, (char*)lds); }
        for (int it = bid; it < DB * 8; it += nblk) dn_scan_sample(it, (char*)lds, w.QC(), w.KC(), w.VC(), w.BETA(), w.G(), p.state_S, w.ORAW(), p.out);
    }
    SEAM(9);
    if (IN(10)) { dn_gate_rows(bid * 8 + wave, nblk * 8, w.ORAW(), w.P2(), p.og, w.AO()); }
    SEAM(10);
    if (IN(11)) {
        { float* yo = p.out + O_Y; const bf16_t* Y1b = w.XA();
          for (int u = bid; u < 256; u += nblk) gemm_small_unit<1>((char*)lds, w.AO(), w.Wt4(), MP + 32 * (u >> 5), 32 * (u & 31), [&](int r_, int c_) { return bf2f(Y1b[(size_t)r_ * D + c_]); }, [&](int r_, int c_, float v, float res) { yo[(size_t)r_ * D + c_] = v + res; }); }
        pg8::Gemm g{w.AO(), w.Wt4(), MP, D, D, 0}; EpiF32ResBf E{p.out + O_Y, w.XA(), D, 0}; pg8::StaticOrder S; S.init(MP, D, nblk, bid);
        pg8::gemm_phase<EpiF32ResBf, pg8::StaticOrder, false>((PG8_LAS unsigned char*)lds, g, S, E, nullptr); }
#undef IN
#undef SEAM
}
}

extern "C" void kernel_launch(void* const* d_in, const int* in_sizes, int n_in, void* d_out, int out_size, void* d_ws, size_t ws_size, hipStream_t stream) {
    using namespace mk;
    static int grid = 0;
    if (!grid) {
        int dev = 0, cus = 0, per_cu = 0;
        (void)hipGetDevice(&dev);
        (void)hipDeviceGetAttribute(&cus, hipDeviceAttributeMultiprocessorCount, dev);
        (void)hipFuncSetAttribute((const void*)mega, hipFuncAttributeMaxDynamicSharedMemorySize, LDS_TOTAL);
        (void)hipOccupancyMaxActiveBlocksPerMultiprocessor(&per_cu, (const void*)mega, 512, LDS_TOTAL);
        (void)hipGetLastError();
        grid = cus > 0 ? cus : 256;
        fprintf(stderr, "mega: cus %d occupancy %d grid %d\n", cus, per_cu, grid);
    }
    Params p; memset(&p, 0, sizeof(p));
    p.x_prompt = (const float*)d_in[0]; p.x_sample = (const float*)d_in[1]; p.cache_k = (const float*)d_in[2]; p.cache_v = (const float*)d_in[3]; p.cache_ik = (const float*)d_in[4];
    p.state_S = (const float*)d_in[5]; p.state_conv = (const float*)d_in[6]; p.page_table = (const int*)d_in[7];
    p.att_norm = (const float*)d_in[8]; p.att_w_in = (const float*)d_in[9]; p.qg = (const float*)d_in[10]; p.kg = (const float*)d_in[11];
    p.ikg = (const float*)d_in[12]; p.att_w_out = (const float*)d_in[13]; p.dn_norm = (const float*)d_in[14]; p.dn_w_in = (const float*)d_in[15];
    p.conv_w = (const float*)d_in[16]; p.A_log = (const float*)d_in[17]; p.dt_bias = (const float*)d_in[18]; p.og = (const float*)d_in[19]; p.dn_w_out = (const float*)d_in[20];
    p.out = (float*)d_out;
    p.w.base = (unsigned char*)d_ws;
    if (W_END > ws_size) { fprintf(stderr, "ws too small\n"); return; }
    (void)hipMemsetAsync(d_ws, 0, (size_t)NPHASE * XCD_BAR_WORDS * 4, stream);
    constexpr int NL = MK_NLAUNCH;
    for (int li = 0; li < NL; ++li) {
        p.ph_lo = (NL == 1) ? 0 : li; p.ph_hi = (NL == 1) ? NPHASE : li + 1; p.li = li;
        hipLaunchKernelGGL(mega, dim3(grid), dim3(512), LDS_TOTAL, stream, p);
    }
}
```

```cpp
#include <hip/hip_runtime.h>
#include <cstdio>
#include <cstdint>
#include <cstring>

namespace mk {
typedef unsigned short bf16_t;
constexpr int D = 1024, NB = 8, SEQ = 2048, MP = NB * SEQ, DB = 32, DS = 8, MS = DB * DS, M = MP + MS;
constexpr int PAST = 16384, PAGE = 128, NPG = PAST / PAGE;
constexpr int NH = 8, HD = 128, NKV = 2, IH = 8, ID = 64, TOPK = 256;
constexpr int ATT_IN = 3144, SQ_ = 0, SK_ = 1024, SV_ = 1280, SIQ = 1536, SIK = 2048, SIW = 2112, SG = 2120;
constexpr int DN_IN = 4112;
constexpr int N1P = 3328, CQ = 0, CK = 1024, CV = 1280, CIQ = 1536, CG = 2048, CIK = 3072, CIW = 3136;
constexpr int N3P = 4352, CONV = 3072, CZ = 3072, CB = 4096, CA = 4104;
constexpr float EPS = 1e-6f;
constexpr size_t O_Y = 0;
constexpr size_t O_KP = (size_t)M * D;
constexpr size_t O_VP = O_KP + (size_t)MP * 256;
constexpr size_t O_IKP = O_VP + (size_t)MP * 256;
constexpr size_t O_KS = O_IKP + (size_t)MP * 64;
constexpr size_t O_VS = O_KS + (size_t)MS * 256;
constexpr size_t O_IKS = O_VS + (size_t)MS * 256;
constexpr size_t O_SP = O_IKS + (size_t)MS * 64;
constexpr size_t O_CP = O_SP + (size_t)NB * 8 * 128 * 128;
constexpr size_t O_SS = O_CP + (size_t)NB * 3 * CONV;
constexpr size_t O_CS = O_SS + (size_t)DB * 8 * 128 * 128;
constexpr size_t O_END = O_CS + (size_t)DB * 3 * CONV;
static_assert(O_END == 32235520, "output size");

__device__ __forceinline__ float* kout(float* out, int m) { return m < MP ? out + O_KP + (size_t)m * 256 : out + O_KS + (size_t)(m - MP) * 256; }
__device__ __forceinline__ float* vout(float* out, int m) { return m < MP ? out + O_VP + (size_t)m * 256 : out + O_VS + (size_t)(m - MP) * 256; }
__device__ __forceinline__ float* ikout(float* out, int m) { return m < MP ? out + O_IKP + (size_t)m * 64 : out + O_IKS + (size_t)(m - MP) * 64; }
__device__ __forceinline__ const float* xrow(const float* xp, const float* xs, int m) { return m < MP ? xp + (size_t)m * D : xs + (size_t)(m - MP) * D; }

__device__ __forceinline__ int ltid() { int t = threadIdx.x; asm volatile("" : "+v"(t)); return t; }
typedef float f32x2_t __attribute__((ext_vector_type(2)));
typedef unsigned u32x4_t __attribute__((ext_vector_type(4)));
typedef float f32x4_t __attribute__((ext_vector_type(4)));
typedef float f32x2_t __attribute__((ext_vector_type(2)));
__device__ __forceinline__ float4 ldnt4(const float* p) { const f32x4_t v = __builtin_nontemporal_load((const f32x4_t*)p); return make_float4(v.x, v.y, v.z, v.w); }
__device__ __forceinline__ float ldnt1(const float* p) { return __builtin_nontemporal_load(p); }
__device__ __forceinline__ void stnt1(float* p, float a) { __builtin_nontemporal_store(a, p); }
__device__ __forceinline__ void stnt2(float* p, float a, float b) { const f32x2_t v = {a, b}; __builtin_nontemporal_store(v, (f32x2_t*)p); }
typedef short bf16x8 __attribute__((ext_vector_type(8)));
typedef float f32x16 __attribute__((ext_vector_type(16)));
typedef __bf16 bf16x2_t __attribute__((ext_vector_type(2)));
__device__ __forceinline__ unsigned cvtpk_native(float lo, float hi) { f32x2_t v = {lo, hi}; return __builtin_bit_cast(unsigned, __builtin_convertvector(v, bf16x2_t)); }
__device__ __forceinline__ void lds_barrier() { asm volatile("s_waitcnt lgkmcnt(0)" ::: "memory"); __builtin_amdgcn_s_barrier(); asm volatile("" ::: "memory"); }
__device__ __forceinline__ float bf2f(bf16_t b) { return __uint_as_float(((unsigned)b) << 16); }
__device__ __forceinline__ bf16_t f2bf(float f) { unsigned u = __float_as_uint(f); u += 0x7FFFu + ((u >> 16) & 1u); return (bf16_t)(u >> 16); }
__device__ __forceinline__ unsigned pk2bf(float lo, float hi) { return (unsigned)f2bf(lo) | ((unsigned)f2bf(hi) << 16); }
template <int N> __device__ __forceinline__ void wave_sum_n(float (&v)[N]) {
#pragma unroll
    for (int i = 0; i < N; ++i) v[i] += __int_as_float(__builtin_amdgcn_update_dpp(0, __float_as_int(v[i]), 0xB1, 0xF, 0xF, false));
#pragma unroll
    for (int i = 0; i < N; ++i) v[i] += __int_as_float(__builtin_amdgcn_update_dpp(0, __float_as_int(v[i]), 0x4E, 0xF, 0xF, false));
#pragma unroll
    for (int i = 0; i < N; ++i) v[i] += __int_as_float(__builtin_amdgcn_update_dpp(0, __float_as_int(v[i]), 0x124, 0xF, 0xF, false));
#pragma unroll
    for (int i = 0; i < N; ++i) v[i] += __int_as_float(__builtin_amdgcn_update_dpp(0, __float_as_int(v[i]), 0x128, 0xF, 0xF, false));
#pragma unroll
    for (int i = 0; i < N; ++i) v[i] += __shfl_xor(v[i], 16);
#pragma unroll
    for (int i = 0; i < N; ++i) v[i] += __shfl_xor(v[i], 32);
}
__device__ __forceinline__ float wave_sum(float v) { float a[1] = {v}; wave_sum_n<1>(a); return a[0]; }
__device__ __forceinline__ float silu(float x) { return x / (1.0f + __expf(-x)); }
}

namespace pg8 {
#define PG8_LAS __attribute__((address_space(3)))
typedef unsigned short bf16_t;
typedef short bf16x8 __attribute__((ext_vector_type(8)));
typedef float f32x4 __attribute__((ext_vector_type(4)));
typedef unsigned u32x4 __attribute__((ext_vector_type(4)));
constexpr int BM = 256, BK = 64, HALF = 128, HTB = HALF * BK * 2  , STAGE_BYTES = 8 * HTB, NXCD = 8, WGM = 8;

__host__ __device__ __forceinline__ int lds_byte(int r, int c) { const int st = (r >> 4) * 2 + (c >> 5), rr = r & 15, cc = c & 31, ob = rr * 64 + cc * 2; return st * 1024 + (ob ^ (((ob >> 9) & 1) << 5)); }
__host__ __device__ __forceinline__ void stage_rc(int b, int& R, int& C) { const int st = b / 1024, sb = b % 1024, swz = sb ^ (((sb >> 9) & 1) << 5); R = (st >> 1) * 16 + swz / 64; C = (st & 1) * 32 + (swz % 64) / 2; }
__host__ __device__ __forceinline__ int perm32(int rho) { const int n = rho >> 4, i = rho & 15; return 8 * (i >> 2) + 4 * n + (i & 3); }

struct Unit { int pm, pn; };
struct Gemm { const bf16_t* A; const bf16_t* Bt; int M, N, K, pad_; };

struct StaticOrder {
    int nM, nN, nwg, G, c;
    __host__ __device__ void init(int M, int N, int G_, int c_) { nM = M / BM; nN = N / BM; nwg = nM * nN; G = G_; c = c_; }
    __host__ __device__ bool next(int i, Unit& u) const {
        const long L = (long)i * G + c; if (L >= nwg) return false;
        int wgid = (int)L; { const int q = nwg / NXCD, r = nwg % NXCD, xcd = wgid % NXCD, off = wgid / NXCD; wgid = (xcd < r ? xcd * (q + 1) : r * (q + 1) + (xcd - r) * q) + off; }
        const int nig = WGM * nN, gid = wgid / nig, fm = gid * WGM, gsz = (nM - fm) < WGM ? (nM - fm) : WGM;
        u.pm = fm + ((wgid % nig) % gsz); u.pn = (wgid % nig) / gsz; return true;
    }
    __device__ __forceinline__ void a_ready(const Unit&) const {}
    __device__ __forceinline__ void done(const Unit&) const {}
};
struct CountedOrder : StaticOrder {
    const unsigned* ready; unsigned need; unsigned* tmo;
    __device__ __forceinline__ void a_ready(const Unit& u) const {
        if (mk::ltid() < 64) {
            const unsigned long long t0 = __builtin_amdgcn_s_memrealtime(); unsigned polls = 0;
            while ((unsigned)__builtin_amdgcn_readfirstlane(__hip_atomic_load(ready + 64 * u.pm, __ATOMIC_RELAXED, __HIP_MEMORY_SCOPE_AGENT)) < need) {
                if ((++polls & 255u) == 0u && __builtin_amdgcn_readfirstlane(__hip_atomic_load(tmo, __ATOMIC_RELAXED, __HIP_MEMORY_SCOPE_AGENT)) != 0u) break;
                if (__builtin_amdgcn_s_memrealtime() - t0 > 2000000ull) {
                    if (mk::ltid() == 0) { unsigned expect = 0u; __hip_atomic_compare_exchange_strong(tmo + 1, &expect, 0x600u | (unsigned)(u.pm & 0xff), __ATOMIC_RELAXED, __ATOMIC_RELAXED, __HIP_MEMORY_SCOPE_AGENT); __hip_atomic_store(tmo, 1u, __ATOMIC_RELAXED, __HIP_MEMORY_SCOPE_AGENT); }
                    break; }
                __builtin_amdgcn_s_sleep(2); }
            __builtin_amdgcn_fence(__ATOMIC_ACQUIRE, "agent");
            asm volatile("s_waitcnt vmcnt(0)" ::: "memory");
        }
#if !defined(BROKEN_HOOK_NO_BARRIER)
        asm volatile("" ::: "memory"); __builtin_amdgcn_s_barrier(); asm volatile("" ::: "memory");
#endif
    }
};

__device__ __forceinline__ unsigned cvt_pk_bf16(float lo, float hi) { return mk::cvtpk_native(lo, hi); }
typedef float f32x2 __attribute__((ext_vector_type(2)));
__device__ __forceinline__ f32x2 gelu_pk(f32x2 v) {
    const f32x2 av = __builtin_elementwise_abs(v), d = av * 0.2316418882f + 1.0f;
    f32x2 t; t.x = __builtin_amdgcn_rcpf(d.x); t.y = __builtin_amdgcn_rcpf(d.y);
    f32x2 q = t * 0.5307027145f + (-0.7265760135f); q = q * t + 0.7107068705f; q = q * t + (-0.142248368f); q = q * t + 0.127414796f; q = q * t;
    const f32x2 s = (v * v) * (-0.72134752044f);
    f32x2 e; e.x = __builtin_amdgcn_exp2f(s.x); e.y = __builtin_amdgcn_exp2f(s.y);
    const f32x2 m = v * (q * e), r = v - m;
    f32x2 o; o.x = v.x < 0.f ? m.x : r.x; o.y = v.y < 0.f ? m.y : r.y; return o;
}

struct EpiF32 {
    static constexpr bool PERM = false, AFTER_DRAIN = false;
    float* C; int ldc; const float* bias;
    __device__ __forceinline__ void operator()(const f32x4 (&acc)[2][2][4][2], const Unit& u, int wr, int wc, int fr, int fq) const {
        const int row0 = u.pm * BM + wr * 64 + fr, col0 = u.pn * BM + wc * 32 + 4 * fq;
        f32x4 bv[2][2];
#pragma unroll
        for (int bj = 0; bj < 2; ++bj)
#pragma unroll
            for (int n = 0; n < 2; ++n) bv[bj][n] = bias ? *(const f32x4*)(bias + col0 + bj * HALF + n * 16) : (f32x4){0.f, 0.f, 0.f, 0.f};
#pragma unroll
        for (int ai = 0; ai < 2; ++ai)
#pragma unroll
            for (int m = 0; m < 4; ++m) { float* rowp = C + (size_t)(row0 + ai * HALF + m * 16) * ldc + col0;
#pragma unroll
                for (int bj = 0; bj < 2; ++bj)
#pragma unroll
                    for (int n = 0; n < 2; ++n) *(f32x4*)(rowp + bj * HALF + n * 16) = acc[ai][bj][m][n] + bv[bj][n]; }
    }
};
template <int ACT  > struct EpiBf16 {
    static constexpr bool PERM = true, AFTER_DRAIN = false;
    bf16_t* O; int ldc; const float* bias; int split_cols; size_t split_stride;
    __device__ __forceinline__ void operator()(const f32x4 (&acc)[2][2][4][2], const Unit& u, int wr, int wc, int fr, int fq) const {
        const int row0 = u.pm * BM + wr * 64 + fr; int colt = u.pn * BM; bf16_t* base = O;
        if (split_cols) { const int t = colt / split_cols; base += (size_t)t * split_stride; colt -= t * split_cols; }
        const int col0 = colt + wc * 32 + 8 * fq, bcol0 = u.pn * BM + wc * 32 + 8 * fq;
        f32x4 bv[2][2];
#pragma unroll
        for (int bj = 0; bj < 2; ++bj)
#pragma unroll
            for (int n = 0; n < 2; ++n) bv[bj][n] = bias ? *(const f32x4*)(bias + bcol0 + bj * HALF + 4 * n) : (f32x4){0.f, 0.f, 0.f, 0.f};
#pragma unroll
        for (int ai = 0; ai < 2; ++ai)
#pragma unroll
            for (int m = 0; m < 4; ++m) { bf16_t* rowp = base + (size_t)(row0 + ai * HALF + m * 16) * ldc + col0;
#pragma unroll
                for (int bj = 0; bj < 2; ++bj) { f32x4 v0 = acc[ai][bj][m][0] + bv[bj][0], v1 = acc[ai][bj][m][1] + bv[bj][1];
                    if (ACT == 1) { f32x2 a = gelu_pk((f32x2){v0[0], v0[1]}), b = gelu_pk((f32x2){v0[2], v0[3]}), c = gelu_pk((f32x2){v1[0], v1[1]}), d = gelu_pk((f32x2){v1[2], v1[3]});
                        v0 = (f32x4){a.x, a.y, b.x, b.y}; v1 = (f32x4){c.x, c.y, d.x, d.y}; }
                    if (ACT == 2) {
#pragma unroll
                        for (int j = 0; j < 4; ++j) { v0[j] = 0.5f * v0[j] * (1.0f + erff(v0[j] * 0.70710678f)); v1[j] = 0.5f * v1[j] * (1.0f + erff(v1[j] * 0.70710678f)); } }
                    u32x4 w; w.x = cvt_pk_bf16(v0[0], v0[1]); w.y = cvt_pk_bf16(v0[2], v0[3]); w.z = cvt_pk_bf16(v1[0], v1[1]); w.w = cvt_pk_bf16(v1[2], v1[3]);
                    *(u32x4*)(rowp + bj * HALF) = w; } }
    }
};

template <class Epi, class Sched, bool STAMP = false>
__device__ __forceinline__ void gemm_phase(PG8_LAS unsigned char* lds, const Gemm g, const Sched& S, const Epi& E, unsigned long long* stamps) {
    const int tid = mk::ltid(), wid = __builtin_amdgcn_readfirstlane(tid >> 6), lane = tid & 63, wr = wid >> 2, wc = wid & 3, fr = lane & 15, fq = lane >> 4;
    const int K = g.K, nt = K / BK;
    int ts_lo = 0, ts_hi = 0, nts = 0; const unsigned long long rt_entry = STAMP ? (unsigned long long)wall_clock64() : 0ull;
#define PG8_STAMP() do { if (STAMP && wid == 0 && nts < 64) { const unsigned long long _c = (unsigned long long)clock64(); \
        ts_lo = (lane == nts) ? (int)(unsigned)_c : ts_lo; ts_hi = (lane == nts) ? (int)(unsigned)(_c >> 32) : ts_hi; ++nts; } } while (0)
    PG8_STAMP();
    unsigned voffA[2], voffB[2];
#pragma unroll
    for (int i = 0; i < 2; ++i) { int R, C; stage_rc(tid * 16 + i * 8192, R, C); const int Rb = Epi::PERM ? ((R & ~31) + perm32(R & 31)) : R;
        voffA[i] = (unsigned)(R * K + C) * 2u; voffB[i] = (unsigned)(Rb * K + C) * 2u; }
    const size_t kstep = (size_t)(BK * 2);
    const size_t hstep = (size_t)HALF * K * 2;
    const size_t tstep = 2 * hstep;
    const unsigned ldsw = (unsigned)wid * 1024u;
    const int aoff = lds_byte(wr * 64 + fr, fq * 8), boff = lds_byte(wc * 32 + fr, fq * 8);
#define PG8_SA(b, h) (((b) * 2 + (h)) * HTB)
#define PG8_SB(b, h) ((4 + (b) * 2 + (h)) * HTB)
#define PG8_STAGE(bufoff, gbase, voff) do { _Pragma("unroll") for (int _i = 0; _i < 2; ++_i) \
        __builtin_amdgcn_global_load_lds((const unsigned*)((const char*)(gbase) + (voff)[_i]), (PG8_LAS unsigned*)(lds + (bufoff) + ldsw + _i * 8192), 16, 0, 0); } while (0)
#define PG8_LDA(dst, b, h) do { _Pragma("unroll") for (int m = 0; m < 4; ++m) _Pragma("unroll") for (int k = 0; k < 2; ++k) dst[m][k] = *(const PG8_LAS bf16x8*)(lds + PG8_SA(b, h) + aoff + m * 2048 + k * 1024); } while (0)
#define PG8_LDB(dst, b, h) do { _Pragma("unroll") for (int n = 0; n < 2; ++n) _Pragma("unroll") for (int k = 0; k < 2; ++k) dst[n][k] = *(const PG8_LAS bf16x8*)(lds + PG8_SB(b, h) + boff + n * 2048 + k * 1024); } while (0)
#define PG8_MMA(ai, bj, At, Bt) do { __builtin_amdgcn_s_setprio(1); _Pragma("unroll") for (int m = 0; m < 4; ++m) _Pragma("unroll") for (int n = 0; n < 2; ++n) _Pragma("unroll") for (int k = 0; k < 2; ++k) \
        acc[ai][bj][m][n] = __builtin_amdgcn_mfma_f32_16x16x32_bf16(Bt[n][k], At[m][k], acc[ai][bj][m][n], 0, 0, 0); __builtin_amdgcn_s_setprio(0); } while (0)
#define PG8_WAIT_V(n) asm volatile("s_waitcnt vmcnt(" #n ")" ::: "memory")
#define PG8_WAIT_L(n) asm volatile("s_waitcnt lgkmcnt(" #n ")" ::: "memory")
#define PG8_BAR __builtin_amdgcn_s_barrier()
#define PG8_SCHED __builtin_amdgcn_sched_barrier(0)
    Unit cur, nxt; int ui = 0;
    if (!S.next(0, cur)) return;
    f32x4 acc[2][2][4][2];
#pragma unroll
    for (int a = 0; a < 2; ++a)
#pragma unroll
        for (int b = 0; b < 2; ++b)
#pragma unroll
            for (int m = 0; m < 4; ++m)
#pragma unroll
                for (int n = 0; n < 2; ++n) acc[a][b][m][n] = (f32x4){0.f, 0.f, 0.f, 0.f};
    bf16x8 At[4][2], B0[2][2], B1[2][2];
    const char* cA = (const char*)g.A + (size_t)cur.pm * tstep; const char* cB = (const char*)g.Bt + (size_t)cur.pn * tstep;
    S.a_ready(cur);
    PG8_STAGE(PG8_SB(0, 0), cB, voffB); PG8_STAGE(PG8_SA(0, 0), cA, voffA); PG8_STAGE(PG8_SB(0, 1), cB + hstep, voffB); PG8_STAGE(PG8_SA(0, 1), cA + hstep, voffA);
    if (wr == 1) PG8_BAR;
    PG8_WAIT_V(4); PG8_BAR;
    PG8_STAGE(PG8_SB(1, 0), cB + kstep, voffB); PG8_STAGE(PG8_SA(1, 0), cA + kstep, voffA); PG8_STAGE(PG8_SB(1, 1), cB + hstep + kstep, voffB);
    PG8_WAIT_V(6); PG8_BAR;
    PG8_STAMP();
    for (;;) {
        const bool has_next = S.next(ui + 1, nxt);
        const char* nA = has_next ? (const char*)g.A + (size_t)nxt.pm * tstep : cA; const char* nB = has_next ? (const char*)g.Bt + (size_t)nxt.pn * tstep : cB;
        for (int t = 0; t < nt; t += 2) {
            const bool last = (t == nt - 2);
            const char* a1 = cA + (size_t)(t + 1) * kstep;
            const char* a2 = last ? nA : cA + (size_t)(t + 2) * kstep; const char* b2 = last ? nB : cB + (size_t)(t + 2) * kstep;
            const char* a3 = a2 + kstep; const char* b3 = b2 + kstep;
            if (last && has_next) S.a_ready(nxt);
            PG8_LDB(B0, 0, 0); PG8_SCHED; PG8_LDA(At, 0, 0); PG8_STAGE(PG8_SA(1, 1), a1 + hstep, voffA);
            PG8_WAIT_L(8); PG8_BAR; PG8_WAIT_L(0); PG8_MMA(0, 0, At, B0); PG8_BAR; PG8_SCHED;
            PG8_LDB(B1, 0, 1); PG8_STAGE(PG8_SB(0, 0), b2, voffB);
            PG8_BAR; PG8_WAIT_L(0); PG8_MMA(0, 1, At, B1); PG8_BAR;
            PG8_LDA(At, 0, 1); PG8_STAGE(PG8_SA(0, 0), a2, voffA);
            PG8_BAR; PG8_WAIT_L(0); PG8_MMA(1, 0, At, B0); PG8_BAR; PG8_SCHED;
            PG8_STAGE(PG8_SB(0, 1), b2 + hstep, voffB);
            PG8_WAIT_V(6); PG8_BAR; PG8_MMA(1, 1, At, B1); PG8_BAR;
            PG8_LDB(B0, 1, 0); PG8_SCHED; PG8_LDA(At, 1, 0); PG8_STAGE(PG8_SA(0, 1), a2 + hstep, voffA);
            PG8_WAIT_L(8); PG8_BAR; PG8_WAIT_L(0); PG8_MMA(0, 0, At, B0); PG8_BAR; PG8_SCHED;
            PG8_LDB(B1, 1, 1); PG8_STAGE(PG8_SB(1, 0), b3, voffB);
            PG8_BAR; PG8_WAIT_L(0); PG8_MMA(0, 1, At, B1); PG8_BAR;
            PG8_LDA(At, 1, 1); PG8_STAGE(PG8_SA(1, 0), a3, voffA);
            PG8_BAR; PG8_WAIT_L(0); PG8_MMA(1, 0, At, B0); PG8_BAR; PG8_SCHED;
            PG8_STAGE(PG8_SB(1, 1), b3 + hstep, voffB);
            PG8_WAIT_V(6); PG8_BAR; PG8_MMA(1, 1, At, B1); PG8_BAR;
        }
        PG8_STAMP();
        if constexpr (!Epi::AFTER_DRAIN) { E(acc, cur, wr, wc, fr, fq); S.done(cur); }
        PG8_STAMP();
        if (!has_next) break;
#pragma unroll
        for (int a = 0; a < 2; ++a)
#pragma unroll
            for (int b = 0; b < 2; ++b)
#pragma unroll
                for (int m = 0; m < 4; ++m)
#pragma unroll
                    for (int n = 0; n < 2; ++n) acc[a][b][m][n] = (f32x4){0.f, 0.f, 0.f, 0.f};
        cur = nxt; cA = nA; cB = nB; ++ui;
    }
    PG8_WAIT_V(0);
    if (wr == 0) PG8_BAR;
    PG8_BAR;
    if constexpr (Epi::AFTER_DRAIN) { E.fused(acc, cur, wr, wc, fr, fq, lds, wid, lane); S.done(cur); }
    PG8_STAMP();
    if (STAMP && wid == 0) { stamps[lane] = lane < nts ? (((unsigned long long)(unsigned)ts_hi << 32) | (unsigned)ts_lo) : 0ull;
        if (lane == 62) stamps[62] = rt_entry; if (lane == 63) stamps[63] = (unsigned long long)wall_clock64(); }
#undef PG8_STAMP
#undef PG8_SA
#undef PG8_SB
#undef PG8_STAGE
#undef PG8_LDA
#undef PG8_LDB
#undef PG8_MMA
#undef PG8_WAIT_V
#undef PG8_WAIT_L
#undef PG8_BAR
#undef PG8_SCHED
}
}

#define XB_TMO      128
#define XB_XCNT(j)  (256  + 64 * (j))
#define XB_XSUB(j)  (1280 + 64 * (j))
#define XB_XGEN(j)  (2304 + 64 * (j))
#define XB_TOP      3328
#define XB_TOPGEN   3392
#define XCD_BAR_WORDS 3456
#define XB_SPIN_CAP (1u << 18)
#define LAS __attribute__((address_space(3)))

__device__ __forceinline__ unsigned xb_ld(unsigned* p)              { return __hip_atomic_load(p, __ATOMIC_RELAXED, __HIP_MEMORY_SCOPE_AGENT); }
__device__ __forceinline__ unsigned xb_add(unsigned* p, unsigned v) { return __hip_atomic_fetch_add(p, v, __ATOMIC_RELAXED, __HIP_MEMORY_SCOPE_AGENT); }
__device__ __forceinline__ unsigned xb_xcc_id() { return (unsigned)__builtin_amdgcn_s_getreg((3 << 11) | 20) & 0xFu; }
#define XB_SPIN(cond, bar) do { unsigned _sp = 0; while (cond) { __builtin_amdgcn_s_sleep(1); \
    if ((++_sp & 255u) == 0u) { if (xb_ld(&(bar)[XB_TMO])) break; if (_sp > XB_SPIN_CAP) { atomicAdd(&(bar)[XB_TMO], 1u); break; } } } } while (0)

struct XcdBarrier {
    unsigned* bar; unsigned x;
    volatile LAS unsigned* st;
};

__device__ __forceinline__ XcdBarrier xcd_barrier_post(unsigned* bar, volatile LAS unsigned* st) {
    XcdBarrier b; b.bar = bar; b.x = xb_xcc_id(); b.st = st;
    if (threadIdx.x == 0) (void)xb_add(&bar[XB_XCNT(b.x)], 1u);
    return b;
}
__device__ __forceinline__ void xcd_barrier_complete(unsigned* bar, unsigned x, unsigned& nloc, unsigned& nx) {
    const unsigned G = gridDim.x * gridDim.y * gridDim.z;
    unsigned sum, cnt, mine, sp = 0u;
    for (;;) {
        sum = 0u; cnt = 0u; mine = 0u;
#pragma unroll
        for (unsigned j = 0; j < 16; ++j) { const unsigned c = xb_ld(&bar[XB_XCNT(j)]); sum += c; cnt += (c > 0u) ? 1u : 0u; mine = (j == x) ? c : mine; }
        if (sum == G) break;
        __builtin_amdgcn_s_sleep(1);
        if ((++sp & 255u) == 0u) { if (xb_ld(&bar[XB_TMO])) break; if (sp > XB_SPIN_CAP) { atomicAdd(&bar[XB_TMO], 1u); break; } }
    }
    nloc = mine > 0u ? mine : 1u; nx = cnt > 0u ? cnt : 1u;
}

__device__ __forceinline__ void xcd_barrier(const XcdBarrier& b) {
    asm volatile("s_waitcnt vmcnt(0)" ::: "memory");
    __syncthreads();
    if (threadIdx.x == 0) {
        unsigned* bar = b.bar;
        __builtin_amdgcn_s_waitcnt(0);
        unsigned nloc = b.st[0], nx = b.st[1];
        if (nloc == 0u) { xcd_barrier_complete(bar, b.x, nloc, nx); b.st[0] = nloc; b.st[1] = nx; }
        const unsigned old = xb_add(&bar[XB_XSUB(b.x)], 1u);
        const unsigned gen = old / nloc;
        if (old + 1u == (gen + 1u) * nloc) {
            __builtin_amdgcn_fence(__ATOMIC_RELEASE, "agent");
            asm volatile("s_waitcnt vmcnt(0)" ::: "memory");
            const unsigned og = xb_add(&bar[XB_TOP], 1u);
            const unsigned tg = og / nx;
            if (og + 1u == (tg + 1u) * nx) xb_add(&bar[XB_TOPGEN], 1u);
            else XB_SPIN(xb_ld(&bar[XB_TOPGEN]) == tg, bar);
            __builtin_amdgcn_fence(__ATOMIC_ACQUIRE, "agent");
            xb_add(&bar[XB_XGEN(b.x)], 1u);
            asm volatile("s_waitcnt vmcnt(0)" ::: "memory");
        } else {
            XB_SPIN(xb_ld(&bar[XB_XGEN(b.x)]) == gen, bar);
            __builtin_amdgcn_fence(__ATOMIC_ACQUIRE, "agent");
            asm volatile("s_waitcnt vmcnt(0)" ::: "memory");
        }
    }
    __syncthreads();
}


namespace mk {
#define LAS3 __attribute__((address_space(3)))
__device__ __forceinline__ int src_col1(int n) { if (n < 2048) return n; if (n < 3072) return SG + (n - 2048); if (n < 3136) return SIK + (n - 3072); if (n < 3144) return SIW + (n - 3136); return -1; }
__device__ __forceinline__ int src_col3(int n) { return n < DN_IN ? n : -1; }
__device__ __forceinline__ int src_colid(int n) { return n; }

template <int MAP> __device__ __forceinline__ void wconv_load(float (&v)[8], const float* W, int ldw, const float* gain, int n0, int k0) {
    const int tid = mk::ltid();
#pragma unroll
    for (int i = 0; i < 8; ++i) {
        const int e = tid + 512 * i, kk = e >> 6, nn = e & 63, n = n0 + nn;
        const int sc = MAP == 1 ? src_col1(n) : (MAP == 3 ? src_col3(n) : src_colid(n));
        float x = 0.f;
        if (sc >= 0) { x = W[(size_t)(k0 + kk) * ldw + sc]; if (gain) x *= gain[k0 + kk]; }
        v[i] = x;
    }
}
template <int MAP> __device__ __forceinline__ void wconv_all(float* tile, const float* W, int ldw, const float* gain, bf16_t* Wt, int K, int NP, int bid, int nblk) {
    const int ntn = NP / 64, ntk = K / 64, total = ntn * ntk, tid = mk::ltid();
    float v[8], vn[8];
    int t = bid;
    if (t < total) wconv_load<MAP>(v, W, ldw, gain, (t % ntn) * 64, (t / ntn) * 64);
    for (; t < total; t += nblk) {
        const int tn = t + nblk, n0 = (t % ntn) * 64, k0 = (t / ntn) * 64;
        if (tn < total) wconv_load<MAP>(vn, W, ldw, gain, (tn % ntn) * 64, (tn / ntn) * 64);
#pragma unroll
        for (int i = 0; i < 8; ++i) { const int e = tid + 512 * i; tile[(e >> 6) * 65 + (e & 63)] = v[i]; }
        __syncthreads();
#pragma unroll
        for (int i = 0; i < 4; ++i) {
            const int e = tid + 512 * i, nn = e >> 5, kk = (e & 31) * 2;
            *(unsigned*)(Wt + (size_t)(n0 + nn) * K + k0 + kk) = pk2bf(tile[kk * 65 + nn], tile[(kk + 1) * 65 + nn]);
        }
        __syncthreads();
#pragma unroll
        for (int i = 0; i < 8; ++i) v[i] = vn[i];
    }
}
template <int MAP> __device__ __forceinline__ void wconv_waves(const float* W, int ldw, const float* gain, bf16_t* Wt, int K, int NP, int wv, int nwv) {
    const int l = mk::ltid() & 63, n = l & 31, kh = l >> 5;
    const int nun = NP / 32, nuk = K / 64;
    for (int u = wv; u < nun * nuk; u += nwv) {
        const int n0 = (u % nun) * 32, k0 = (u / nun) * 64 + 32 * kh;
        const int sc = MAP == 1 ? src_col1(n0 + n) : (MAP == 3 ? src_col3(n0 + n) : src_colid(n0 + n));
        float x[32];
#pragma unroll
        for (int i = 0; i < 32; ++i) x[i] = sc >= 0 ? W[(size_t)(k0 + i) * ldw + sc] : 0.f;
        if (gain) {
#pragma unroll
            for (int i = 0; i < 32; ++i) x[i] *= gain[k0 + i];
        }
        uint4* dst = (uint4*)(Wt + (size_t)(n0 + n) * K + k0);
#pragma unroll
        for (int q = 0; q < 4; ++q) dst[q] = make_uint4(cvtpk_native(x[8 * q], x[8 * q + 1]), cvtpk_native(x[8 * q + 2], x[8 * q + 3]), cvtpk_native(x[8 * q + 4], x[8 * q + 5]), cvtpk_native(x[8 * q + 6], x[8 * q + 7]));
    }
}
__device__ __forceinline__ void xnorm_load(const float* x, float4 (&v)[4]) { const int lane = mk::ltid() & 63;
#pragma unroll
    for (int i = 0; i < 4; ++i) v[i] = ldnt4(x + 4 * (lane + 64 * i)); }
__device__ __forceinline__ void xnorm_finish(const float4 (&v)[4], bf16_t* xa, float* inv) {
    const int lane = mk::ltid() & 63;
    float ss = 0.f;
#pragma unroll
    for (int i = 0; i < 4; ++i) ss += v[i].x * v[i].x + v[i].y * v[i].y + v[i].z * v[i].z + v[i].w * v[i].w;
    ss = wave_sum(ss);
    const float ms = ss * (1.0f / D) + EPS, r = rsqrtf(ms);
    if (lane == 0) *inv = ms * r;
#pragma unroll
    for (int i = 0; i < 4; ++i) { uint2 w; w.x = pk2bf(v[i].x * r, v[i].y * r); w.y = pk2bf(v[i].z * r, v[i].w * r); ((uint2*)xa)[lane + 64 * i] = w; }
}

using pg8::f32x4; using pg8::u32x4; using pg8::Unit; using pg8::BM; using pg8::HALF;
struct EpiF32Res {
    static constexpr bool PERM = false, AFTER_DRAIN = false;
    float* C; const float* R0; const float* R1; bf16_t* XB; float* SS; int ld; int pad_;
    __device__ __forceinline__ void operator()(const f32x4 (&acc)[2][2][4][2], const Unit& u, int wr, int wc, int fr, int fq) const {
        const int row0 = u.pm * BM + wr * 64 + fr, col0 = u.pn * BM + wc * 32 + 4 * fq;
        const float* Rb = (u.pm * BM < MP) ? R0 : R1 - (size_t)MP * ld;
#pragma unroll
        for (int ai = 0; ai < 2; ++ai)
#pragma unroll
            for (int m = 0; m < 4; ++m) { const size_t ro = (size_t)(row0 + ai * HALF + m * 16) * ld + col0;
                float ss = 0.f;
#pragma unroll
                for (int bj = 0; bj < 2; ++bj)
#pragma unroll
                    for (int n = 0; n < 2; ++n) { const f32x4 v = acc[ai][bj][m][n] + *(const f32x4*)(Rb + ro + bj * HALF + n * 16);
                        if (C) *(f32x4*)(C + ro + bj * HALF + n * 16) = v;
                        if (XB) { *(uint2*)(XB + ro + bj * HALF + n * 16) = make_uint2(cvtpk_native(v[0], v[1]), cvtpk_native(v[2], v[3])); ss += (v[0] * v[0] + v[1] * v[1]) + (v[2] * v[2] + v[3] * v[3]); } }
                if (XB) { ss += __shfl_xor(ss, 16); ss += __shfl_xor(ss, 32); if (fq == 0) atomicAdd(SS + row0 + ai * HALF + m * 16, ss); }
            }
    }
};
struct EpiY1 {
    static constexpr bool PERM = false, AFTER_DRAIN = false;
    bf16_t* XB; const float* INV; float* SS; int ld; int pad_;
    __device__ __forceinline__ void operator()(const f32x4 (&acc)[2][2][4][2], const Unit& u, int wr, int wc, int fr, int fq) const {
        const int row0 = u.pm * BM + wr * 64 + fr, col0 = u.pn * BM + wc * 32 + 4 * fq;
#pragma unroll
        for (int ai = 0; ai < 2; ++ai)
#pragma unroll
            for (int m = 0; m < 4; ++m) { const int row = row0 + ai * HALF + m * 16; const size_t ro = (size_t)row * ld + col0;
                const float inv = INV[row];
                float ss = 0.f;
#pragma unroll
                for (int bj = 0; bj < 2; ++bj)
#pragma unroll
                    for (int n = 0; n < 2; ++n) { uint2* xp = (uint2*)(XB + ro + bj * HALF + n * 16); const uint2 rb = *xp;
                        f32x4 v = acc[ai][bj][m][n];
                        v[0] = fmaf(__uint_as_float(rb.x << 16), inv, v[0]); v[1] = fmaf(__uint_as_float(rb.x & 0xFFFF0000u), inv, v[1]);
                        v[2] = fmaf(__uint_as_float(rb.y << 16), inv, v[2]); v[3] = fmaf(__uint_as_float(rb.y & 0xFFFF0000u), inv, v[3]);
                        *xp = make_uint2(cvtpk_native(v[0], v[1]), cvtpk_native(v[2], v[3])); ss += (v[0] * v[0] + v[1] * v[1]) + (v[2] * v[2] + v[3] * v[3]); }
                ss += __shfl_xor(ss, 16); ss += __shfl_xor(ss, 32); if (fq == 0) atomicAdd(SS + row, ss);
            }
    }
};
struct EpiF32ResBf {
    static constexpr bool PERM = false, AFTER_DRAIN = false;
    float* C; const bf16_t* RB; int ld; int pad_;
    __device__ __forceinline__ void operator()(const f32x4 (&acc)[2][2][4][2], const Unit& u, int wr, int wc, int fr, int fq) const {
        const int row0 = u.pm * BM + wr * 64 + fr, col0 = u.pn * BM + wc * 32 + 4 * fq;
#pragma unroll
        for (int ai = 0; ai < 2; ++ai)
#pragma unroll
            for (int m = 0; m < 4; ++m) { const size_t ro = (size_t)(row0 + ai * HALF + m * 16) * ld + col0;
#pragma unroll
                for (int bj = 0; bj < 2; ++bj)
#pragma unroll
                    for (int n = 0; n < 2; ++n) { const uint2 rb = *(const uint2*)(RB + ro + bj * HALF + n * 16);
                        f32x4 v = acc[ai][bj][m][n];
                        v[0] += __uint_as_float(rb.x << 16); v[1] += __uint_as_float(rb.x & 0xFFFF0000u); v[2] += __uint_as_float(rb.y << 16); v[3] += __uint_as_float(rb.y & 0xFFFF0000u);
                        *(f32x4*)(C + ro + bj * HALF + n * 16) = v; }
            }
    }
};
struct EpiBf16Tail {
    static constexpr bool PERM = true, AFTER_DRAIN = false;
    bf16_t* O; int ldc; int ntile_bf; float* BA; const float* SS;
    float* QSS;
    __device__ __forceinline__ void operator()(const f32x4 (&acc)[2][2][4][2], const Unit& u, int wr, int wc, int fr, int fq) const {
        const int row0 = u.pm * BM + wr * 64 + fr;
        float rs[2][4];
#pragma unroll
        for (int ai = 0; ai < 2; ++ai)
#pragma unroll
            for (int m = 0; m < 4; ++m) rs[ai][m] = SS ? rsqrtf(SS[row0 + ai * HALF + m * 16] * (1.0f / D) + EPS) : 1.0f;
        if (u.pn >= ntile_bf) {
            if (wc == 0 && fq < 2) {
#pragma unroll
                for (int ai = 0; ai < 2; ++ai)
#pragma unroll
                    for (int m = 0; m < 4; ++m) { float* rp = BA + (size_t)(row0 + ai * HALF + m * 16) * 16 + 8 * fq;
                        *(f32x4*)(rp) = acc[ai][0][m][0] * rs[ai][m]; *(f32x4*)(rp + 4) = acc[ai][0][m][1] * rs[ai][m]; }
            }
            return;
        }
        const int col0 = u.pn * BM + wc * 32 + 8 * fq;
        const bool qsum = QSS != nullptr && u.pn < 4;
#pragma unroll
        for (int ai = 0; ai < 2; ++ai)
#pragma unroll
            for (int m = 0; m < 4; ++m) { bf16_t* rowp = O + (size_t)(row0 + ai * HALF + m * 16) * ldc + col0;
#pragma unroll
                for (int bj = 0; bj < 2; ++bj) { const f32x4 v0 = acc[ai][bj][m][0] * rs[ai][m], v1 = acc[ai][bj][m][1] * rs[ai][m];
                    u32x4 w; w.x = pg8::cvt_pk_bf16(v0[0], v0[1]); w.y = pg8::cvt_pk_bf16(v0[2], v0[3]); w.z = pg8::cvt_pk_bf16(v1[0], v1[1]); w.w = pg8::cvt_pk_bf16(v1[2], v1[3]);
                    *(u32x4*)(rowp + bj * HALF) = w;
                    if (qsum) { float ss = ((v0[0] * v0[0] + v0[1] * v0[1]) + (v0[2] * v0[2] + v0[3] * v0[3])) + ((v1[0] * v1[0] + v1[1] * v1[1]) + (v1[2] * v1[2] + v1[3] * v1[3]));
                        ss += __shfl_xor(ss, 16); ss += __shfl_xor(ss, 32);
                        if (fq == 0) atomicAdd(QSS + (size_t)(row0 + ai * HALF + m * 16) * 8 + 2 * u.pn + bj, ss); } } }
    }
};
}
namespace mk {
template <int NJ, class P, class F> __device__ __forceinline__ void gemm_small_unit(char* lds, const bf16_t* A, const bf16_t* Bt, int row0, int col0, P&& pre, F&& emit) {
    const int tid = ltid(), w = __builtin_amdgcn_readfirstlane(tid >> 6), l = tid & 63, r = l & 31, hh = l >> 5;
    const bf16_t* ap = A + (size_t)(row0 + r) * D + 128 * w + 8 * hh;
    const bf16_t* bp = Bt + (size_t)(col0 + r) * D + 128 * w + 8 * hh;
    bf16x8 af[8], bfr[NJ][8];
#pragma unroll
    for (int s = 0; s < 8; ++s) { af[s] = *(const bf16x8*)(ap + 16 * s);
#pragma unroll
        for (int j = 0; j < NJ; ++j) bfr[j][s] = *(const bf16x8*)(bp + (size_t)(32 * j) * D + 16 * s); }
    float rsd[NJ][2];
#pragma unroll
    for (int j = 0; j < NJ; ++j)
#pragma unroll
        for (int e = 0; e < 2; ++e) { const int q = 2 * w + e; rsd[j][e] = pre(row0 + (q & 3) + 8 * (q >> 2) + 4 * hh, col0 + 32 * j + r); }
    f32x16 acc[NJ];
#pragma unroll
    for (int j = 0; j < NJ; ++j) acc[j] = f32x16{};
#pragma unroll
    for (int s = 0; s < 8; ++s)
#pragma unroll
        for (int j = 0; j < NJ; ++j) acc[j] = __builtin_amdgcn_mfma_f32_32x32x16_bf16(af[s], bfr[j][s], acc[j], 0, 0, 0);
    float* part = (float*)lds;
#pragma unroll
    for (int j = 0; j < NJ; ++j)
#pragma unroll
        for (int q = 0; q < 16; ++q) part[((w * NJ + j) * 16 + q) * 64 + l] = acc[j][q];
    __syncthreads();
#pragma unroll
    for (int j = 0; j < NJ; ++j)
#pragma unroll
        for (int e = 0; e < 2; ++e) {
            const int q = 2 * w + e;
            float v = 0.f;
#pragma unroll
            for (int ww = 0; ww < 8; ++ww) v += part[((ww * NJ + j) * 16 + q) * 64 + l];
            emit(row0 + (q & 3) + 8 * (q >> 2) + 4 * hh, col0 + 32 * j + r, v, rsd[j][e]);
        }
    __syncthreads();
}
}

namespace mk {

struct AttPostRegs { unsigned k[2], v[2]; bf16_t ik, iw; };
__device__ __forceinline__ void att_post_load(int m, const bf16_t* P1, AttPostRegs& R) {
    const int l = mk::ltid() & 63;
    const unsigned* p = (const unsigned*)(P1 + (size_t)m * N1P);
#pragma unroll
    for (int h = 0; h < 2; ++h) { R.k[h] = p[(CK >> 1) + h * 64 + l]; R.v[h] = p[(CV >> 1) + h * 64 + l]; }
    R.ik = P1[(size_t)m * N1P + CIK + l]; R.iw = P1[(size_t)m * N1P + CIW + (l & 7)];
}
__device__ __forceinline__ void att_post_finish(int m, const AttPostRegs& R, const float* qg, const float* kg, const float* ikg, bf16_t* KB, bf16_t* IKB, float* IW, float* out) {
    const int l = mk::ltid() & 63;
    const float g0 = qg[2 * l], g1 = qg[2 * l + 1];
    {
        const float k0 = kg[2 * l], k1 = kg[2 * l + 1];
        float* ko = kout(out, m); unsigned* kb = (unsigned*)(KB + (size_t)m * 256);
        float ka[2], kb2[2], ss[3];
#pragma unroll
        for (int h = 0; h < 2; ++h) { ka[h] = __uint_as_float(R.k[h] << 16); kb2[h] = __uint_as_float(R.k[h] & 0xFFFF0000u); ss[h] = ka[h] * ka[h] + kb2[h] * kb2[h]; }
        const float ia = bf2f(R.ik); ss[2] = ia * ia;
        wave_sum_n<3>(ss);
#pragma unroll
        for (int h = 0; h < 2; ++h) {
            const float r = rsqrtf(ss[h] * (1.0f / 128) + EPS);
            const float x = ka[h] * r * k0, y = kb2[h] * r * k1;
            *(float2*)(ko + h * 128 + 2 * l) = make_float2(x, y);
            kb[h * 64 + l] = pk2bf(x * g0, y * g1);
        }
        float* vo = vout(out, m);
#pragma unroll
        for (int h = 0; h < 2; ++h) *(float2*)(vo + h * 128 + 2 * l) = make_float2(__uint_as_float(R.v[h] << 16), __uint_as_float(R.v[h] & 0xFFFF0000u));
        const float ri = rsqrtf(ss[2] * (1.0f / 64) + EPS);
        const float xi = ia * ri * ikg[l];
        ikout(out, m)[l] = xi;
        IKB[(size_t)m * 64 + l] = f2bf(xi);
        if (l < 8) IW[(size_t)m * 8 + l] = bf2f(R.iw) * (0.35355339059327373f * 0.125f);
    }
}
__device__ __forceinline__ void att_post_rows(int gw, int nw, const bf16_t* P1, const float* qg, const float* kg, const float* ikg, bf16_t* KB, bf16_t* IKB, float* IW, float* out) {
    AttPostRegs R0, R1, R2;
    int m = gw;
    if (m < M) att_post_load(m, P1, R0);
    if (m + nw < M) att_post_load(m + nw, P1, R1);
    for (; m < M; m += 3 * nw) {
        if (m + 2 * nw < M) att_post_load(m + 2 * nw, P1, R2);
        att_post_finish(m, R0, qg, kg, ikg, KB, IKB, IW, out);
        if (m + nw < M) { if (m + 3 * nw < M) att_post_load(m + 3 * nw, P1, R0);
            att_post_finish(m + nw, R1, qg, kg, ikg, KB, IKB, IW, out); }
        if (m + 2 * nw < M) { if (m + 4 * nw < M) att_post_load(m + 4 * nw, P1, R1);
            att_post_finish(m + 2 * nw, R2, qg, kg, ikg, KB, IKB, IW, out); }
    }
}
}

namespace ix {
using mk::bf16_t; using mk::bf16x8; using mk::f32x16;
constexpr int TOPK = mk::TOPK;
constexpr float NEGINF = -__builtin_inff();
__device__ __forceinline__ float key2f(unsigned k) { return (k & 0x80000000u) ? __uint_as_float(k & 0x7FFFFFFFu) : __uint_as_float(~k); }

__device__ __forceinline__ void tile_partial(const bf16x8 (&af)[4], const bf16x8 (&bfr)[4], const float (&w)[16], float (&p)[4]) {
    f32x16 acc = {};
#pragma unroll
    for (int s = 0; s < 4; ++s) acc = __builtin_amdgcn_mfma_f32_32x32x16_bf16(af[s], bfr[s], acc, 0, 0, 0);
#pragma unroll
    for (int T = 0; T < 4; ++T) {
        float x = w[4 * T] * fmaxf(acc[4 * T], 0.f);
        x = fmaf(w[4 * T + 1], fmaxf(acc[4 * T + 1], 0.f), x);
        x = fmaf(w[4 * T + 2], fmaxf(acc[4 * T + 2], 0.f), x);
        x = fmaf(w[4 * T + 3], fmaxf(acc[4 * T + 3], 0.f), x);
        p[T] = x;
    }
}
__device__ __forceinline__ float pair_combine(float pa, float pb) {
    auto rr = __builtin_amdgcn_permlane32_swap(__float_as_uint(pa), __float_as_uint(pb), false, false);
    return __uint_as_float(rr[0]) + __uint_as_float(rr[1]);
}
__device__ __forceinline__ void load_af_w(const bf16_t* P1, const float* IW, int m0, int r, int hh, bf16x8 (&af)[4], float (&w)[16]) {
    const bf16_t* ap = P1 + (size_t)(m0 + (r >> 3)) * mk::N1P + mk::CIQ + (r & 7) * 64 + 8 * hh;
#pragma unroll
    for (int s = 0; s < 4; ++s) af[s] = *(const bf16x8*)(ap + 16 * s);
#pragma unroll
    for (int i = 0; i < 16; ++i) w[i] = IW[(size_t)(m0 + (i >> 2)) * 8 + (i & 3) + 4 * hh];
}

template <int NA, int NR, int MI = 0, class F> __device__ __forceinline__ void topk_select(const float (&sc)[NA], F&& emit) {
    unsigned lo = 0x007FFFFFu, hi = 0xFF800001u;
    float tau = NEGINF; bool exact = false;
    auto count_ge = [&](float tf) __attribute__((always_inline)) -> int {
        int c = 0;
#pragma unroll
        for (int k0 = 0; k0 < NR; k0 += 8) {
            unsigned long long bm[8];
#pragma unroll
            for (int q = 0; q < 8; ++q) bm[q] = (k0 + q < NR) ? __builtin_amdgcn_ballot_w64(sc[k0 + q < NR ? k0 + q : 0] >= tf) : 0ull;
            __builtin_amdgcn_sched_barrier(0);
#pragma unroll
            for (int q = 0; q < 8; ++q) c += __builtin_popcountll(bm[q]);
            __builtin_amdgcn_sched_barrier(0);
        }
        return c;
    };
    if (MI) {
        float mx = sc[0];
#pragma unroll
        for (int k = 1; k < NR; ++k) mx = fmaxf(mx, sc[k]);
        mx = fmaxf(mx, __int_as_float(__builtin_amdgcn_update_dpp(0, __float_as_int(mx), 0xB1, 0xF, 0xF, false)));
        mx = fmaxf(mx, __int_as_float(__builtin_amdgcn_update_dpp(0, __float_as_int(mx), 0x4E, 0xF, 0xF, false)));
        mx = fmaxf(mx, __int_as_float(__builtin_amdgcn_update_dpp(0, __float_as_int(mx), 0x124, 0xF, 0xF, false)));
        mx = fmaxf(mx, __int_as_float(__builtin_amdgcn_update_dpp(0, __float_as_int(mx), 0x128, 0xF, 0xF, false)));
        const int mi = __float_as_int(mx);
        const float m4 = fmaxf(fmaxf(__int_as_float(__builtin_amdgcn_readlane(mi, 0)), __int_as_float(__builtin_amdgcn_readlane(mi, 16))),
                               fmaxf(__int_as_float(__builtin_amdgcn_readlane(mi, 32)), __int_as_float(__builtin_amdgcn_readlane(mi, 48))));
        if (m4 > 1e-30f) {
            hi = (__float_as_uint(m4) | 0x80000000u) + 1u;
            const float tf = m4 * 0.0625f; const unsigned kf = __float_as_uint(tf) | 0x80000000u;
            const int c = count_ge(tf);
            if (c >= TOPK) { lo = kf; tau = tf; if (c == TOPK) { exact = true; hi = lo + 1u; } } else hi = kf;
        }
    }
    while (hi - lo > 1u) {
        const unsigned mid = lo + ((hi - lo) >> 1);
        const float tf = key2f(mid);
        const int c = count_ge(tf);
        if (c >= TOPK) { lo = mid; tau = tf; if (c == TOPK) { exact = true; break; } } else hi = mid;
    }
    if (exact) {
#pragma unroll
        for (int k = 0; k < NA; ++k) emit(k, k < NR ? __builtin_amdgcn_ballot_w64(sc[k] >= tau) : 0ull);
        return;
    }
    int cgt = 0;
#pragma unroll
    for (int k = 0; k < NR; ++k) cgt += __builtin_popcountll(__builtin_amdgcn_ballot_w64(sc[k] > tau));
    int need = TOPK - cgt;
#pragma unroll
    for (int k = 0; k < NA; ++k) {
        unsigned long long bm = 0ull;
        if (k < NR) {
            const unsigned long long gt = __builtin_amdgcn_ballot_w64(sc[k] > tau);
            unsigned long long eq = __builtin_amdgcn_ballot_w64(sc[k] == tau);
            int pc = __builtin_popcountll(eq);
            while (pc > need) { eq &= ~(1ull << (63 - __builtin_clzll(eq))); --pc; }
            need -= pc;
            bm = gt | eq;
        }
        emit(k, bm);
    }
}

__device__ __forceinline__ void index_prompt_block(int b, int gi, char* lds, const bf16_t* P1, const bf16_t* IKB, const float* IW, unsigned* MASK) {
    const int tid = mk::ltid(), w = __builtin_amdgcn_readfirstlane(tid >> 6), l = tid & 63, r = l & 31, hh = l >> 5;
    const int t0 = 32 * gi + 4 * w, m0 = b * mk::SEQ + t0;
    if (gi < 8) {
#pragma unroll
        for (int T = 0; T < 4; ++T) { const int nb = t0 + T + 1 - 32 * l; MASK[(size_t)(m0 + T) * 64 + l] = nb >= 32 ? 0xFFFFFFFFu : (nb <= 0 ? 0u : ((1u << nb) - 1u)); }
        return;
    }
    bf16x8 af[4]; float wt[16];
    load_af_w(P1, IW, m0, r, hh, af, wt);
    const int JP = (32 * gi + 31) / 64 + 1;
    const int skey = tid >> 3, sch = tid & 7;
    const bf16_t* gsrc = IKB + (size_t)(b * mk::SEQ + skey) * 64 + 8 * sch;
    const int sdst = (skey * 8 + (sch ^ ((skey >> 1) & 7))) * 16;
    const int rd0 = r * 128 + ((hh ^ ((r >> 1) & 1)) << 4), rda = ((r >> 1) & 6) << 4;
#define RDO(s) (rd0 + ((32 * (s)) ^ rda))
    float sc[4][32];
    uint4 stA, stB = make_uint4(0u, 0u, 0u, 0u);
    stA = *(const uint4*)gsrc;
    if (1 < JP) stB = *(const uint4*)(gsrc + (size_t)1 * 64 * 64);
    *(uint4*)(lds + sdst) = stA;
    __syncthreads();
#pragma unroll
    for (int jp = 0; jp < 32; ++jp) {
        if (jp < JP) {
            if (jp + 2 < JP) { if (jp & 1) stB = *(const uint4*)(gsrc + (size_t)(jp + 2) * 64 * 64); else stA = *(const uint4*)(gsrc + (size_t)(jp + 2) * 64 * 64); }
            const char* buf = lds + (jp & 1) * 8192;
            if (jp * 64 <= t0 + 3) {
                float pa[4], pb[4];
                { bf16x8 bfr[4];
#pragma unroll
                  for (int s = 0; s < 4; ++s) bfr[s] = *(const bf16x8*)(buf + RDO(s));
                  tile_partial(af, bfr, wt, pa); }
                { bf16x8 bfr[4];
#pragma unroll
                  for (int s = 0; s < 4; ++s) bfr[s] = *(const bf16x8*)(buf + RDO(s) + 4096);
                  tile_partial(af, bfr, wt, pb); }
#pragma unroll
                for (int T = 0; T < 4; ++T) {
                    float s = pair_combine(pa[T], pb[T]);
                    if (jp * 64 + 63 > t0) { if (jp * 64 + l > t0 + T) s = NEGINF; }
                    sc[T][jp] = s;
                }
            } else {
#pragma unroll
                for (int T = 0; T < 4; ++T) sc[T][jp] = NEGINF;
            }
            if (jp + 1 < JP) *(uint4*)(lds + ((jp + 1) & 1) * 8192 + sdst) = ((jp + 1) & 1) ? stB : stA;
            mk::lds_barrier();
        } else {
#pragma unroll
            for (int T = 0; T < 4; ++T) sc[T][jp] = NEGINF;
        }
    }
#define IX_SELECT(T) do { \
        unsigned wv = 0u; \
        auto put = [&](int k, unsigned long long bm) { const unsigned mine = (l & 1) ? (unsigned)(bm >> 32) : (unsigned)bm; wv = ((l >> 1) == k) ? mine : wv; }; \
        const int nreg = (t0 + (T)) / 64 + 1;                                    \
        if (nreg <= 8) topk_select<32, 8, 1>(sc[T], put); else if (nreg <= 16) topk_select<32, 16, 1>(sc[T], put); else if (nreg <= 24) topk_select<32, 24, 1>(sc[T], put); else topk_select<32, 32, 1>(sc[T], put); \
        MASK[(size_t)(m0 + (T)) * 64 + l] = wv; \
    } while (0)
    IX_SELECT(0); IX_SELECT(1); IX_SELECT(2); IX_SELECT(3);
#undef IX_SELECT
}

constexpr int SCR_BYTES = 8 * 2048 * 4, SCX_OFF = SCR_BYTES;
__device__ __forceinline__ void index_sample_block(int b, int kc, char* lds, const bf16_t* P1, const bf16_t* IKB, const float* IW, const float* cache_ik, const int* page_table, float* CS, int* CI) {
    const int tid = mk::ltid(), w = __builtin_amdgcn_readfirstlane(tid >> 6), l = tid & 63, r = l & 31, hh = l >> 5;
    const int m0 = mk::MP + b * mk::DS;
    float* scr = (float*)lds; float* scx = (float*)(lds + SCX_OFF);
    bf16x8 afA[4], afB[4]; float wtA[16], wtB[16];
    load_af_w(P1, IW, m0, r, hh, afA, wtA);
    load_af_w(P1, IW, m0 + 4, r, hh, afB, wtB);
    const int kbase = 2048 * kc + 256 * w;
    const int pg0 = __builtin_amdgcn_readfirstlane(page_table[b * mk::NPG + (kbase >> 7)]), pg1 = __builtin_amdgcn_readfirstlane(page_table[b * mk::NPG + (kbase >> 7) + 1]);
    const float* kp0 = cache_ik + ((size_t)pg0 * mk::PAGE + r) * 64 + 8 * hh;
    const float* kp1 = cache_ik + ((size_t)pg1 * mk::PAGE + r) * 64 + 8 * hh;
    float4 ring[3][8];
#define SI_LOAD(slot, tl_) do { const float* p_ = (((tl_) >> 2) ? kp1 : kp0) + ((tl_) & 3) * 32 * 64; _Pragma("unroll") for (int s = 0; s < 4; ++s) { ring[slot][2 * s] = *(const float4*)(p_ + 16 * s); ring[slot][2 * s + 1] = *(const float4*)(p_ + 16 * s + 4); } } while (0)
    SI_LOAD(0, 0); SI_LOAD(1, 1); SI_LOAD(2, 2);
    float pA[4] = {0.f, 0.f, 0.f, 0.f}, pB[4] = {0.f, 0.f, 0.f, 0.f};
#pragma unroll
    for (int tl = 0; tl < 8; ++tl) {
        bf16x8 bfr[4];
#pragma unroll
        for (int s = 0; s < 4; ++s) { const float4 x = ring[tl % 3][2 * s], y = ring[tl % 3][2 * s + 1];
            mk::u32x4_t u = {mk::cvtpk_native(x.x, x.y), mk::cvtpk_native(x.z, x.w), mk::cvtpk_native(y.x, y.y), mk::cvtpk_native(y.z, y.w)}; bfr[s] = *reinterpret_cast<bf16x8*>(&u); }
        if (tl + 3 < 8) SI_LOAD(tl % 3, tl + 3);
        float qa[4], qb[4];
        tile_partial(afA, bfr, wtA, qa);
        tile_partial(afB, bfr, wtB, qb);
        if (tl & 1) {
#pragma unroll
            for (int T = 0; T < 4; ++T) { scr[T * 2048 + 256 * w + 32 * (tl - 1) + l] = pair_combine(pA[T], qa[T]); scr[(4 + T) * 2048 + 256 * w + 32 * (tl - 1) + l] = pair_combine(pB[T], qb[T]); }
        } else {
#pragma unroll
            for (int T = 0; T < 4; ++T) { pA[T] = qa[T]; pB[T] = qb[T]; }
        }
    }
#undef SI_LOAD
    if (kc == 7 && w < 2) {
        bf16x8 bfr[4];
#pragma unroll
        for (int s = 0; s < 4; ++s) { bfr[s] = bf16x8{}; if (r < mk::DS) bfr[s] = *(const bf16x8*)(IKB + (size_t)(mk::MP + b * mk::DS + r) * 64 + 16 * s + 8 * hh); }
        float p[4];
        if (w == 0) tile_partial(afA, bfr, wtA, p); else tile_partial(afB, bfr, wtB, p);
#pragma unroll
        for (int T = 0; T < 4; ++T) { const float s = pair_combine(p[T], p[T]); if (l < mk::DS) scx[(4 * w + T) * 8 + l] = (l <= 4 * w + T) ? s : NEGINF; }
    }
    __syncthreads();
    {
        const int tok = w;
        float sc[33];
#pragma unroll
        for (int k = 0; k < 32; ++k) sc[k] = scr[tok * 2048 + 64 * k + l];
        sc[32] = (kc == 7 && l < mk::DS) ? scx[tok * 8 + l] : NEGINF;
        float* cs = CS + ((size_t)(b * mk::DS + tok) * 8 + kc) * TOPK; int* ci = CI + ((size_t)(b * mk::DS + tok) * 8 + kc) * TOPK;
        int run = 0;
        topk_select<33, 33>(sc, [&](int k, unsigned long long bm) {
            const bool mine = (bm >> l) & 1ull;
            const int pos = run + __builtin_popcountll(bm & ((1ull << l) - 1ull));
            if (mine) { cs[pos] = sc[k]; ci[pos] = (k < 32) ? 2048 * kc + 64 * k + l : mk::PAST + l; }
            run += __builtin_popcountll(bm);
        });
    }
    __syncthreads();
}

__device__ __forceinline__ void merge_sample_row(int r, const float* CS, const int* CI, const int* page_table, int* rowi) {
    const int l = mk::ltid() & 63, b = r / mk::DS;
    float sc[32];
    const float* cs = CS + (size_t)r * 8 * TOPK; const int* ci = CI + (size_t)r * 8 * TOPK;
#pragma unroll
    for (int k = 0; k < 32; ++k) sc[k] = cs[64 * k + l];
    int run = 0;
    topk_select<32, 32>(sc, [&](int k, unsigned long long bm) {
        const bool mine = (bm >> l) & 1ull;
        const int pos = run + __builtin_popcountll(bm & ((1ull << l) - 1ull));
        if (mine) { const int idx = ci[64 * k + l];
            rowi[pos] = idx < mk::PAST ? page_table[b * mk::NPG + idx / mk::PAGE] * mk::PAGE + (idx % mk::PAGE) : -(b * mk::DS + (idx - mk::PAST)) - 1; }
        run += __builtin_popcountll(bm);
    });
}
}

namespace dsa {
using mk::bf16_t;
typedef short bf16x8 __attribute__((ext_vector_type(8)));
typedef short s16x4 __attribute__((ext_vector_type(4)));
typedef float f32x16 __attribute__((ext_vector_type(16)));
typedef float f32x4 __attribute__((ext_vector_type(4)));
typedef unsigned u32x4 __attribute__((ext_vector_type(4)));
constexpr float SCALE = 0.08838834764831845f;
constexpr float THR = 8.f;
constexpr int NW = 8, QBLK = 32, KVBLK = 64, HDIM = 128;
constexpr int SHM_V = KVBLK * HDIM * 2, SHM_K = KVBLK * HDIM * 2;
constexpr int LDS_BYTES = 2 * SHM_V + 2 * SHM_K + NW * 64 * 4;

#define KSWZ(row, colB) ((row) * 256 + ((colB) ^ (((row) & 7) << 4)))
#define SBAR() __builtin_amdgcn_sched_barrier(0)
__device__ __forceinline__ int v_st(int k, int c) { const int kk = (k & ~0xC) | ((k & 4) << 1) | ((k & 8) >> 1); return ((kk >> 3) * 4 + (c >> 5)) * 512 + ((kk & 7) * 32 + (c & 31)) * 2; }
__device__ __forceinline__ int v_rd_base(int lane) { return ((lane & 3) << 3) | (((lane >> 2) & 3) << 6) | (((lane >> 4) & 1) << 5) | (((lane >> 5) & 1) << 8); }
constexpr int v_rd_off(int d0, int ks, int half) { return d0 * 512 + ks * 4096 + half * 2048; }
__device__ __forceinline__ int crow(int r, int hi) { return (r & 3) + 8 * (r >> 2) + 4 * hi; }
__device__ __forceinline__ unsigned cvtpk(float lo, float hi) { return mk::cvtpk_native(lo, hi); }

__device__ __forceinline__ void partialSM(f32x16& p0, f32x16& p1, float& m_reg, float& mn, float& alpha) {
    float pmax = p0[0]; for (int r = 1; r < 16; ++r) pmax = fmaxf(pmax, p0[r]); for (int r = 0; r < 16; ++r) pmax = fmaxf(pmax, p1[r]);
    { auto rr = __builtin_amdgcn_permlane32_swap(__float_as_uint(pmax), __float_as_uint(pmax), false, false);
      pmax = fmaxf(__uint_as_float(rr[0]), __uint_as_float(rr[1])); }
    constexpr float C2 = 1.4426950408889634f * SCALE;
    if (__builtin_expect(__all((pmax - m_reg) * SCALE <= THR), 1)) { mn = m_reg; alpha = 1.f; }
    else { mn = fmaxf(m_reg, pmax); alpha = __builtin_amdgcn_exp2f((m_reg - mn) * C2); m_reg = mn; }
    const float mnL = -mn * C2;
    for (int r = 0; r < 16; ++r) p0[r] = fmaf(p0[r], C2, mnL); for (int r = 0; r < 16; ++r) p1[r] = fmaf(p1[r], C2, mnL);
    for (int r = 0; r < 16; ++r) p0[r] = __builtin_amdgcn_exp2f(p0[r]);
}
__device__ __forceinline__ void finishSM(f32x16& p0, f32x16& p1, float alpha, float& l_reg, uint2 mw, int hi, bf16x8& pa0, bf16x8& pa1, bf16x8& pa2, bf16x8& pa3) {
    for (int r = 0; r < 16; ++r) p1[r] = __builtin_amdgcn_exp2f(p1[r]);
    const int w0 = (int)(mw.x >> (4 * hi)), w1 = (int)(mw.y >> (4 * hi));
#pragma unroll
    for (int r = 0; r < 16; ++r) {
        const int c = (r & 3) + 8 * (r >> 2);
        int b0 = __builtin_amdgcn_sbfe(w0, c, 1), b1 = __builtin_amdgcn_sbfe(w1, c, 1);
        asm volatile("" : "+v"(b0), "+v"(b1));
        p0[r] = __uint_as_float(__float_as_uint(p0[r]) & (unsigned)b0);
        p1[r] = __uint_as_float(__float_as_uint(p1[r]) & (unsigned)b1);
    }
    float ps = 0; for (int r = 0; r < 16; ++r) ps += p0[r]; for (int r = 0; r < 16; ++r) ps += p1[r];
    { auto rr = __builtin_amdgcn_permlane32_swap(__float_as_uint(ps), __float_as_uint(ps), false, false);
      ps = __uint_as_float(rr[0]) + __uint_as_float(rr[1]); }
    l_reg = l_reg * alpha + ps;
#define PK4(P, B_, OUT) do { unsigned a0 = cvtpk(P[B_+0], P[B_+1]), a1 = cvtpk(P[B_+2], P[B_+3]);                          \
        unsigned b0 = cvtpk(P[B_+4], P[B_+5]), b1 = cvtpk(P[B_+6], P[B_+7]);                                             \
        auto r0 = __builtin_amdgcn_permlane32_swap(a0, b0, false, false); auto r1 = __builtin_amdgcn_permlane32_swap(a1, b1, false, false); \
        u32x4 w = {r0[0], r1[0], r0[1], r1[1]}; OUT = *reinterpret_cast<bf16x8*>(&w); } while (0)
    PK4(p0, 0, pa0); PK4(p0, 8, pa1); PK4(p1, 0, pa2); PK4(p1, 8, pa3);
#undef PK4
}
template <int KB>
__device__ __forceinline__ void qkt(f32x16& p0, f32x16& p1, const char* K_lds, int r32, int hi, const bf16x8* qr) {
    p0 = f32x16{}; p1 = f32x16{};
    const char* kb[4];
#pragma unroll
    for (int dd = 0; dd < 4; ++dd) kb[dd] = K_lds + KB * SHM_K + KSWZ(r32, (dd * 16 + hi * 8) * 2);
#pragma unroll
    for (int d0 = 0; d0 < 8; ++d0) { const char* a = kb[d0 & 3] + (d0 >> 2) * 128;
        bf16x8 b0 = *reinterpret_cast<const bf16x8*>(a);
        bf16x8 b1 = *reinterpret_cast<const bf16x8*>(a + 32 * 256);
        p0 = __builtin_amdgcn_mfma_f32_32x32x16_bf16(b0, qr[d0], p0, 0, 0, 0);
        p1 = __builtin_amdgcn_mfma_f32_32x32x16_bf16(b1, qr[d0], p1, 0, 0, 0); }
}
template <int VB>
__device__ __forceinline__ void pv_tile(f32x16* o, int vb0, bf16x8 pa0, bf16x8 pa1, bf16x8 pa2, bf16x8 pa3) {
#define TRRD(dst, off) asm volatile("ds_read_b64_tr_b16 %0, %1 offset:%2" : "=&v"(dst) : "v"(vb0), "i"(off) : "memory")
#define PV_D0(d0) do { s16x4 l0, l1, l2, l3, h0, h1, h2, h3; constexpr int b_ = VB * SHM_V + v_rd_off(d0, 0, 0);   \
        TRRD(l0, b_); TRRD(h0, b_ + 2048); TRRD(l1, b_ + 4096); TRRD(h1, b_ + 6144); TRRD(l2, b_ + 8192); TRRD(h2, b_ + 10240); TRRD(l3, b_ + 12288); TRRD(h3, b_ + 14336); \
        asm volatile("s_waitcnt lgkmcnt(0)" ::: "memory"); SBAR();   \
        o[d0] = __builtin_amdgcn_mfma_f32_32x32x16_bf16(pa0, (bf16x8){l0[0], l0[1], l0[2], l0[3], h0[0], h0[1], h0[2], h0[3]}, o[d0], 0, 0, 0);   \
        o[d0] = __builtin_amdgcn_mfma_f32_32x32x16_bf16(pa1, (bf16x8){l1[0], l1[1], l1[2], l1[3], h1[0], h1[1], h1[2], h1[3]}, o[d0], 0, 0, 0);   \
        o[d0] = __builtin_amdgcn_mfma_f32_32x32x16_bf16(pa2, (bf16x8){l2[0], l2[1], l2[2], l2[3], h2[0], h2[1], h2[2], h2[3]}, o[d0], 0, 0, 0);   \
        o[d0] = __builtin_amdgcn_mfma_f32_32x32x16_bf16(pa3, (bf16x8){l3[0], l3[1], l3[2], l3[3], h3[0], h3[1], h3[2], h3[3]}, o[d0], 0, 0, 0); } while (0)
    PV_D0(0); PV_D0(1); PV_D0(2); PV_D0(3);
#undef PV_D0
#undef TRRD
}

struct Tensors { const float* QSS; const bf16_t* KB; const bf16_t* P1; const unsigned* MASK; bf16_t* AO; };
struct Blk { int b, g, qc; };
struct Seam { bf16x8 qr[8]; bf16x8 st_v0, st_v1, st_k0, st_k1; float qss; };
__device__ __forceinline__ const bf16_t* q_row(const Tensors& T, const Blk& k, int wid, int r32) { return T.P1 + (size_t)(k.b * mk::SEQ + k.qc * 64 + (wid & 1) * 32 + r32) * mk::N1P + mk::CQ + (4 * k.g + (wid >> 1)) * 128; }
__device__ __forceinline__ const float* qss_ptr(const Tensors& T, const Blk& k, int wid, int r32) { return T.QSS + (size_t)(k.b * mk::SEQ + k.qc * 64 + (wid & 1) * 32 + r32) * 8 + (4 * k.g + (wid >> 1)); }
__device__ __forceinline__ const bf16_t* k_row(const Tensors& T, const Blk& k, int key) { return T.KB + (size_t)(k.b * mk::SEQ + key) * 256 + k.g * 128; }
__device__ __forceinline__ const bf16_t* v_row(const Tensors& T, const Blk& k, int key) { return T.P1 + (size_t)(k.b * mk::SEQ + key) * mk::N1P + mk::CV + k.g * 128; }

#define VMW() asm volatile("s_waitcnt vmcnt(0)" ::: "memory")
#define VMWN(n) asm volatile("s_waitcnt vmcnt(%0)" :: "i"(n) : "memory")
#define SLOAD_H(blk, k0) do { S.st_v0 = *(const bf16x8*)(v_row(T, blk, (k0) + sr) + sc); S.st_v1 = *(const bf16x8*)(v_row(T, blk, (k0) + 32 + sr) + sc);   \
                              S.st_k0 = *(const bf16x8*)(k_row(T, blk, (k0) + sr) + sc); S.st_k1 = *(const bf16x8*)(k_row(T, blk, (k0) + 32 + sr) + sc); } while (0)
#define SWRITE_HK(bf) do { *(bf16x8*)(K_lds + (bf) * SHM_K + kws) = S.st_k0; *(bf16x8*)(K_lds + (bf) * SHM_K + kws + 32 * 256) = S.st_k1; } while (0)
#define SWRITE_HV(bf) do { *(bf16x8*)(V_lds + (bf) * SHM_V + vst0) = S.st_v0; *(bf16x8*)(V_lds + (bf) * SHM_V + vst0 + VST1) = S.st_v1; } while (0)
#define SWRITE_H(bf) do { SWRITE_HV(bf); SWRITE_HK(bf); } while (0)

__device__ __forceinline__ void dsa_prime(const Tensors& T, const Blk& cur, char* lds, Seam& S) {
    const int tid = mk::ltid(), wid = __builtin_amdgcn_readfirstlane(tid >> 6), lane = tid & 63, r32 = lane & 31, hi = lane >> 5;
    const int sr = tid >> 4, sc = (tid & 15) * 8, kws = KSWZ(sr, sc * 2); char* K_lds = lds + 2 * SHM_V;
    const bf16_t* qp = q_row(T, cur, wid, r32) + hi * 8;
    for (int d0 = 0; d0 < 8; ++d0) S.qr[d0] = *(const bf16x8*)(qp + d0 * 16);
    S.qss = *qss_ptr(T, cur, wid, r32);
    SLOAD_H(cur, 0); VMW(); SWRITE_HK(0);
    __syncthreads();
}
__device__ __forceinline__ void dsa_block(const Tensors& T, const Blk& cur, const Blk& nxt, char* lds, Seam& S) {
    const int tid = mk::ltid(), wid = __builtin_amdgcn_readfirstlane(tid >> 6), lane = tid & 63, r32 = lane & 31, hi = lane >> 5;
    const int NT = cur.qc + 1;
    char* V_lds = lds; char* K_lds = lds + 2 * SHM_V;
    float* ws = (float*)(lds + 2 * SHM_V + 2 * SHM_K) + wid * 64; float* li_l = ws, * al_l = ws + 32;
    float m_reg = -1e30f, l_reg = 0; f32x16 o[4] = {};
    const int sr = tid >> 4, sc = (tid & 15) * 8, vst0 = v_st(sr, sc), kws = KSWZ(sr, sc * 2);
    constexpr int VST1 = 8192;
    const int vb0 = (int)(uintptr_t)V_lds + v_rd_base(lane);
    const int qtok = cur.b * mk::SEQ + cur.qc * 64 + (wid & 1) * 32;
    const int moff = (qtok + r32) * 64;
#define LDMASK(t) (*(const uint2*)(T.MASK + (moff + 2 * (t))))
#define RESC(a) do { if (__any((a) < 1.f)) { if (hi == 0) al_l[r32] = (a); asm volatile("s_waitcnt lgkmcnt(0)" ::: "memory");              \
                     for (int d_ = 0; d_ < 4; ++d_) for (int r = 0; r < 16; ++r) o[d_][r] *= al_l[crow(r, hi)]; } } while (0)
#define KBASE(t) ((t) * KVBLK)
    constexpr int NQL = 9;
#define SEAM_K0() do { VMWN(NQL); SWRITE_HK(0); SBAR(); } while (0)
    f32x16 pA0, pA1, pB0, pB1; float mnA, mnB, alA, alB; bf16x8 pa0, pa1, pa2, pa3; uint2 mcur;
    {
        const float rs = rsqrtf(S.qss * (1.0f / 128) + mk::EPS);
#pragma unroll
        for (int d0 = 0; d0 < 8; ++d0) { u32x4 u = *reinterpret_cast<u32x4*>(&S.qr[d0]);
#pragma unroll
            for (int e = 0; e < 4; ++e) u[e] = cvtpk(__uint_as_float(u[e] << 16) * rs, __uint_as_float(u[e] & 0xFFFF0000u) * rs);
            S.qr[d0] = *reinterpret_cast<bf16x8*>(&u); }
    }
    SWRITE_HV(0); SBAR();
    if (NT > 1) { SLOAD_H(cur, KBASE(1)); }
    SBAR(); qkt<0>(pA0, pA1, K_lds, r32, hi, S.qr); mcur = LDMASK(0);
    partialSM(pA0, pA1, m_reg, mnA, alA);
    if (NT > 1) { VMW(); SWRITE_H(1); }
    __syncthreads();
#define HALF_STEP(PX0, PX1, mnX, alX, PY0, PY1, alY, t, KB, VB, SB) do {                                             \
        SBAR(); qkt<KB>(PX0, PX1, K_lds, r32, hi, S.qr);                                                                       \
        finishSM(PY0, PY1, alY, l_reg, mcur, hi, pa0, pa1, pa2, pa3); mcur = LDMASK(t); SBAR();                                                   \
        if ((t) + 1 < NT) { SLOAD_H(cur, KBASE((t) + 1)); SBAR(); }                                                           \
        pv_tile<VB>(o, vb0, pa0, pa1, pa2, pa3); partialSM(PX0, PX1, m_reg, mnX, alX);                                        \
        __syncthreads();                                                                                                      \
        if ((t) + 1 < NT) { VMW(); SWRITE_H(SB); }                                                                            \
        RESC(alX); __syncthreads(); } while (0)
    for (int t = 1; t + 1 < NT; t += 2) {
        HALF_STEP(pB0, pB1, mnB, alB, pA0, pA1, alA, t, 1, 0, 0);
        HALF_STEP(pA0, pA1, mnA, alA, pB0, pB1, alB, t + 1, 0, 1, 1);
    }
    const bool even = (NT & 1) == 0;
    if (even) { SBAR(); qkt<1>(pB0, pB1, K_lds, r32, hi, S.qr); SBAR(); }
    SLOAD_H(nxt, 0); SBAR();
    { const bf16_t* qp = q_row(T, nxt, wid, r32) + hi * 8;
#pragma unroll
      for (int d0 = 0; d0 < 8; ++d0) S.qr[d0] = *(const bf16x8*)(qp + d0 * 16);
      S.qss = *qss_ptr(T, nxt, wid, r32); }
    SBAR();
    finishSM(pA0, pA1, alA, l_reg, mcur, hi, pa0, pa1, pa2, pa3); if (even) mcur = LDMASK(NT - 1); SBAR();
    pv_tile<0>(o, vb0, pa0, pa1, pa2, pa3);
    if (even) { partialSM(pB0, pB1, m_reg, mnB, alB); __syncthreads(); RESC(alB);
        finishSM(pB0, pB1, alB, l_reg, mcur, hi, pa0, pa1, pa2, pa3); SBAR(); pv_tile<1>(o, vb0, pa0, pa1, pa2, pa3); }
    SBAR(); SEAM_K0();
    if (hi == 0) li_l[r32] = l_reg; asm volatile("s_waitcnt lgkmcnt(0)" ::: "memory");
    { const int le = mk::ltid() & 63, re = le & 31, he = le >> 5;
      const int hq = 4 * cur.g + (wid >> 1);
#pragma unroll
      for (int r = 0; r < 16; ++r) { const int orow = crow(r, he); const size_t tok = (size_t)(qtok + orow);
        const float rl = __builtin_amdgcn_rcpf(li_l[orow]);
        const bf16_t* gp = T.P1 + tok * mk::N1P + mk::CG + hq * 128 + re;
        bf16_t* op = T.AO + tok * mk::D + hq * 128 + re;
#pragma unroll
        for (int d0 = 0; d0 < 4; ++d0) { const float gt = mk::bf2f(gp[d0 * 32]);
            const float v = o[d0][r] * rl * (gt * __builtin_amdgcn_rcpf(1.0f + __builtin_amdgcn_exp2f(-1.4426950408889634f * gt)));
            const float vn = __int_as_float(__builtin_amdgcn_update_dpp(0, __float_as_int(v), 0xB1, 0xF, 0xF, false));
            if ((re & 1) == 0) *(unsigned*)(op + d0 * 32) = cvtpk(v, vn); } } }
    __syncthreads();
#undef LDMASK
#undef RESC
#undef KBASE
#undef SEAM_K0
#undef HALF_STEP
}
#undef VMW
#undef VMWN
#undef SLOAD_H
#undef SWRITE_HK
#undef SWRITE_HV
#undef SWRITE_H

__device__ __forceinline__ void attn_prompt_phase(const Tensors& T, char* lds, int bid, int nblk) {
    constexpr int NITEM = 256;
    if (bid >= NITEM) return;
    int id = bid, pass = 0;
    Blk cur{id & 7, (id >> 3) & 1, 31 - (id >> 4)};
    Seam S;
    dsa_prime(T, cur, lds, S);
    for (;;) {
        const bool more_pass = pass == 0, more_item = id + nblk < NITEM, last = !more_pass && !more_item;
        int idn = id, passn = pass + 1;
        if (!more_pass) { passn = 0; idn = more_item ? id + nblk : id; }
        Blk nxt = cur;
        if (!last) { nxt.b = idn & 7; nxt.g = (idn >> 3) & 1; nxt.qc = passn ? (idn >> 4) : 31 - (idn >> 4); }
        dsa_block(T, cur, nxt, lds, S);
        if (last) break;
        cur = nxt; id = idn; pass = passn;
    }
}
}

namespace dn {
using mk::bf16_t;
typedef short bf16x8 __attribute__((ext_vector_type(8)));
typedef float f32x16 __attribute__((ext_vector_type(16)));
constexpr int NITEM = mk::NB * 8 * 32;
constexpr size_t IT_W = 0, IT_QD = 16384, IT_KDT = 32768, IT_U0T = 49152, IT_QKD = 65536, IT_BYTES = 73728;
constexpr int L_KR = 0, L_QR = 17408, L_KT = 34816, L_VT = 53248, L_AM = 71680, L_TW = 89088, L_TU = 98304, L_SC = 107520, L_END = 108032;
constexpr int RS = 272;
constexpr int TS = 144;
constexpr int L_SK = 108032, L_SU = L_SK + 128 * 144, L_SEND = L_SU + 128 * 136, L_SW = L_AM;
static_assert(L_SEND <= 147456 - 16, "pre-phase LDS map");

__device__ __forceinline__ int crow(int r, int hi) { return (r & 3) + 8 * (r >> 2) + 4 * hi; }
__device__ __forceinline__ unsigned cvtpk(float lo, float hi) { return mk::cvtpk_native(lo, hi); }
__device__ __forceinline__ float silu_f(float x) { return x * __builtin_amdgcn_rcpf(1.0f + __builtin_amdgcn_exp2f(-1.4426950408889634f * x)); }
__device__ __forceinline__ float quad_sum(float v) {
    v += __int_as_float(__builtin_amdgcn_update_dpp(0, __float_as_int(v), 0xB1, 0xF, 0xF, false));
    v += __int_as_float(__builtin_amdgcn_update_dpp(0, __float_as_int(v), 0x4E, 0xF, 0xF, false));
    return v;
}

struct PreArgs { const bf16_t* P2; const float* BA; const float* conv_w; const float* A_log; const float* dt_bias; unsigned char* CH; float* EG; float* out; };

struct PreRaw { unsigned x[3][11]; float wc[3][4][2]; float bv, av; };
__device__ __forceinline__ void pre_load(const PreArgs& a, int item, PreRaw& R) {
    const int tid = mk::ltid(), w = __builtin_amdgcn_readfirstlane(tid >> 6), l = tid & 63;
    const int c = item & 31, h = (item >> 5) & 7, b = item >> 8;
    const int m0 = b * mk::SEQ + c * 64;
    R.bv = a.BA[(size_t)(m0 + l) * 16 + h]; R.av = a.BA[(size_t)(m0 + l) * 16 + 8 + h];
#pragma unroll
    for (int part = 0; part < 3; ++part) {
        const int colb = part * 1024 + h * 128 + 2 * l;
#pragma unroll
        for (int i = 0; i < 4; ++i) { const float2 t = *(const float2*)(a.conv_w + (size_t)i * mk::CONV + colb); R.wc[part][i][0] = t.x; R.wc[part][i][1] = t.y; }
#pragma unroll
        for (int k = 0; k < 11; ++k) {
            const int rl = 8 * w + k - 3;
            unsigned u = 0u;
            if (rl >= 0 || c > 0) u = __builtin_nontemporal_load((const unsigned*)(a.P2 + (size_t)(m0 + rl) * mk::N3P + colb));
            R.x[part][k] = u;
        }
    }
}
__device__ __forceinline__ void pre_item(const PreArgs& a, int item, int next, char* lds, PreRaw& R) {
    const int tid = mk::ltid(), w = __builtin_amdgcn_readfirstlane(tid >> 6), l = tid & 63, r32 = l & 31, hh = l >> 5;
    const int c = item & 31, h = (item >> 5) & 7, b = item >> 8;
    const int m0 = b * mk::SEQ + c * 64;
    unsigned char* ch = a.CH + (size_t)item * IT_BYTES;
    float* sc_beta = (float*)(lds + L_SC); float* sc_gc = sc_beta + 64;
    float beta_l, gc_l;
    {
        const float bv = R.bv, av = R.av;
        beta_l = __builtin_amdgcn_rcpf(1.0f + __expf(-bv));
        const float x = av + a.dt_bias[h];
        const float sp = x > 20.f ? x : log1pf(__expf(x));
        float g = -__expf(a.A_log[h]) * sp;
#pragma unroll
        for (int o = 1; o < 64; o <<= 1) { const float t = __shfl_up(g, o); if (l >= o) g += t; }
        gc_l = g;
    }
    const float gc_last = __shfl(gc_l, 63);
    if (w == 0) { sc_beta[l] = beta_l; sc_gc[l] = gc_l; if (l == 0) a.EG[item] = __expf(gc_last); }
    {
        float sq[8][2], sk[8][2], sv[8][2];
#pragma unroll
        for (int part = 0; part < 3; ++part) {
            const int colb = part * 1024 + h * 128 + 2 * l;
            float wc[4][2];
#pragma unroll
            for (int i = 0; i < 4; ++i) { wc[i][0] = R.wc[part][i][0]; wc[i][1] = R.wc[part][i][1]; }
            float x[11][2];
#pragma unroll
            for (int k = 0; k < 11; ++k) { const unsigned u = R.x[part][k]; x[k][0] = __uint_as_float(u << 16); x[k][1] = __uint_as_float(u & 0xFFFF0000u); }
            if (c == 31 && w == 7) {
#pragma unroll
                for (int j = 0; j < 3; ++j) *(float2*)(a.out + mk::O_CP + ((size_t)b * 3 + j) * mk::CONV + colb) = make_float2(x[8 + j][0], x[8 + j][1]);
            }
#pragma unroll
            for (int rr = 0; rr < 8; ++rr) {
#pragma unroll
                for (int e = 0; e < 2; ++e) {
                    float y = wc[0][e] * x[rr][e]; y = fmaf(wc[1][e], x[rr + 1][e], y); y = fmaf(wc[2][e], x[rr + 2][e], y); y = fmaf(wc[3][e], x[rr + 3][e], y);
                    const float s = silu_f(y);
                    if (part == 0) sq[rr][e] = s; else if (part == 1) sk[rr][e] = s; else sv[rr][e] = s;
                }
            }
        }
        if (next >= 0) pre_load(a, next, R);
        float nq[8], nk[8];
#pragma unroll
        for (int rr = 0; rr < 8; ++rr) { nq[rr] = sq[rr][0] * sq[rr][0] + sq[rr][1] * sq[rr][1]; nk[rr] = sk[rr][0] * sk[rr][0] + sk[rr][1] * sk[rr][1]; }
        mk::wave_sum_n<8>(nq); mk::wave_sum_n<8>(nk);
        unsigned ktp[2][4], vtp[2][4], kdp[2][4];
#pragma unroll
        for (int rr = 0; rr < 8; ++rr) {
            const int i = 8 * w + rr;
            const float rq = rsqrtf(nq[rr] + mk::EPS) * 0.08838834764831845f;
            const float rk = rsqrtf(nk[rr] + mk::EPS);
            const float gci = __shfl(gc_l, i);
            const float eg = __expf(gci), egl = __expf(gc_last - gci);
            const float q0 = sq[rr][0] * rq, q1 = sq[rr][1] * rq, k0 = sk[rr][0] * rk, k1 = sk[rr][1] * rk;
            *(unsigned*)(lds + L_QR + i * RS + 4 * l) = cvtpk(q0, q1);
            *(unsigned*)(lds + L_KR + i * RS + 4 * l) = cvtpk(k0, k1);
            *(unsigned*)(ch + IT_QD + (size_t)i * 256 + 4 * l) = cvtpk(q0 * eg, q1 * eg);
            if ((rr & 1) == 0) { sq[rr][0] = k0; sq[rr][1] = k1; }
            else {
                ktp[0][rr >> 1] = cvtpk(sq[rr - 1][0], k0); ktp[1][rr >> 1] = cvtpk(sq[rr - 1][1], k1);
                vtp[0][rr >> 1] = cvtpk(sv[rr - 1][0], sv[rr][0]); vtp[1][rr >> 1] = cvtpk(sv[rr - 1][1], sv[rr][1]);
                const float gcp = __shfl(gc_l, i - 1); const float eglp = __expf(gc_last - gcp);
                kdp[0][rr >> 1] = cvtpk(sq[rr - 1][0] * eglp, k0 * egl); kdp[1][rr >> 1] = cvtpk(sq[rr - 1][1] * eglp, k1 * egl);
            }
        }
#pragma unroll
        for (int e = 0; e < 2; ++e) {
            *(uint4*)(lds + L_KT + (2 * l + e) * TS + 16 * w) = make_uint4(ktp[e][0], ktp[e][1], ktp[e][2], ktp[e][3]);
            *(uint4*)(lds + L_VT + (2 * l + e) * TS + 16 * w) = make_uint4(vtp[e][0], vtp[e][1], vtp[e][2], vtp[e][3]);
            *(uint4*)(lds + L_SK + (2 * l + e) * 144 + 16 * w) = make_uint4(kdp[e][0], kdp[e][1], kdp[e][2], kdp[e][3]);
        }
    }
    mk::lds_barrier();
#pragma unroll
    for (int j = 0; j < 2; ++j) { const int pc = tid + 512 * j;
        *(uint4*)(ch + IT_KDT + (size_t)16 * pc) = *(const uint4*)(lds + L_SK + (pc >> 3) * 144 + 16 * (pc & 7)); }
    if (w < 6) {
        const int kind = w >= 3, tix = kind ? w - 3 : w, ti = tix > 0, tj = tix > 1;
        const char* ap = lds + (kind ? L_QR : L_KR) + (32 * ti + r32) * RS + 16 * hh;
        const char* bp = lds + L_KR + (32 * tj + r32) * RS + 16 * hh;
        f32x16 acc = {};
#pragma unroll
        for (int s = 0; s < 8; ++s) acc = __builtin_amdgcn_mfma_f32_32x32x16_bf16(*(const bf16x8*)(ap + 32 * s), *(const bf16x8*)(bp + 32 * s), acc, 0, 0, 0);
        const int j = 32 * tj + r32; const float gcj = sc_gc[j];
#pragma unroll
        for (int r = 0; r < 16; ++r) {
            const int i = 32 * ti + crow(r, hh);
            const float dec = __expf(sc_gc[i] - gcj);
            if (!kind) { const float v = (i > j) ? sc_beta[i] * acc[r] * dec : 0.f; *(float*)(lds + L_AM + i * RS + 4 * j) = v; }
            else { const float v = (i >= j) ? acc[r] * dec : 0.f; const float vn = __shfl_xor(v, 1);
                   if ((r32 & 1) == 0) *(unsigned*)(ch + IT_QKD + (size_t)i * 128 + 2 * j) = cvtpk(v, vn); }
        }
    } else if (w == 6) {
#pragma unroll
        for (int k = 0; k < 16; ++k) { const int e = l + 64 * k; *(float*)(lds + L_AM + (e >> 5) * RS + 4 * (32 + (e & 31))) = 0.f; }
    }
    mk::lds_barrier();
    constexpr int L_T1T = L_KR, L_TBR = L_KR + 2560, L_P3T = L_KR + 5120;
    if (w < 2) {
        const int blk = w, ccl = l >> 1, q = l & 1, cc = 32 * blk + ccl;
        float x[16];
#pragma unroll
        for (int k = 0; k < 16; ++k) x[k] = 0.f;
        const char* arow = lds + L_AM + (32 * blk) * RS + 4 * (32 * blk) + 16 * q;
#pragma unroll
        for (int ib = 0; ib < 8; ++ib) {
            const int i0 = 4 * ib, aS = ib >> 1, qS = ib & 1;
            float p[4] = {0.f, 0.f, 0.f, 0.f};
#pragma unroll
            for (int rr = 0; rr < 4; ++rr)
#pragma unroll
                for (int a4 = 0; a4 <= aS; ++a4) { const float4 av = *(const float4*)(arow + (i0 + rr) * RS + 32 * a4);
                    p[rr] = fmaf(av.x, x[4 * a4], p[rr]); p[rr] = fmaf(av.y, x[4 * a4 + 1], p[rr]); p[rr] = fmaf(av.z, x[4 * a4 + 2], p[rr]); p[rr] = fmaf(av.w, x[4 * a4 + 3], p[rr]); }
#pragma unroll
            for (int rr = 0; rr < 4; ++rr) p[rr] += __int_as_float(__builtin_amdgcn_update_dpp(0, __float_as_int(p[rr]), 0xB1, 0xF, 0xF, false));
            const char* rb = lds + L_AM + (32 * blk + i0) * RS + 4 * (32 * blk + i0);
            const float4 r1 = *(const float4*)(rb + RS), r2 = *(const float4*)(rb + 2 * RS), r3 = *(const float4*)(rb + 3 * RS);
            const float x0 = ((i0 == ccl) ? 1.f : 0.f) - p[0];
            const float x1 = ((i0 + 1 == ccl) ? 1.f : 0.f) - p[1] - r1.x * x0;
            const float x2 = ((i0 + 2 == ccl) ? 1.f : 0.f) - p[2] - r2.x * x0 - r2.y * x1;
            const float x3 = ((i0 + 3 == ccl) ? 1.f : 0.f) - p[3] - r3.x * x0 - r3.y * x1 - r3.z * x2;
            if (q == qS) { x[4 * aS] = x0; x[4 * aS + 1] = x1; x[4 * aS + 2] = x2; x[4 * aS + 3] = x3; }
        }
        const float bc = sc_beta[cc], bw = bc * __expf(sc_gc[cc]);
#pragma unroll
        for (int k = 0; k < 16; ++k) { const int j = 8 * (k >> 2) + 4 * q + (k & 3);
            *(bf16_t*)(lds + L_TW + (32 * blk + j) * TS + 2 * cc) = mk::f2bf(x[k] * bw);
            *(bf16_t*)(lds + L_TU + (32 * blk + j) * TS + 2 * cc) = mk::f2bf(x[k] * bc);
            if (blk == 1) *(bf16_t*)(lds + L_TBR + j * 80 + 2 * ccl) = mk::f2bf(x[k]); }
        if (blk == 0) {
#pragma unroll
            for (int a4 = 0; a4 < 4; ++a4) *(uint2*)(lds + L_T1T + ccl * 80 + 2 * (8 * a4 + 4 * q)) = make_uint2(cvtpk(x[4 * a4], x[4 * a4 + 1]), cvtpk(x[4 * a4 + 2], x[4 * a4 + 3]));
        }
    }
    mk::lds_barrier();
    if (w == 0) {
        f32x16 a3 = {};
#pragma unroll
        for (int s = 0; s < 2; ++s) {
            const float4 f0 = *(const float4*)(lds + L_AM + (32 + r32) * RS + 4 * (16 * s + 8 * hh)), f1 = *(const float4*)(lds + L_AM + (32 + r32) * RS + 4 * (16 * s + 8 * hh) + 16);
            mk::u32x4_t au_ = {cvtpk(f0.x, f0.y), cvtpk(f0.z, f0.w), cvtpk(f1.x, f1.y), cvtpk(f1.z, f1.w)};
            a3 = __builtin_amdgcn_mfma_f32_32x32x16_bf16(*reinterpret_cast<bf16x8*>(&au_), *(const bf16x8*)(lds + L_T1T + r32 * 80 + 2 * (16 * s + 8 * hh)), a3, 0, 0, 0);
        }
#pragma unroll
        for (int g = 0; g < 4; ++g) *(uint2*)(lds + L_P3T + r32 * 80 + 2 * (8 * g + 4 * hh)) = make_uint2(cvtpk(a3[4 * g], a3[4 * g + 1]), cvtpk(a3[4 * g + 2], a3[4 * g + 3]));
        asm volatile("s_waitcnt lgkmcnt(0)" ::: "memory");
        f32x16 a4 = {};
#pragma unroll
        for (int s = 0; s < 2; ++s)
            a4 = __builtin_amdgcn_mfma_f32_32x32x16_bf16(*(const bf16x8*)(lds + L_TBR + r32 * 80 + 2 * (16 * s + 8 * hh)), *(const bf16x8*)(lds + L_P3T + r32 * 80 + 2 * (16 * s + 8 * hh)), a4, 0, 0, 0);
        const float bc = sc_beta[r32], bw = bc * __expf(sc_gc[r32]);
#pragma unroll
        for (int r = 0; r < 16; ++r) { const int i = 32 + crow(r, hh);
            *(bf16_t*)(lds + L_TW + i * TS + 2 * r32) = mk::f2bf(-a4[r] * bw);
            *(bf16_t*)(lds + L_TU + i * TS + 2 * r32) = mk::f2bf(-a4[r] * bc); }
    }
    mk::lds_barrier();
    {
        const int it = w >> 2, dt = w & 3, ns = it ? 4 : 2;
        f32x16 aw = {}, au = {};
        const char* kt = lds + L_KT + (32 * dt + r32) * TS + 16 * hh;
        const char* vt = lds + L_VT + (32 * dt + r32) * TS + 16 * hh;
        const char* tw = lds + L_TW + (32 * it + r32) * TS + 16 * hh;
        const char* tu = lds + L_TU + (32 * it + r32) * TS + 16 * hh;
#pragma unroll
        for (int s = 0; s < 4; ++s) if (s < ns) {
            aw = __builtin_amdgcn_mfma_f32_32x32x16_bf16(*(const bf16x8*)(kt + 32 * s), *(const bf16x8*)(tw + 32 * s), aw, 0, 0, 0);
            au = __builtin_amdgcn_mfma_f32_32x32x16_bf16(*(const bf16x8*)(tu + 32 * s), *(const bf16x8*)(vt + 32 * s), au, 0, 0, 0);
        }
#pragma unroll
        for (int g = 0; g < 4; ++g) {
            *(uint2*)(lds + L_SW + (32 * it + r32) * RS + 2 * (32 * dt + 8 * g + 4 * hh)) = make_uint2(cvtpk(aw[4 * g], aw[4 * g + 1]), cvtpk(aw[4 * g + 2], aw[4 * g + 3]));
            *(uint2*)(lds + L_SU + (32 * dt + r32) * 136 + 2 * (32 * it + 8 * g + 4 * hh)) = make_uint2(cvtpk(au[4 * g], au[4 * g + 1]), cvtpk(au[4 * g + 2], au[4 * g + 3]));
        }
    }
    mk::lds_barrier();
#pragma unroll
    for (int j = 0; j < 2; ++j) { const int pc = tid + 512 * j;
        *(uint4*)(ch + IT_W + (size_t)16 * pc) = *(const uint4*)(lds + L_SW + (pc >> 4) * RS + 16 * (pc & 15)); }
#pragma unroll
    for (int j = 0; j < 4; ++j) { const int pc = tid + 512 * j;
        *(uint2*)(ch + IT_U0T + (size_t)8 * pc) = *(const uint2*)(lds + L_SU + (pc >> 4) * 136 + 8 * (pc & 15)); }
}

constexpr int SL_ST = 0, SL_UT = 8704, SL_END = 8704 + 4608;
struct ScanArgs { const unsigned char* CH; const float* EG; bf16_t* ORAW; float* out; };

__device__ __forceinline__ void scan_item(const ScanArgs& a, int bh, int sl, char* lds) {
    const int tid = mk::ltid(), w = __builtin_amdgcn_readfirstlane(tid >> 6), l = tid & 63, r32 = l & 31, hh = l >> 5;
    const int b = bh >> 3, h = bh & 7;
    const unsigned char* chb = a.CH + (size_t)bh * 32 * IT_BYTES;
    for (int k = tid; k < SL_END / 4; k += 512) ((unsigned*)lds)[k] = 0u;
    __syncthreads();
    const char* stp = lds + SL_ST + r32 * RS + 16 * hh;
    const char* utp = lds + SL_UT + r32 * TS + 16 * hh;
    if (w < 2) {
        const int tt = w;
        bf16x8 wf[4][8]; uint2 u0[4][4];
#define LD_W(dst, dstu, cix) do { const unsigned char* cb = chb + (size_t)(cix) * IT_BYTES; \
        _Pragma("unroll") for (int s = 0; s < 8; ++s) dst[s] = *(const bf16x8*)(cb + IT_W + (size_t)(32 * tt + r32) * 256 + 32 * s + 16 * hh); \
        _Pragma("unroll") for (int g = 0; g < 4; ++g) dstu[g] = *(const uint2*)(cb + IT_U0T + (size_t)(32 * sl + r32) * 128 + 2 * (32 * tt + 8 * g + 4 * hh)); } while (0)
        LD_W(wf[0], u0[0], 0); LD_W(wf[1], u0[1], 1); LD_W(wf[2], u0[2], 2);
        for (int c0 = 0; c0 < 32; c0 += 4) {
#pragma unroll
            for (int k = 0; k < 4; ++k) {
                const int c = c0 + k;
                if (c + 3 < 32) LD_W(wf[(k + 3) & 3], u0[(k + 3) & 3], c + 3);
                f32x16 acc = {};
#pragma unroll
                for (int s = 0; s < 8; ++s) acc = __builtin_amdgcn_mfma_f32_32x32x16_bf16(wf[k][s], *(const bf16x8*)(stp + 32 * s), acc, 0, 0, 0);
#pragma unroll
                for (int g = 0; g < 4; ++g) {
                    const float a0 = __uint_as_float(u0[k][g].x << 16) - acc[4 * g], a1 = __uint_as_float(u0[k][g].x & 0xFFFF0000u) - acc[4 * g + 1];
                    const float a2 = __uint_as_float(u0[k][g].y << 16) - acc[4 * g + 2], a3 = __uint_as_float(u0[k][g].y & 0xFFFF0000u) - acc[4 * g + 3];
                    *(uint2*)(lds + SL_UT + r32 * TS + 2 * (32 * tt + 8 * g + 4 * hh)) = make_uint2(cvtpk(a0, a1), cvtpk(a2, a3));
                }
                mk::lds_barrier();
                mk::lds_barrier();
            }
        }
#undef LD_W
    } else if (w < 4) {
        const int tt = w - 2;
        bf16x8 qf[4][8], pf[4][4];
#pragma unroll
        for (int k = 0; k < 4; ++k)
#pragma unroll
            for (int s = 0; s < 4; ++s) pf[k][s] = bf16x8{};
#define LD_Q(dq, dp, cix) do { const unsigned char* cb = chb + (size_t)(cix) * IT_BYTES; \
        _Pragma("unroll") for (int s = 0; s < 8; ++s) dq[s] = *(const bf16x8*)(cb + IT_QD + (size_t)(32 * tt + r32) * 256 + 32 * s + 16 * hh); \
        _Pragma("unroll") for (int s = 0; s < 4; ++s) if (s < 2 * (tt + 1)) dp[s] = *(const bf16x8*)(cb + IT_QKD + (size_t)(32 * tt + r32) * 128 + 32 * s + 16 * hh); } while (0)
        LD_Q(qf[0], pf[0], 0); LD_Q(qf[1], pf[1], 1); LD_Q(qf[2], pf[2], 2);
        const size_t orow0 = (size_t)(b * mk::SEQ + 32 * tt) * mk::D + h * 128 + 32 * sl + r32;
        for (int c0 = 0; c0 < 32; c0 += 4) {
#pragma unroll
            for (int k = 0; k < 4; ++k) {
                const int c = c0 + k;
                if (c + 3 < 32) LD_Q(qf[(k + 3) & 3], pf[(k + 3) & 3], c + 3);
                f32x16 acc = {};
#pragma unroll
                for (int s = 0; s < 8; ++s) acc = __builtin_amdgcn_mfma_f32_32x32x16_bf16(qf[k][s], *(const bf16x8*)(stp + 32 * s), acc, 0, 0, 0);
                mk::lds_barrier();
#pragma unroll
                for (int s = 0; s < 4; ++s) if (s < 2 * (tt + 1)) acc = __builtin_amdgcn_mfma_f32_32x32x16_bf16(pf[k][s], *(const bf16x8*)(utp + 32 * s), acc, 0, 0, 0);
#pragma unroll
                for (int r = 0; r < 16; ++r) { const float v = acc[r]; const float vn = __shfl_xor(v, 1);
                    if ((r32 & 1) == 0) *(unsigned*)(a.ORAW + orow0 + (size_t)(64 * c + crow(r, hh)) * mk::D) = cvtpk(v, vn); }
                mk::lds_barrier();
            }
        }
#undef LD_Q
    } else {
        const int dt = w - 4;
        bf16x8 kf[4][4]; float eg[4];
#define LD_S(dk_, deg, cix) do { const unsigned char* cb = chb + (size_t)(cix) * IT_BYTES; \
        _Pragma("unroll") for (int s = 0; s < 4; ++s) dk_[s] = *(const bf16x8*)(cb + IT_KDT + (size_t)(32 * dt + r32) * 128 + 32 * s + 16 * hh); \
        deg = a.EG[bh * 32 + (cix)]; } while (0)
        LD_S(kf[0], eg[0], 0); LD_S(kf[1], eg[1], 1); LD_S(kf[2], eg[2], 2);
        f32x16 S = {};
        for (int c0 = 0; c0 < 32; c0 += 4) {
#pragma unroll
            for (int k = 0; k < 4; ++k) {
                const int c = c0 + k;
                if (c + 3 < 32) LD_S(kf[(k + 3) & 3], eg[(k + 3) & 3], c + 3);
#pragma unroll
                for (int r = 0; r < 16; ++r) S[r] *= eg[k];
                mk::lds_barrier();
#pragma unroll
                for (int s = 0; s < 4; ++s) S = __builtin_amdgcn_mfma_f32_32x32x16_bf16(kf[k][s], *(const bf16x8*)(utp + 32 * s), S, 0, 0, 0);
#pragma unroll
                for (int g = 0; g < 4; ++g)
                    *(uint2*)(lds + SL_ST + r32 * RS + 2 * (32 * dt + 8 * g + 4 * hh)) = make_uint2(cvtpk(S[4 * g], S[4 * g + 1]), cvtpk(S[4 * g + 2], S[4 * g + 3]));
                mk::lds_barrier();
            }
        }
#undef LD_S
        float* so = a.out + mk::O_SP + ((size_t)bh * 128) * 128 + 32 * sl + r32;
#pragma unroll
        for (int r = 0; r < 16; ++r) so[(size_t)(32 * dt + crow(r, hh)) * 128] = S[r];
    }
    __syncthreads();
}
}

namespace mk {
__device__ __forceinline__ unsigned f2key(float f) { f += 0.0f; unsigned u = __float_as_uint(f); return (u & 0x80000000u) ? ~u : (u | 0x80000000u); }
__device__ __forceinline__ int block_sum_i512(int c, int* red) {
    c += __shfl_xor(c, 32); c += __shfl_xor(c, 16); c += __shfl_xor(c, 8); c += __shfl_xor(c, 4); c += __shfl_xor(c, 2); c += __shfl_xor(c, 1);
    __syncthreads();
    if ((mk::ltid() & 63) == 0) red[mk::ltid() >> 6] = c;
    __syncthreads();
    return red[0] + red[1] + red[2] + red[3] + red[4] + red[5] + red[6] + red[7];
}
__device__ __forceinline__ void attend_sample_row(int r, char* lds, const float* QSS, const float* qg, const bf16_t* P1, const float* CS, const int* CI, const float* out, const float* cache_k, const float* cache_v, const int* page_table, bf16_t* AO) {
    float* lg = (float*)lds;
    int* rowi = (int*)(lg + 2048);
    int* pt = rowi + 256;
    float* red = (float*)(pt + 128);
    bf16_t* qs = (bf16_t*)(red + 64);
    float* part = (float*)(qs + 1024);
    const int m = MP + r, b = r / DS, t = mk::ltid(), w = __builtin_amdgcn_readfirstlane(t >> 6), l = t & 63;
    {
        const unsigned u = ((const unsigned*)(P1 + (size_t)m * N1P + CQ))[t];
        const float rs = rsqrtf(QSS[(size_t)m * 8 + (t >> 6)] * (1.0f / 128) + EPS);
        ((unsigned*)qs)[t] = pk2bf(__uint_as_float(u << 16) * rs * qg[(2 * t) & 127], __uint_as_float(u & 0xFFFF0000u) * rs * qg[(2 * t + 1) & 127]);
    }
    if (t >= 64 && t < 64 + NPG) pt[t - 64] = page_table[b * NPG + t - 64];
    if (w == 0) {
        float sc[32]; int ci[32];
        const float* cs = CS + (size_t)r * 8 * ix::TOPK; const int* cip = CI + (size_t)r * 8 * ix::TOPK;
#pragma unroll
        for (int k = 0; k < 32; ++k) { sc[k] = cs[64 * k + l]; ci[k] = cip[64 * k + l]; }
        __syncthreads();
        int run = 0;
        ix::topk_select<32, 32>(sc, [&](int k, unsigned long long bm) {
            const bool mine = (bm >> l) & 1ull;
            const int pos = run + __builtin_popcountll(bm & ((1ull << l) - 1ull));
            if (mine) { const int idx = ci[k]; rowi[pos] = idx < PAST ? pt[idx >> 7] * PAGE + (idx & (PAGE - 1)) : -(b * DS + (idx - PAST)) - 1; }
            run += __builtin_popcountll(bm);
        });
    } else __syncthreads();
    __syncthreads();
    const int rr = l & 31, hh = l >> 5;
    f32x16 acc0 = {}, acc1 = {};
    {
        const int ri = rowi[32 * w + rr];
        const float* kr = (ri >= 0 ? cache_k + (size_t)ri * 256 : out + O_KS + (size_t)(-ri - 1) * 256) + 8 * hh;
        float4 kf[2][8][2];
#pragma unroll
        for (int g = 0; g < 2; ++g)
#pragma unroll
            for (int s = 0; s < 8; ++s) { kf[g][s][0] = *(const float4*)(kr + g * 128 + 16 * s); kf[g][s][1] = *(const float4*)(kr + g * 128 + 16 * s + 4); }
        const bf16_t* qa = qs + (rr & 3) * 128 + 8 * hh;
#pragma unroll
        for (int s = 0; s < 8; ++s) {
            bf16x8 a0 = *(const bf16x8*)(qa + 16 * s), a1 = *(const bf16x8*)(qa + 512 + 16 * s);
            if (rr >= 4) { a0 = bf16x8{}; a1 = bf16x8{}; }
            { const float4 x = kf[0][s][0], y = kf[0][s][1];
              u32x4_t u = {cvtpk_native(x.x, x.y), cvtpk_native(x.z, x.w), cvtpk_native(y.x, y.y), cvtpk_native(y.z, y.w)};
              acc0 = __builtin_amdgcn_mfma_f32_32x32x16_bf16(a0, *reinterpret_cast<bf16x8*>(&u), acc0, 0, 0, 0); }
            { const float4 x = kf[1][s][0], y = kf[1][s][1];
              u32x4_t u = {cvtpk_native(x.x, x.y), cvtpk_native(x.z, x.w), cvtpk_native(y.x, y.y), cvtpk_native(y.z, y.w)};
              acc1 = __builtin_amdgcn_mfma_f32_32x32x16_bf16(a1, *reinterpret_cast<bf16x8*>(&u), acc1, 0, 0, 0); }
        }
    }
    __builtin_amdgcn_sched_barrier(0);
    float4 vf[32];
#pragma unroll
    for (int jj = 0; jj < 32; ++jj) { const int ri = rowi[32 * w + jj];
        vf[jj] = *(const float4*)((ri >= 0 ? cache_v + (size_t)ri * 256 : out + O_VS + (size_t)(-ri - 1) * 256) + 4 * l); }
    if (hh == 0) {
        *(float4*)(lg + (32 * w + rr) * 8) = make_float4(acc0[0] * 0.08838834764831845f, acc0[1] * 0.08838834764831845f, acc0[2] * 0.08838834764831845f, acc0[3] * 0.08838834764831845f);
        *(float4*)(lg + (32 * w + rr) * 8 + 4) = make_float4(acc1[0] * 0.08838834764831845f, acc1[1] * 0.08838834764831845f, acc1[2] * 0.08838834764831845f, acc1[3] * 0.08838834764831845f);
    }
    mk::lds_barrier();
    {
        float x[4], mx = -INFINITY;
#pragma unroll
        for (int i = 0; i < 4; ++i) { x[i] = lg[(l + 64 * i) * 8 + w]; mx = fmaxf(mx, x[i]); }
#pragma unroll
        for (int o = 32; o > 0; o >>= 1) mx = fmaxf(mx, __shfl_xor(mx, o));
        float s = 0.f;
#pragma unroll
        for (int i = 0; i < 4; ++i) { x[i] = __expf(x[i] - mx); s += x[i]; lg[(l + 64 * i) * 8 + w] = x[i]; }
        s = wave_sum(s);
        if (l == 0) red[w] = 1.0f / s;
    }
    mk::lds_barrier();
    {
        float4 o0 = make_float4(0.f, 0.f, 0.f, 0.f), o1 = o0, o2 = o0, o3 = o0;
#pragma unroll
        for (int jj = 0; jj < 32; ++jj) {
            const float4 p4 = *(const float4*)(lg + (32 * w + jj) * 8 + 4 * hh); const float4 v = vf[jj];
            o0.x = fmaf(p4.x, v.x, o0.x); o0.y = fmaf(p4.x, v.y, o0.y); o0.z = fmaf(p4.x, v.z, o0.z); o0.w = fmaf(p4.x, v.w, o0.w);
            o1.x = fmaf(p4.y, v.x, o1.x); o1.y = fmaf(p4.y, v.y, o1.y); o1.z = fmaf(p4.y, v.z, o1.z); o1.w = fmaf(p4.y, v.w, o1.w);
            o2.x = fmaf(p4.z, v.x, o2.x); o2.y = fmaf(p4.z, v.y, o2.y); o2.z = fmaf(p4.z, v.z, o2.z); o2.w = fmaf(p4.z, v.w, o2.w);
            o3.x = fmaf(p4.w, v.x, o3.x); o3.y = fmaf(p4.w, v.y, o3.y); o3.z = fmaf(p4.w, v.z, o3.z); o3.w = fmaf(p4.w, v.w, o3.w);
        }
        float* pp = part + w * 1024 + (4 * hh) * 128 + 4 * rr;
        *(float4*)(pp) = o0; *(float4*)(pp + 128) = o1; *(float4*)(pp + 256) = o2; *(float4*)(pp + 384) = o3;
    }
    __syncthreads();
    {
        const int c0 = 2 * t, h = c0 >> 7;
        float o0 = 0.f, o1 = 0.f;
#pragma unroll
        for (int ww = 0; ww < 8; ++ww) { const float2 x = *(const float2*)(part + ww * 1024 + c0); o0 += x.x; o1 += x.y; }
        const float rinv = red[h];
        const bf16_t* gate = P1 + (size_t)m * N1P + CG + c0;
        *(unsigned*)(AO + (size_t)m * D + c0) = pk2bf(o0 * rinv * silu(bf2f(gate[0])), o1 * rinv * silu(bf2f(gate[1])));
    }
    __syncthreads();
}

__device__ __forceinline__ void dn_post_row(int m, char* lds, const bf16_t* P2, const float* BA, const float* conv_w, const float* conv_state, const float* A_log, const float* dt_bias,
                                            float* QC, float* KC, float* VC, float* BETA, float* G, float* out) {
    float* y = (float*)lds;
    const int t = mk::ltid();
    const int b = (m - MP) / DS, tt = (m - MP) % DS;
    {
        float xv[6][4], wv[6][4];
#pragma unroll
        for (int k = 0; k < 6; ++k) { const int c = t + 512 * k;
#pragma unroll
            for (int i = 0; i < 4; ++i) { const int j = tt + i;
                xv[k][i] = (j < 3) ? conv_state[((size_t)b * 3 + j) * CONV + c] : bf2f(P2[(size_t)(m - tt + (j - 3)) * N3P + c]);
                wv[k][i] = conv_w[i * CONV + c]; } }
#pragma unroll
        for (int k = 0; k < 6; ++k) { const int c = t + 512 * k;
            float acc = wv[k][0] * xv[k][0]; acc += wv[k][1] * xv[k][1]; acc += wv[k][2] * xv[k][2]; acc += wv[k][3] * xv[k][3];
            y[c] = silu(acc);
            if (tt >= DS - 3) out[O_CS + ((size_t)b * 3 + (tt - (DS - 3))) * CONV + c] = xv[k][3]; }
    }
    __syncthreads();
    const int w = t >> 6, l = t & 63;
    for (int hh = w; hh < 16; hh += 8) {
        const float a = y[hh * 128 + l], bb = y[hh * 128 + 64 + l];
        const float ss = wave_sum(a * a + bb * bb);
        float r = rsqrtf(ss + EPS);
        if (hh < 8) { r *= 0.08838834764831845f; QC[(size_t)m * D + hh * 128 + l] = a * r; QC[(size_t)m * D + hh * 128 + 64 + l] = bb * r; }
        else { KC[(size_t)m * D + (hh - 8) * 128 + l] = a * r; KC[(size_t)m * D + (hh - 8) * 128 + 64 + l] = bb * r; }
    }
    for (int c = t; c < 1024; c += 512) VC[(size_t)m * D + c] = y[2048 + c];
    if (t < 8) {
        const float bv = BA[(size_t)m * 16 + t], av = BA[(size_t)m * 16 + 8 + t];
        BETA[(size_t)m * 8 + t] = 1.0f / (1.0f + expf(-bv));
        const float x = av + dt_bias[t];
        const float sp = x > 20.f ? x : log1pf(expf(x));
        G[(size_t)m * 8 + t] = -expf(A_log[t]) * sp;
    }
    __syncthreads();
}

__device__ __forceinline__ void dn_scan_sample(int it, char* lds, const float* QC, const float* KC, const float* VC, const float* BETA, const float* G, const float* S0, bf16_t* ORAW, float* out) {
    const int t = mk::ltid(), v = t & 127, hq = __builtin_amdgcn_readfirstlane(t >> 7);
    float* qs = (float*)lds; float* ks = qs + DS * 128; float* ex = ks + DS * 128;
    const int b = it >> 3, h = it & 7, m0 = MP + b * DS;
    float S[32], vv[DS], beta[DS], alpha[DS];
    const float* sp = S0 + (((size_t)b * 8 + h) * 128 + hq * 32) * 128 + v;
#pragma unroll
    for (int d = 0; d < 32; ++d) S[d] = ldnt1(sp + (size_t)d * 128);
#pragma unroll
    for (int j = 0; j < 2; ++j) { const int tt = hq + 4 * j;
        qs[tt * 128 + v] = QC[(size_t)(m0 + tt) * D + h * 128 + v]; ks[tt * 128 + v] = KC[(size_t)(m0 + tt) * D + h * 128 + v]; }
#pragma unroll
    for (int tt = 0; tt < DS; ++tt) { vv[tt] = VC[(size_t)(m0 + tt) * D + h * 128 + v]; beta[tt] = BETA[(size_t)(m0 + tt) * 8 + h]; alpha[tt] = expf(G[(size_t)(m0 + tt) * 8 + h]); }
    __syncthreads();
#pragma unroll
    for (int tt = 0; tt < DS; ++tt) {
        const float4* k4 = (const float4*)(ks + tt * 128 + hq * 32); const float4* q4 = (const float4*)(qs + tt * 128 + hq * 32);
        float kS = 0.f;
#pragma unroll
        for (int d = 0; d < 8; ++d) { const float4 kk = k4[d]; kS = fmaf(kk.x, S[4 * d], kS); kS = fmaf(kk.y, S[4 * d + 1], kS); kS = fmaf(kk.z, S[4 * d + 2], kS); kS = fmaf(kk.w, S[4 * d + 3], kS); }
        ex[hq * 128 + v] = kS;
        mk::lds_barrier();
        const float u = beta[tt] * (vv[tt] - alpha[tt] * ((ex[v] + ex[128 + v]) + (ex[256 + v] + ex[384 + v])));
        float o = 0.f;
#pragma unroll
        for (int d = 0; d < 8; ++d) { const float4 kk = k4[d], qq = q4[d];
            S[4 * d] = fmaf(alpha[tt], S[4 * d], kk.x * u); o = fmaf(qq.x, S[4 * d], o);
            S[4 * d + 1] = fmaf(alpha[tt], S[4 * d + 1], kk.y * u); o = fmaf(qq.y, S[4 * d + 1], o);
            S[4 * d + 2] = fmaf(alpha[tt], S[4 * d + 2], kk.z * u); o = fmaf(qq.z, S[4 * d + 2], o);
            S[4 * d + 3] = fmaf(alpha[tt], S[4 * d + 3], kk.w * u); o = fmaf(qq.w, S[4 * d + 3], o); }
        ex[512 + hq * 128 + v] = o;
        mk::lds_barrier();
        if (hq == 0) ORAW[(size_t)(m0 + tt) * D + h * 128 + v] = f2bf((ex[512 + v] + ex[512 + 128 + v]) + (ex[512 + 256 + v] + ex[512 + 384 + v]));
    }
    float* so_ = out + O_SS + (((size_t)b * 8 + h) * 128 + hq * 32) * 128 + v;
#pragma unroll
    for (int d = 0; d < 32; ++d) so_[(size_t)d * 128] = S[d];
    __syncthreads();
}

struct GateRegs { unsigned o[8], z[8]; };
__device__ __forceinline__ void dn_gate_load(int m, const bf16_t* ORAW, const bf16_t* P2, GateRegs& R) {
    const int l = mk::ltid() & 63;
#pragma unroll
    for (int h = 0; h < 8; ++h) { R.o[h] = *(const unsigned*)(ORAW + (size_t)m * D + h * 128 + 2 * l); R.z[h] = __builtin_nontemporal_load((const unsigned*)(P2 + (size_t)m * N3P + CZ + h * 128 + 2 * l)); }
}
__device__ __forceinline__ void dn_gate_finish(int m, const GateRegs& R, const float* og, bf16_t* AO2) {
    const int l = mk::ltid() & 63;
    const float g0 = og[2 * l], g1 = og[2 * l + 1];
    float oa[8], ob[8], ss[8];
#pragma unroll
    for (int h = 0; h < 8; ++h) { oa[h] = __uint_as_float(R.o[h] << 16); ob[h] = __uint_as_float(R.o[h] & 0xFFFF0000u); ss[h] = oa[h] * oa[h] + ob[h] * ob[h]; }
    wave_sum_n<8>(ss);
#pragma unroll
    for (int h = 0; h < 8; ++h) {
        const float r = rsqrtf(ss[h] * (1.0f / 128) + EPS);
        const float z0 = __uint_as_float(R.z[h] << 16), z1 = __uint_as_float(R.z[h] & 0xFFFF0000u);
        *(unsigned*)(AO2 + (size_t)m * D + h * 128 + 2 * l) = pk2bf(oa[h] * r * g0 * silu(z0), ob[h] * r * g1 * silu(z1));
    }
}
__device__ __forceinline__ int dn_gate_rowmap(int j) { return j < MS ? MP + j : ((j - MS) & (NB - 1)) * SEQ + (SEQ - 1 - ((j - MS) >> 3)); }
__device__ __forceinline__ void dn_gate_rows(int gw, int nw, const bf16_t* ORAW, const bf16_t* P2, const float* og, bf16_t* AO2) {
    GateRegs R0, R1, R2;
    int m = gw;
#define RM(j) dn_gate_rowmap(j)
    if (m < M) dn_gate_load(RM(m), ORAW, P2, R0);
    if (m + nw < M) dn_gate_load(RM(m + nw), ORAW, P2, R1);
    for (; m < M; m += 3 * nw) {
        if (m + 2 * nw < M) dn_gate_load(RM(m + 2 * nw), ORAW, P2, R2);
        dn_gate_finish(RM(m), R0, og, AO2);
        if (m + nw < M) { if (m + 3 * nw < M) dn_gate_load(RM(m + 3 * nw), ORAW, P2, R0); dn_gate_finish(RM(m + nw), R1, og, AO2); }
        if (m + 2 * nw < M) { if (m + 4 * nw < M) dn_gate_load(RM(m + 4 * nw), ORAW, P2, R1); dn_gate_finish(RM(m + 2 * nw), R2, og, AO2); }
    }
#undef RM
}
}

namespace mk {
constexpr size_t al256(size_t x) { return (x + 255) & ~(size_t)255; }
constexpr size_t W_BAR = 0, W_WT1 = al256(W_BAR + (size_t)12 * XCD_BAR_WORDS * 4), W_WT2 = al256(W_WT1 + (size_t)N1P * D * 2), W_WT3 = al256(W_WT2 + (size_t)D * D * 2), W_WT4 = al256(W_WT3 + (size_t)N3P * D * 2),
    W_XA = al256(W_WT4 + (size_t)D * D * 2), W_P1 = al256(W_XA + (size_t)M * D * 2), W_P2 = al256(W_P1 + (size_t)M * N1P * 2), W_AO = al256(W_P2 + (size_t)M * N3P * 2), W_QN = al256(W_AO + (size_t)M * D * 2),
    W_KB = al256(W_QN + (size_t)M * D * 2), W_IKB = al256(W_KB + (size_t)M * 256 * 2), W_BA = al256(W_IKB + (size_t)M * 64 * 2), W_IW = al256(W_BA + (size_t)M * 16 * 4), W_Y1 = al256(W_IW + (size_t)M * 8 * 4),
    W_QC = al256(W_Y1 + (size_t)M * D * 4), W_KC = al256(W_QC + (size_t)M * D * 4), W_VC = al256(W_KC + (size_t)M * D * 4), W_BETA = al256(W_VC + (size_t)M * D * 4), W_G = al256(W_BETA + (size_t)M * 8 * 4),
    W_ORAW = al256(W_G + (size_t)M * 8 * 4), W_CH = al256(W_ORAW + (size_t)M * D * 2), W_EG = al256(W_CH + (size_t)dn::NITEM * dn::IT_BYTES), W_CS = al256(W_EG + (size_t)dn::NITEM * 4), W_CI = al256(W_CS + (size_t)MS * 8 * 256 * 4), W_MASK = al256(W_CI + (size_t)MS * 8 * 256 * 4), W_SS = al256(W_MASK + (size_t)MP * 64 * 4), W_END = al256(W_SS + (size_t)M * 4);
struct WsMap {
    unsigned char* base;
#define WSP(name, T, off) __device__ __forceinline__ T* name() const { return (T*)(base + (off)); }
    WSP(bar, unsigned, W_BAR) WSP(Wt1, bf16_t, W_WT1) WSP(Wt2, bf16_t, W_WT2) WSP(Wt3, bf16_t, W_WT3) WSP(Wt4, bf16_t, W_WT4) WSP(XA, bf16_t, W_XA) WSP(P1, bf16_t, W_P1) WSP(P2, bf16_t, W_P2)
    WSP(AO, bf16_t, W_AO) WSP(QNb, bf16_t, W_QN) WSP(KB, bf16_t, W_KB) WSP(IKB, bf16_t, W_IKB) WSP(BA, float, W_BA) WSP(IW, float, W_IW) WSP(Y1, float, W_Y1) WSP(QC, float, W_QC) WSP(KC, float, W_KC)
    WSP(VC, float, W_VC) WSP(BETA, float, W_BETA) WSP(G, float, W_G) WSP(ORAW, bf16_t, W_ORAW) WSP(CH, unsigned char, W_CH) WSP(EG, float, W_EG) WSP(CS, float, W_CS) WSP(CI, int, W_CI) WSP(SS, float, W_SS) WSP(MASK, unsigned, W_MASK)
#undef WSP
};
struct Params {
    const float *x_prompt, *x_sample, *cache_k, *cache_v, *cache_ik, *state_S, *state_conv; const int* page_table;
    const float *att_norm, *att_w_in, *qg, *kg, *ikg, *att_w_out, *dn_norm, *dn_w_in, *conv_w, *A_log, *dt_bias, *og, *dn_w_out;
    float* out; WsMap w; int ph_lo, ph_hi, li, pad_;
};
constexpr int LDS_TOTAL = 147456;
constexpr int NPHASE = 12;
#ifndef MK_NLAUNCH
#define MK_NLAUNCH 1
#endif

__global__ void __launch_bounds__(512, 2) mega(Params p) {
    extern __shared__ __attribute__((aligned(16))) unsigned char lds[];
    const int bid = blockIdx.x, nblk = gridDim.x;
#define wave (mk::ltid() >> 6)
    uint4* xbw = (uint4*)(lds + LDS_TOTAL - 16);
    if (threadIdx.x == 0) *xbw = make_uint4(0u, 0u, 0u, 0u);
    __syncthreads();
    XcdBarrier bar = xcd_barrier_post(p.w.bar() + (size_t)p.li * XCD_BAR_WORDS, (volatile LAS unsigned*)xbw);
    const int lo = p.ph_lo, hi = p.ph_hi;
#define IN(k) (lo <= (k) && (k) < hi)
#define SEAM(k) do { if (IN(k) && IN((k) + 1)) xcd_barrier(bar); } while (0)
    const WsMap& w = p.w;
    if (IN(0)) {
        float* tile = (float*)lds;
        { float* qss = (float*)w.QNb(); for (int i = bid * 512 + mk::ltid(); i < M * 8; i += nblk * 512) qss[i] = 0.f; }
        wconv_waves<1>(p.att_w_in, ATT_IN, p.att_norm, w.Wt1(), D, N1P, bid * 8 + wave, nblk * 8);
        wconv_waves<0>(p.att_w_out, D, nullptr, w.Wt2(), D, D, (bid * 8 + wave + nblk * 8 - 1664 % (nblk * 8)) % (nblk * 8), nblk * 8);
        wconv_waves<3>(p.dn_w_in, DN_IN, p.dn_norm, w.Wt3(), D, N3P, (bid * 8 + wave + nblk * 8 - 2176 % (nblk * 8)) % (nblk * 8), nblk * 8);
        wconv_waves<0>(p.dn_w_out, D, nullptr, w.Wt4(), D, D, (bid * 8 + wave + nblk * 8 - 4352 % (nblk * 8)) % (nblk * 8), nblk * 8);
        { const int gw = bid * 8 + wave, nw = nblk * 8;
          if (nw >= 2048) { float4 v[9][4];
#pragma unroll
              for (int k = 0; k < 9; ++k) { const int m = gw + k * nw; if (m < M) xnorm_load(xrow(p.x_prompt, p.x_sample, m), v[k]); }
#pragma unroll
              for (int k = 0; k < 9; ++k) { const int m = gw + k * nw; if (m < M) xnorm_finish(v[k], w.XA() + (size_t)m * D, w.Y1() + m); } }
          else { float4 v[4]; for (int m = gw; m < M; m += nw) { xnorm_load(xrow(p.x_prompt, p.x_sample, m), v); xnorm_finish(v, w.XA() + (size_t)m * D, w.Y1() + m); } } }
    }
    SEAM(0);
    if (IN(1)) { pg8::Gemm g{w.XA(), w.Wt1(), M, N1P, D, 0}; EpiBf16Tail E{w.P1(), N1P, N1P / 256, nullptr, nullptr, (float*)w.QNb()}; pg8::StaticOrder S; S.init(M, N1P, nblk, bid);
        pg8::gemm_phase<EpiBf16Tail, pg8::StaticOrder, false>((PG8_LAS unsigned char*)lds, g, S, E, nullptr);
    }
    SEAM(1);
    if (IN(2)) { for (int i = bid * 512 + mk::ltid(); i < M; i += nblk * 512) w.SS()[i] = 0.f;
        att_post_rows(bid * 8 + wave, nblk * 8, w.P1(), p.qg, p.kg, p.ikg, w.KB(), w.IKB(), w.IW(), p.out); }
    SEAM(2);
    if (IN(3)) {
        const bool sfirst = (bid >> 3) & 1;
        if (sfirst) { for (int id = bid; id < 256; id += nblk) ix::index_sample_block(id >> 3, id & 7, (char*)lds, w.P1(), w.IKB(), w.IW(), p.cache_ik, p.page_table, w.CS(), w.CI()); }
        for (int id = bid; id < 256; id += nblk) { const int b = id & 7, pr = id >> 3;
#pragma nounroll
            for (int k = 0; k < 2; ++k) {
                ix::index_prompt_block(b, k ? pr : 63 - pr, (char*)lds, w.P1(), w.IKB(), w.IW(), w.MASK());
                __syncthreads(); } }
        if (!sfirst) { for (int id = bid; id < 256; id += nblk) ix::index_sample_block(id >> 3, id & 7, (char*)lds, w.P1(), w.IKB(), w.IW(), p.cache_ik, p.page_table, w.CS(), w.CI()); }
    }
    SEAM(3);
    if (IN(4)) {
        dsa::Tensors T{(const float*)w.QNb(), w.KB(), w.P1(), w.MASK(), w.AO()};
        const bool sfirst = (bid >> 3) & 1;
        if (sfirst) { for (int r = bid; r < MS; r += nblk) attend_sample_row(r, (char*)lds, (const float*)w.QNb(), p.qg, w.P1(), w.CS(), w.CI(), p.out, p.cache_k, p.cache_v, p.page_table, w.AO()); }
        dsa::attn_prompt_phase(T, (char*)lds, bid, nblk);
        __syncthreads();
        if (!sfirst) { for (int r = bid; r < MS; r += nblk) attend_sample_row(r, (char*)lds, (const float*)w.QNb(), p.qg, w.P1(), w.CS(), w.CI(), p.out, p.cache_k, p.cache_v, p.page_table, w.AO()); }
    }
    SEAM(4);
    if (IN(5)) {
        { const float* INV = w.Y1(); bf16_t* XB = w.XA(); float* SS = w.SS();
          for (int u = bid; u < 256; u += nblk) gemm_small_unit<1>((char*)lds, w.AO(), w.Wt2(), MP + 32 * (u >> 5), 32 * (u & 31), [&](int r_, int c_) { return bf2f(XB[(size_t)r_ * D + c_]) * INV[r_]; }, [&](int r_, int c_, float v, float res) {
              const float y = v + res; XB[(size_t)r_ * D + c_] = f2bf(y);
              float ss = y * y; ss += __shfl_xor(ss, 1); ss += __shfl_xor(ss, 2); ss += __shfl_xor(ss, 4); ss += __shfl_xor(ss, 8); ss += __shfl_xor(ss, 16);
              if ((ltid() & 31) == 0) atomicAdd(SS + r_, ss); }); }
        pg8::Gemm g{w.AO(), w.Wt2(), MP, D, D, 0}; EpiY1 E{w.XA(), w.Y1(), w.SS(), D, 0}; pg8::StaticOrder S; S.init(MP, D, nblk, bid);
        pg8::gemm_phase<EpiY1, pg8::StaticOrder, false>((PG8_LAS unsigned char*)lds, g, S, E, nullptr); }
    SEAM(5);
    if (IN(7)) { pg8::Gemm g{w.XA(), w.Wt3(), M, N3P, D, 0}; EpiBf16Tail E{w.P2(), N3P, 16, w.BA(), w.SS(), nullptr}; pg8::StaticOrder S; S.init(M, N3P, nblk, bid);
        pg8::gemm_phase<EpiBf16Tail, pg8::StaticOrder, false>((PG8_LAS unsigned char*)lds, g, S, E, nullptr); }
    SEAM(7);
    if (IN(8)) {
        dn::PreArgs pa{w.P2(), w.BA(), p.conv_w, p.A_log, p.dt_bias, w.CH(), w.EG(), p.out};
        { dn::PreRaw R;
          if (nblk == 256) {
              const int bh = bid & 63, cq = bid >> 6;
              dn::pre_load(pa, bh * 32 + 31 - cq, R);
              for (int k = 0; k < 8; ++k) dn::pre_item(pa, bh * 32 + 31 - (4 * k + cq), k + 1 < 8 ? bh * 32 + 31 - (4 * (k + 1) + cq) : -1, (char*)lds, R);
          } else {
              int item = bid;
              if (item < dn::NITEM) dn::pre_load(pa, item, R);
              for (; item < dn::NITEM; item += nblk) dn::pre_item(pa, item, item + nblk < dn::NITEM ? item + nblk : -1, (char*)lds, R);
          }
          __syncthreads(); }
        for (int m = MP + bid; m < M; m += nblk) dn_post_row(m, (char*)lds, w.P2(), w.BA(), p.conv_w, p.state_conv, p.A_log, p.dt_bias, w.QC(), w.KC(), w.VC(), w.BETA(), w.G(), p.out);
    }
    SEAM(8);
    if (IN(9)) {
        dn::ScanArgs sa{w.CH(), w.EG(), w.ORAW(), p.out};
        for (int it = bid; it < 256; it += nblk) { const int xcd = it & 7, slot = it >> 3; dn::scan_item(sa, xcd * 8 + (slot >> 2), slot & 3, (char*)lds); }
        for (int it = bid; it < DB * 8; it += nblk) dn_scan_sample(it, (char*)lds, w.QC(), w.KC(), w.VC(), w.BETA(), w.G(), p.state_S, w.ORAW(), p.out);
    }
    SEAM(9);
    if (IN(10)) { dn_gate_rows(bid * 8 + wave, nblk * 8, w.ORAW(), w.P2(), p.og, w.AO()); }
    SEAM(10);
    if (IN(11)) {
        { float* yo = p.out + O_Y; const bf16_t* Y1b = w.XA();
          for (int u = bid; u < 256; u += nblk) gemm_small_unit<1>((char*)lds, w.AO(), w.Wt4(), MP + 32 * (u >> 5), 32 * (u & 31), [&](int r_, int c_) { return bf2f(Y1b[(size_t)r_ * D + c_]); }, [&](int r_, int c_, float v, float res) { yo[(size_t)r_ * D + c_] = v + res; }); }
        pg8::Gemm g{w.AO(), w.Wt4(), MP, D, D, 0}; EpiF32ResBf E{p.out + O_Y, w.XA(), D, 0}; pg8::StaticOrder S; S.init(MP, D, nblk, bid);
        pg8::gemm_phase<EpiF32ResBf, pg8::StaticOrder, false>((PG8_LAS unsigned char*)lds, g, S, E, nullptr); }
#undef IN
#undef SEAM
}
}

extern "C" void kernel_launch(void* const* d_in, const int* in_sizes, int n_in, void* d_out, int out_size, void* d_ws, size_t ws_size, hipStream_t stream) {
    using namespace mk;
    static int grid = 0;
    if (!grid) {
        int dev = 0, cus = 0, per_cu = 0;
        (void)hipGetDevice(&dev);
        (void)hipDeviceGetAttribute(&cus, hipDeviceAttributeMultiprocessorCount, dev);
        (void)hipFuncSetAttribute((const void*)mega, hipFuncAttributeMaxDynamicSharedMemorySize, LDS_TOTAL);
        (void)hipOccupancyMaxActiveBlocksPerMultiprocessor(&per_cu, (const void*)mega, 512, LDS_TOTAL);
        (void)hipGetLastError();
        grid = cus > 0 ? cus : 256;
        fprintf(stderr, "mega: cus %d occupancy %d grid %d\n", cus, per_cu, grid);
    }
    Params p; memset(&p, 0, sizeof(p));
    p.x_prompt = (const float*)d_in[0]; p.x_sample = (const float*)d_in[1]; p.cache_k = (const float*)d_in[2]; p.cache_v = (const float*)d_in[3]; p.cache_ik = (const float*)d_in[4];
    p.state_S = (const float*)d_in[5]; p.state_conv = (const float*)d_in[6]; p.page_table = (const int*)d_in[7];
    p.att_norm = (const float*)d_in[8]; p.att_w_in = (const float*)d_in[9]; p.qg = (const float*)d_in[10]; p.kg = (const float*)d_in[11];
    p.ikg = (const float*)d_in[12]; p.att_w_out = (const float*)d_in[13]; p.dn_norm = (const float*)d_in[14]; p.dn_w_in = (const float*)d_in[15];
    p.conv_w = (const float*)d_in[16]; p.A_log = (const float*)d_in[17]; p.dt_bias = (const float*)d_in[18]; p.og = (const float*)d_in[19]; p.dn_w_out = (const float*)d_in[20];
    p.out = (float*)d_out;
    p.w.base = (unsigned char*)d_ws;
    if (W_END > ws_size) { fprintf(stderr, "ws too small\n"); return; }
    (void)hipMemsetAsync(d_ws, 0, (size_t)NPHASE * XCD_BAR_WORDS * 4, stream);
    constexpr int NL = MK_NLAUNCH;
    for (int li = 0; li < NL; ++li) {
        p.ph_lo = (NL == 1) ? 0 : li; p.ph_hi = (NL == 1) ? NPHASE : li + 1; p.li = li;
        hipLaunchKernelGGL(mega, dim3(grid), dim3(512), LDS_TOTAL, stream, p);
    }
}
```

```cpp
#include <hip/hip_runtime.h>
#include <cstdio>
#include <cstdint>
#include <cstring>

namespace mk {
typedef unsigned short bf16_t;
constexpr int D = 1024, NB = 8, SEQ = 2048, MP = NB * SEQ, DB = 32, DS = 8, MS = DB * DS, M = MP + MS;
constexpr int PAST = 16384, PAGE = 128, NPG = PAST / PAGE;
constexpr int NH = 8, HD = 128, NKV = 2, IH = 8, ID = 64, TOPK = 256;
constexpr int ATT_IN = 3144, SQ_ = 0, SK_ = 1024, SV_ = 1280, SIQ = 1536, SIK = 2048, SIW = 2112, SG = 2120;
constexpr int DN_IN = 4112;
constexpr int N1P = 3328, CQ = 0, CK = 1024, CV = 1280, CIQ = 1536, CG = 2048, CIK = 3072, CIW = 3136;
constexpr int N3P = 4352, CONV = 3072, CZ = 3072, CB = 4096, CA = 4104;
constexpr float EPS = 1e-6f;
constexpr size_t O_Y = 0;
constexpr size_t O_KP = (size_t)M * D;
constexpr size_t O_VP = O_KP + (size_t)MP * 256;
constexpr size_t O_IKP = O_VP + (size_t)MP * 256;
constexpr size_t O_KS = O_IKP + (size_t)MP * 64;
constexpr size_t O_VS = O_KS + (size_t)MS * 256;
constexpr size_t O_IKS = O_VS + (size_t)MS * 256;
constexpr size_t O_SP = O_IKS + (size_t)MS * 64;
constexpr size_t O_CP = O_SP + (size_t)NB * 8 * 128 * 128;
constexpr size_t O_SS = O_CP + (size_t)NB * 3 * CONV;
constexpr size_t O_CS = O_SS + (size_t)DB * 8 * 128 * 128;
constexpr size_t O_END = O_CS + (size_t)DB * 3 * CONV;
static_assert(O_END == 32235520, "output size");

__device__ __forceinline__ float* kout(float* out, int m) { return m < MP ? out + O_KP + (size_t)m * 256 : out + O_KS + (size_t)(m - MP) * 256; }
__device__ __forceinline__ float* vout(float* out, int m) { return m < MP ? out + O_VP + (size_t)m * 256 : out + O_VS + (size_t)(m - MP) * 256; }
__device__ __forceinline__ float* ikout(float* out, int m) { return m < MP ? out + O_IKP + (size_t)m * 64 : out + O_IKS + (size_t)(m - MP) * 64; }
__device__ __forceinline__ const float* xrow(const float* xp, const float* xs, int m) { return m < MP ? xp + (size_t)m * D : xs + (size_t)(m - MP) * D; }

__device__ __forceinline__ int ltid() { int t = threadIdx.x; asm volatile("" : "+v"(t)); return t; }
typedef float f32x2_t __attribute__((ext_vector_type(2)));
typedef unsigned u32x4_t __attribute__((ext_vector_type(4)));
typedef float f32x4_t __attribute__((ext_vector_type(4)));
typedef float f32x2_t __attribute__((ext_vector_type(2)));
__device__ __forceinline__ float4 ldnt4(const float* p) { const f32x4_t v = __builtin_nontemporal_load((const f32x4_t*)p); return make_float4(v.x, v.y, v.z, v.w); }
__device__ __forceinline__ float ldnt1(const float* p) { return __builtin_nontemporal_load(p); }
__device__ __forceinline__ void stnt1(float* p, float a) { __builtin_nontemporal_store(a, p); }
__device__ __forceinline__ void stnt2(float* p, float a, float b) { const f32x2_t v = {a, b}; __builtin_nontemporal_store(v, (f32x2_t*)p); }
typedef short bf16x8 __attribute__((ext_vector_type(8)));
typedef float f32x16 __attribute__((ext_vector_type(16)));
typedef __bf16 bf16x2_t __attribute__((ext_vector_type(2)));
__device__ __forceinline__ unsigned cvtpk_native(float lo, float hi) { f32x2_t v = {lo, hi}; return __builtin_bit_cast(unsigned, __builtin_convertvector(v, bf16x2_t)); }
__device__ __forceinline__ void lds_barrier() { asm volatile("s_waitcnt lgkmcnt(0)" ::: "memory"); __builtin_amdgcn_s_barrier(); asm volatile("" ::: "memory"); }
__device__ __forceinline__ float bf2f(bf16_t b) { return __uint_as_float(((unsigned)b) << 16); }
__device__ __forceinline__ bf16_t f2bf(float f) { unsigned u = __float_as_uint(f); u += 0x7FFFu + ((u >> 16) & 1u); return (bf16_t)(u >> 16); }
__device__ __forceinline__ unsigned pk2bf(float lo, float hi) { return (unsigned)f2bf(lo) | ((unsigned)f2bf(hi) << 16); }
template <int N> __device__ __forceinline__ void wave_sum_n(float (&v)[N]) {
#pragma unroll
    for (int i = 0; i < N; ++i) v[i] += __int_as_float(__builtin_amdgcn_update_dpp(0, __float_as_int(v[i]), 0xB1, 0xF, 0xF, false));
#pragma unroll
    for (int i = 0; i < N; ++i) v[i] += __int_as_float(__builtin_amdgcn_update_dpp(0, __float_as_int(v[i]), 0x4E, 0xF, 0xF, false));
#pragma unroll
    for (int i = 0; i < N; ++i) v[i] += __int_as_float(__builtin_amdgcn_update_dpp(0, __float_as_int(v[i]), 0x124, 0xF, 0xF, false));
#pragma unroll
    for (int i = 0; i < N; ++i) v[i] += __int_as_float(__builtin_amdgcn_update_dpp(0, __float_as_int(v[i]), 0x128, 0xF, 0xF, false));
#pragma unroll
    for (int i = 0; i < N; ++i) v[i] += __shfl_xor(v[i], 16);
#pragma unroll
    for (int i = 0; i < N; ++i) v[i] += __shfl_xor(v[i], 32);
}
__device__ __forceinline__ float wave_sum(float v) { float a[1] = {v}; wave_sum_n<1>(a); return a[0]; }
__device__ __forceinline__ float silu(float x) { return x / (1.0f + __expf(-x)); }
}

namespace pg8 {
#define PG8_LAS __attribute__((address_space(3)))
typedef unsigned short bf16_t;
typedef short bf16x8 __attribute__((ext_vector_type(8)));
typedef float f32x4 __attribute__((ext_vector_type(4)));
typedef unsigned u32x4 __attribute__((ext_vector_type(4)));
constexpr int BM = 256, BK = 64, HALF = 128, HTB = HALF * BK * 2  , STAGE_BYTES = 8 * HTB, NXCD = 8, WGM = 8;

__host__ __device__ __forceinline__ int lds_byte(int r, int c) { const int st = (r >> 4) * 2 + (c >> 5), rr = r & 15, cc = c & 31, ob = rr * 64 + cc * 2; return st * 1024 + (ob ^ (((ob >> 9) & 1) << 5)); }
__host__ __device__ __forceinline__ void stage_rc(int b, int& R, int& C) { const int st = b / 1024, sb = b % 1024, swz = sb ^ (((sb >> 9) & 1) << 5); R = (st >> 1) * 16 + swz / 64; C = (st & 1) * 32 + (swz % 64) / 2; }
__host__ __device__ __forceinline__ int perm32(int rho) { const int n = rho >> 4, i = rho & 15; return 8 * (i >> 2) + 4 * n + (i & 3); }

struct Unit { int pm, pn; };
struct Gemm { const bf16_t* A; const bf16_t* Bt; int M, N, K, pad_; };

struct StaticOrder {
    int nM, nN, nwg, G, c;
    __host__ __device__ void init(int M, int N, int G_, int c_) { nM = M / BM; nN = N / BM; nwg = nM * nN; G = G_; c = c_; }
    __host__ __device__ bool next(int i, Unit& u) const {
        const long L = (long)i * G + c; if (L >= nwg) return false;
        int wgid = (int)L; { const int q = nwg / NXCD, r = nwg % NXCD, xcd = wgid % NXCD, off = wgid / NXCD; wgid = (xcd < r ? xcd * (q + 1) : r * (q + 1) + (xcd - r) * q) + off; }
        const int nig = WGM * nN, gid = wgid / nig, fm = gid * WGM, gsz = (nM - fm) < WGM ? (nM - fm) : WGM;
        u.pm = fm + ((wgid % nig) % gsz); u.pn = (wgid % nig) / gsz; return true;
    }
    __device__ __forceinline__ void a_ready(const Unit&) const {}
    __device__ __forceinline__ void done(const Unit&) const {}
};
struct CountedOrder : StaticOrder {
    const unsigned* ready; unsigned need; unsigned* tmo;
    __device__ __forceinline__ void a_ready(const Unit& u) const {
        if (mk::ltid() < 64) {
            const unsigned long long t0 = __builtin_amdgcn_s_memrealtime(); unsigned polls = 0;
            while ((unsigned)__builtin_amdgcn_readfirstlane(__hip_atomic_load(ready + 64 * u.pm, __ATOMIC_RELAXED, __HIP_MEMORY_SCOPE_AGENT)) < need) {
                if ((++polls & 255u) == 0u && __builtin_amdgcn_readfirstlane(__hip_atomic_load(tmo, __ATOMIC_RELAXED, __HIP_MEMORY_SCOPE_AGENT)) != 0u) break;
                if (__builtin_amdgcn_s_memrealtime() - t0 > 2000000ull) {
                    if (mk::ltid() == 0) { unsigned expect = 0u; __hip_atomic_compare_exchange_strong(tmo + 1, &expect, 0x600u | (unsigned)(u.pm & 0xff), __ATOMIC_RELAXED, __ATOMIC_RELAXED, __HIP_MEMORY_SCOPE_AGENT); __hip_atomic_store(tmo, 1u, __ATOMIC_RELAXED, __HIP_MEMORY_SCOPE_AGENT); }
                    break; }
                __builtin_amdgcn_s_sleep(2); }
            __builtin_amdgcn_fence(__ATOMIC_ACQUIRE, "agent");
            asm volatile("s_waitcnt vmcnt(0)" ::: "memory");
        }
#if !defined(BROKEN_HOOK_NO_BARRIER)
        asm volatile("" ::: "memory"); __builtin_amdgcn_s_barrier(); asm volatile("" ::: "memory");
#endif
    }
};

__device__ __forceinline__ unsigned cvt_pk_bf16(float lo, float hi) { return mk::cvtpk_native(lo, hi); }
typedef float f32x2 __attribute__((ext_vector_type(2)));
__device__ __forceinline__ f32x2 gelu_pk(f32x2 v) {
    const f32x2 av = __builtin_elementwise_abs(v), d = av * 0.2316418882f + 1.0f;
    f32x2 t; t.x = __builtin_amdgcn_rcpf(d.x); t.y = __builtin_amdgcn_rcpf(d.y);
    f32x2 q = t * 0.5307027145f + (-0.7265760135f); q = q * t + 0.7107068705f; q = q * t + (-0.142248368f); q = q * t + 0.127414796f; q = q * t;
    const f32x2 s = (v * v) * (-0.72134752044f);
    f32x2 e; e.x = __builtin_amdgcn_exp2f(s.x); e.y = __builtin_amdgcn_exp2f(s.y);
    const f32x2 m = v * (q * e), r = v - m;
    f32x2 o; o.x = v.x < 0.f ? m.x : r.x; o.y = v.y < 0.f ? m.y : r.y; return o;
}

struct EpiF32 {
    static constexpr bool PERM = false, AFTER_DRAIN = false;
    float* C; int ldc; const float* bias;
    __device__ __forceinline__ void operator()(const f32x4 (&acc)[2][2][4][2], const Unit& u, int wr, int wc, int fr, int fq) const {
        const int row0 = u.pm * BM + wr * 64 + fr, col0 = u.pn * BM + wc * 32 + 4 * fq;
        f32x4 bv[2][2];
#pragma unroll
        for (int bj = 0; bj < 2; ++bj)
#pragma unroll
            for (int n = 0; n < 2; ++n) bv[bj][n] = bias ? *(const f32x4*)(bias + col0 + bj * HALF + n * 16) : (f32x4){0.f, 0.f, 0.f, 0.f};
#pragma unroll
        for (int ai = 0; ai < 2; ++ai)
#pragma unroll
            for (int m = 0; m < 4; ++m) { float* rowp = C + (size_t)(row0 + ai * HALF + m * 16) * ldc + col0;
#pragma unroll
                for (int bj = 0; bj < 2; ++bj)
#pragma unroll
                    for (int n = 0; n < 2; ++n) *(f32x4*)(rowp + bj * HALF + n * 16) = acc[ai][bj][m][n] + bv[bj][n]; }
    }
};
template <int ACT  > struct EpiBf16 {
    static constexpr bool PERM = true, AFTER_DRAIN = false;
    bf16_t* O; int ldc; const float* bias; int split_cols; size_t split_stride;
    __device__ __forceinline__ void operator()(const f32x4 (&acc)[2][2][4][2], const Unit& u, int wr, int wc, int fr, int fq) const {
        const int row0 = u.pm * BM + wr * 64 + fr; int colt = u.pn * BM; bf16_t* base = O;
        if (split_cols) { const int t = colt / split_cols; base += (size_t)t * split_stride; colt -= t * split_cols; }
        const int col0 = colt + wc * 32 + 8 * fq, bcol0 = u.pn * BM + wc * 32 + 8 * fq;
        f32x4 bv[2][2];
#pragma unroll
        for (int bj = 0; bj < 2; ++bj)
#pragma unroll
            for (int n = 0; n < 2; ++n) bv[bj][n] = bias ? *(const f32x4*)(bias + bcol0 + bj * HALF + 4 * n) : (f32x4){0.f, 0.f, 0.f, 0.f};
#pragma unroll
        for (int ai = 0; ai < 2; ++ai)
#pragma unroll
            for (int m = 0; m < 4; ++m) { bf16_t* rowp = base + (size_t)(row0 + ai * HALF + m * 16) * ldc + col0;
#pragma unroll
                for (int bj = 0; bj < 2; ++bj) { f32x4 v0 = acc[ai][bj][m][0] + bv[bj][0], v1 = acc[ai][bj][m][1] + bv[bj][1];
                    if (ACT == 1) { f32x2 a = gelu_pk((f32x2){v0[0], v0[1]}), b = gelu_pk((f32x2){v0[2], v0[3]}), c = gelu_pk((f32x2){v1[0], v1[1]}), d = gelu_pk((f32x2){v1[2], v1[3]});
                        v0 = (f32x4){a.x, a.y, b.x, b.y}; v1 = (f32x4){c.x, c.y, d.x, d.y}; }
                    if (ACT == 2) {
#pragma unroll
                        for (int j = 0; j < 4; ++j) { v0[j] = 0.5f * v0[j] * (1.0f + erff(v0[j] * 0.70710678f)); v1[j] = 0.5f * v1[j] * (1.0f + erff(v1[j] * 0.70710678f)); } }
                    u32x4 w; w.x = cvt_pk_bf16(v0[0], v0[1]); w.y = cvt_pk_bf16(v0[2], v0[3]); w.z = cvt_pk_bf16(v1[0], v1[1]); w.w = cvt_pk_bf16(v1[2], v1[3]);
                    *(u32x4*)(rowp + bj * HALF) = w; } }
    }
};

template <class Epi, class Sched, bool STAMP = false>
__device__ __forceinline__ void gemm_phase(PG8_LAS unsigned char* lds, const Gemm g, const Sched& S, const Epi& E, unsigned long long* stamps) {
    const int tid = mk::ltid(), wid = __builtin_amdgcn_readfirstlane(tid >> 6), lane = tid & 63, wr = wid >> 2, wc = wid & 3, fr = lane & 15, fq = lane >> 4;
    const int K = g.K, nt = K / BK;
    int ts_lo = 0, ts_hi = 0, nts = 0; const unsigned long long rt_entry = STAMP ? (unsigned long long)wall_clock64() : 0ull;
#define PG8_STAMP() do { if (STAMP && wid == 0 && nts < 64) { const unsigned long long _c = (unsigned long long)clock64(); \
        ts_lo = (lane == nts) ? (int)(unsigned)_c : ts_lo; ts_hi = (lane == nts) ? (int)(unsigned)(_c >> 32) : ts_hi; ++nts; } } while (0)
    PG8_STAMP();
    unsigned voffA[2], voffB[2];
#pragma unroll
    for (int i = 0; i < 2; ++i) { int R, C; stage_rc(tid * 16 + i * 8192, R, C); const int Rb = Epi::PERM ? ((R & ~31) + perm32(R & 31)) : R;
        voffA[i] = (unsigned)(R * K + C) * 2u; voffB[i] = (unsigned)(Rb * K + C) * 2u; }
    const size_t kstep = (size_t)(BK * 2);
    const size_t hstep = (size_t)HALF * K * 2;
    const size_t tstep = 2 * hstep;
    const unsigned ldsw = (unsigned)wid * 1024u;
    const int aoff = lds_byte(wr * 64 + fr, fq * 8), boff = lds_byte(wc * 32 + fr, fq * 8);
#define PG8_SA(b, h) (((b) * 2 + (h)) * HTB)
#define PG8_SB(b, h) ((4 + (b) * 2 + (h)) * HTB)
#define PG8_STAGE(bufoff, gbase, voff) do { _Pragma("unroll") for (int _i = 0; _i < 2; ++_i) \
        __builtin_amdgcn_global_load_lds((const unsigned*)((const char*)(gbase) + (voff)[_i]), (PG8_LAS unsigned*)(lds + (bufoff) + ldsw + _i * 8192), 16, 0, 0); } while (0)
#define PG8_LDA(dst, b, h) do { _Pragma("unroll") for (int m = 0; m < 4; ++m) _Pragma("unroll") for (int k = 0; k < 2; ++k) dst[m][k] = *(const PG8_LAS bf16x8*)(lds + PG8_SA(b, h) + aoff + m * 2048 + k * 1024); } while (0)
#define PG8_LDB(dst, b, h) do { _Pragma("unroll") for (int n = 0; n < 2; ++n) _Pragma("unroll") for (int k = 0; k < 2; ++k) dst[n][k] = *(const PG8_LAS bf16x8*)(lds + PG8_SB(b, h) + boff + n * 2048 + k * 1024); } while (0)
#define PG8_MMA(ai, bj, At, Bt) do { __builtin_amdgcn_s_setprio(1); _Pragma("unroll") for (int m = 0; m < 4; ++m) _Pragma("unroll") for (int n = 0; n < 2; ++n) _Pragma("unroll") for (int k = 0; k < 2; ++k) \
        acc[ai][bj][m][n] = __builtin_amdgcn_mfma_f32_16x16x32_bf16(Bt[n][k], At[m][k], acc[ai][bj][m][n], 0, 0, 0); __builtin_amdgcn_s_setprio(0); } while (0)
#define PG8_WAIT_V(n) asm volatile("s_waitcnt vmcnt(" #n ")" ::: "memory")
#define PG8_WAIT_L(n) asm volatile("s_waitcnt lgkmcnt(" #n ")" ::: "memory")
#define PG8_BAR __builtin_amdgcn_s_barrier()
#define PG8_SCHED __builtin_amdgcn_sched_barrier(0)
    Unit cur, nxt; int ui = 0;
    if (!S.next(0, cur)) return;
    f32x4 acc[2][2][4][2];
#pragma unroll
    for (int a = 0; a < 2; ++a)
#pragma unroll
        for (int b = 0; b < 2; ++b)
#pragma unroll
            for (int m = 0; m < 4; ++m)
#pragma unroll
                for (int n = 0; n < 2; ++n) acc[a][b][m][n] = (f32x4){0.f, 0.f, 0.f, 0.f};
    bf16x8 At[4][2], B0[2][2], B1[2][2];
    const char* cA = (const char*)g.A + (size_t)cur.pm * tstep; const char* cB = (const char*)g.Bt + (size_t)cur.pn * tstep;
    S.a_ready(cur);
    PG8_STAGE(PG8_SB(0, 0), cB, voffB); PG8_STAGE(PG8_SA(0, 0), cA, voffA); PG8_STAGE(PG8_SB(0, 1), cB + hstep, voffB); PG8_STAGE(PG8_SA(0, 1), cA + hstep, voffA);
    if (wr == 1) PG8_BAR;
    PG8_WAIT_V(4); PG8_BAR;
    PG8_STAGE(PG8_SB(1, 0), cB + kstep, voffB); PG8_STAGE(PG8_SA(1, 0), cA + kstep, voffA); PG8_STAGE(PG8_SB(1, 1), cB + hstep + kstep, voffB);
    PG8_WAIT_V(6); PG8_BAR;
    PG8_STAMP();
    for (;;) {
        const bool has_next = S.next(ui + 1, nxt);
        const char* nA = has_next ? (const char*)g.A + (size_t)nxt.pm * tstep : cA; const char* nB = has_next ? (const char*)g.Bt + (size_t)nxt.pn * tstep : cB;
        for (int t = 0; t < nt; t += 2) {
            const bool last = (t == nt - 2);
            const char* a1 = cA + (size_t)(t + 1) * kstep;
            const char* a2 = last ? nA : cA + (size_t)(t + 2) * kstep; const char* b2 = last ? nB : cB + (size_t)(t + 2) * kstep;
            const char* a3 = a2 + kstep; const char* b3 = b2 + kstep;
            if (last && has_next) S.a_ready(nxt);
            PG8_LDB(B0, 0, 0); PG8_SCHED; PG8_LDA(At, 0, 0); PG8_STAGE(PG8_SA(1, 1), a1 + hstep, voffA);
            PG8_WAIT_L(8); PG8_BAR; PG8_WAIT_L(0); PG8_MMA(0, 0, At, B0); PG8_BAR; PG8_SCHED;
            PG8_LDB(B1, 0, 1); PG8_STAGE(PG8_SB(0, 0), b2, voffB);
            PG8_BAR; PG8_WAIT_L(0); PG8_MMA(0, 1, At, B1); PG8_BAR;
            PG8_LDA(At, 0, 1); PG8_STAGE(PG8_SA(0, 0), a2, voffA);
            PG8_BAR; PG8_WAIT_L(0); PG8_MMA(1, 0, At, B0); PG8_BAR; PG8_SCHED;
            PG8_STAGE(PG8_SB(0, 1), b2 + hstep, voffB);
            PG8_WAIT_V(6); PG8_BAR; PG8_MMA(1, 1, At, B1); PG8_BAR;
            PG8_LDB(B0, 1, 0); PG8_SCHED; PG8_LDA(At, 1, 0); PG8_STAGE(PG8_SA(0, 1), a2 + hstep, voffA);
            PG8_WAIT_L(8); PG8_BAR; PG8_WAIT_L(0); PG8_MMA(0, 0, At, B0); PG8_BAR; PG8_SCHED;
            PG8_LDB(B1, 1, 1); PG8_STAGE(PG8_SB(1, 0), b3, voffB);
            PG8_BAR; PG8_WAIT_L(0); PG8_MMA(0, 1, At, B1); PG8_BAR;
            PG8_LDA(At, 1, 1); PG8_STAGE(PG8_SA(1, 0), a3, voffA);
            PG8_BAR; PG8_WAIT_L(0); PG8_MMA(1, 0, At, B0); PG8_BAR; PG8_SCHED;
            PG8_STAGE(PG8_SB(1, 1), b3 + hstep, voffB);
            PG8_WAIT_V(6); PG8_BAR; PG8_MMA(1, 1, At, B1); PG8_BAR;
        }
        PG8_STAMP();
        if constexpr (!Epi::AFTER_DRAIN) { E(acc, cur, wr, wc, fr, fq); S.done(cur); }
        PG8_STAMP();
        if (!has_next) break;
#pragma unroll
        for (int a = 0; a < 2; ++a)
#pragma unroll
            for (int b = 0; b < 2; ++b)
#pragma unroll
                for (int m = 0; m < 4; ++m)
#pragma unroll
                    for (int n = 0; n < 2; ++n) acc[a][b][m][n] = (f32x4){0.f, 0.f, 0.f, 0.f};
        cur = nxt; cA = nA; cB = nB; ++ui;
    }
    PG8_WAIT_V(0);
    if (wr == 0) PG8_BAR;
    PG8_BAR;
    if constexpr (Epi::AFTER_DRAIN) { E.fused(acc, cur, wr, wc, fr, fq, lds, wid, lane); S.done(cur); }
    PG8_STAMP();
    if (STAMP && wid == 0) { stamps[lane] = lane < nts ? (((unsigned long long)(unsigned)ts_hi << 32) | (unsigned)ts_lo) : 0ull;
        if (lane == 62) stamps[62] = rt_entry; if (lane == 63) stamps[63] = (unsigned long long)wall_clock64(); }
#undef PG8_STAMP
#undef PG8_SA
#undef PG8_SB
#undef PG8_STAGE
#undef PG8_LDA
#undef PG8_LDB
#undef PG8_MMA
#undef PG8_WAIT_V
#undef PG8_WAIT_L
#undef PG8_BAR
#undef PG8_SCHED
}
}

#define XB_TMO      128
#define XB_XCNT(j)  (256  + 64 * (j))
#define XB_XSUB(j)  (1280 + 64 * (j))
#define XB_XGEN(j)  (2304 + 64 * (j))
#define XB_TOP      3328
#define XB_TOPGEN   3392
#define XCD_BAR_WORDS 3456
#define XB_SPIN_CAP (1u << 18)
#define LAS __attribute__((address_space(3)))

__device__ __forceinline__ unsigned xb_ld(unsigned* p)              { return __hip_atomic_load(p, __ATOMIC_RELAXED, __HIP_MEMORY_SCOPE_AGENT); }
__device__ __forceinline__ unsigned xb_add(unsigned* p, unsigned v) { return __hip_atomic_fetch_add(p, v, __ATOMIC_RELAXED, __HIP_MEMORY_SCOPE_AGENT); }
__device__ __forceinline__ unsigned xb_xcc_id() { return (unsigned)__builtin_amdgcn_s_getreg((3 << 11) | 20) & 0xFu; }
#define XB_SPIN(cond, bar) do { unsigned _sp = 0; while (cond) { __builtin_amdgcn_s_sleep(1); \
    if ((++_sp & 255u) == 0u) { if (xb_ld(&(bar)[XB_TMO])) break; if (_sp > XB_SPIN_CAP) { atomicAdd(&(bar)[XB_TMO], 1u); break; } } } } while (0)

struct XcdBarrier {
    unsigned* bar; unsigned x;
    volatile LAS unsigned* st;
};

__device__ __forceinline__ XcdBarrier xcd_barrier_post(unsigned* bar, volatile LAS unsigned* st) {
    XcdBarrier b; b.bar = bar; b.x = xb_xcc_id(); b.st = st;
    if (threadIdx.x == 0) (void)xb_add(&bar[XB_XCNT(b.x)], 1u);
    return b;
}
__device__ __forceinline__ void xcd_barrier_complete(unsigned* bar, unsigned x, unsigned& nloc, unsigned& nx) {
    const unsigned G = gridDim.x * gridDim.y * gridDim.z;
    unsigned sum, cnt, mine, sp = 0u;
    for (;;) {
        sum = 0u; cnt = 0u; mine = 0u;
#pragma unroll
        for (unsigned j = 0; j < 16; ++j) { const unsigned c = xb_ld(&bar[XB_XCNT(j)]); sum += c; cnt += (c > 0u) ? 1u : 0u; mine = (j == x) ? c : mine; }
        if (sum == G) break;
        __builtin_amdgcn_s_sleep(1);
        if ((++sp & 255u) == 0u) { if (xb_ld(&bar[XB_TMO])) break; if (sp > XB_SPIN_CAP) { atomicAdd(&bar[XB_TMO], 1u); break; } }
    }
    nloc = mine > 0u ? mine : 1u; nx = cnt > 0u ? cnt : 1u;
}

__device__ __forceinline__ void xcd_barrier(const XcdBarrier& b) {
    asm volatile("s_waitcnt vmcnt(0)" ::: "memory");
    __syncthreads();
    if (threadIdx.x == 0) {
        unsigned* bar = b.bar;
        __builtin_amdgcn_s_waitcnt(0);
        unsigned nloc = b.st[0], nx = b.st[1];
        if (nloc == 0u) { xcd_barrier_complete(bar, b.x, nloc, nx); b.st[0] = nloc; b.st[1] = nx; }
        const unsigned old = xb_add(&bar[XB_XSUB(b.x)], 1u);
        const unsigned gen = old / nloc;
        if (old + 1u == (gen + 1u) * nloc) {
            __builtin_amdgcn_fence(__ATOMIC_RELEASE, "agent");
            asm volatile("s_waitcnt vmcnt(0)" ::: "memory");
            const unsigned og = xb_add(&bar[XB_TOP], 1u);
            const unsigned tg = og / nx;
            if (og + 1u == (tg + 1u) * nx) xb_add(&bar[XB_TOPGEN], 1u);
            else XB_SPIN(xb_ld(&bar[XB_TOPGEN]) == tg, bar);
            __builtin_amdgcn_fence(__ATOMIC_ACQUIRE, "agent");
            xb_add(&bar[XB_XGEN(b.x)], 1u);
            asm volatile("s_waitcnt vmcnt(0)" ::: "memory");
        } else {
            XB_SPIN(xb_ld(&bar[XB_XGEN(b.x)]) == gen, bar);
            __builtin_amdgcn_fence(__ATOMIC_ACQUIRE, "agent");
            asm volatile("s_waitcnt vmcnt(0)" ::: "memory");
        }
    }
    __syncthreads();
}


namespace mk {
#define LAS3 __attribute__((address_space(3)))
__device__ __forceinline__ int src_col1(int n) { if (n < 2048) return n; if (n < 3072) return SG + (n - 2048); if (n < 3136) return SIK + (n - 3072); if (n < 3144) return SIW + (n - 3136); return -1; }
__device__ __forceinline__ int src_col3(int n) { return n < DN_IN ? n : -1; }
__device__ __forceinline__ int src_colid(int n) { return n; }

template <int MAP> __device__ __forceinline__ void wconv_load(float (&v)[8], const float* W, int ldw, const float* gain, int n0, int k0) {
    const int tid = mk::ltid();
#pragma unroll
    for (int i = 0; i < 8; ++i) {
        const int e = tid + 512 * i, kk = e >> 6, nn = e & 63, n = n0 + nn;
        const int sc = MAP == 1 ? src_col1(n) : (MAP == 3 ? src_col3(n) : src_colid(n));
        float x = 0.f;
        if (sc >= 0) { x = W[(size_t)(k0 + kk) * ldw + sc]; if (gain) x *= gain[k0 + kk]; }
        v[i] = x;
    }
}
template <int MAP> __device__ __forceinline__ void wconv_all(float* tile, const float* W, int ldw, const float* gain, bf16_t* Wt, int K, int NP, int bid, int nblk) {
    const int ntn = NP / 64, ntk = K / 64, total = ntn * ntk, tid = mk::ltid();
    float v[8], vn[8];
    int t = bid;
    if (t < total) wconv_load<MAP>(v, W, ldw, gain, (t % ntn) * 64, (t / ntn) * 64);
    for (; t < total; t += nblk) {
        const int tn = t + nblk, n0 = (t % ntn) * 64, k0 = (t / ntn) * 64;
        if (tn < total) wconv_load<MAP>(vn, W, ldw, gain, (tn % ntn) * 64, (tn / ntn) * 64);
#pragma unroll
        for (int i = 0; i < 8; ++i) { const int e = tid + 512 * i; tile[(e >> 6) * 65 + (e & 63)] = v[i]; }
        __syncthreads();
#pragma unroll
        for (int i = 0; i < 4; ++i) {
            const int e = tid + 512 * i, nn = e >> 5, kk = (e & 31) * 2;
            *(unsigned*)(Wt + (size_t)(n0 + nn) * K + k0 + kk) = pk2bf(tile[kk * 65 + nn], tile[(kk + 1) * 65 + nn]);
        }
        __syncthreads();
#pragma unroll
        for (int i = 0; i < 8; ++i) v[i] = vn[i];
    }
}
template <int MAP> __device__ __forceinline__ void wconv_waves(const float* W, int ldw, const float* gain, bf16_t* Wt, int K, int NP, int wv, int nwv) {
    const int l = mk::ltid() & 63, n = l & 31, kh = l >> 5;
    const int nun = NP / 32, nuk = K / 64;
    for (int u = wv; u < nun * nuk; u += nwv) {
        const int n0 = (u % nun) * 32, k0 = (u / nun) * 64 + 32 * kh;
        const int sc = MAP == 1 ? src_col1(n0 + n) : (MAP == 3 ? src_col3(n0 + n) : src_colid(n0 + n));
        float x[32];
#pragma unroll
        for (int i = 0; i < 32; ++i) x[i] = sc >= 0 ? W[(size_t)(k0 + i) * ldw + sc] : 0.f;
        if (gain) {
#pragma unroll
            for (int i = 0; i < 32; ++i) x[i] *= gain[k0 + i];
        }
        uint4* dst = (uint4*)(Wt + (size_t)(n0 + n) * K + k0);
#pragma unroll
        for (int q = 0; q < 4; ++q) dst[q] = make_uint4(cvtpk_native(x[8 * q], x[8 * q + 1]), cvtpk_native(x[8 * q + 2], x[8 * q + 3]), cvtpk_native(x[8 * q + 4], x[8 * q + 5]), cvtpk_native(x[8 * q + 6], x[8 * q + 7]));
    }
}
__device__ __forceinline__ void xnorm_load(const float* x, float4 (&v)[4]) { const int lane = mk::ltid() & 63;
#pragma unroll
    for (int i = 0; i < 4; ++i) v[i] = ldnt4(x + 4 * (lane + 64 * i)); }
__device__ __forceinline__ void xnorm_finish(const float4 (&v)[4], bf16_t* xa, float* inv) {
    const int lane = mk::ltid() & 63;
    float ss = 0.f;
#pragma unroll
    for (int i = 0; i < 4; ++i) ss += v[i].x * v[i].x + v[i].y * v[i].y + v[i].z * v[i].z + v[i].w * v[i].w;
    ss = wave_sum(ss);
    const float ms = ss * (1.0f / D) + EPS, r = rsqrtf(ms);
    if (lane == 0) *inv = ms * r;
#pragma unroll
    for (int i = 0; i < 4; ++i) { uint2 w; w.x = pk2bf(v[i].x * r, v[i].y * r); w.y = pk2bf(v[i].z * r, v[i].w * r); ((uint2*)xa)[lane + 64 * i] = w; }
}

using pg8::f32x4; using pg8::u32x4; using pg8::Unit; using pg8::BM; using pg8::HALF;
struct EpiF32Res {
    static constexpr bool PERM = false, AFTER_DRAIN = false;
    float* C; const float* R0; const float* R1; bf16_t* XB; float* SS; int ld; int pad_;
    __device__ __forceinline__ void operator()(const f32x4 (&acc)[2][2][4][2], const Unit& u, int wr, int wc, int fr, int fq) const {
        const int row0 = u.pm * BM + wr * 64 + fr, col0 = u.pn * BM + wc * 32 + 4 * fq;
        const float* Rb = (u.pm * BM < MP) ? R0 : R1 - (size_t)MP * ld;
#pragma unroll
        for (int ai = 0; ai < 2; ++ai)
#pragma unroll
            for (int m = 0; m < 4; ++m) { const size_t ro = (size_t)(row0 + ai * HALF + m * 16) * ld + col0;
                float ss = 0.f;
#pragma unroll
                for (int bj = 0; bj < 2; ++bj)
#pragma unroll
                    for (int n = 0; n < 2; ++n) { const f32x4 v = acc[ai][bj][m][n] + *(const f32x4*)(Rb + ro + bj * HALF + n * 16);
                        if (C) *(f32x4*)(C + ro + bj * HALF + n * 16) = v;
                        if (XB) { *(uint2*)(XB + ro + bj * HALF + n * 16) = make_uint2(cvtpk_native(v[0], v[1]), cvtpk_native(v[2], v[3])); ss += (v[0] * v[0] + v[1] * v[1]) + (v[2] * v[2] + v[3] * v[3]); } }
                if (XB) { ss += __shfl_xor(ss, 16); ss += __shfl_xor(ss, 32); if (fq == 0) atomicAdd(SS + row0 + ai * HALF + m * 16, ss); }
            }
    }
};
struct EpiY1 {
    static constexpr bool PERM = false, AFTER_DRAIN = false;
    bf16_t* XB; const float* INV; float* SS; int ld; int pad_;
    __device__ __forceinline__ void operator()(const f32x4 (&acc)[2][2][4][2], const Unit& u, int wr, int wc, int fr, int fq) const {
        const int row0 = u.pm * BM + wr * 64 + fr, col0 = u.pn * BM + wc * 32 + 4 * fq;
#pragma unroll
        for (int ai = 0; ai < 2; ++ai)
#pragma unroll
            for (int m = 0; m < 4; ++m) { const int row = row0 + ai * HALF + m * 16; const size_t ro = (size_t)row * ld + col0;
                const float inv = INV[row];
                float ss = 0.f;
#pragma unroll
                for (int bj = 0; bj < 2; ++bj)
#pragma unroll
                    for (int n = 0; n < 2; ++n) { uint2* xp = (uint2*)(XB + ro + bj * HALF + n * 16); const uint2 rb = *xp;
                        f32x4 v = acc[ai][bj][m][n];
                        v[0] = fmaf(__uint_as_float(rb.x << 16), inv, v[0]); v[1] = fmaf(__uint_as_float(rb.x & 0xFFFF0000u), inv, v[1]);
                        v[2] = fmaf(__uint_as_float(rb.y << 16), inv, v[2]); v[3] = fmaf(__uint_as_float(rb.y & 0xFFFF0000u), inv, v[3]);
                        *xp = make_uint2(cvtpk_native(v[0], v[1]), cvtpk_native(v[2], v[3])); ss += (v[0] * v[0] + v[1] * v[1]) + (v[2] * v[2] + v[3] * v[3]); }
                ss += __shfl_xor(ss, 16); ss += __shfl_xor(ss, 32); if (fq == 0) atomicAdd(SS + row, ss);
            }
    }
};
struct EpiF32ResBf {
    static constexpr bool PERM = false, AFTER_DRAIN = false;
    float* C; const bf16_t* RB; int ld; int pad_;
    __device__ __forceinline__ void operator()(const f32x4 (&acc)[2][2][4][2], const Unit& u, int wr, int wc, int fr, int fq) const {
        const int row0 = u.pm * BM + wr * 64 + fr, col0 = u.pn * BM + wc * 32 + 4 * fq;
#pragma unroll
        for (int ai = 0; ai < 2; ++ai)
#pragma unroll
            for (int m = 0; m < 4; ++m) { const size_t ro = (size_t)(row0 + ai * HALF + m * 16) * ld + col0;
#pragma unroll
                for (int bj = 0; bj < 2; ++bj)
#pragma unroll
                    for (int n = 0; n < 2; ++n) { const uint2 rb = *(const uint2*)(RB + ro + bj * HALF + n * 16);
                        f32x4 v = acc[ai][bj][m][n];
                        v[0] += __uint_as_float(rb.x << 16); v[1] += __uint_as_float(rb.x & 0xFFFF0000u); v[2] += __uint_as_float(rb.y << 16); v[3] += __uint_as_float(rb.y & 0xFFFF0000u);
                        *(f32x4*)(C + ro + bj * HALF + n * 16) = v; }
            }
    }
};
struct EpiBf16Tail {
    static constexpr bool PERM = true, AFTER_DRAIN = false;
    bf16_t* O; int ldc; int ntile_bf; float* BA; const float* SS;
    float* QSS;
    __device__ __forceinline__ void operator()(const f32x4 (&acc)[2][2][4][2], const Unit& u, int wr, int wc, int fr, int fq) const {
        const int row0 = u.pm * BM + wr * 64 + fr;
        float rs[2][4];
#pragma unroll
        for (int ai = 0; ai < 2; ++ai)
#pragma unroll
            for (int m = 0; m < 4; ++m) rs[ai][m] = SS ? rsqrtf(SS[row0 + ai * HALF + m * 16] * (1.0f / D) + EPS) : 1.0f;
        if (u.pn >= ntile_bf) {
            if (wc == 0 && fq < 2) {
#pragma unroll
                for (int ai = 0; ai < 2; ++ai)
#pragma unroll
                    for (int m = 0; m < 4; ++m) { float* rp = BA + (size_t)(row0 + ai * HALF + m * 16) * 16 + 8 * fq;
                        *(f32x4*)(rp) = acc[ai][0][m][0] * rs[ai][m]; *(f32x4*)(rp + 4) = acc[ai][0][m][1] * rs[ai][m]; }
            }
            return;
        }
        const int col0 = u.pn * BM + wc * 32 + 8 * fq;
        const bool qsum = QSS != nullptr && u.pn < 4;
#pragma unroll
        for (int ai = 0; ai < 2; ++ai)
#pragma unroll
            for (int m = 0; m < 4; ++m) { bf16_t* rowp = O + (size_t)(row0 + ai * HALF + m * 16) * ldc + col0;
#pragma unroll
                for (int bj = 0; bj < 2; ++bj) { const f32x4 v0 = acc[ai][bj][m][0] * rs[ai][m], v1 = acc[ai][bj][m][1] * rs[ai][m];
                    u32x4 w; w.x = pg8::cvt_pk_bf16(v0[0], v0[1]); w.y = pg8::cvt_pk_bf16(v0[2], v0[3]); w.z = pg8::cvt_pk_bf16(v1[0], v1[1]); w.w = pg8::cvt_pk_bf16(v1[2], v1[3]);
                    *(u32x4*)(rowp + bj * HALF) = w;
                    if (qsum) { float ss = ((v0[0] * v0[0] + v0[1] * v0[1]) + (v0[2] * v0[2] + v0[3] * v0[3])) + ((v1[0] * v1[0] + v1[1] * v1[1]) + (v1[2] * v1[2] + v1[3] * v1[3]));
                        ss += __shfl_xor(ss, 16); ss += __shfl_xor(ss, 32);
                        if (fq == 0) atomicAdd(QSS + (size_t)(row0 + ai * HALF + m * 16) * 8 + 2 * u.pn + bj, ss); } } }
    }
};
}
namespace mk {
template <int NJ, class P, class F> __device__ __forceinline__ void gemm_small_unit(char* lds, const bf16_t* A, const bf16_t* Bt, int row0, int col0, P&& pre, F&& emit) {
    const int tid = ltid(), w = __builtin_amdgcn_readfirstlane(tid >> 6), l = tid & 63, r = l & 31, hh = l >> 5;
    const bf16_t* ap = A + (size_t)(row0 + r) * D + 128 * w + 8 * hh;
    const bf16_t* bp = Bt + (size_t)(col0 + r) * D + 128 * w + 8 * hh;
    bf16x8 af[8], bfr[NJ][8];
#pragma unroll
    for (int s = 0; s < 8; ++s) { af[s] = *(const bf16x8*)(ap + 16 * s);
#pragma unroll
        for (int j = 0; j < NJ; ++j) bfr[j][s] = *(const bf16x8*)(bp + (size_t)(32 * j) * D + 16 * s); }
    float rsd[NJ][2];
#pragma unroll
    for (int j = 0; j < NJ; ++j)
#pragma unroll
        for (int e = 0; e < 2; ++e) { const int q = 2 * w + e; rsd[j][e] = pre(row0 + (q & 3) + 8 * (q >> 2) + 4 * hh, col0 + 32 * j + r); }
    f32x16 acc[NJ];
#pragma unroll
    for (int j = 0; j < NJ; ++j) acc[j] = f32x16{};
#pragma unroll
    for (int s = 0; s < 8; ++s)
#pragma unroll
        for (int j = 0; j < NJ; ++j) acc[j] = __builtin_amdgcn_mfma_f32_32x32x16_bf16(af[s], bfr[j][s], acc[j], 0, 0, 0);
    float* part = (float*)lds;
#pragma unroll
    for (int j = 0; j < NJ; ++j)
#pragma unroll
        for (int q = 0; q < 16; ++q) part[((w * NJ + j) * 16 + q) * 64 + l] = acc[j][q];
    __syncthreads();
#pragma unroll
    for (int j = 0; j < NJ; ++j)
#pragma unroll
        for (int e = 0; e < 2; ++e) {
            const int q = 2 * w + e;
            float v = 0.f;
#pragma unroll
            for (int ww = 0; ww < 8; ++ww) v += part[((ww * NJ + j) * 16 + q) * 64 + l];
            emit(row0 + (q & 3) + 8 * (q >> 2) + 4 * hh, col0 + 32 * j + r, v, rsd[j][e]);
        }
    __syncthreads();
}
}

namespace mk {

struct AttPostRegs { unsigned k[2], v[2]; bf16_t ik, iw; };
__device__ __forceinline__ void att_post_load(int m, const bf16_t* P1, AttPostRegs& R) {
    const int l = mk::ltid() & 63;
    const unsigned* p = (const unsigned*)(P1 + (size_t)m * N1P);
#pragma unroll
    for (int h = 0; h < 2; ++h) { R.k[h] = p[(CK >> 1) + h * 64 + l]; R.v[h] = p[(CV >> 1) + h * 64 + l]; }
    R.ik = P1[(size_t)m * N1P + CIK + l]; R.iw = P1[(size_t)m * N1P + CIW + (l & 7)];
}
__device__ __forceinline__ void att_post_finish(int m, const AttPostRegs& R, const float* qg, const float* kg, const float* ikg, bf16_t* KB, bf16_t* IKB, float* IW, float* out) {
    const int l = mk::ltid() & 63;
    const float g0 = qg[2 * l], g1 = qg[2 * l + 1];
    {
        const float k0 = kg[2 * l], k1 = kg[2 * l + 1];
        float* ko = kout(out, m); unsigned* kb = (unsigned*)(KB + (size_t)m * 256);
        float ka[2], kb2[2], ss[3];
#pragma unroll
        for (int h = 0; h < 2; ++h) { ka[h] = __uint_as_float(R.k[h] << 16); kb2[h] = __uint_as_float(R.k[h] & 0xFFFF0000u); ss[h] = ka[h] * ka[h] + kb2[h] * kb2[h]; }
        const float ia = bf2f(R.ik); ss[2] = ia * ia;
        wave_sum_n<3>(ss);
#pragma unroll
        for (int h = 0; h < 2; ++h) {
            const float r = rsqrtf(ss[h] * (1.0f / 128) + EPS);
            const float x = ka[h] * r * k0, y = kb2[h] * r * k1;
            *(float2*)(ko + h * 128 + 2 * l) = make_float2(x, y);
            kb[h * 64 + l] = pk2bf(x * g0, y * g1);
        }
        float* vo = vout(out, m);
#pragma unroll
        for (int h = 0; h < 2; ++h) *(float2*)(vo + h * 128 + 2 * l) = make_float2(__uint_as_float(R.v[h] << 16), __uint_as_float(R.v[h] & 0xFFFF0000u));
        const float ri = rsqrtf(ss[2] * (1.0f / 64) + EPS);
        const float xi = ia * ri * ikg[l];
        ikout(out, m)[l] = xi;
        IKB[(size_t)m * 64 + l] = f2bf(xi);
        if (l < 8) IW[(size_t)m * 8 + l] = bf2f(R.iw) * (0.35355339059327373f * 0.125f);
    }
}
__device__ __forceinline__ void att_post_rows(int gw, int nw, const bf16_t* P1, const float* qg, const float* kg, const float* ikg, bf16_t* KB, bf16_t* IKB, float* IW, float* out) {
    AttPostRegs R0, R1, R2;
    int m = gw;
    if (m < M) att_post_load(m, P1, R0);
    if (m + nw < M) att_post_load(m + nw, P1, R1);
    for (; m < M; m += 3 * nw) {
        if (m + 2 * nw < M) att_post_load(m + 2 * nw, P1, R2);
        att_post_finish(m, R0, qg, kg, ikg, KB, IKB, IW, out);
        if (m + nw < M) { if (m + 3 * nw < M) att_post_load(m + 3 * nw, P1, R0);
            att_post_finish(m + nw, R1, qg, kg, ikg, KB, IKB, IW, out); }
        if (m + 2 * nw < M) { if (m + 4 * nw < M) att_post_load(m + 4 * nw, P1, R1);
            att_post_finish(m + 2 * nw, R2, qg, kg, ikg, KB, IKB, IW, out); }
    }
}
}

namespace ix {
using mk::bf16_t; using mk::bf16x8; using mk::f32x16;
constexpr int TOPK = mk::TOPK;
constexpr float NEGINF = -__builtin_inff();
__device__ __forceinline__ float key2f(unsigned k) { return (k & 0x80000000u) ? __uint_as_float(k & 0x7FFFFFFFu) : __uint_as_float(~k); }

__device__ __forceinline__ void tile_partial(const bf16x8 (&af)[4], const bf16x8 (&bfr)[4], const float (&w)[16], float (&p)[4]) {
    f32x16 acc = {};
#pragma unroll
    for (int s = 0; s < 4; ++s) acc = __builtin_amdgcn_mfma_f32_32x32x16_bf16(af[s], bfr[s], acc, 0, 0, 0);
#pragma unroll
    for (int T = 0; T < 4; ++T) {
        float x = w[4 * T] * fmaxf(acc[4 * T], 0.f);
        x = fmaf(w[4 * T + 1], fmaxf(acc[4 * T + 1], 0.f), x);
        x = fmaf(w[4 * T + 2], fmaxf(acc[4 * T + 2], 0.f), x);
        x = fmaf(w[4 * T + 3], fmaxf(acc[4 * T + 3], 0.f), x);
        p[T] = x;
    }
}
__device__ __forceinline__ float pair_combine(float pa, float pb) {
    auto rr = __builtin_amdgcn_permlane32_swap(__float_as_uint(pa), __float_as_uint(pb), false, false);
    return __uint_as_float(rr[0]) + __uint_as_float(rr[1]);
}
__device__ __forceinline__ void load_af_w(const bf16_t* P1, const float* IW, int m0, int r, int hh, bf16x8 (&af)[4], float (&w)[16]) {
    const bf16_t* ap = P1 + (size_t)(m0 + (r >> 3)) * mk::N1P + mk::CIQ + (r & 7) * 64 + 8 * hh;
#pragma unroll
    for (int s = 0; s < 4; ++s) af[s] = *(const bf16x8*)(ap + 16 * s);
#pragma unroll
    for (int i = 0; i < 16; ++i) w[i] = IW[(size_t)(m0 + (i >> 2)) * 8 + (i & 3) + 4 * hh];
}

template <int NA, int NR, int MI = 0, class F> __device__ __forceinline__ void topk_select(const float (&sc)[NA], F&& emit) {
    unsigned lo = 0x007FFFFFu, hi = 0xFF800001u;
    float tau = NEGINF; bool exact = false;
    auto count_ge = [&](float tf) __attribute__((always_inline)) -> int {
        int c = 0;
#pragma unroll
        for (int k0 = 0; k0 < NR; k0 += 8) {
            unsigned long long bm[8];
#pragma unroll
            for (int q = 0; q < 8; ++q) bm[q] = (k0 + q < NR) ? __builtin_amdgcn_ballot_w64(sc[k0 + q < NR ? k0 + q : 0] >= tf) : 0ull;
            __builtin_amdgcn_sched_barrier(0);
#pragma unroll
            for (int q = 0; q < 8; ++q) c += __builtin_popcountll(bm[q]);
            __builtin_amdgcn_sched_barrier(0);
        }
        return c;
    };
    if (MI) {
        float mx = sc[0];
#pragma unroll
        for (int k = 1; k < NR; ++k) mx = fmaxf(mx, sc[k]);
        mx = fmaxf(mx, __int_as_float(__builtin_amdgcn_update_dpp(0, __float_as_int(mx), 0xB1, 0xF, 0xF, false)));
        mx = fmaxf(mx, __int_as_float(__builtin_amdgcn_update_dpp(0, __float_as_int(mx), 0x4E, 0xF, 0xF, false)));
        mx = fmaxf(mx, __int_as_float(__builtin_amdgcn_update_dpp(0, __float_as_int(mx), 0x124, 0xF, 0xF, false)));
        mx = fmaxf(mx, __int_as_float(__builtin_amdgcn_update_dpp(0, __float_as_int(mx), 0x128, 0xF, 0xF, false)));
        const int mi = __float_as_int(mx);
        const float m4 = fmaxf(fmaxf(__int_as_float(__builtin_amdgcn_readlane(mi, 0)), __int_as_float(__builtin_amdgcn_readlane(mi, 16))),
                               fmaxf(__int_as_float(__builtin_amdgcn_readlane(mi, 32)), __int_as_float(__builtin_amdgcn_readlane(mi, 48))));
        if (m4 > 1e-30f) {
            hi = (__float_as_uint(m4) | 0x80000000u) + 1u;
            const float tf = m4 * 0.0625f; const unsigned kf = __float_as_uint(tf) | 0x80000000u;
            const int c = count_ge(tf);
            if (c >= TOPK) { lo = kf; tau = tf; if (c == TOPK) { exact = true; hi = lo + 1u; } } else hi = kf;
        }
    }
    while (hi - lo > 1u) {
        const unsigned mid = lo + ((hi - lo) >> 1);
        const float tf = key2f(mid);
        const int c = count_ge(tf);
        if (c >= TOPK) { lo = mid; tau = tf; if (c == TOPK) { exact = true; break; } } else hi = mid;
    }
    if (exact) {
#pragma unroll
        for (int k = 0; k < NA; ++k) emit(k, k < NR ? __builtin_amdgcn_ballot_w64(sc[k] >= tau) : 0ull);
        return;
    }
    int cgt = 0;
#pragma unroll
    for (int k = 0; k < NR; ++k) cgt += __builtin_popcountll(__builtin_amdgcn_ballot_w64(sc[k] > tau));
    int need = TOPK - cgt;
#pragma unroll
    for (int k = 0; k < NA; ++k) {
        unsigned long long bm = 0ull;
        if (k < NR) {
            const unsigned long long gt = __builtin_amdgcn_ballot_w64(sc[k] > tau);
            unsigned long long eq = __builtin_amdgcn_ballot_w64(sc[k] == tau);
            int pc = __builtin_popcountll(eq);
            while (pc > need) { eq &= ~(1ull << (63 - __builtin_clzll(eq))); --pc; }
            need -= pc;
            bm = gt | eq;
        }
        emit(k, bm);
    }
}

__device__ __forceinline__ void index_prompt_block(int b, int gi, char* lds, const bf16_t* P1, const bf16_t* IKB, const float* IW, unsigned* MASK) {
    const int tid = mk::ltid(), w = __builtin_amdgcn_readfirstlane(tid >> 6), l = tid & 63, r = l & 31, hh = l >> 5;
    const int t0 = 32 * gi + 4 * w, m0 = b * mk::SEQ + t0;
    if (gi < 8) {
#pragma unroll
        for (int T = 0; T < 4; ++T) { const int nb = t0 + T + 1 - 32 * l; MASK[(size_t)(m0 + T) * 64 + l] = nb >= 32 ? 0xFFFFFFFFu : (nb <= 0 ? 0u : ((1u << nb) - 1u)); }
        return;
    }
    bf16x8 af[4]; float wt[16];
    load_af_w(P1, IW, m0, r, hh, af, wt);
    const int JP = (32 * gi + 31) / 64 + 1;
    const int skey = tid >> 3, sch = tid & 7;
    const bf16_t* gsrc = IKB + (size_t)(b * mk::SEQ + skey) * 64 + 8 * sch;
    const int sdst = (skey * 8 + (sch ^ ((skey >> 1) & 7))) * 16;
    const int rd0 = r * 128 + ((hh ^ ((r >> 1) & 1)) << 4), rda = ((r >> 1) & 6) << 4;
#define RDO(s) (rd0 + ((32 * (s)) ^ rda))
    float sc[4][32];
    uint4 stA, stB = make_uint4(0u, 0u, 0u, 0u);
    stA = *(const uint4*)gsrc;
    if (1 < JP) stB = *(const uint4*)(gsrc + (size_t)1 * 64 * 64);
    *(uint4*)(lds + sdst) = stA;
    __syncthreads();
#pragma unroll
    for (int jp = 0; jp < 32; ++jp) {
        if (jp < JP) {
            if (jp + 2 < JP) { if (jp & 1) stB = *(const uint4*)(gsrc + (size_t)(jp + 2) * 64 * 64); else stA = *(const uint4*)(gsrc + (size_t)(jp + 2) * 64 * 64); }
            const char* buf = lds + (jp & 1) * 8192;
            if (jp * 64 <= t0 + 3) {
                float pa[4], pb[4];
                { bf16x8 bfr[4];
#pragma unroll
                  for (int s = 0; s < 4; ++s) bfr[s] = *(const bf16x8*)(buf + RDO(s));
                  tile_partial(af, bfr, wt, pa); }
                { bf16x8 bfr[4];
#pragma unroll
                  for (int s = 0; s < 4; ++s) bfr[s] = *(const bf16x8*)(buf + RDO(s) + 4096);
                  tile_partial(af, bfr, wt, pb); }
#pragma unroll
                for (int T = 0; T < 4; ++T) {
                    float s = pair_combine(pa[T], pb[T]);
                    if (jp * 64 + 63 > t0) { if (jp * 64 + l > t0 + T) s = NEGINF; }
                    sc[T][jp] = s;
                }
            } else {
#pragma unroll
                for (int T = 0; T < 4; ++T) sc[T][jp] = NEGINF;
            }
            if (jp + 1 < JP) *(uint4*)(lds + ((jp + 1) & 1) * 8192 + sdst) = ((jp + 1) & 1) ? stB : stA;
            mk::lds_barrier();
        } else {
#pragma unroll
            for (int T = 0; T < 4; ++T) sc[T][jp] = NEGINF;
        }
    }
#define IX_SELECT(T) do { \
        unsigned wv = 0u; \
        auto put = [&](int k, unsigned long long bm) { const unsigned mine = (l & 1) ? (unsigned)(bm >> 32) : (unsigned)bm; wv = ((l >> 1) == k) ? mine : wv; }; \
        const int nreg = (t0 + (T)) / 64 + 1;                                    \
        if (nreg <= 8) topk_select<32, 8, 1>(sc[T], put); else if (nreg <= 16) topk_select<32, 16, 1>(sc[T], put); else if (nreg <= 24) topk_select<32, 24, 1>(sc[T], put); else topk_select<32, 32, 1>(sc[T], put); \
        MASK[(size_t)(m0 + (T)) * 64 + l] = wv; \
    } while (0)
    IX_SELECT(0); IX_SELECT(1); IX_SELECT(2); IX_SELECT(3);
#undef IX_SELECT
}

constexpr int SCR_BYTES = 8 * 2048 * 4, SCX_OFF = SCR_BYTES;
__device__ __forceinline__ void index_sample_block(int b, int kc, char* lds, const bf16_t* P1, const bf16_t* IKB, const float* IW, const float* cache_ik, const int* page_table, float* CS, int* CI) {
    const int tid = mk::ltid(), w = __builtin_amdgcn_readfirstlane(tid >> 6), l = tid & 63, r = l & 31, hh = l >> 5;
    const int m0 = mk::MP + b * mk::DS;
    float* scr = (float*)lds; float* scx = (float*)(lds + SCX_OFF);
    bf16x8 afA[4], afB[4]; float wtA[16], wtB[16];
    load_af_w(P1, IW, m0, r, hh, afA, wtA);
    load_af_w(P1, IW, m0 + 4, r, hh, afB, wtB);
    const int kbase = 2048 * kc + 256 * w;
    const int pg0 = __builtin_amdgcn_readfirstlane(page_table[b * mk::NPG + (kbase >> 7)]), pg1 = __builtin_amdgcn_readfirstlane(page_table[b * mk::NPG + (kbase >> 7) + 1]);
    const float* kp0 = cache_ik + ((size_t)pg0 * mk::PAGE + r) * 64 + 8 * hh;
    const float* kp1 = cache_ik + ((size_t)pg1 * mk::PAGE + r) * 64 + 8 * hh;
    float4 ring[3][8];
#define SI_LOAD(slot, tl_) do { const float* p_ = (((tl_) >> 2) ? kp1 : kp0) + ((tl_) & 3) * 32 * 64; _Pragma("unroll") for (int s = 0; s < 4; ++s) { ring[slot][2 * s] = *(const float4*)(p_ + 16 * s); ring[slot][2 * s + 1] = *(const float4*)(p_ + 16 * s + 4); } } while (0)
    SI_LOAD(0, 0); SI_LOAD(1, 1); SI_LOAD(2, 2);
    float pA[4] = {0.f, 0.f, 0.f, 0.f}, pB[4] = {0.f, 0.f, 0.f, 0.f};
#pragma unroll
    for (int tl = 0; tl < 8; ++tl) {
        bf16x8 bfr[4];
#pragma unroll
        for (int s = 0; s < 4; ++s) { const float4 x = ring[tl % 3][2 * s], y = ring[tl % 3][2 * s + 1];
            mk::u32x4_t u = {mk::cvtpk_native(x.x, x.y), mk::cvtpk_native(x.z, x.w), mk::cvtpk_native(y.x, y.y), mk::cvtpk_native(y.z, y.w)}; bfr[s] = *reinterpret_cast<bf16x8*>(&u); }
        if (tl + 3 < 8) SI_LOAD(tl % 3, tl + 3);
        float qa[4], qb[4];
        tile_partial(afA, bfr, wtA, qa);
        tile_partial(afB, bfr, wtB, qb);
        if (tl & 1) {
#pragma unroll
            for (int T = 0; T < 4; ++T) { scr[T * 2048 + 256 * w + 32 * (tl - 1) + l] = pair_combine(pA[T], qa[T]); scr[(4 + T) * 2048 + 256 * w + 32 * (tl - 1) + l] = pair_combine(pB[T], qb[T]); }
        } else {
#pragma unroll
            for (int T = 0; T < 4; ++T) { pA[T] = qa[T]; pB[T] = qb[T]; }
        }
    }
#undef SI_LOAD
    if (kc == 7 && w < 2) {
        bf16x8 bfr[4];
#pragma unroll
        for (int s = 0; s < 4; ++s) { bfr[s] = bf16x8{}; if (r < mk::DS) bfr[s] = *(const bf16x8*)(IKB + (size_t)(mk::MP + b * mk::DS + r) * 64 + 16 * s + 8 * hh); }
        float p[4];
        if (w == 0) tile_partial(afA, bfr, wtA, p); else tile_partial(afB, bfr, wtB, p);
#pragma unroll
        for (int T = 0; T < 4; ++T) { const float s = pair_combine(p[T], p[T]); if (l < mk::DS) scx[(4 * w + T) * 8 + l] = (l <= 4 * w + T) ? s : NEGINF; }
    }
    __syncthreads();
    {
        const int tok = w;
        float sc[33];
#pragma unroll
        for (int k = 0; k < 32; ++k) sc[k] = scr[tok * 2048 + 64 * k + l];
        sc[32] = (kc == 7 && l < mk::DS) ? scx[tok * 8 + l] : NEGINF;
        float* cs = CS + ((size_t)(b * mk::DS + tok) * 8 + kc) * TOPK; int* ci = CI + ((size_t)(b * mk::DS + tok) * 8 + kc) * TOPK;
        int run = 0;
        topk_select<33, 33>(sc, [&](int k, unsigned long long bm) {
            const bool mine = (bm >> l) & 1ull;
            const int pos = run + __builtin_popcountll(bm & ((1ull << l) - 1ull));
            if (mine) { cs[pos] = sc[k]; ci[pos] = (k < 32) ? 2048 * kc + 64 * k + l : mk::PAST + l; }
            run += __builtin_popcountll(bm);
        });
    }
    __syncthreads();
}

__device__ __forceinline__ void merge_sample_row(int r, const float* CS, const int* CI, const int* page_table, int* rowi) {
    const int l = mk::ltid() & 63, b = r / mk::DS;
    float sc[32];
    const float* cs = CS + (size_t)r * 8 * TOPK; const int* ci = CI + (size_t)r * 8 * TOPK;
#pragma unroll
    for (int k = 0; k < 32; ++k) sc[k] = cs[64 * k + l];
    int run = 0;
    topk_select<32, 32>(sc, [&](int k, unsigned long long bm) {
        const bool mine = (bm >> l) & 1ull;
        const int pos = run + __builtin_popcountll(bm & ((1ull << l) - 1ull));
        if (mine) { const int idx = ci[64 * k + l];
            rowi[pos] = idx < mk::PAST ? page_table[b * mk::NPG + idx / mk::PAGE] * mk::PAGE + (idx % mk::PAGE) : -(b * mk::DS + (idx - mk::PAST)) - 1; }
        run += __builtin_popcountll(bm);
    });
}
}

namespace dsa {
using mk::bf16_t;
typedef short bf16x8 __attribute__((ext_vector_type(8)));
typedef short s16x4 __attribute__((ext_vector_type(4)));
typedef float f32x16 __attribute__((ext_vector_type(16)));
typedef float f32x4 __attribute__((ext_vector_type(4)));
typedef unsigned u32x4 __attribute__((ext_vector_type(4)));
constexpr float SCALE = 0.08838834764831845f;
constexpr float THR = 8.f;
constexpr int NW = 8, QBLK = 32, KVBLK = 64, HDIM = 128;
constexpr int SHM_V = KVBLK * HDIM * 2, SHM_K = KVBLK * HDIM * 2;
constexpr int LDS_BYTES = 2 * SHM_V + 2 * SHM_K + NW * 64 * 4;

#define KSWZ(row, colB) ((row) * 256 + ((colB) ^ (((row) & 7) << 4)))
#define SBAR() __builtin_amdgcn_sched_barrier(0)
__device__ __forceinline__ int v_st(int k, int c) { const int kk = (k & ~0xC) | ((k & 4) << 1) | ((k & 8) >> 1); return ((kk >> 3) * 4 + (c >> 5)) * 512 + ((kk & 7) * 32 + (c & 31)) * 2; }
__device__ __forceinline__ int v_rd_base(int lane) { return ((lane & 3) << 3) | (((lane >> 2) & 3) << 6) | (((lane >> 4) & 1) << 5) | (((lane >> 5) & 1) << 8); }
constexpr int v_rd_off(int d0, int ks, int half) { return d0 * 512 + ks * 4096 + half * 2048; }
__device__ __forceinline__ int crow(int r, int hi) { return (r & 3) + 8 * (r >> 2) + 4 * hi; }
__device__ __forceinline__ unsigned cvtpk(float lo, float hi) { return mk::cvtpk_native(lo, hi); }

__device__ __forceinline__ void partialSM(f32x16& p0, f32x16& p1, float& m_reg, float& mn, float& alpha) {
    float pmax = p0[0]; for (int r = 1; r < 16; ++r) pmax = fmaxf(pmax, p0[r]); for (int r = 0; r < 16; ++r) pmax = fmaxf(pmax, p1[r]);
    { auto rr = __builtin_amdgcn_permlane32_swap(__float_as_uint(pmax), __float_as_uint(pmax), false, false);
      pmax = fmaxf(__uint_as_float(rr[0]), __uint_as_float(rr[1])); }
    constexpr float C2 = 1.4426950408889634f * SCALE;
    if (__builtin_expect(__all((pmax - m_reg) * SCALE <= THR), 1)) { mn = m_reg; alpha = 1.f; }
    else { mn = fmaxf(m_reg, pmax); alpha = __builtin_amdgcn_exp2f((m_reg - mn) * C2); m_reg = mn; }
    const float mnL = -mn * C2;
    for (int r = 0; r < 16; ++r) p0[r] = fmaf(p0[r], C2, mnL); for (int r = 0; r < 16; ++r) p1[r] = fmaf(p1[r], C2, mnL);
    for (int r = 0; r < 16; ++r) p0[r] = __builtin_amdgcn_exp2f(p0[r]);
}
__device__ __forceinline__ void finishSM(f32x16& p0, f32x16& p1, float alpha, float& l_reg, uint2 mw, int hi, bf16x8& pa0, bf16x8& pa1, bf16x8& pa2, bf16x8& pa3) {
    for (int r = 0; r < 16; ++r) p1[r] = __builtin_amdgcn_exp2f(p1[r]);
    const int w0 = (int)(mw.x >> (4 * hi)), w1 = (int)(mw.y >> (4 * hi));
#pragma unroll
    for (int r = 0; r < 16; ++r) {
        const int c = (r & 3) + 8 * (r >> 2);
        int b0 = __builtin_amdgcn_sbfe(w0, c, 1), b1 = __builtin_amdgcn_sbfe(w1, c, 1);
        asm volatile("" : "+v"(b0), "+v"(b1));
        p0[r] = __uint_as_float(__float_as_uint(p0[r]) & (unsigned)b0);
        p1[r] = __uint_as_float(__float_as_uint(p1[r]) & (unsigned)b1);
    }
    float ps = 0; for (int r = 0; r < 16; ++r) ps += p0[r]; for (int r = 0; r < 16; ++r) ps += p1[r];
    { auto rr = __builtin_amdgcn_permlane32_swap(__float_as_uint(ps), __float_as_uint(ps), false, false);
      ps = __uint_as_float(rr[0]) + __uint_as_float(rr[1]); }
    l_reg = l_reg * alpha + ps;
#define PK4(P, B_, OUT) do { unsigned a0 = cvtpk(P[B_+0], P[B_+1]), a1 = cvtpk(P[B_+2], P[B_+3]);                          \
        unsigned b0 = cvtpk(P[B_+4], P[B_+5]), b1 = cvtpk(P[B_+6], P[B_+7]);                                             \
        auto r0 = __builtin_amdgcn_permlane32_swap(a0, b0, false, false); auto r1 = __builtin_amdgcn_permlane32_swap(a1, b1, false, false); \
        u32x4 w = {r0[0], r1[0], r0[1], r1[1]}; OUT = *reinterpret_cast<bf16x8*>(&w); } while (0)
    PK4(p0, 0, pa0); PK4(p0, 8, pa1); PK4(p1, 0, pa2); PK4(p1, 8, pa3);
#undef PK4
}
template <int KB>
__device__ __forceinline__ void qkt(f32x16& p0, f32x16& p1, const char* K_lds, int r32, int hi, const bf16x8* qr) {
    p0 = f32x16{}; p1 = f32x16{};
    const char* kb[4];
#pragma unroll
    for (int dd = 0; dd < 4; ++dd) kb[dd] = K_lds + KB * SHM_K + KSWZ(r32, (dd * 16 + hi * 8) * 2);
#pragma unroll
    for (int d0 = 0; d0 < 8; ++d0) { const char* a = kb[d0 & 3] + (d0 >> 2) * 128;
        bf16x8 b0 = *reinterpret_cast<const bf16x8*>(a);
        bf16x8 b1 = *reinterpret_cast<const bf16x8*>(a + 32 * 256);
        p0 = __builtin_amdgcn_mfma_f32_32x32x16_bf16(b0, qr[d0], p0, 0, 0, 0);
        p1 = __builtin_amdgcn_mfma_f32_32x32x16_bf16(b1, qr[d0], p1, 0, 0, 0); }
}
template <int VB>
__device__ __forceinline__ void pv_tile(f32x16* o, int vb0, bf16x8 pa0, bf16x8 pa1, bf16x8 pa2, bf16x8 pa3) {
#define TRRD(dst, off) asm volatile("ds_read_b64_tr_b16 %0, %1 offset:%2" : "=&v"(dst) : "v"(vb0), "i"(off) : "memory")
#define PV_D0(d0) do { s16x4 l0, l1, l2, l3, h0, h1, h2, h3; constexpr int b_ = VB * SHM_V + v_rd_off(d0, 0, 0);   \
        TRRD(l0, b_); TRRD(h0, b_ + 2048); TRRD(l1, b_ + 4096); TRRD(h1, b_ + 6144); TRRD(l2, b_ + 8192); TRRD(h2, b_ + 10240); TRRD(l3, b_ + 12288); TRRD(h3, b_ + 14336); \
        asm volatile("s_waitcnt lgkmcnt(0)" ::: "memory"); SBAR();   \
        o[d0] = __builtin_amdgcn_mfma_f32_32x32x16_bf16(pa0, (bf16x8){l0[0], l0[1], l0[2], l0[3], h0[0], h0[1], h0[2], h0[3]}, o[d0], 0, 0, 0);   \
        o[d0] = __builtin_amdgcn_mfma_f32_32x32x16_bf16(pa1, (bf16x8){l1[0], l1[1], l1[2], l1[3], h1[0], h1[1], h1[2], h1[3]}, o[d0], 0, 0, 0);   \
        o[d0] = __builtin_amdgcn_mfma_f32_32x32x16_bf16(pa2, (bf16x8){l2[0], l2[1], l2[2], l2[3], h2[0], h2[1], h2[2], h2[3]}, o[d0], 0, 0, 0);   \
        o[d0] = __builtin_amdgcn_mfma_f32_32x32x16_bf16(pa3, (bf16x8){l3[0], l3[1], l3[2], l3[3], h3[0], h3[1], h3[2], h3[3]}, o[d0], 0, 0, 0); } while (0)
    PV_D0(0); PV_D0(1); PV_D0(2); PV_D0(3);
#undef PV_D0
#undef TRRD
}

struct Tensors { const float* QSS; const bf16_t* KB; const bf16_t* P1; const unsigned* MASK; bf16_t* AO; };
struct Blk { int b, g, qc; };
struct Seam { bf16x8 qr[8]; bf16x8 st_v0, st_v1, st_k0, st_k1; float qss; };
__device__ __forceinline__ const bf16_t* q_row(const Tensors& T, const Blk& k, int wid, int r32) { return T.P1 + (size_t)(k.b * mk::SEQ + k.qc * 64 + (wid & 1) * 32 + r32) * mk::N1P + mk::CQ + (4 * k.g + (wid >> 1)) * 128; }
__device__ __forceinline__ const float* qss_ptr(const Tensors& T, const Blk& k, int wid, int r32) { return T.QSS + (size_t)(k.b * mk::SEQ + k.qc * 64 + (wid & 1) * 32 + r32) * 8 + (4 * k.g + (wid >> 1)); }
__device__ __forceinline__ const bf16_t* k_row(const Tensors& T, const Blk& k, int key) { return T.KB + (size_t)(k.b * mk::SEQ + key) * 256 + k.g * 128; }
__device__ __forceinline__ const bf16_t* v_row(const Tensors& T, const Blk& k, int key) { return T.P1 + (size_t)(k.b * mk::SEQ + key) * mk::N1P + mk::CV + k.g * 128; }

#define VMW() asm volatile("s_waitcnt vmcnt(0)" ::: "memory")
#define VMWN(n) asm volatile("s_waitcnt vmcnt(%0)" :: "i"(n) : "memory")
#define SLOAD_H(blk, k0) do { S.st_v0 = *(const bf16x8*)(v_row(T, blk, (k0) + sr) + sc); S.st_v1 = *(const bf16x8*)(v_row(T, blk, (k0) + 32 + sr) + sc);   \
                              S.st_k0 = *(const bf16x8*)(k_row(T, blk, (k0) + sr) + sc); S.st_k1 = *(const bf16x8*)(k_row(T, blk, (k0) + 32 + sr) + sc); } while (0)
#define SWRITE_HK(bf) do { *(bf16x8*)(K_lds + (bf) * SHM_K + kws) = S.st_k0; *(bf16x8*)(K_lds + (bf) * SHM_K + kws + 32 * 256) = S.st_k1; } while (0)
#define SWRITE_HV(bf) do { *(bf16x8*)(V_lds + (bf) * SHM_V + vst0) = S.st_v0; *(bf16x8*)(V_lds + (bf) * SHM_V + vst0 + VST1) = S.st_v1; } while (0)
#define SWRITE_H(bf) do { SWRITE_HV(bf); SWRITE_HK(bf); } while (0)

__device__ __forceinline__ void dsa_prime(const Tensors& T, const Blk& cur, char* lds, Seam& S) {
    const int tid = mk::ltid(), wid = __builtin_amdgcn_readfirstlane(tid >> 6), lane = tid & 63, r32 = lane & 31, hi = lane >> 5;
    const int sr = tid >> 4, sc = (tid & 15) * 8, kws = KSWZ(sr, sc * 2); char* K_lds = lds + 2 * SHM_V;
    const bf16_t* qp = q_row(T, cur, wid, r32) + hi * 8;
    for (int d0 = 0; d0 < 8; ++d0) S.qr[d0] = *(const bf16x8*)(qp + d0 * 16);
    S.qss = *qss_ptr(T, cur, wid, r32);
    SLOAD_H(cur, 0); VMW(); SWRITE_HK(0);
    __syncthreads();
}
__device__ __forceinline__ void dsa_block(const Tensors& T, const Blk& cur, const Blk& nxt, char* lds, Seam& S) {
    const int tid = mk::ltid(), wid = __builtin_amdgcn_readfirstlane(tid >> 6), lane = tid & 63, r32 = lane & 31, hi = lane >> 5;
    const int NT = cur.qc + 1;
    char* V_lds = lds; char* K_lds = lds + 2 * SHM_V;
    float* ws = (float*)(lds + 2 * SHM_V + 2 * SHM_K) + wid * 64; float* li_l = ws, * al_l = ws + 32;
    float m_reg = -1e30f, l_reg = 0; f32x16 o[4] = {};
    const int sr = tid >> 4, sc = (tid & 15) * 8, vst0 = v_st(sr, sc), kws = KSWZ(sr, sc * 2);
    constexpr int VST1 = 8192;
    const int vb0 = (int)(uintptr_t)V_lds + v_rd_base(lane);
    const int qtok = cur.b * mk::SEQ + cur.qc * 64 + (wid & 1) * 32;
    const int moff = (qtok + r32) * 64;
#define LDMASK(t) (*(const uint2*)(T.MASK + (moff + 2 * (t))))
#define RESC(a) do { if (__any((a) < 1.f)) { if (hi == 0) al_l[r32] = (a); asm volatile("s_waitcnt lgkmcnt(0)" ::: "memory");              \
                     for (int d_ = 0; d_ < 4; ++d_) for (int r = 0; r < 16; ++r) o[d_][r] *= al_l[crow(r, hi)]; } } while (0)
#define KBASE(t) ((t) * KVBLK)
    constexpr int NQL = 9;
#define SEAM_K0() do { VMWN(NQL); SWRITE_HK(0); SBAR(); } while (0)
    f32x16 pA0, pA1, pB0, pB1; float mnA, mnB, alA, alB; bf16x8 pa0, pa1, pa2, pa3; uint2 mcur;
    {
        const float rs = rsqrtf(S.qss * (1.0f / 128) + mk::EPS);
#pragma unroll
        for (int d0 = 0; d0 < 8; ++d0) { u32x4 u = *reinterpret_cast<u32x4*>(&S.qr[d0]);
#pragma unroll
            for (int e = 0; e < 4; ++e) u[e] = cvtpk(__uint_as_float(u[e] << 16) * rs, __uint_as_float(u[e] & 0xFFFF0000u) * rs);
            S.qr[d0] = *reinterpret_cast<bf16x8*>(&u); }
    }
    SWRITE_HV(0); SBAR();
    if (NT > 1) { SLOAD_H(cur, KBASE(1)); }
    SBAR(); qkt<0>(pA0, pA1, K_lds, r32, hi, S.qr); mcur = LDMASK(0);
    partialSM(pA0, pA1, m_reg, mnA, alA);
    if (NT > 1) { VMW(); SWRITE_H(1); }
    __syncthreads();
#define HALF_STEP(PX0, PX1, mnX, alX, PY0, PY1, alY, t, KB, VB, SB) do {                                             \
        SBAR(); qkt<KB>(PX0, PX1, K_lds, r32, hi, S.qr);                                                                       \
        finishSM(PY0, PY1, alY, l_reg, mcur, hi, pa0, pa1, pa2, pa3); mcur = LDMASK(t); SBAR();                                                   \
        if ((t) + 1 < NT) { SLOAD_H(cur, KBASE((t) + 1)); SBAR(); }                                                           \
        pv_tile<VB>(o, vb0, pa0, pa1, pa2, pa3); partialSM(PX0, PX1, m_reg, mnX, alX);                                        \
        __syncthreads();                                                                                                      \
        if ((t) + 1 < NT) { VMW(); SWRITE_H(SB); }                                                                            \
        RESC(alX); __syncthreads(); } while (0)
    for (int t = 1; t + 1 < NT; t += 2) {
        HALF_STEP(pB0, pB1, mnB, alB, pA0, pA1, alA, t, 1, 0, 0);
        HALF_STEP(pA0, pA1, mnA, alA, pB0, pB1, alB, t + 1, 0, 1, 1);
    }
    const bool even = (NT & 1) == 0;
    if (even) { SBAR(); qkt<1>(pB0, pB1, K_lds, r32, hi, S.qr); SBAR(); }
    SLOAD_H(nxt, 0); SBAR();
    { const bf16_t* qp = q_row(T, nxt, wid, r32) + hi * 8;
#pragma unroll
      for (int d0 = 0; d0 < 8; ++d0) S.qr[d0] = *(const bf16x8*)(qp + d0 * 16);
      S.qss = *qss_ptr(T, nxt, wid, r32); }
    SBAR();
    finishSM(pA0, pA1, alA, l_reg, mcur, hi, pa0, pa1, pa2, pa3); if (even) mcur = LDMASK(NT - 1); SBAR();
    pv_tile<0>(o, vb0, pa0, pa1, pa2, pa3);
    if (even) { partialSM(pB0, pB1, m_reg, mnB, alB); __syncthreads(); RESC(alB);
        finishSM(pB0, pB1, alB, l_reg, mcur, hi, pa0, pa1, pa2, pa3); SBAR(); pv_tile<1>(o, vb0, pa0, pa1, pa2, pa3); }
    SBAR(); SEAM_K0();
    if (hi == 0) li_l[r32] = l_reg; asm volatile("s_waitcnt lgkmcnt(0)" ::: "memory");
    { const int le = mk::ltid() & 63, re = le & 31, he = le >> 5;
      const int hq = 4 * cur.g + (wid >> 1);
#pragma unroll
      for (int r = 0; r < 16; ++r) { const int orow = crow(r, he); const size_t tok = (size_t)(qtok + orow);
        const float rl = __builtin_amdgcn_rcpf(li_l[orow]);
        const bf16_t* gp = T.P1 + tok * mk::N1P + mk::CG + hq * 128 + re;
        bf16_t* op = T.AO + tok * mk::D + hq * 128 + re;
#pragma unroll
        for (int d0 = 0; d0 < 4; ++d0) { const float gt = mk::bf2f(gp[d0 * 32]);
            const float v = o[d0][r] * rl * (gt * __builtin_amdgcn_rcpf(1.0f + __builtin_amdgcn_exp2f(-1.4426950408889634f * gt)));
            const float vn = __int_as_float(__builtin_amdgcn_update_dpp(0, __float_as_int(v), 0xB1, 0xF, 0xF, false));
            if ((re & 1) == 0) *(unsigned*)(op + d0 * 32) = cvtpk(v, vn); } } }
    __syncthreads();
#undef LDMASK
#undef RESC
#undef KBASE
#undef SEAM_K0
#undef HALF_STEP
}
#undef VMW
#undef VMWN
#undef SLOAD_H
#undef SWRITE_HK
#undef SWRITE_HV
#undef SWRITE_H

__device__ __forceinline__ void attn_prompt_phase(const Tensors& T, char* lds, int bid, int nblk) {
    constexpr int NITEM = 256;
    if (bid >= NITEM) return;
    int id = bid, pass = 0;
    Blk cur{id & 7, (id >> 3) & 1, 31 - (id >> 4)};
    Seam S;
    dsa_prime(T, cur, lds, S);
    for (;;) {
        const bool more_pass = pass == 0, more_item = id + nblk < NITEM, last = !more_pass && !more_item;
        int idn = id, passn = pass + 1;
        if (!more_pass) { passn = 0; idn = more_item ? id + nblk : id; }
        Blk nxt = cur;
        if (!last) { nxt.b = idn & 7; nxt.g = (idn >> 3) & 1; nxt.qc = passn ? (idn >> 4) : 31 - (idn >> 4); }
        dsa_block(T, cur, nxt, lds, S);
        if (last) break;
        cur = nxt; id = idn; pass = passn;
    }
}
}

namespace dn {
using mk::bf16_t;
typedef short bf16x8 __attribute__((ext_vector_type(8)));
typedef float f32x16 __attribute__((ext_vector_type(16)));
constexpr int NITEM = mk::NB * 8 * 32;
constexpr size_t IT_W = 0, IT_QD = 16384, IT_KDT = 32768, IT_U0T = 49152, IT_QKD = 65536, IT_BYTES = 73728;
constexpr int L_KR = 0, L_QR = 17408, L_KT = 34816, L_VT = 53248, L_AM = 71680, L_TW = 89088, L_TU = 98304, L_SC = 107520, L_END = 108032;
constexpr int RS = 272;
constexpr int TS = 144;
constexpr int L_SK = 108032, L_SU = L_SK + 128 * 144, L_SEND = L_SU + 128 * 136, L_SW = L_AM;
static_assert(L_SEND <= 147456 - 16, "pre-phase LDS map");

__device__ __forceinline__ int crow(int r, int hi) { return (r & 3) + 8 * (r >> 2) + 4 * hi; }
__device__ __forceinline__ unsigned cvtpk(float lo, float hi) { return mk::cvtpk_native(lo, hi); }
__device__ __forceinline__ float silu_f(float x) { return x * __builtin_amdgcn_rcpf(1.0f + __builtin_amdgcn_exp2f(-1.4426950408889634f * x)); }
__device__ __forceinline__ float quad_sum(float v) {
    v += __int_as_float(__builtin_amdgcn_update_dpp(0, __float_as_int(v), 0xB1, 0xF, 0xF, false));
    v += __int_as_float(__builtin_amdgcn_update_dpp(0, __float_as_int(v), 0x4E, 0xF, 0xF, false));
    return v;
}

struct PreArgs { const bf16_t* P2; const float* BA; const float* conv_w; const float* A_log; const float* dt_bias; unsigned char* CH; float* EG; float* out; };

struct PreRaw { unsigned x[3][11]; float wc[3][4][2]; float bv, av; };
__device__ __forceinline__ void pre_load(const PreArgs& a, int item, PreRaw& R) {
    const int tid = mk::ltid(), w = __builtin_amdgcn_readfirstlane(tid >> 6), l = tid & 63;
    const int c = item & 31, h = (item >> 5) & 7, b = item >> 8;
    const int m0 = b * mk::SEQ + c * 64;
    R.bv = a.BA[(size_t)(m0 + l) * 16 + h]; R.av = a.BA[(size_t)(m0 + l) * 16 + 8 + h];
#pragma unroll
    for (int part = 0; part < 3; ++part) {
        const int colb = part * 1024 + h * 128 + 2 * l;
#pragma unroll
        for (int i = 0; i < 4; ++i) { const float2 t = *(const float2*)(a.conv_w + (size_t)i * mk::CONV + colb); R.wc[part][i][0] = t.x; R.wc[part][i][1] = t.y; }
#pragma unroll
        for (int k = 0; k < 11; ++k) {
            const int rl = 8 * w + k - 3;
            unsigned u = 0u;
            if (rl >= 0 || c > 0) u = __builtin_nontemporal_load((const unsigned*)(a.P2 + (size_t)(m0 + rl) * mk::N3P + colb));
            R.x[part][k] = u;
        }
    }
}
__device__ __forceinline__ void pre_item(const PreArgs& a, int item, int next, char* lds, PreRaw& R) {
    const int tid = mk::ltid(), w = __builtin_amdgcn_readfirstlane(tid >> 6), l = tid & 63, r32 = l & 31, hh = l >> 5;
    const int c = item & 31, h = (item >> 5) & 7, b = item >> 8;
    const int m0 = b * mk::SEQ + c * 64;
    unsigned char* ch = a.CH + (size_t)item * IT_BYTES;
    float* sc_beta = (float*)(lds + L_SC); float* sc_gc = sc_beta + 64;
    float beta_l, gc_l;
    {
        const float bv = R.bv, av = R.av;
        beta_l = __builtin_amdgcn_rcpf(1.0f + __expf(-bv));
        const float x = av + a.dt_bias[h];
        const float sp = x > 20.f ? x : log1pf(__expf(x));
        float g = -__expf(a.A_log[h]) * sp;
#pragma unroll
        for (int o = 1; o < 64; o <<= 1) { const float t = __shfl_up(g, o); if (l >= o) g += t; }
        gc_l = g;
    }
    const float gc_last = __shfl(gc_l, 63);
    if (w == 0) { sc_beta[l] = beta_l; sc_gc[l] = gc_l; if (l == 0) a.EG[item] = __expf(gc_last); }
    {
        float sq[8][2], sk[8][2], sv[8][2];
#pragma unroll
        for (int part = 0; part < 3; ++part) {
            const int colb = part * 1024 + h * 128 + 2 * l;
            float wc[4][2];
#pragma unroll
            for (int i = 0; i < 4; ++i) { wc[i][0] = R.wc[part][i][0]; wc[i][1] = R.wc[part][i][1]; }
            float x[11][2];
#pragma unroll
            for (int k = 0; k < 11; ++k) { const unsigned u = R.x[part][k]; x[k][0] = __uint_as_float(u << 16); x[k][1] = __uint_as_float(u & 0xFFFF0000u); }
            if (c == 31 && w == 7) {
#pragma unroll
                for (int j = 0; j < 3; ++j) *(float2*)(a.out + mk::O_CP + ((size_t)b * 3 + j) * mk::CONV + colb) = make_float2(x[8 + j][0], x[8 + j][1]);
            }
#pragma unroll
            for (int rr = 0; rr < 8; ++rr) {
#pragma unroll
                for (int e = 0; e < 2; ++e) {
                    float y = wc[0][e] * x[rr][e]; y = fmaf(wc[1][e], x[rr + 1][e], y); y = fmaf(wc[2][e], x[rr + 2][e], y); y = fmaf(wc[3][e], x[rr + 3][e], y);
                    const float s = silu_f(y);
                    if (part == 0) sq[rr][e] = s; else if (part == 1) sk[rr][e] = s; else sv[rr][e] = s;
                }
            }
        }
        if (next >= 0) pre_load(a, next, R);
        float nq[8], nk[8];
#pragma unroll
        for (int rr = 0; rr < 8; ++rr) { nq[rr] = sq[rr][0] * sq[rr][0] + sq[rr][1] * sq[rr][1]; nk[rr] = sk[rr][0] * sk[rr][0] + sk[rr][1] * sk[rr][1]; }
        mk::wave_sum_n<8>(nq); mk::wave_sum_n<8>(nk);
        unsigned ktp[2][4], vtp[2][4], kdp[2][4];
#pragma unroll
        for (int rr = 0; rr < 8; ++rr) {
            const int i = 8 * w + rr;
            const float rq = rsqrtf(nq[rr] + mk::EPS) * 0.08838834764831845f;
            const float rk = rsqrtf(nk[rr] + mk::EPS);
            const float gci = __shfl(gc_l, i);
            const float eg = __expf(gci), egl = __expf(gc_last - gci);
            const float q0 = sq[rr][0] * rq, q1 = sq[rr][1] * rq, k0 = sk[rr][0] * rk, k1 = sk[rr][1] * rk;
            *(unsigned*)(lds + L_QR + i * RS + 4 * l) = cvtpk(q0, q1);
            *(unsigned*)(lds + L_KR + i * RS + 4 * l) = cvtpk(k0, k1);
            *(unsigned*)(ch + IT_QD + (size_t)i * 256 + 4 * l) = cvtpk(q0 * eg, q1 * eg);
            if ((rr & 1) == 0) { sq[rr][0] = k0; sq[rr][1] = k1; }
            else {
                ktp[0][rr >> 1] = cvtpk(sq[rr - 1][0], k0); ktp[1][rr >> 1] = cvtpk(sq[rr - 1][1], k1);
                vtp[0][rr >> 1] = cvtpk(sv[rr - 1][0], sv[rr][0]); vtp[1][rr >> 1] = cvtpk(sv[rr - 1][1], sv[rr][1]);
                const float gcp = __shfl(gc_l, i - 1); const float eglp = __expf(gc_last - gcp);
                kdp[0][rr >> 1] = cvtpk(sq[rr - 1][0] * eglp, k0 * egl); kdp[1][rr >> 1] = cvtpk(sq[rr - 1][1] * eglp, k1 * egl);
            }
        }
#pragma unroll
        for (int e = 0; e < 2; ++e) {
            *(uint4*)(lds + L_KT + (2 * l + e) * TS + 16 * w) = make_uint4(ktp[e][0], ktp[e][1], ktp[e][2], ktp[e][3]);
            *(uint4*)(lds + L_VT + (2 * l + e) * TS + 16 * w) = make_uint4(vtp[e][0], vtp[e][1], vtp[e][2], vtp[e][3]);
            *(uint4*)(lds + L_SK + (2 * l + e) * 144 + 16 * w) = make_uint4(kdp[e][0], kdp[e][1], kdp[e][2], kdp[e][3]);
        }
    }
    mk::lds_barrier();
#pragma unroll
    for (int j = 0; j < 2; ++j) { const int pc = tid + 512 * j;
        *(uint4*)(ch + IT_KDT + (size_t)16 * pc) = *(const uint4*)(lds + L_SK + (pc >> 3) * 144 + 16 * (pc & 7)); }
    if (w < 6) {
        const int kind = w >= 3, tix = kind ? w - 3 : w, ti = tix > 0, tj = tix > 1;
        const char* ap = lds + (kind ? L_QR : L_KR) + (32 * ti + r32) * RS + 16 * hh;
        const char* bp = lds + L_KR + (32 * tj + r32) * RS + 16 * hh;
        f32x16 acc = {};
#pragma unroll
        for (int s = 0; s < 8; ++s) acc = __builtin_amdgcn_mfma_f32_32x32x16_bf16(*(const bf16x8*)(ap + 32 * s), *(const bf16x8*)(bp + 32 * s), acc, 0, 0, 0);
        const int j = 32 * tj + r32; const float gcj = sc_gc[j];
#pragma unroll
        for (int r = 0; r < 16; ++r) {
            const int i = 32 * ti + crow(r, hh);
            const float dec = __expf(sc_gc[i] - gcj);
            if (!kind) { const float v = (i > j) ? sc_beta[i] * acc[r] * dec : 0.f; *(float*)(lds + L_AM + i * RS + 4 * j) = v; }
            else { const float v = (i >= j) ? acc[r] * dec : 0.f; const float vn = __shfl_xor(v, 1);
                   if ((r32 & 1) == 0) *(unsigned*)(ch + IT_QKD + (size_t)i * 128 + 2 * j) = cvtpk(v, vn); }
        }
    } else if (w == 6) {
#pragma unroll
        for (int k = 0; k < 16; ++k) { const int e = l + 64 * k; *(float*)(lds + L_AM + (e >> 5) * RS + 4 * (32 + (e & 31))) = 0.f; }
    }
    mk::lds_barrier();
    constexpr int L_T1T = L_KR, L_TBR = L_KR + 2560, L_P3T = L_KR + 5120;
    if (w < 2) {
        const int blk = w, ccl = l >> 1, q = l & 1, cc = 32 * blk + ccl;
        float x[16];
#pragma unroll
        for (int k = 0; k < 16; ++k) x[k] = 0.f;
        const char* arow = lds + L_AM + (32 * blk) * RS + 4 * (32 * blk) + 16 * q;
#pragma unroll
        for (int ib = 0; ib < 8; ++ib) {
            const int i0 = 4 * ib, aS = ib >> 1, qS = ib & 1;
            float p[4] = {0.f, 0.f, 0.f, 0.f};
#pragma unroll
            for (int rr = 0; rr < 4; ++rr)
#pragma unroll
                for (int a4 = 0; a4 <= aS; ++a4) { const float4 av = *(const float4*)(arow + (i0 + rr) * RS + 32 * a4);
                    p[rr] = fmaf(av.x, x[4 * a4], p[rr]); p[rr] = fmaf(av.y, x[4 * a4 + 1], p[rr]); p[rr] = fmaf(av.z, x[4 * a4 + 2], p[rr]); p[rr] = fmaf(av.w, x[4 * a4 + 3], p[rr]); }
#pragma unroll
            for (int rr = 0; rr < 4; ++rr) p[rr] += __int_as_float(__builtin_amdgcn_update_dpp(0, __float_as_int(p[rr]), 0xB1, 0xF, 0xF, false));
            const char* rb = lds + L_AM + (32 * blk + i0) * RS + 4 * (32 * blk + i0);
            const float4 r1 = *(const float4*)(rb + RS), r2 = *(const float4*)(rb + 2 * RS), r3 = *(const float4*)(rb + 3 * RS);
            const float x0 = ((i0 == ccl) ? 1.f : 0.f) - p[0];
            const float x1 = ((i0 + 1 == ccl) ? 1.f : 0.f) - p[1] - r1.x * x0;
            const float x2 = ((i0 + 2 == ccl) ? 1.f : 0.f) - p[2] - r2.x * x0 - r2.y * x1;
            const float x3 = ((i0 + 3 == ccl) ? 1.f : 0.f) - p[3] - r3.x * x0 - r3.y * x1 - r3.z * x2;
            if (q == qS) { x[4 * aS] = x0; x[4 * aS + 1] = x1; x[4 * aS + 2] = x2; x[4 * aS + 3] = x3; }
        }
        const float bc = sc_beta[cc], bw = bc * __expf(sc_gc[cc]);
#pragma unroll
        for (int k = 0; k < 16; ++k) { const int j = 8 * (k >> 2) + 4 * q + (k & 3);
            *(bf16_t*)(lds + L_TW + (32 * blk + j) * TS + 2 * cc) = mk::f2bf(x[k] * bw);
            *(bf16_t*)(lds + L_TU + (32 * blk + j) * TS + 2 * cc) = mk::f2bf(x[k] * bc);
            if (blk == 1) *(bf16_t*)(lds + L_TBR + j * 80 + 2 * ccl) = mk::f2bf(x[k]); }
        if (blk == 0) {
#pragma unroll
            for (int a4 = 0; a4 < 4; ++a4) *(uint2*)(lds + L_T1T + ccl * 80 + 2 * (8 * a4 + 4 * q)) = make_uint2(cvtpk(x[4 * a4], x[4 * a4 + 1]), cvtpk(x[4 * a4 + 2], x[4 * a4 + 3]));
        }
    }
    mk::lds_barrier();
    if (w == 0) {
        f32x16 a3 = {};
#pragma unroll
        for (int s = 0; s < 2; ++s) {
            const float4 f0 = *(const float4*)(lds + L_AM + (32 + r32) * RS + 4 * (16 * s + 8 * hh)), f1 = *(const float4*)(lds + L_AM + (32 + r32) * RS + 4 * (16 * s + 8 * hh) + 16);
            mk::u32x4_t au_ = {cvtpk(f0.x, f0.y), cvtpk(f0.z, f0.w), cvtpk(f1.x, f1.y), cvtpk(f1.z, f1.w)};
            a3 = __builtin_amdgcn_mfma_f32_32x32x16_bf16(*reinterpret_cast<bf16x8*>(&au_), *(const bf16x8*)(lds + L_T1T + r32 * 80 + 2 * (16 * s + 8 * hh)), a3, 0, 0, 0);
        }
#pragma unroll
        for (int g = 0; g < 4; ++g) *(uint2*)(lds + L_P3T + r32 * 80 + 2 * (8 * g + 4 * hh)) = make_uint2(cvtpk(a3[4 * g], a3[4 * g + 1]), cvtpk(a3[4 * g + 2], a3[4 * g + 3]));
        asm volatile("s_waitcnt lgkmcnt(0)" ::: "memory");
        f32x16 a4 = {};
#pragma unroll
        for (int s = 0; s < 2; ++s)
            a4 = __builtin_amdgcn_mfma_f32_32x32x16_bf16(*(const bf16x8*)(lds + L_TBR + r32 * 80 + 2 * (16 * s + 8 * hh)), *(const bf16x8*)(lds + L_P3T + r32 * 80 + 2 * (16 * s + 8 * hh)), a4, 0, 0, 0);
        const float bc = sc_beta[r32], bw = bc * __expf(sc_gc[r32]);
#pragma unroll
        for (int r = 0; r < 16; ++r) { const int i = 32 + crow(r, hh);
            *(bf16_t*)(lds + L_TW + i * TS + 2 * r32) = mk::f2bf(-a4[r] * bw);
            *(bf16_t*)(lds + L_TU + i * TS + 2 * r32) = mk::f2bf(-a4[r] * bc); }
    }
    mk::lds_barrier();
    {
        const int it = w >> 2, dt = w & 3, ns = it ? 4 : 2;
        f32x16 aw = {}, au = {};
        const char* kt = lds + L_KT + (32 * dt + r32) * TS + 16 * hh;
        const char* vt = lds + L_VT + (32 * dt + r32) * TS + 16 * hh;
        const char* tw = lds + L_TW + (32 * it + r32) * TS + 16 * hh;
        const char* tu = lds + L_TU + (32 * it + r32) * TS + 16 * hh;
#pragma unroll
        for (int s = 0; s < 4; ++s) if (s < ns) {
            aw = __builtin_amdgcn_mfma_f32_32x32x16_bf16(*(const bf16x8*)(kt + 32 * s), *(const bf16x8*)(tw + 32 * s), aw, 0, 0, 0);
            au = __builtin_amdgcn_mfma_f32_32x32x16_bf16(*(const bf16x8*)(tu + 32 * s), *(const bf16x8*)(vt + 32 * s), au, 0, 0, 0);
        }
#pragma unroll
        for (int g = 0; g < 4; ++g) {
            *(uint2*)(lds + L_SW + (32 * it + r32) * RS + 2 * (32 * dt + 8 * g + 4 * hh)) = make_uint2(cvtpk(aw[4 * g], aw[4 * g + 1]), cvtpk(aw[4 * g + 2], aw[4 * g + 3]));
            *(uint2*)(lds + L_SU + (32 * dt + r32) * 136 + 2 * (32 * it + 8 * g + 4 * hh)) = make_uint2(cvtpk(au[4 * g], au[4 * g + 1]), cvtpk(au[4 * g + 2], au[4 * g + 3]));
        }
    }
    mk::lds_barrier();
#pragma unroll
    for (int j = 0; j < 2; ++j) { const int pc = tid + 512 * j;
        *(uint4*)(ch + IT_W + (size_t)16 * pc) = *(const uint4*)(lds + L_SW + (pc >> 4) * RS + 16 * (pc & 15)); }
#pragma unroll
    for (int j = 0; j < 4; ++j) { const int pc = tid + 512 * j;
        *(uint2*)(ch + IT_U0T + (size_t)8 * pc) = *(const uint2*)(lds + L_SU + (pc >> 4) * 136 + 8 * (pc & 15)); }
}

constexpr int SL_ST = 0, SL_UT = 8704, SL_END = 8704 + 4608;
struct ScanArgs { const unsigned char* CH; const float* EG; bf16_t* ORAW; float* out; };

__device__ __forceinline__ void scan_item(const ScanArgs& a, int bh, int sl, char* lds) {
    const int tid = mk::ltid(), w = __builtin_amdgcn_readfirstlane(tid >> 6), l = tid & 63, r32 = l & 31, hh = l >> 5;
    const int b = bh >> 3, h = bh & 7;
    const unsigned char* chb = a.CH + (size_t)bh * 32 * IT_BYTES;
    for (int k = tid; k < SL_END / 4; k += 512) ((unsigned*)lds)[k] = 0u;
    __syncthreads();
    const char* stp = lds + SL_ST + r32 * RS + 16 * hh;
    const char* utp = lds + SL_UT + r32 * TS + 16 * hh;
    if (w < 2) {
        const int tt = w;
        bf16x8 wf[4][8]; uint2 u0[4][4];
#define LD_W(dst, dstu, cix) do { const unsigned char* cb = chb + (size_t)(cix) * IT_BYTES; \
        _Pragma("unroll") for (int s = 0; s < 8; ++s) dst[s] = *(const bf16x8*)(cb + IT_W + (size_t)(32 * tt + r32) * 256 + 32 * s + 16 * hh); \
        _Pragma("unroll") for (int g = 0; g < 4; ++g) dstu[g] = *(const uint2*)(cb + IT_U0T + (size_t)(32 * sl + r32) * 128 + 2 * (32 * tt + 8 * g + 4 * hh)); } while (0)
        LD_W(wf[0], u0[0], 0); LD_W(wf[1], u0[1], 1); LD_W(wf[2], u0[2], 2);
        for (int c0 = 0; c0 < 32; c0 += 4) {
#pragma unroll
            for (int k = 0; k < 4; ++k) {
                const int c = c0 + k;
                if (c + 3 < 32) LD_W(wf[(k + 3) & 3], u0[(k + 3) & 3], c + 3);
                f32x16 acc = {};
#pragma unroll
                for (int s = 0; s < 8; ++s) acc = __builtin_amdgcn_mfma_f32_32x32x16_bf16(wf[k][s], *(const bf16x8*)(stp + 32 * s), acc, 0, 0, 0);
#pragma unroll
                for (int g = 0; g < 4; ++g) {
                    const float a0 = __uint_as_float(u0[k][g].x << 16) - acc[4 * g], a1 = __uint_as_float(u0[k][g].x & 0xFFFF0000u) - acc[4 * g + 1];
                    const float a2 = __uint_as_float(u0[k][g].y << 16) - acc[4 * g + 2], a3 = __uint_as_float(u0[k][g].y & 0xFFFF0000u) - acc[4 * g + 3];
                    *(uint2*)(lds + SL_UT + r32 * TS + 2 * (32 * tt + 8 * g + 4 * hh)) = make_uint2(cvtpk(a0, a1), cvtpk(a2, a3));
                }
                mk::lds_barrier();
                mk::lds_barrier();
            }
        }
#undef LD_W
    } else if (w < 4) {
        const int tt = w - 2;
        bf16x8 qf[4][8], pf[4][4];
#pragma unroll
        for (int k = 0; k < 4; ++k)
#pragma unroll
            for (int s = 0; s < 4; ++s) pf[k][s] = bf16x8{};
#define LD_Q(dq, dp, cix) do { const unsigned char* cb = chb + (size_t)(cix) * IT_BYTES; \
        _Pragma("unroll") for (int s = 0; s < 8; ++s) dq[s] = *(const bf16x8*)(cb + IT_QD + (size_t)(32 * tt + r32) * 256 + 32 * s + 16 * hh); \
        _Pragma("unroll") for (int s = 0; s < 4; ++s) if (s < 2 * (tt + 1)) dp[s] = *(const bf16x8*)(cb + IT_QKD + (size_t)(32 * tt + r32) * 128 + 32 * s + 16 * hh); } while (0)
        LD_Q(qf[0], pf[0], 0); LD_Q(qf[1], pf[1], 1); LD_Q(qf[2], pf[2], 2);
        const size_t orow0 = (size_t)(b * mk::SEQ + 32 * tt) * mk::D + h * 128 + 32 * sl + r32;
        for (int c0 = 0; c0 < 32; c0 += 4) {
#pragma unroll
            for (int k = 0; k < 4; ++k) {
                const int c = c0 + k;
                if (c + 3 < 32) LD_Q(qf[(k + 3) & 3], pf[(k + 3) & 3], c + 3);
                f32x16 acc = {};
#pragma unroll
                for (int s = 0; s < 8; ++s) acc = __builtin_amdgcn_mfma_f32_32x32x16_bf16(qf[k][s], *(const bf16x8*)(stp + 32 * s), acc, 0, 0, 0);
                mk::lds_barrier();
#pragma unroll
                for (int s = 0; s < 4; ++s) if (s < 2 * (tt + 1)) acc = __builtin_amdgcn_mfma_f32_32x32x16_bf16(pf[k][s], *(const bf16x8*)(utp + 32 * s), acc, 0, 0, 0);
#pragma unroll
                for (int r = 0; r < 16; ++r) { const float v = acc[r]; const float vn = __shfl_xor(v, 1);
                    if ((r32 & 1) == 0) *(unsigned*)(a.ORAW + orow0 + (size_t)(64 * c + crow(r, hh)) * mk::D) = cvtpk(v, vn); }
                mk::lds_barrier();
            }
        }
#undef LD_Q
    } else {
        const int dt = w - 4;
        bf16x8 kf[4][4]; float eg[4];
#define LD_S(dk_, deg, cix) do { const unsigned char* cb = chb + (size_t)(cix) * IT_BYTES; \
        _Pragma("unroll") for (int s = 0; s < 4; ++s) dk_[s] = *(const bf16x8*)(cb + IT_KDT + (size_t)(32 * dt + r32) * 128 + 32 * s + 16 * hh); \
        deg = a.EG[bh * 32 + (cix)]; } while (0)
        LD_S(kf[0], eg[0], 0); LD_S(kf[1], eg[1], 1); LD_S(kf[2], eg[2], 2);
        f32x16 S = {};
        for (int c0 = 0; c0 < 32; c0 += 4) {
#pragma unroll
            for (int k = 0; k < 4; ++k) {
                const int c = c0 + k;
                if (c + 3 < 32) LD_S(kf[(k + 3) & 3], eg[(k + 3) & 3], c + 3);
#pragma unroll
                for (int r = 0; r < 16; ++r) S[r] *= eg[k];
                mk::lds_barrier();
#pragma unroll
                for (int s = 0; s < 4; ++s) S = __builtin_amdgcn_mfma_f32_32x32x16_bf16(kf[k][s], *(const bf16x8*)(utp + 32 * s), S, 0, 0, 0);
#pragma unroll
                for (int g = 0; g < 4; ++g)
                    *(uint2*)(lds + SL_ST + r32 * RS + 2 * (32 * dt + 8 * g + 4 * hh)) = make_uint2(cvtpk(S[4 * g], S[4 * g + 1]), cvtpk(S[4 * g + 2], S[4 * g + 3]));
                mk::lds_barrier();
            }
        }
#undef LD_S
        float* so = a.out + mk::O_SP + ((size_t)bh * 128) * 128 + 32 * sl + r32;
#pragma unroll
        for (int r = 0; r < 16; ++r) so[(size_t)(32 * dt + crow(r, hh)) * 128] = S[r];
    }
    __syncthreads();
}
}

namespace mk {
__device__ __forceinline__ unsigned f2key(float f) { f += 0.0f; unsigned u = __float_as_uint(f); return (u & 0x80000000u) ? ~u : (u | 0x80000000u); }
__device__ __forceinline__ int block_sum_i512(int c, int* red) {
    c += __shfl_xor(c, 32); c += __shfl_xor(c, 16); c += __shfl_xor(c, 8); c += __shfl_xor(c, 4); c += __shfl_xor(c, 2); c += __shfl_xor(c, 1);
    __syncthreads();
    if ((mk::ltid() & 63) == 0) red[mk::ltid() >> 6] = c;
    __syncthreads();
    return red[0] + red[1] + red[2] + red[3] + red[4] + red[5] + red[6] + red[7];
}
__device__ __forceinline__ void attend_sample_row(int r, char* lds, const float* QSS, const float* qg, const bf16_t* P1, const float* CS, const int* CI, const float* out, const float* cache_k, const float* cache_v, const int* page_table, bf16_t* AO) {
    float* lg = (float*)lds;
    int* rowi = (int*)(lg + 2048);
    int* pt = rowi + 256;
    float* red = (float*)(pt + 128);
    bf16_t* qs = (bf16_t*)(red + 64);
    float* part = (float*)(qs + 1024);
    const int m = MP + r, b = r / DS, t = mk::ltid(), w = __builtin_amdgcn_readfirstlane(t >> 6), l = t & 63;
    {
        const unsigned u = ((const unsigned*)(P1 + (size_t)m * N1P + CQ))[t];
        const float rs = rsqrtf(QSS[(size_t)m * 8 + (t >> 6)] * (1.0f / 128) + EPS);
        ((unsigned*)qs)[t] = pk2bf(__uint_as_float(u << 16) * rs * qg[(2 * t) & 127], __uint_as_float(u & 0xFFFF0000u) * rs * qg[(2 * t + 1) & 127]);
    }
    if (t >= 64 && t < 64 + NPG) pt[t - 64] = page_table[b * NPG + t - 64];
    if (w == 0) {
        float sc[32]; int ci[32];
        const float* cs = CS + (size_t)r * 8 * ix::TOPK; const int* cip = CI + (size_t)r * 8 * ix::TOPK;
#pragma unroll
        for (int k = 0; k < 32; ++k) { sc[k] = cs[64 * k + l]; ci[k] = cip[64 * k + l]; }
        __syncthreads();
        int run = 0;
        ix::topk_select<32, 32>(sc, [&](int k, unsigned long long bm) {
            const bool mine = (bm >> l) & 1ull;
            const int pos = run + __builtin_popcountll(bm & ((1ull << l) - 1ull));
            if (mine) { const int idx = ci[k]; rowi[pos] = idx < PAST ? pt[idx >> 7] * PAGE + (idx & (PAGE - 1)) : -(b * DS + (idx - PAST)) - 1; }
            run += __builtin_popcountll(bm);
        });
    } else __syncthreads();
    __syncthreads();
    const int rr = l & 31, hh = l >> 5;
    f32x16 acc0 = {}, acc1 = {};
    {
        const int ri = rowi[32 * w + rr];
        const float* kr = (ri >= 0 ? cache_k + (size_t)ri * 256 : out + O_KS + (size_t)(-ri - 1) * 256) + 8 * hh;
        float4 kf[2][8][2];
#pragma unroll
        for (int g = 0; g < 2; ++g)
#pragma unroll
            for (int s = 0; s < 8; ++s) { kf[g][s][0] = *(const float4*)(kr + g * 128 + 16 * s); kf[g][s][1] = *(const float4*)(kr + g * 128 + 16 * s + 4); }
        const bf16_t* qa = qs + (rr & 3) * 128 + 8 * hh;
#pragma unroll
        for (int s = 0; s < 8; ++s) {
            bf16x8 a0 = *(const bf16x8*)(qa + 16 * s), a1 = *(const bf16x8*)(qa + 512 + 16 * s);
            if (rr >= 4) { a0 = bf16x8{}; a1 = bf16x8{}; }
            { const float4 x = kf[0][s][0], y = kf[0][s][1];
              u32x4_t u = {cvtpk_native(x.x, x.y), cvtpk_native(x.z, x.w), cvtpk_native(y.x, y.y), cvtpk_native(y.z, y.w)};
              acc0 = __builtin_amdgcn_mfma_f32_32x32x16_bf16(a0, *reinterpret_cast<bf16x8*>(&u), acc0, 0, 0, 0); }
            { const float4 x = kf[1][s][0], y = kf[1][s][1];
              u32x4_t u = {cvtpk_native(x.x, x.y), cvtpk_native(x.z, x.w), cvtpk_native(y.x, y.y), cvtpk_native(y.z, y.w)};
              acc1 = __builtin_amdgcn_mfma_f32_32x32x16_bf16(a1, *reinterpret_cast<bf16x8*>(&u), acc1, 0, 0, 0); }
        }
    }
    __builtin_amdgcn_sched_barrier(0);
    float4 vf[32];
#pragma unroll
    for (int jj = 0; jj < 32; ++jj) { const int ri = rowi[32 * w + jj];
        vf[jj] = *(const float4*)((ri >= 0 ? cache_v + (size_t)ri * 256 : out + O_VS + (size_t)(-ri - 1) * 256) + 4 * l); }
    if (hh == 0) {
        *(float4*)(lg + (32 * w + rr) * 8) = make_float4(acc0[0] * 0.08838834764831845f, acc0[1] * 0.08838834764831845f, acc0[2] * 0.08838834764831845f, acc0[3] * 0.08838834764831845f);
        *(float4*)(lg + (32 * w + rr) * 8 + 4) = make_float4(acc1[0] * 0.08838834764831845f, acc1[1] * 0.08838834764831845f, acc1[2] * 0.08838834764831845f, acc1[3] * 0.08838834764831845f);
    }
    mk::lds_barrier();
    {
        float x[4], mx = -INFINITY;
#pragma unroll
        for (int i = 0; i < 4; ++i) { x[i] = lg[(l + 64 * i) * 8 + w]; mx = fmaxf(mx, x[i]); }
#pragma unroll
        for (int o = 32; o > 0; o >>= 1) mx = fmaxf(mx, __shfl_xor(mx, o));
        float s = 0.f;
#pragma unroll
        for (int i = 0; i < 4; ++i) { x[i] = __expf(x[i] - mx); s += x[i]; lg[(l + 64 * i) * 8 + w] = x[i]; }
        s = wave_sum(s);
        if (l == 0) red[w] = 1.0f / s;
    }
    mk::lds_barrier();
    {
        float4 o0 = make_float4(0.f, 0.f, 0.f, 0.f), o1 = o0, o2 = o0, o3 = o0;
#pragma unroll
        for (int jj = 0; jj < 32; ++jj) {
            const float4 p4 = *(const float4*)(lg + (32 * w + jj) * 8 + 4 * hh); const float4 v = vf[jj];
            o0.x = fmaf(p4.x, v.x, o0.x); o0.y = fmaf(p4.x, v.y, o0.y); o0.z = fmaf(p4.x, v.z, o0.z); o0.w = fmaf(p4.x, v.w, o0.w);
            o1.x = fmaf(p4.y, v.x, o1.x); o1.y = fmaf(p4.y, v.y, o1.y); o1.z = fmaf(p4.y, v.z, o1.z); o1.w = fmaf(p4.y, v.w, o1.w);
            o2.x = fmaf(p4.z, v.x, o2.x); o2.y = fmaf(p4.z, v.y, o2.y); o2.z = fmaf(p4.z, v.z, o2.z); o2.w = fmaf(p4.z, v.w, o2.w);
            o3.x = fmaf(p4.w, v.x, o3.x); o3.y = fmaf(p4.w, v.y, o3.y); o3.z = fmaf(p4.w, v.z, o3.z); o3.w = fmaf(p4.w, v.w, o3.w);
        }
        float* pp = part + w * 1024 + (4 * hh) * 128 + 4 * rr;
        *(float4*)(pp) = o0; *(float4*)(pp + 128) = o1; *(float4*)(pp + 256) = o2; *(float4*)(pp + 384) = o3;
    }
    __syncthreads();
    {
        const int c0 = 2 * t, h = c0 >> 7;
        float o0 = 0.f, o1 = 0.f;
#pragma unroll
        for (int ww = 0; ww < 8; ++ww) { const float2 x = *(const float2*)(part + ww * 1024 + c0); o0 += x.x; o1 += x.y; }
        const float rinv = red[h];
        const bf16_t* gate = P1 + (size_t)m * N1P + CG + c0;
        *(unsigned*)(AO + (size_t)m * D + c0) = pk2bf(o0 * rinv * silu(bf2f(gate[0])), o1 * rinv * silu(bf2f(gate[1])));
    }
    __syncthreads();
}

__device__ __forceinline__ void dn_post_row(int m, char* lds, const bf16_t* P2, const float* BA, const float* conv_w, const float* conv_state, const float* A_log, const float* dt_bias,
                                            float* QC, float* KC, float* VC, float* BETA, float* G, float* out) {
    float* y = (float*)lds;
    const int t = mk::ltid();
    const int b = (m - MP) / DS, tt = (m - MP) % DS;
    {
        float xv[6][4], wv[6][4];
#pragma unroll
        for (int k = 0; k < 6; ++k) { const int c = t + 512 * k;
#pragma unroll
            for (int i = 0; i < 4; ++i) { const int j = tt + i;
                xv[k][i] = (j < 3) ? conv_state[((size_t)b * 3 + j) * CONV + c] : bf2f(P2[(size_t)(m - tt + (j - 3)) * N3P + c]);
                wv[k][i] = conv_w[i * CONV + c]; } }
#pragma unroll
        for (int k = 0; k < 6; ++k) { const int c = t + 512 * k;
            float acc = wv[k][0] * xv[k][0]; acc += wv[k][1] * xv[k][1]; acc += wv[k][2] * xv[k][2]; acc += wv[k][3] * xv[k][3];
            y[c] = silu(acc);
            if (tt >= DS - 3) out[O_CS + ((size_t)b * 3 + (tt - (DS - 3))) * CONV + c] = xv[k][3]; }
    }
    __syncthreads();
    const int w = t >> 6, l = t & 63;
    for (int hh = w; hh < 16; hh += 8) {
        const float a = y[hh * 128 + l], bb = y[hh * 128 + 64 + l];
        const float ss = wave_sum(a * a + bb * bb);
        float r = rsqrtf(ss + EPS);
        if (hh < 8) { r *= 0.08838834764831845f; QC[(size_t)m * D + hh * 128 + l] = a * r; QC[(size_t)m * D + hh * 128 + 64 + l] = bb * r; }
        else { KC[(size_t)m * D + (hh - 8) * 128 + l] = a * r; KC[(size_t)m * D + (hh - 8) * 128 + 64 + l] = bb * r; }
    }
    for (int c = t; c < 1024; c += 512) VC[(size_t)m * D + c] = y[2048 + c];
    if (t < 8) {
        const float bv = BA[(size_t)m * 16 + t], av = BA[(size_t)m * 16 + 8 + t];
        BETA[(size_t)m * 8 + t] = 1.0f / (1.0f + expf(-bv));
        const float x = av + dt_bias[t];
        const float sp = x > 20.f ? x : log1pf(expf(x));
        G[(size_t)m * 8 + t] = -expf(A_log[t]) * sp;
    }
    __syncthreads();
}

__device__ __forceinline__ void dn_scan_sample(int it, char* lds, const float* QC, const float* KC, const float* VC, const float* BETA, const float* G, const float* S0, bf16_t* ORAW, float* out) {
    const int t = mk::ltid(), v = t & 127, hq = __builtin_amdgcn_readfirstlane(t >> 7);
    float* qs = (float*)lds; float* ks = qs + DS * 128; float* ex = ks + DS * 128;
    const int b = it >> 3, h = it & 7, m0 = MP + b * DS;
    float S[32], vv[DS], beta[DS], alpha[DS];
    const float* sp = S0 + (((size_t)b * 8 + h) * 128 + hq * 32) * 128 + v;
#pragma unroll
    for (int d = 0; d < 32; ++d) S[d] = ldnt1(sp + (size_t)d * 128);
#pragma unroll
    for (int j = 0; j < 2; ++j) { const int tt = hq + 4 * j;
        qs[tt * 128 + v] = QC[(size_t)(m0 + tt) * D + h * 128 + v]; ks[tt * 128 + v] = KC[(size_t)(m0 + tt) * D + h * 128 + v]; }
#pragma unroll
    for (int tt = 0; tt < DS; ++tt) { vv[tt] = VC[(size_t)(m0 + tt) * D + h * 128 + v]; beta[tt] = BETA[(size_t)(m0 + tt) * 8 + h]; alpha[tt] = expf(G[(size_t)(m0 + tt) * 8 + h]); }
    __syncthreads();
#pragma unroll
    for (int tt = 0; tt < DS; ++tt) {
        const float4* k4 = (const float4*)(ks + tt * 128 + hq * 32); const float4* q4 = (const float4*)(qs + tt * 128 + hq * 32);
        float kS = 0.f;
#pragma unroll
        for (int d = 0; d < 8; ++d) { const float4 kk = k4[d]; kS = fmaf(kk.x, S[4 * d], kS); kS = fmaf(kk.y, S[4 * d + 1], kS); kS = fmaf(kk.z, S[4 * d + 2], kS); kS = fmaf(kk.w, S[4 * d + 3], kS); }
        ex[hq * 128 + v] = kS;
        mk::lds_barrier();
        const float u = beta[tt] * (vv[tt] - alpha[tt] * ((ex[v] + ex[128 + v]) + (ex[256 + v] + ex[384 + v])));
        float o = 0.f;
#pragma unroll
        for (int d = 0; d < 8; ++d) { const float4 kk = k4[d], qq = q4[d];
            S[4 * d] = fmaf(alpha[tt], S[4 * d], kk.x * u); o = fmaf(qq.x, S[4 * d], o);
            S[4 * d + 1] = fmaf(alpha[tt], S[4 * d + 1], kk.y * u); o = fmaf(qq.y, S[4 * d + 1], o);
            S[4 * d + 2] = fmaf(alpha[tt], S[4 * d + 2], kk.z * u); o = fmaf(qq.z, S[4 * d + 2], o);
            S[4 * d + 3] = fmaf(alpha[tt], S[4 * d + 3], kk.w * u); o = fmaf(qq.w, S[4 * d + 3], o); }
        ex[512 + hq * 128 + v] = o;
        mk::lds_barrier();
        if (hq == 0) ORAW[(size_t)(m0 + tt) * D + h * 128 + v] = f2bf((ex[512 + v] + ex[512 + 128 + v]) + (ex[512 + 256 + v] + ex[512 + 384 + v]));
    }
    float* so_ = out + O_SS + (((size_t)b * 8 + h) * 128 + hq * 32) * 128 + v;
#pragma unroll
    for (int d = 0; d < 32; ++d) so_[(size_t)d * 128] = S[d];
    __syncthreads();
}

struct GateRegs { unsigned o[8], z[8]; };
__device__ __forceinline__ void dn_gate_load(int m, const bf16_t* ORAW, const bf16_t* P2, GateRegs& R) {
    const int l = mk::ltid() & 63;
#pragma unroll
    for (int h = 0; h < 8; ++h) { R.o[h] = *(const unsigned*)(ORAW + (size_t)m * D + h * 128 + 2 * l); R.z[h] = __builtin_nontemporal_load((const unsigned*)(P2 + (size_t)m * N3P + CZ + h * 128 + 2 * l)); }
}
__device__ __forceinline__ void dn_gate_finish(int m, const GateRegs& R, const float* og, bf16_t* AO2) {
    const int l = mk::ltid() & 63;
    const float g0 = og[2 * l], g1 = og[2 * l + 1];
    float oa[8], ob[8], ss[8];
#pragma unroll
    for (int h = 0; h < 8; ++h) { oa[h] = __uint_as_float(R.o[h] << 16); ob[h] = __uint_as_float(R.o[h] & 0xFFFF0000u); ss[h] = oa[h] * oa[h] + ob[h] * ob[h]; }
    wave_sum_n<8>(ss);
#pragma unroll
    for (int h = 0; h < 8; ++h) {
        const float r = rsqrtf(ss[h] * (1.0f / 128) + EPS);
        const float z0 = __uint_as_float(R.z[h] << 16), z1 = __uint_as_float(R.z[h] & 0xFFFF0000u);
        *(unsigned*)(AO2 + (size_t)m * D + h * 128 + 2 * l) = pk2bf(oa[h] * r * g0 * silu(z0), ob[h] * r * g1 * silu(z1));
    }
}
__device__ __forceinline__ int dn_gate_rowmap(int j) { return j < MS ? MP + j : ((j - MS) & (NB - 1)) * SEQ + (SEQ - 1 - ((j - MS) >> 3)); }
__device__ __forceinline__ void dn_gate_rows(int gw, int nw, const bf16_t* ORAW, const bf16_t* P2, const float* og, bf16_t* AO2) {
    GateRegs R0, R1, R2;
    int m = gw;
#define RM(j) dn_gate_rowmap(j)
    if (m < M) dn_gate_load(RM(m), ORAW, P2, R0);
    if (m + nw < M) dn_gate_load(RM(m + nw), ORAW, P2, R1);
    for (; m < M; m += 3 * nw) {
        if (m + 2 * nw < M) dn_gate_load(RM(m + 2 * nw), ORAW, P2, R2);
        dn_gate_finish(RM(m), R0, og, AO2);
        if (m + nw < M) { if (m + 3 * nw < M) dn_gate_load(RM(m + 3 * nw), ORAW, P2, R0); dn_gate_finish(RM(m + nw), R1, og, AO2); }
        if (m + 2 * nw < M) { if (m + 4 * nw < M) dn_gate_load(RM(m + 4 * nw), ORAW, P2, R1); dn_gate_finish(RM(m + 2 * nw), R2, og, AO2); }
    }
#undef RM
}
}

namespace mk {
constexpr size_t al256(size_t x) { return (x + 255) & ~(size_t)255; }
constexpr size_t W_BAR = 0, W_WT1 = al256(W_BAR + (size_t)12 * XCD_BAR_WORDS * 4), W_WT2 = al256(W_WT1 + (size_t)N1P * D * 2), W_WT3 = al256(W_WT2 + (size_t)D * D * 2), W_WT4 = al256(W_WT3 + (size_t)N3P * D * 2),
    W_XA = al256(W_WT4 + (size_t)D * D * 2), W_P1 = al256(W_XA + (size_t)M * D * 2), W_P2 = al256(W_P1 + (size_t)M * N1P * 2), W_AO = al256(W_P2 + (size_t)M * N3P * 2), W_QN = al256(W_AO + (size_t)M * D * 2),
    W_KB = al256(W_QN + (size_t)M * D * 2), W_IKB = al256(W_KB + (size_t)M * 256 * 2), W_BA = al256(W_IKB + (size_t)M * 64 * 2), W_IW = al256(W_BA + (size_t)M * 16 * 4), W_Y1 = al256(W_IW + (size_t)M * 8 * 4),
    W_QC = al256(W_Y1 + (size_t)M * D * 4), W_KC = al256(W_QC + (size_t)M * D * 4), W_VC = al256(W_KC + (size_t)M * D * 4), W_BETA = al256(W_VC + (size_t)M * D * 4), W_G = al256(W_BETA + (size_t)M * 8 * 4),
    W_ORAW = al256(W_G + (size_t)M * 8 * 4), W_CH = al256(W_ORAW + (size_t)M * D * 2), W_EG = al256(W_CH + (size_t)dn::NITEM * dn::IT_BYTES), W_CS = al256(W_EG + (size_t)dn::NITEM * 4), W_CI = al256(W_CS + (size_t)MS * 8 * 256 * 4), W_MASK = al256(W_CI + (size_t)MS * 8 * 256 * 4), W_SS = al256(W_MASK + (size_t)MP * 64 * 4), W_END = al256(W_SS + (size_t)M * 4);
struct WsMap {
    unsigned char* base;
#define WSP(name, T, off) __device__ __forceinline__ T* name() const { return (T*)(base + (off)); }
    WSP(bar, unsigned, W_BAR) WSP(Wt1, bf16_t, W_WT1) WSP(Wt2, bf16_t, W_WT2) WSP(Wt3, bf16_t, W_WT3) WSP(Wt4, bf16_t, W_WT4) WSP(XA, bf16_t, W_XA) WSP(P1, bf16_t, W_P1) WSP(P2, bf16_t, W_P2)
    WSP(AO, bf16_t, W_AO) WSP(QNb, bf16_t, W_QN) WSP(KB, bf16_t, W_KB) WSP(IKB, bf16_t, W_IKB) WSP(BA, float, W_BA) WSP(IW, float, W_IW) WSP(Y1, float, W_Y1) WSP(QC, float, W_QC) WSP(KC, float, W_KC)
    WSP(VC, float, W_VC) WSP(BETA, float, W_BETA) WSP(G, float, W_G) WSP(ORAW, bf16_t, W_ORAW) WSP(CH, unsigned char, W_CH) WSP(EG, float, W_EG) WSP(CS, float, W_CS) WSP(CI, int, W_CI) WSP(SS, float, W_SS) WSP(MASK, unsigned, W_MASK)
#undef WSP
};
struct Params {
    const float *x_prompt, *x_sample, *cache_k, *cache_v, *cache_ik, *state_S, *state_conv; const int* page_table;
    const float *att_norm, *att_w_in, *qg, *kg, *ikg, *att_w_out, *dn_norm, *dn_w_in, *conv_w, *A_log, *dt_bias, *og, *dn_w_out;
    float* out; WsMap w; int ph_lo, ph_hi, li, pad_;
};
constexpr int LDS_TOTAL = 147456;
constexpr int NPHASE = 12;
#ifndef MK_NLAUNCH
#define MK_NLAUNCH 1
#endif

__global__ void __launch_bounds__(512, 2) mega(Params p) {
    extern __shared__ __attribute__((aligned(16))) unsigned char lds[];
    const int bid = blockIdx.x, nblk = gridDim.x;
#define wave (mk::ltid() >> 6)
    uint4* xbw = (uint4*)(lds + LDS_TOTAL - 16);
    if (threadIdx.x == 0) *xbw = make_uint4(0u, 0u, 0u, 0u);
    __syncthreads();
    XcdBarrier bar = xcd_barrier_post(p.w.bar() + (size_t)p.li * XCD_BAR_WORDS, (volatile LAS unsigned*)xbw);
    const int lo = p.ph_lo, hi = p.ph_hi;
#define IN(k) (lo <= (k) && (k) < hi)
#define SEAM(k) do { if (IN(k) && IN((k) + 1)) xcd_barrier(bar); } while (0)
    const WsMap& w = p.w;
    if (IN(0)) {
        float* tile = (float*)lds;
        { float* qss = (float*)w.QNb(); for (int i = bid * 512 + mk::ltid(); i < M * 8; i += nblk * 512) qss[i] = 0.f; }
        wconv_waves<1>(p.att_w_in, ATT_IN, p.att_norm, w.Wt1(), D, N1P, bid * 8 + wave, nblk * 8);
        wconv_waves<0>(p.att_w_out, D, nullptr, w.Wt2(), D, D, (bid * 8 + wave + nblk * 8 - 1664 % (nblk * 8)) % (nblk * 8), nblk * 8);
        wconv_waves<3>(p.dn_w_in, DN_IN, p.dn_norm, w.Wt3(), D, N3P, (bid * 8 + wave + nblk * 8 - 2176 % (nblk * 8)) % (nblk * 8), nblk * 8);
        wconv_waves<0>(p.dn_w_out, D, nullptr, w.Wt4(), D, D, (bid * 8 + wave + nblk * 8 - 4352 % (nblk * 8)) % (nblk * 8), nblk * 8);
        { const int gw = bid * 8 + wave, nw = nblk * 8;
          if (nw >= 2048) { float4 v[9][4];
#pragma unroll
              for (int k = 0; k < 9; ++k) { const int m = gw + k * nw; if (m < M) xnorm_load(xrow(p.x_prompt, p.x_sample, m), v[k]); }
#pragma unroll
              for (int k = 0; k < 9; ++k) { const int m = gw + k * nw; if (m < M) xnorm_finish(v[k], w.XA() + (size_t)m * D, w.Y1() + m); } }
          else { float4 v[4]; for (int m = gw; m < M; m += nw) { xnorm_load(xrow(p.x_prompt, p.x_sample, m), v); xnorm_finish(v, w.XA() + (size_t)m * D, w.Y1() + m); } } }
    }
    SEAM(0);
    if (IN(1)) { pg8::Gemm g{w.XA(), w.Wt1(), M, N1P, D, 0}; EpiBf16Tail E{w.P1(), N1P, N1P / 256, nullptr, nullptr, (float*)w.QNb()}; pg8::StaticOrder S; S.init(M, N1P, nblk, bid);
        pg8::gemm_phase<EpiBf16Tail, pg8::StaticOrder, false>((PG8_LAS unsigned char*)lds, g, S, E, nullptr);
    }
    SEAM(1);
    if (IN(2)) { for (int i = bid * 512 + mk::ltid(); i < M; i += nblk * 512) w.SS()[i] = 0.f;
        att_post_rows(bid * 8 + wave, nblk * 8, w.P1(), p.qg, p.kg, p.ikg, w.KB(), w.IKB(), w.IW(), p.out); }
    SEAM(2);
    if (IN(3)) {
        const int pos = (bid >> 3) % 3;
        for (int id = bid; id < 256; id += nblk) { const int b = id & 7, pr = id >> 3;
#pragma nounroll
            for (int s = 0; s < 3; ++s) {
                if (s == pos) ix::index_sample_block(id >> 3, id & 7, (char*)lds, w.P1(), w.IKB(), w.IW(), p.cache_ik, p.page_table, w.CS(), w.CI());
                else { const int k = s - (s > pos ? 1 : 0);
                    ix::index_prompt_block(b, k ? pr : 63 - pr, (char*)lds, w.P1(), w.IKB(), w.IW(), w.MASK());
                    __syncthreads(); } } }
    }
    SEAM(3);
    if (IN(4)) {
        dsa::Tensors T{(const float*)w.QNb(), w.KB(), w.P1(), w.MASK(), w.AO()};
        const bool sfirst = (bid >> 3) & 1;
        if (sfirst) { for (int r = bid; r < MS; r += nblk) attend_sample_row(r, (char*)lds, (const float*)w.QNb(), p.qg, w.P1(), w.CS(), w.CI(), p.out, p.cache_k, p.cache_v, p.page_table, w.AO()); }
        dsa::attn_prompt_phase(T, (char*)lds, bid, nblk);
        __syncthreads();
        if (!sfirst) { for (int r = bid; r < MS; r += nblk) attend_sample_row(r, (char*)lds, (const float*)w.QNb(), p.qg, w.P1(), w.CS(), w.CI(), p.out, p.cache_k, p.cache_v, p.page_table, w.AO()); }
    }
    SEAM(4);
    if (IN(5)) {
        { const float* INV = w.Y1(); bf16_t* XB = w.XA(); float* SS = w.SS();
          for (int u = bid; u < 256; u += nblk) gemm_small_unit<1>((char*)lds, w.AO(), w.Wt2(), MP + 32 * (u >> 5), 32 * (u & 31), [&](int r_, int c_) { return bf2f(XB[(size_t)r_ * D + c_]) * INV[r_]; }, [&](int r_, int c_, float v, float res) {
              const float y = v + res; XB[(size_t)r_ * D + c_] = f2bf(y);
              float ss = y * y; ss += __shfl_xor(ss, 1); ss += __shfl_xor(ss, 2); ss += __shfl_xor(ss, 4); ss += __shfl_xor(ss, 8); ss += __shfl_xor(ss, 16);
              if ((ltid() & 31) == 0) atomicAdd(SS + r_, ss); }); }
        pg8::Gemm g{w.AO(), w.Wt2(), MP, D, D, 0}; EpiY1 E{w.XA(), w.Y1(), w.SS(), D, 0}; pg8::StaticOrder S; S.init(MP, D, nblk, bid);
        pg8::gemm_phase<EpiY1, pg8::StaticOrder, false>((PG8_LAS unsigned char*)lds, g, S, E, nullptr); }
    SEAM(5);
    if (IN(7)) { pg8::Gemm g{w.XA(), w.Wt3(), M, N3P, D, 0}; EpiBf16Tail E{w.P2(), N3P, 16, w.BA(), w.SS(), nullptr}; pg8::StaticOrder S; S.init(M, N3P, nblk, bid);
        pg8::gemm_phase<EpiBf16Tail, pg8::StaticOrder, false>((PG8_LAS unsigned char*)lds, g, S, E, nullptr); }
    SEAM(7);
    if (IN(8)) {
        dn::PreArgs pa{w.P2(), w.BA(), p.conv_w, p.A_log, p.dt_bias, w.CH(), w.EG(), p.out};
        { dn::PreRaw R;
          if (nblk == 256) {
              const int bh = bid & 63, cq = bid >> 6;
              dn::pre_load(pa, bh * 32 + 31 - cq, R);
              for (int k = 0; k < 8; ++k) dn::pre_item(pa, bh * 32 + 31 - (4 * k + cq), k + 1 < 8 ? bh * 32 + 31 - (4 * (k + 1) + cq) : -1, (char*)lds, R);
          } else {
              int item = bid;
              if (item < dn::NITEM) dn::pre_load(pa, item, R);
              for (; item < dn::NITEM; item += nblk) dn::pre_item(pa, item, item + nblk < dn::NITEM ? item + nblk : -1, (char*)lds, R);
          }
          __syncthreads(); }
        for (int m = MP + bid; m < M; m += nblk) dn_post_row(m, (char*)lds, w.P2(), w.BA(), p.conv_w, p.state_conv, p.A_log, p.dt_bias, w.QC(), w.KC(), w.VC(), w.BETA(), w.G(), p.out);
    }
    SEAM(8);
    if (IN(9)) {
        dn::ScanArgs sa{w.CH(), w.EG(), w.ORAW(), p.out};
        for (int it = bid; it < 256; it += nblk) { const int xcd = it & 7, slot = it >> 3; dn::scan_item(sa, xcd * 8 + (slot >> 2), slot & 3, (char*)lds); }
        for (int it = bid; it < DB * 8; it += nblk) dn_scan_sample(it, (char*)lds, w.QC(), w.KC(), w.VC(), w.BETA(), w.G(), p.state_S, w.ORAW(), p.out);
    }
    SEAM(9);
    if (IN(10)) { dn_gate_rows(bid * 8 + wave, nblk * 8, w.ORAW(), w.P2(), p.og, w.AO()); }
    SEAM(10);
    if (IN(11)) {
        { float* yo = p.out + O_Y; const bf16_t* Y1b = w.XA();
          for (int u = bid; u < 256; u += nblk) gemm_small_unit<1>((char*)lds, w.AO(), w.Wt4(), MP + 32 * (u >> 5), 32 * (u & 31), [&](int r_, int c_) { return bf2f(Y1b[(size_t)r_ * D + c_]); }, [&](int r_, int c_, float v, float res) { yo[(size_t)r_ * D + c_] = v + res; }); }
        pg8::Gemm g{w.AO(), w.Wt4(), MP, D, D, 0}; EpiF32ResBf E{p.out + O_Y, w.XA(), D, 0}; pg8::StaticOrder S; S.init(MP, D, nblk, bid);
        pg8::gemm_phase<EpiF32ResBf, pg8::StaticOrder, false>((PG8_LAS unsigned char*)lds, g, S, E, nullptr); }
#undef IN
#undef SEAM
}
}

extern "C" void kernel_launch(void* const* d_in, const int* in_sizes, int n_in, void* d_out, int out_size, void* d_ws, size_t ws_size, hipStream_t stream) {
    using namespace mk;
    static int grid = 0;
    if (!grid) {
        int dev = 0, cus = 0, per_cu = 0;
        (void)hipGetDevice(&dev);
        (void)hipDeviceGetAttribute(&cus, hipDeviceAttributeMultiprocessorCount, dev);
        (void)hipFuncSetAttribute((const void*)mega, hipFuncAttributeMaxDynamicSharedMemorySize, LDS_TOTAL);
        (void)hipOccupancyMaxActiveBlocksPerMultiprocessor(&per_cu, (const void*)mega, 512, LDS_TOTAL);
        (void)hipGetLastError();
        grid = cus > 0 ? cus : 256;
        fprintf(stderr, "mega: cus %d occupancy %d grid %d\n", cus, per_cu, grid);
    }
    Params p; memset(&p, 0, sizeof(p));
    p.x_prompt = (const float*)d_in[0]; p.x_sample = (const float*)d_in[1]; p.cache_k = (const float*)d_in[2]; p.cache_v = (const float*)d_in[3]; p.cache_ik = (const float*)d_in[4];
    p.state_S = (const float*)d_in[5]; p.state_conv = (const float*)d_in[6]; p.page_table = (const int*)d_in[7];
    p.att_norm = (const float*)d_in[8]; p.att_w_in = (const float*)d_in[9]; p.qg = (const float*)d_in[10]; p.kg = (const float*)d_in[11];
    p.ikg = (const float*)d_in[12]; p.att_w_out = (const float*)d_in[13]; p.dn_norm = (const float*)d_in[14]; p.dn_w_in = (const float*)d_in[15];
    p.conv_w = (const float*)d_in[16]; p.A_log = (const float*)d_in[17]; p.dt_bias = (const float*)d_in[18]; p.og = (const float*)d_in[19]; p.dn_w_out = (const float*)d_in[20];
    p.out = (float*)d_out;
    p.w.base = (unsigned char*)d_ws;
    if (W_END > ws_size) { fprintf(stderr, "ws too small\n"); return; }
    (void)hipMemsetAsync(d_ws, 0, (size_t)NPHASE * XCD_BAR_WORDS * 4, stream);
    constexpr int NL = MK_NLAUNCH;
    for (int li = 0; li < NL; ++li) {
        p.ph_lo = (NL == 1) ? 0 : li; p.ph_hi = (NL == 1) ? NPHASE : li + 1; p.li = li;
        hipLaunchKernelGGL(mega, dim3(grid), dim3(512), LDS_TOTAL, stream, p);
    }
}
```

```cpp
#include <hip/hip_runtime.h>
#include <cstdio>
#include <cstdint>
#include <cstring>

namespace mk {
typedef unsigned short bf16_t;
constexpr int D = 1024, NB = 8, SEQ = 2048, MP = NB * SEQ, DB = 32, DS = 8, MS = DB * DS, M = MP + MS;
constexpr int PAST = 16384, PAGE = 128, NPG = PAST / PAGE;
constexpr int NH = 8, HD = 128, NKV = 2, IH = 8, ID = 64, TOPK = 256;
constexpr int ATT_IN = 3144, SQ_ = 0, SK_ = 1024, SV_ = 1280, SIQ = 1536, SIK = 2048, SIW = 2112, SG = 2120;
constexpr int DN_IN = 4112;
constexpr int N1P = 3328, CQ = 0, CK = 1024, CV = 1280, CIQ = 1536, CG = 2048, CIK = 3072, CIW = 3136;
constexpr int N3P = 4352, CONV = 3072, CZ = 3072, CB = 4096, CA = 4104;
constexpr float EPS = 1e-6f;
constexpr size_t O_Y = 0;
constexpr size_t O_KP = (size_t)M * D;
constexpr size_t O_VP = O_KP + (size_t)MP * 256;
constexpr size_t O_IKP = O_VP + (size_t)MP * 256;
constexpr size_t O_KS = O_IKP + (size_t)MP * 64;
constexpr size_t O_VS = O_KS + (size_t)MS * 256;
constexpr size_t O_IKS = O_VS + (size_t)MS * 256;
constexpr size_t O_SP = O_IKS + (size_t)MS * 64;
constexpr size_t O_CP = O_SP + (size_t)NB * 8 * 128 * 128;
constexpr size_t O_SS = O_CP + (size_t)NB * 3 * CONV;
constexpr size_t O_CS = O_SS + (size_t)DB * 8 * 128 * 128;
constexpr size_t O_END = O_CS + (size_t)DB * 3 * CONV;
static_assert(O_END == 32235520, "output size");

__device__ __forceinline__ float* kout(float* out, int m) { return m < MP ? out + O_KP + (size_t)m * 256 : out + O_KS + (size_t)(m - MP) * 256; }
__device__ __forceinline__ float* vout(float* out, int m) { return m < MP ? out + O_VP + (size_t)m * 256 : out + O_VS + (size_t)(m - MP) * 256; }
__device__ __forceinline__ float* ikout(float* out, int m) { return m < MP ? out + O_IKP + (size_t)m * 64 : out + O_IKS + (size_t)(m - MP) * 64; }
__device__ __forceinline__ const float* xrow(const float* xp, const float* xs, int m) { return m < MP ? xp + (size_t)m * D : xs + (size_t)(m - MP) * D; }

__device__ __forceinline__ int ltid() { int t = threadIdx.x; asm volatile("" : "+v"(t)); return t; }
typedef float f32x2_t __attribute__((ext_vector_type(2)));
typedef unsigned u32x4_t __attribute__((ext_vector_type(4)));
typedef float f32x4_t __attribute__((ext_vector_type(4)));
typedef float f32x2_t __attribute__((ext_vector_type(2)));
__device__ __forceinline__ float4 ldnt4(const float* p) { const f32x4_t v = __builtin_nontemporal_load((const f32x4_t*)p); return make_float4(v.x, v.y, v.z, v.w); }
__device__ __forceinline__ float ldnt1(const float* p) { return __builtin_nontemporal_load(p); }
__device__ __forceinline__ void stnt1(float* p, float a) { __builtin_nontemporal_store(a, p); }
__device__ __forceinline__ void stnt2(float* p, float a, float b) { const f32x2_t v = {a, b}; __builtin_nontemporal_store(v, (f32x2_t*)p); }
typedef short bf16x8 __attribute__((ext_vector_type(8)));
typedef float f32x16 __attribute__((ext_vector_type(16)));
typedef __bf16 bf16x2_t __attribute__((ext_vector_type(2)));
__device__ __forceinline__ unsigned cvtpk_native(float lo, float hi) { f32x2_t v = {lo, hi}; return __builtin_bit_cast(unsigned, __builtin_convertvector(v, bf16x2_t)); }
__device__ __forceinline__ void lds_barrier() { asm volatile("s_waitcnt lgkmcnt(0)" ::: "memory"); __builtin_amdgcn_s_barrier(); asm volatile("" ::: "memory"); }
__device__ __forceinline__ float bf2f(bf16_t b) { return __uint_as_float(((unsigned)b) << 16); }
__device__ __forceinline__ bf16_t f2bf(float f) { unsigned u = __float_as_uint(f); u += 0x7FFFu + ((u >> 16) & 1u); return (bf16_t)(u >> 16); }
__device__ __forceinline__ unsigned pk2bf(float lo, float hi) { return (unsigned)f2bf(lo) | ((unsigned)f2bf(hi) << 16); }
template <int N> __device__ __forceinline__ void wave_sum_n(float (&v)[N]) {
#pragma unroll
    for (int i = 0; i < N; ++i) v[i] += __int_as_float(__builtin_amdgcn_update_dpp(0, __float_as_int(v[i]), 0xB1, 0xF, 0xF, false));
#pragma unroll
    for (int i = 0; i < N; ++i) v[i] += __int_as_float(__builtin_amdgcn_update_dpp(0, __float_as_int(v[i]), 0x4E, 0xF, 0xF, false));
#pragma unroll
    for (int i = 0; i < N; ++i) v[i] += __int_as_float(__builtin_amdgcn_update_dpp(0, __float_as_int(v[i]), 0x124, 0xF, 0xF, false));
#pragma unroll
    for (int i = 0; i < N; ++i) v[i] += __int_as_float(__builtin_amdgcn_update_dpp(0, __float_as_int(v[i]), 0x128, 0xF, 0xF, false));
#pragma unroll
    for (int i = 0; i < N; ++i) v[i] += __shfl_xor(v[i], 16);
#pragma unroll
    for (int i = 0; i < N; ++i) v[i] += __shfl_xor(v[i], 32);
}
__device__ __forceinline__ float wave_sum(float v) { float a[1] = {v}; wave_sum_n<1>(a); return a[0]; }
__device__ __forceinline__ float silu(float x) { return x / (1.0f + __expf(-x)); }
}

namespace pg8 {
#define PG8_LAS __attribute__((address_space(3)))
typedef unsigned short bf16_t;
typedef short bf16x8 __attribute__((ext_vector_type(8)));
typedef float f32x4 __attribute__((ext_vector_type(4)));
typedef unsigned u32x4 __attribute__((ext_vector_type(4)));
constexpr int BM = 256, BK = 64, HALF = 128, HTB = HALF * BK * 2  , STAGE_BYTES = 8 * HTB, NXCD = 8, WGM = 8;

__host__ __device__ __forceinline__ int lds_byte(int r, int c) { const int st = (r >> 4) * 2 + (c >> 5), rr = r & 15, cc = c & 31, ob = rr * 64 + cc * 2; return st * 1024 + (ob ^ (((ob >> 9) & 1) << 5)); }
__host__ __device__ __forceinline__ void stage_rc(int b, int& R, int& C) { const int st = b / 1024, sb = b % 1024, swz = sb ^ (((sb >> 9) & 1) << 5); R = (st >> 1) * 16 + swz / 64; C = (st & 1) * 32 + (swz % 64) / 2; }
__host__ __device__ __forceinline__ int perm32(int rho) { const int n = rho >> 4, i = rho & 15; return 8 * (i >> 2) + 4 * n + (i & 3); }

struct Unit { int pm, pn; };
struct Gemm { const bf16_t* A; const bf16_t* Bt; int M, N, K, pad_; };

struct StaticOrder {
    int nM, nN, nwg, G, c;
    __host__ __device__ void init(int M, int N, int G_, int c_) { nM = M / BM; nN = N / BM; nwg = nM * nN; G = G_; c = c_; }
    __host__ __device__ bool next(int i, Unit& u) const {
        const long L = (long)i * G + c; if (L >= nwg) return false;
        int wgid = (int)L; { const int q = nwg / NXCD, r = nwg % NXCD, xcd = wgid % NXCD, off = wgid / NXCD; wgid = (xcd < r ? xcd * (q + 1) : r * (q + 1) + (xcd - r) * q) + off; }
        const int nig = WGM * nN, gid = wgid / nig, fm = gid * WGM, gsz = (nM - fm) < WGM ? (nM - fm) : WGM;
        u.pm = fm + ((wgid % nig) % gsz); u.pn = (wgid % nig) / gsz; return true;
    }
    __device__ __forceinline__ void a_ready(const Unit&) const {}
    __device__ __forceinline__ void done(const Unit&) const {}
};
struct CountedOrder : StaticOrder {
    const unsigned* ready; unsigned need; unsigned* tmo;
    __device__ __forceinline__ void a_ready(const Unit& u) const {
        if (mk::ltid() < 64) {
            const unsigned long long t0 = __builtin_amdgcn_s_memrealtime(); unsigned polls = 0;
            while ((unsigned)__builtin_amdgcn_readfirstlane(__hip_atomic_load(ready + 64 * u.pm, __ATOMIC_RELAXED, __HIP_MEMORY_SCOPE_AGENT)) < need) {
                if ((++polls & 255u) == 0u && __builtin_amdgcn_readfirstlane(__hip_atomic_load(tmo, __ATOMIC_RELAXED, __HIP_MEMORY_SCOPE_AGENT)) != 0u) break;
                if (__builtin_amdgcn_s_memrealtime() - t0 > 2000000ull) {
                    if (mk::ltid() == 0) { unsigned expect = 0u; __hip_atomic_compare_exchange_strong(tmo + 1, &expect, 0x600u | (unsigned)(u.pm & 0xff), __ATOMIC_RELAXED, __ATOMIC_RELAXED, __HIP_MEMORY_SCOPE_AGENT); __hip_atomic_store(tmo, 1u, __ATOMIC_RELAXED, __HIP_MEMORY_SCOPE_AGENT); }
                    break; }
                __builtin_amdgcn_s_sleep(2); }
            __builtin_amdgcn_fence(__ATOMIC_ACQUIRE, "agent");
            asm volatile("s_waitcnt vmcnt(0)" ::: "memory");
        }
#if !defined(BROKEN_HOOK_NO_BARRIER)
        asm volatile("" ::: "memory"); __builtin_amdgcn_s_barrier(); asm volatile("" ::: "memory");
#endif
    }
};

__device__ __forceinline__ unsigned cvt_pk_bf16(float lo, float hi) { return mk::cvtpk_native(lo, hi); }
typedef float f32x2 __attribute__((ext_vector_type(2)));
__device__ __forceinline__ f32x2 gelu_pk(f32x2 v) {
    const f32x2 av = __builtin_elementwise_abs(v), d = av * 0.2316418882f + 1.0f;
    f32x2 t; t.x = __builtin_amdgcn_rcpf(d.x); t.y = __builtin_amdgcn_rcpf(d.y);
    f32x2 q = t * 0.5307027145f + (-0.7265760135f); q = q * t + 0.7107068705f; q = q * t + (-0.142248368f); q = q * t + 0.127414796f; q = q * t;
    const f32x2 s = (v * v) * (-0.72134752044f);
    f32x2 e; e.x = __builtin_amdgcn_exp2f(s.x); e.y = __builtin_amdgcn_exp2f(s.y);
    const f32x2 m = v * (q * e), r = v - m;
    f32x2 o; o.x = v.x < 0.f ? m.x : r.x; o.y = v.y < 0.f ? m.y : r.y; return o;
}

struct EpiF32 {
    static constexpr bool PERM = false, AFTER_DRAIN = false;
    float* C; int ldc; const float* bias;
    __device__ __forceinline__ void operator()(const f32x4 (&acc)[2][2][4][2], const Unit& u, int wr, int wc, int fr, int fq) const {
        const int row0 = u.pm * BM + wr * 64 + fr, col0 = u.pn * BM + wc * 32 + 4 * fq;
        f32x4 bv[2][2];
#pragma unroll
        for (int bj = 0; bj < 2; ++bj)
#pragma unroll
            for (int n = 0; n < 2; ++n) bv[bj][n] = bias ? *(const f32x4*)(bias + col0 + bj * HALF + n * 16) : (f32x4){0.f, 0.f, 0.f, 0.f};
#pragma unroll
        for (int ai = 0; ai < 2; ++ai)
#pragma unroll
            for (int m = 0; m < 4; ++m) { float* rowp = C + (size_t)(row0 + ai * HALF + m * 16) * ldc + col0;
#pragma unroll
                for (int bj = 0; bj < 2; ++bj)
#pragma unroll
                    for (int n = 0; n < 2; ++n) *(f32x4*)(rowp + bj * HALF + n * 16) = acc[ai][bj][m][n] + bv[bj][n]; }
    }
};
template <int ACT  > struct EpiBf16 {
    static constexpr bool PERM = true, AFTER_DRAIN = false;
    bf16_t* O; int ldc; const float* bias; int split_cols; size_t split_stride;
    __device__ __forceinline__ void operator()(const f32x4 (&acc)[2][2][4][2], const Unit& u, int wr, int wc, int fr, int fq) const {
        const int row0 = u.pm * BM + wr * 64 + fr; int colt = u.pn * BM; bf16_t* base = O;
        if (split_cols) { const int t = colt / split_cols; base += (size_t)t * split_stride; colt -= t * split_cols; }
        const int col0 = colt + wc * 32 + 8 * fq, bcol0 = u.pn * BM + wc * 32 + 8 * fq;
        f32x4 bv[2][2];
#pragma unroll
        for (int bj = 0; bj < 2; ++bj)
#pragma unroll
            for (int n = 0; n < 2; ++n) bv[bj][n] = bias ? *(const f32x4*)(bias + bcol0 + bj * HALF + 4 * n) : (f32x4){0.f, 0.f, 0.f, 0.f};
#pragma unroll
        for (int ai = 0; ai < 2; ++ai)
#pragma unroll
            for (int m = 0; m < 4; ++m) { bf16_t* rowp = base + (size_t)(row0 + ai * HALF + m * 16) * ldc + col0;
#pragma unroll
                for (int bj = 0; bj < 2; ++bj) { f32x4 v0 = acc[ai][bj][m][0] + bv[bj][0], v1 = acc[ai][bj][m][1] + bv[bj][1];
                    if (ACT == 1) { f32x2 a = gelu_pk((f32x2){v0[0], v0[1]}), b = gelu_pk((f32x2){v0[2], v0[3]}), c = gelu_pk((f32x2){v1[0], v1[1]}), d = gelu_pk((f32x2){v1[2], v1[3]});
                        v0 = (f32x4){a.x, a.y, b.x, b.y}; v1 = (f32x4){c.x, c.y, d.x, d.y}; }
                    if (ACT == 2) {
#pragma unroll
                        for (int j = 0; j < 4; ++j) { v0[j] = 0.5f * v0[j] * (1.0f + erff(v0[j] * 0.70710678f)); v1[j] = 0.5f * v1[j] * (1.0f + erff(v1[j] * 0.70710678f)); } }
                    u32x4 w; w.x = cvt_pk_bf16(v0[0], v0[1]); w.y = cvt_pk_bf16(v0[2], v0[3]); w.z = cvt_pk_bf16(v1[0], v1[1]); w.w = cvt_pk_bf16(v1[2], v1[3]);
                    *(u32x4*)(rowp + bj * HALF) = w; } }
    }
};

template <class Epi, class Sched, bool STAMP = false>
__device__ __forceinline__ void gemm_phase(PG8_LAS unsigned char* lds, const Gemm g, const Sched& S, const Epi& E, unsigned long long* stamps) {
    const int tid = mk::ltid(), wid = __builtin_amdgcn_readfirstlane(tid >> 6), lane = tid & 63, wr = wid >> 2, wc = wid & 3, fr = lane & 15, fq = lane >> 4;
    const int K = g.K, nt = K / BK;
    int ts_lo = 0, ts_hi = 0, nts = 0; const unsigned long long rt_entry = STAMP ? (unsigned long long)wall_clock64() : 0ull;
#define PG8_STAMP() do { if (STAMP && wid == 0 && nts < 64) { const unsigned long long _c = (unsigned long long)clock64(); \
        ts_lo = (lane == nts) ? (int)(unsigned)_c : ts_lo; ts_hi = (lane == nts) ? (int)(unsigned)(_c >> 32) : ts_hi; ++nts; } } while (0)
    PG8_STAMP();
    unsigned voffA[2], voffB[2];
#pragma unroll
    for (int i = 0; i < 2; ++i) { int R, C; stage_rc(tid * 16 + i * 8192, R, C); const int Rb = Epi::PERM ? ((R & ~31) + perm32(R & 31)) : R;
        voffA[i] = (unsigned)(R * K + C) * 2u; voffB[i] = (unsigned)(Rb * K + C) * 2u; }
    const size_t kstep = (size_t)(BK * 2);
    const size_t hstep = (size_t)HALF * K * 2;
    const size_t tstep = 2 * hstep;
    const unsigned ldsw = (unsigned)wid * 1024u;
    const int aoff = lds_byte(wr * 64 + fr, fq * 8), boff = lds_byte(wc * 32 + fr, fq * 8);
#define PG8_SA(b, h) (((b) * 2 + (h)) * HTB)
#define PG8_SB(b, h) ((4 + (b) * 2 + (h)) * HTB)
#define PG8_STAGE(bufoff, gbase, voff) do { _Pragma("unroll") for (int _i = 0; _i < 2; ++_i) \
        __builtin_amdgcn_global_load_lds((const unsigned*)((const char*)(gbase) + (voff)[_i]), (PG8_LAS unsigned*)(lds + (bufoff) + ldsw + _i * 8192), 16, 0, 0); } while (0)
#define PG8_LDA(dst, b, h) do { _Pragma("unroll") for (int m = 0; m < 4; ++m) _Pragma("unroll") for (int k = 0; k < 2; ++k) dst[m][k] = *(const PG8_LAS bf16x8*)(lds + PG8_SA(b, h) + aoff + m * 2048 + k * 1024); } while (0)
#define PG8_LDB(dst, b, h) do { _Pragma("unroll") for (int n = 0; n < 2; ++n) _Pragma("unroll") for (int k = 0; k < 2; ++k) dst[n][k] = *(const PG8_LAS bf16x8*)(lds + PG8_SB(b, h) + boff + n * 2048 + k * 1024); } while (0)
#define PG8_MMA(ai, bj, At, Bt) do { __builtin_amdgcn_s_setprio(1); _Pragma("unroll") for (int m = 0; m < 4; ++m) _Pragma("unroll") for (int n = 0; n < 2; ++n) _Pragma("unroll") for (int k = 0; k < 2; ++k) \
        acc[ai][bj][m][n] = __builtin_amdgcn_mfma_f32_16x16x32_bf16(Bt[n][k], At[m][k], acc[ai][bj][m][n], 0, 0, 0); __builtin_amdgcn_s_setprio(0); } while (0)
#define PG8_WAIT_V(n) asm volatile("s_waitcnt vmcnt(" #n ")" ::: "memory")
#define PG8_WAIT_L(n) asm volatile("s_waitcnt lgkmcnt(" #n ")" ::: "memory")
#define PG8_BAR __builtin_amdgcn_s_barrier()
#define PG8_SCHED __builtin_amdgcn_sched_barrier(0)
    Unit cur, nxt; int ui = 0;
    if (!S.next(0, cur)) return;
    f32x4 acc[2][2][4][2];
#pragma unroll
    for (int a = 0; a < 2; ++a)
#pragma unroll
        for (int b = 0; b < 2; ++b)
#pragma unroll
            for (int m = 0; m < 4; ++m)
#pragma unroll
                for (int n = 0; n < 2; ++n) acc[a][b][m][n] = (f32x4){0.f, 0.f, 0.f, 0.f};
    bf16x8 At[4][2], B0[2][2], B1[2][2];
    const char* cA = (const char*)g.A + (size_t)cur.pm * tstep; const char* cB = (const char*)g.Bt + (size_t)cur.pn * tstep;
    S.a_ready(cur);
    PG8_STAGE(PG8_SB(0, 0), cB, voffB); PG8_STAGE(PG8_SA(0, 0), cA, voffA); PG8_STAGE(PG8_SB(0, 1), cB + hstep, voffB); PG8_STAGE(PG8_SA(0, 1), cA + hstep, voffA);
    if (wr == 1) PG8_BAR;
    PG8_WAIT_V(4); PG8_BAR;
    PG8_STAGE(PG8_SB(1, 0), cB + kstep, voffB); PG8_STAGE(PG8_SA(1, 0), cA + kstep, voffA); PG8_STAGE(PG8_SB(1, 1), cB + hstep + kstep, voffB);
    PG8_WAIT_V(6); PG8_BAR;
    PG8_STAMP();
    for (;;) {
        const bool has_next = S.next(ui + 1, nxt);
        const char* nA = has_next ? (const char*)g.A + (size_t)nxt.pm * tstep : cA; const char* nB = has_next ? (const char*)g.Bt + (size_t)nxt.pn * tstep : cB;
        for (int t = 0; t < nt; t += 2) {
            const bool last = (t == nt - 2);
            const char* a1 = cA + (size_t)(t + 1) * kstep;
            const char* a2 = last ? nA : cA + (size_t)(t + 2) * kstep; const char* b2 = last ? nB : cB + (size_t)(t + 2) * kstep;
            const char* a3 = a2 + kstep; const char* b3 = b2 + kstep;
            if (last && has_next) S.a_ready(nxt);
            PG8_LDB(B0, 0, 0); PG8_SCHED; PG8_LDA(At, 0, 0); PG8_STAGE(PG8_SA(1, 1), a1 + hstep, voffA);
            PG8_WAIT_L(8); PG8_BAR; PG8_WAIT_L(0); PG8_MMA(0, 0, At, B0); PG8_BAR; PG8_SCHED;
            PG8_LDB(B1, 0, 1); PG8_STAGE(PG8_SB(0, 0), b2, voffB);
            PG8_BAR; PG8_WAIT_L(0); PG8_MMA(0, 1, At, B1); PG8_BAR;
            PG8_LDA(At, 0, 1); PG8_STAGE(PG8_SA(0, 0), a2, voffA);
            PG8_BAR; PG8_WAIT_L(0); PG8_MMA(1, 0, At, B0); PG8_BAR; PG8_SCHED;
            PG8_STAGE(PG8_SB(0, 1), b2 + hstep, voffB);
            PG8_WAIT_V(6); PG8_BAR; PG8_MMA(1, 1, At, B1); PG8_BAR;
            PG8_LDB(B0, 1, 0); PG8_SCHED; PG8_LDA(At, 1, 0); PG8_STAGE(PG8_SA(0, 1), a2 + hstep, voffA);
            PG8_WAIT_L(8); PG8_BAR; PG8_WAIT_L(0); PG8_MMA(0, 0, At, B0); PG8_BAR; PG8_SCHED;
            PG8_LDB(B1, 1, 1); PG8_STAGE(PG8_SB(1, 0), b3, voffB);
            PG8_BAR; PG8_WAIT_L(0); PG8_MMA(0, 1, At, B1); PG8_BAR;
            PG8_LDA(At, 1, 1); PG8_STAGE(PG8_SA(1, 0), a3, voffA);
            PG8_BAR; PG8_WAIT_L(0); PG8_MMA(1, 0, At, B0); PG8_BAR; PG8_SCHED;
            PG8_STAGE(PG8_SB(1, 1), b3 + hstep, voffB);
            PG8_WAIT_V(6); PG8_BAR; PG8_MMA(1, 1, At, B1); PG8_BAR;
        }
        PG8_STAMP();
        if constexpr (!Epi::AFTER_DRAIN) { E(acc, cur, wr, wc, fr, fq); S.done(cur); }
        PG8_STAMP();
        if (!has_next) break;
#pragma unroll
        for (int a = 0; a < 2; ++a)
#pragma unroll
            for (int b = 0; b < 2; ++b)
#pragma unroll
                for (int m = 0; m < 4; ++m)
#pragma unroll
                    for (int n = 0; n < 2; ++n) acc[a][b][m][n] = (f32x4){0.f, 0.f, 0.f, 0.f};
        cur = nxt; cA = nA; cB = nB; ++ui;
    }
    PG8_WAIT_V(0);
    if (wr == 0) PG8_BAR;
    PG8_BAR;
    if constexpr (Epi::AFTER_DRAIN) { E.fused(acc, cur, wr, wc, fr, fq, lds, wid, lane); S.done(cur); }
    PG8_STAMP();
    if (STAMP && wid == 0) { stamps[lane] = lane < nts ? (((unsigned long long)(unsigned)ts_hi << 32) | (unsigned)ts_lo) : 0ull;
        if (lane == 62) stamps[62] = rt_entry; if (lane == 63) stamps[63] = (unsigned long long)wall_clock64(); }
#undef PG8_STAMP
#undef PG8_SA
#undef PG8_SB
#undef PG8_STAGE
#undef PG8_LDA
#undef PG8_LDB
#undef PG8_MMA
#undef PG8_WAIT_V
#undef PG8_WAIT_L
#undef PG8_BAR
#undef PG8_SCHED
}
}

#define XB_TMO      128
#define XB_XCNT(j)  (256  + 64 * (j))
#define XB_XSUB(j)  (1280 + 64 * (j))
#define XB_XGEN(j)  (2304 + 64 * (j))
#define XB_TOP      3328
#define XB_TOPGEN   3392
#define XCD_BAR_WORDS 3456
#define XB_SPIN_CAP (1u << 18)
#define LAS __attribute__((address_space(3)))

__device__ __forceinline__ unsigned xb_ld(unsigned* p)              { return __hip_atomic_load(p, __ATOMIC_RELAXED, __HIP_MEMORY_SCOPE_AGENT); }
__device__ __forceinline__ unsigned xb_add(unsigned* p, unsigned v) { return __hip_atomic_fetch_add(p, v, __ATOMIC_RELAXED, __HIP_MEMORY_SCOPE_AGENT); }
__device__ __forceinline__ unsigned xb_xcc_id() { return (unsigned)__builtin_amdgcn_s_getreg((3 << 11) | 20) & 0xFu; }
#define XB_SPIN(cond, bar) do { unsigned _sp = 0; while (cond) { __builtin_amdgcn_s_sleep(1); \
    if ((++_sp & 255u) == 0u) { if (xb_ld(&(bar)[XB_TMO])) break; if (_sp > XB_SPIN_CAP) { atomicAdd(&(bar)[XB_TMO], 1u); break; } } } } while (0)

struct XcdBarrier {
    unsigned* bar; unsigned x;
    volatile LAS unsigned* st;
};

__device__ __forceinline__ XcdBarrier xcd_barrier_post(unsigned* bar, volatile LAS unsigned* st) {
    XcdBarrier b; b.bar = bar; b.x = xb_xcc_id(); b.st = st;
    if (threadIdx.x == 0) (void)xb_add(&bar[XB_XCNT(b.x)], 1u);
    return b;
}
__device__ __forceinline__ void xcd_barrier_complete(unsigned* bar, unsigned x, unsigned& nloc, unsigned& nx) {
    const unsigned G = gridDim.x * gridDim.y * gridDim.z;
    unsigned sum, cnt, mine, sp = 0u;
    for (;;) {
        sum = 0u; cnt = 0u; mine = 0u;
#pragma unroll
        for (unsigned j = 0; j < 16; ++j) { const unsigned c = xb_ld(&bar[XB_XCNT(j)]); sum += c; cnt += (c > 0u) ? 1u : 0u; mine = (j == x) ? c : mine; }
        if (sum == G) break;
        __builtin_amdgcn_s_sleep(1);
        if ((++sp & 255u) == 0u) { if (xb_ld(&bar[XB_TMO])) break; if (sp > XB_SPIN_CAP) { atomicAdd(&bar[XB_TMO], 1u); break; } }
    }
    nloc = mine > 0u ? mine : 1u; nx = cnt > 0u ? cnt : 1u;
}

__device__ __forceinline__ void xcd_barrier(const XcdBarrier& b) {
    asm volatile("s_waitcnt vmcnt(0)" ::: "memory");
    __syncthreads();
    if (threadIdx.x == 0) {
        unsigned* bar = b.bar;
        __builtin_amdgcn_s_waitcnt(0);
        unsigned nloc = b.st[0], nx = b.st[1];
        if (nloc == 0u) { xcd_barrier_complete(bar, b.x, nloc, nx); b.st[0] = nloc; b.st[1] = nx; }
        const unsigned old = xb_add(&bar[XB_XSUB(b.x)], 1u);
        const unsigned gen = old / nloc;
        if (old + 1u == (gen + 1u) * nloc) {
            __builtin_amdgcn_fence(__ATOMIC_RELEASE, "agent");
            asm volatile("s_waitcnt vmcnt(0)" ::: "memory");
            const unsigned og = xb_add(&bar[XB_TOP], 1u);
            const unsigned tg = og / nx;
            if (og + 1u == (tg + 1u) * nx) xb_add(&bar[XB_TOPGEN], 1u);
            else XB_SPIN(xb_ld(&bar[XB_TOPGEN]) == tg, bar);
            __builtin_amdgcn_fence(__ATOMIC_ACQUIRE, "agent");
            xb_add(&bar[XB_XGEN(b.x)], 1u);
            asm volatile("s_waitcnt vmcnt(0)" ::: "memory");
        } else {
            XB_SPIN(xb_ld(&bar[XB_XGEN(b.x)]) == gen, bar);
            __builtin_amdgcn_fence(__ATOMIC_ACQUIRE, "agent");
            asm volatile("s_waitcnt vmcnt(0)" ::: "memory");
        }
    }
    __syncthreads();
}


namespace mk {
#define LAS3 __attribute__((address_space(3)))
__device__ __forceinline__ int src_col1(int n) { if (n < 2048) return n; if (n < 3072) return SG + (n - 2048); if (n < 3136) return SIK + (n - 3072); if (n < 3144) return SIW + (n - 3136); return -1; }
__device__ __forceinline__ int src_col3(int n) { return n < DN_IN ? n : -1; }
__device__ __forceinline__ int src_colid(int n) { return n; }

template <int MAP> __device__ __forceinline__ void wconv_load(float (&v)[8], const float* W, int ldw, const float* gain, int n0, int k0) {
    const int tid = mk::ltid();
#pragma unroll
    for (int i = 0; i < 8; ++i) {
        const int e = tid + 512 * i, kk = e >> 6, nn = e & 63, n = n0 + nn;
        const int sc = MAP == 1 ? src_col1(n) : (MAP == 3 ? src_col3(n) : src_colid(n));
        float x = 0.f;
        if (sc >= 0) { x = W[(size_t)(k0 + kk) * ldw + sc]; if (gain) x *= gain[k0 + kk]; }
        v[i] = x;
    }
}
template <int MAP> __device__ __forceinline__ void wconv_all(float* tile, const float* W, int ldw, const float* gain, bf16_t* Wt, int K, int NP, int bid, int nblk) {
    const int ntn = NP / 64, ntk = K / 64, total = ntn * ntk, tid = mk::ltid();
    float v[8], vn[8];
    int t = bid;
    if (t < total) wconv_load<MAP>(v, W, ldw, gain, (t % ntn) * 64, (t / ntn) * 64);
    for (; t < total; t += nblk) {
        const int tn = t + nblk, n0 = (t % ntn) * 64, k0 = (t / ntn) * 64;
        if (tn < total) wconv_load<MAP>(vn, W, ldw, gain, (tn % ntn) * 64, (tn / ntn) * 64);
#pragma unroll
        for (int i = 0; i < 8; ++i) { const int e = tid + 512 * i; tile[(e >> 6) * 65 + (e & 63)] = v[i]; }
        __syncthreads();
#pragma unroll
        for (int i = 0; i < 4; ++i) {
            const int e = tid + 512 * i, nn = e >> 5, kk = (e & 31) * 2;
            *(unsigned*)(Wt + (size_t)(n0 + nn) * K + k0 + kk) = pk2bf(tile[kk * 65 + nn], tile[(kk + 1) * 65 + nn]);
        }
        __syncthreads();
#pragma unroll
        for (int i = 0; i < 8; ++i) v[i] = vn[i];
    }
}
template <int MAP> __device__ __forceinline__ void wconv_waves(const float* W, int ldw, const float* gain, bf16_t* Wt, int K, int NP, int wv, int nwv) {
    const int l = mk::ltid() & 63, n = l & 31, kh = l >> 5;
    const int nun = NP / 32, nuk = K / 64;
    for (int u = wv; u < nun * nuk; u += nwv) {
        const int n0 = (u % nun) * 32, k0 = (u / nun) * 64 + 32 * kh;
        const int sc = MAP == 1 ? src_col1(n0 + n) : (MAP == 3 ? src_col3(n0 + n) : src_colid(n0 + n));
        float x[32];
#pragma unroll
        for (int i = 0; i < 32; ++i) x[i] = sc >= 0 ? W[(size_t)(k0 + i) * ldw + sc] : 0.f;
        if (gain) {
#pragma unroll
            for (int i = 0; i < 32; ++i) x[i] *= gain[k0 + i];
        }
        uint4* dst = (uint4*)(Wt + (size_t)(n0 + n) * K + k0);
#pragma unroll
        for (int q = 0; q < 4; ++q) dst[q] = make_uint4(cvtpk_native(x[8 * q], x[8 * q + 1]), cvtpk_native(x[8 * q + 2], x[8 * q + 3]), cvtpk_native(x[8 * q + 4], x[8 * q + 5]), cvtpk_native(x[8 * q + 6], x[8 * q + 7]));
    }
}
__device__ __forceinline__ void xnorm_load(const float* x, float4 (&v)[4]) { const int lane = mk::ltid() & 63;
#pragma unroll
    for (int i = 0; i < 4; ++i) v[i] = ldnt4(x + 4 * (lane + 64 * i)); }
__device__ __forceinline__ void xnorm_finish(const float4 (&v)[4], bf16_t* xa, float* inv) {
    const int lane = mk::ltid() & 63;
    float ss = 0.f;
#pragma unroll
    for (int i = 0; i < 4; ++i) ss += v[i].x * v[i].x + v[i].y * v[i].y + v[i].z * v[i].z + v[i].w * v[i].w;
    ss = wave_sum(ss);
    const float ms = ss * (1.0f / D) + EPS, r = rsqrtf(ms);
    if (lane == 0) *inv = ms * r;
#pragma unroll
    for (int i = 0; i < 4; ++i) { uint2 w; w.x = pk2bf(v[i].x * r, v[i].y * r); w.y = pk2bf(v[i].z * r, v[i].w * r); ((uint2*)xa)[lane + 64 * i] = w; }
}

using pg8::f32x4; using pg8::u32x4; using pg8::Unit; using pg8::BM; using pg8::HALF;
struct EpiF32Res {
    static constexpr bool PERM = false, AFTER_DRAIN = false;
    float* C; const float* R0; const float* R1; bf16_t* XB; float* SS; int ld; int pad_;
    __device__ __forceinline__ void operator()(const f32x4 (&acc)[2][2][4][2], const Unit& u, int wr, int wc, int fr, int fq) const {
        const int row0 = u.pm * BM + wr * 64 + fr, col0 = u.pn * BM + wc * 32 + 4 * fq;
        const float* Rb = (u.pm * BM < MP) ? R0 : R1 - (size_t)MP * ld;
#pragma unroll
        for (int ai = 0; ai < 2; ++ai)
#pragma unroll
            for (int m = 0; m < 4; ++m) { const size_t ro = (size_t)(row0 + ai * HALF + m * 16) * ld + col0;
                float ss = 0.f;
#pragma unroll
                for (int bj = 0; bj < 2; ++bj)
#pragma unroll
                    for (int n = 0; n < 2; ++n) { const f32x4 v = acc[ai][bj][m][n] + *(const f32x4*)(Rb + ro + bj * HALF + n * 16);
                        if (C) *(f32x4*)(C + ro + bj * HALF + n * 16) = v;
                        if (XB) { *(uint2*)(XB + ro + bj * HALF + n * 16) = make_uint2(cvtpk_native(v[0], v[1]), cvtpk_native(v[2], v[3])); ss += (v[0] * v[0] + v[1] * v[1]) + (v[2] * v[2] + v[3] * v[3]); } }
                if (XB) { ss += __shfl_xor(ss, 16); ss += __shfl_xor(ss, 32); if (fq == 0) atomicAdd(SS + row0 + ai * HALF + m * 16, ss); }
            }
    }
};
struct EpiY1 {
    static constexpr bool PERM = false, AFTER_DRAIN = false;
    bf16_t* XB; const float* INV; float* SS; int ld; int pad_;
    __device__ __forceinline__ void operator()(const f32x4 (&acc)[2][2][4][2], const Unit& u, int wr, int wc, int fr, int fq) const {
        const int row0 = u.pm * BM + wr * 64 + fr, col0 = u.pn * BM + wc * 32 + 4 * fq;
#pragma unroll
        for (int ai = 0; ai < 2; ++ai)
#pragma unroll
            for (int m = 0; m < 4; ++m) { const int row = row0 + ai * HALF + m * 16; const size_t ro = (size_t)row * ld + col0;
                const float inv = INV[row];
                float ss = 0.f;
#pragma unroll
                for (int bj = 0; bj < 2; ++bj)
#pragma unroll
                    for (int n = 0; n < 2; ++n) { uint2* xp = (uint2*)(XB + ro + bj * HALF + n * 16); const uint2 rb = *xp;
                        f32x4 v = acc[ai][bj][m][n];
                        v[0] = fmaf(__uint_as_float(rb.x << 16), inv, v[0]); v[1] = fmaf(__uint_as_float(rb.x & 0xFFFF0000u), inv, v[1]);
                        v[2] = fmaf(__uint_as_float(rb.y << 16), inv, v[2]); v[3] = fmaf(__uint_as_float(rb.y & 0xFFFF0000u), inv, v[3]);
                        *xp = make_uint2(cvtpk_native(v[0], v[1]), cvtpk_native(v[2], v[3])); ss += (v[0] * v[0] + v[1] * v[1]) + (v[2] * v[2] + v[3] * v[3]); }
                ss += __shfl_xor(ss, 16); ss += __shfl_xor(ss, 32); if (fq == 0) atomicAdd(SS + row, ss);
            }
    }
};
struct EpiF32ResBf {
    static constexpr bool PERM = false, AFTER_DRAIN = false;
    float* C; const bf16_t* RB; int ld; int pad_;
    __device__ __forceinline__ void operator()(const f32x4 (&acc)[2][2][4][2], const Unit& u, int wr, int wc, int fr, int fq) const {
        const int row0 = u.pm * BM + wr * 64 + fr, col0 = u.pn * BM + wc * 32 + 4 * fq;
#pragma unroll
        for (int ai = 0; ai < 2; ++ai)
#pragma unroll
            for (int m = 0; m < 4; ++m) { const size_t ro = (size_t)(row0 + ai * HALF + m * 16) * ld + col0;
#pragma unroll
                for (int bj = 0; bj < 2; ++bj)
#pragma unroll
                    for (int n = 0; n < 2; ++n) { const uint2 rb = *(const uint2*)(RB + ro + bj * HALF + n * 16);
                        f32x4 v = acc[ai][bj][m][n];
                        v[0] += __uint_as_float(rb.x << 16); v[1] += __uint_as_float(rb.x & 0xFFFF0000u); v[2] += __uint_as_float(rb.y << 16); v[3] += __uint_as_float(rb.y & 0xFFFF0000u);
                        *(f32x4*)(C + ro + bj * HALF + n * 16) = v; }
            }
    }
};
struct EpiBf16Tail {
    static constexpr bool PERM = true, AFTER_DRAIN = false;
    bf16_t* O; int ldc; int ntile_bf; float* BA; const float* SS;
    float* QSS;
    __device__ __forceinline__ void operator()(const f32x4 (&acc)[2][2][4][2], const Unit& u, int wr, int wc, int fr, int fq) const {
        const int row0 = u.pm * BM + wr * 64 + fr;
        float rs[2][4];
#pragma unroll
        for (int ai = 0; ai < 2; ++ai)
#pragma unroll
            for (int m = 0; m < 4; ++m) rs[ai][m] = SS ? rsqrtf(SS[row0 + ai * HALF + m * 16] * (1.0f / D) + EPS) : 1.0f;
        if (u.pn >= ntile_bf) {
            if (wc == 0 && fq < 2) {
#pragma unroll
                for (int ai = 0; ai < 2; ++ai)
#pragma unroll
                    for (int m = 0; m < 4; ++m) { float* rp = BA + (size_t)(row0 + ai * HALF + m * 16) * 16 + 8 * fq;
                        *(f32x4*)(rp) = acc[ai][0][m][0] * rs[ai][m]; *(f32x4*)(rp + 4) = acc[ai][0][m][1] * rs[ai][m]; }
            }
            return;
        }
        const int col0 = u.pn * BM + wc * 32 + 8 * fq;
        const bool qsum = QSS != nullptr && u.pn < 4;
#pragma unroll
        for (int ai = 0; ai < 2; ++ai)
#pragma unroll
            for (int m = 0; m < 4; ++m) { bf16_t* rowp = O + (size_t)(row0 + ai * HALF + m * 16) * ldc + col0;
#pragma unroll
                for (int bj = 0; bj < 2; ++bj) { const f32x4 v0 = acc[ai][bj][m][0] * rs[ai][m], v1 = acc[ai][bj][m][1] * rs[ai][m];
                    u32x4 w; w.x = pg8::cvt_pk_bf16(v0[0], v0[1]); w.y = pg8::cvt_pk_bf16(v0[2], v0[3]); w.z = pg8::cvt_pk_bf16(v1[0], v1[1]); w.w = pg8::cvt_pk_bf16(v1[2], v1[3]);
                    *(u32x4*)(rowp + bj * HALF) = w;
                    if (qsum) { float ss = ((v0[0] * v0[0] + v0[1] * v0[1]) + (v0[2] * v0[2] + v0[3] * v0[3])) + ((v1[0] * v1[0] + v1[1] * v1[1]) + (v1[2] * v1[2] + v1[3] * v1[3]));
                        ss += __shfl_xor(ss, 16); ss += __shfl_xor(ss, 32);
                        if (fq == 0) atomicAdd(QSS + (size_t)(row0 + ai * HALF + m * 16) * 8 + 2 * u.pn + bj, ss); } } }
    }
};
}
namespace mk {
template <int NJ, class P, class F> __device__ __forceinline__ void gemm_small_unit(char* lds, const bf16_t* A, const bf16_t* Bt, int row0, int col0, P&& pre, F&& emit) {
    const int tid = ltid(), w = __builtin_amdgcn_readfirstlane(tid >> 6), l = tid & 63, r = l & 31, hh = l >> 5;
    const bf16_t* ap = A + (size_t)(row0 + r) * D + 128 * w + 8 * hh;
    const bf16_t* bp = Bt + (size_t)(col0 + r) * D + 128 * w + 8 * hh;
    bf16x8 af[8], bfr[NJ][8];
#pragma unroll
    for (int s = 0; s < 8; ++s) { af[s] = *(const bf16x8*)(ap + 16 * s);
#pragma unroll
        for (int j = 0; j < NJ; ++j) bfr[j][s] = *(const bf16x8*)(bp + (size_t)(32 * j) * D + 16 * s); }
    float rsd[NJ][2];
#pragma unroll
    for (int j = 0; j < NJ; ++j)
#pragma unroll
        for (int e = 0; e < 2; ++e) { const int q = 2 * w + e; rsd[j][e] = pre(row0 + (q & 3) + 8 * (q >> 2) + 4 * hh, col0 + 32 * j + r); }
    f32x16 acc[NJ];
#pragma unroll
    for (int j = 0; j < NJ; ++j) acc[j] = f32x16{};
#pragma unroll
    for (int s = 0; s < 8; ++s)
#pragma unroll
        for (int j = 0; j < NJ; ++j) acc[j] = __builtin_amdgcn_mfma_f32_32x32x16_bf16(af[s], bfr[j][s], acc[j], 0, 0, 0);
    float* part = (float*)lds;
#pragma unroll
    for (int j = 0; j < NJ; ++j)
#pragma unroll
        for (int q = 0; q < 16; ++q) part[((w * NJ + j) * 16 + q) * 64 + l] = acc[j][q];
    __syncthreads();
#pragma unroll
    for (int j = 0; j < NJ; ++j)
#pragma unroll
        for (int e = 0; e < 2; ++e) {
            const int q = 2 * w + e;
            float v = 0.f;
#pragma unroll
            for (int ww = 0; ww < 8; ++ww) v += part[((ww * NJ + j) * 16 + q) * 64 + l];
            emit(row0 + (q & 3) + 8 * (q >> 2) + 4 * hh, col0 + 32 * j + r, v, rsd[j][e]);
        }
    __syncthreads();
}
}

namespace mk {

struct AttPostRegs { unsigned k[2], v[2]; bf16_t ik, iw; };
__device__ __forceinline__ void att_post_load(int m, const bf16_t* P1, AttPostRegs& R) {
    const int l = mk::ltid() & 63;
    const unsigned* p = (const unsigned*)(P1 + (size_t)m * N1P);
#pragma unroll
    for (int h = 0; h < 2; ++h) { R.k[h] = p[(CK >> 1) + h * 64 + l]; R.v[h] = p[(CV >> 1) + h * 64 + l]; }
    R.ik = P1[(size_t)m * N1P + CIK + l]; R.iw = P1[(size_t)m * N1P + CIW + (l & 7)];
}
__device__ __forceinline__ void att_post_finish(int m, const AttPostRegs& R, const float* qg, const float* kg, const float* ikg, bf16_t* KB, bf16_t* IKB, float* IW, float* out) {
    const int l = mk::ltid() & 63;
    const float g0 = qg[2 * l], g1 = qg[2 * l + 1];
    {
        const float k0 = kg[2 * l], k1 = kg[2 * l + 1];
        float* ko = kout(out, m); unsigned* kb = (unsigned*)(KB + (size_t)m * 256);
        float ka[2], kb2[2], ss[3];
#pragma unroll
        for (int h = 0; h < 2; ++h) { ka[h] = __uint_as_float(R.k[h] << 16); kb2[h] = __uint_as_float(R.k[h] & 0xFFFF0000u); ss[h] = ka[h] * ka[h] + kb2[h] * kb2[h]; }
        const float ia = bf2f(R.ik); ss[2] = ia * ia;
        wave_sum_n<3>(ss);
#pragma unroll
        for (int h = 0; h < 2; ++h) {
            const float r = rsqrtf(ss[h] * (1.0f / 128) + EPS);
            const float x = ka[h] * r * k0, y = kb2[h] * r * k1;
            *(float2*)(ko + h * 128 + 2 * l) = make_float2(x, y);
            kb[h * 64 + l] = pk2bf(x * g0, y * g1);
        }
        float* vo = vout(out, m);
#pragma unroll
        for (int h = 0; h < 2; ++h) *(float2*)(vo + h * 128 + 2 * l) = make_float2(__uint_as_float(R.v[h] << 16), __uint_as_float(R.v[h] & 0xFFFF0000u));
        const float ri = rsqrtf(ss[2] * (1.0f / 64) + EPS);
        const float xi = ia * ri * ikg[l];
        ikout(out, m)[l] = xi;
        IKB[(size_t)m * 64 + l] = f2bf(xi);
        if (l < 8) IW[(size_t)m * 8 + l] = bf2f(R.iw) * (0.35355339059327373f * 0.125f);
    }
}
__device__ __forceinline__ void att_post_rows(int gw, int nw, const bf16_t* P1, const float* qg, const float* kg, const float* ikg, bf16_t* KB, bf16_t* IKB, float* IW, float* out) {
    AttPostRegs R0, R1, R2;
    int m = gw;
    if (m < M) att_post_load(m, P1, R0);
    if (m + nw < M) att_post_load(m + nw, P1, R1);
    for (; m < M; m += 3 * nw) {
        if (m + 2 * nw < M) att_post_load(m + 2 * nw, P1, R2);
        att_post_finish(m, R0, qg, kg, ikg, KB, IKB, IW, out);
        if (m + nw < M) { if (m + 3 * nw < M) att_post_load(m + 3 * nw, P1, R0);
            att_post_finish(m + nw, R1, qg, kg, ikg, KB, IKB, IW, out); }
        if (m + 2 * nw < M) { if (m + 4 * nw < M) att_post_load(m + 4 * nw, P1, R1);
            att_post_finish(m + 2 * nw, R2, qg, kg, ikg, KB, IKB, IW, out); }
    }
}
}

namespace ix {
using mk::bf16_t; using mk::bf16x8; using mk::f32x16;
constexpr int TOPK = mk::TOPK;
constexpr float NEGINF = -__builtin_inff();
__device__ __forceinline__ float key2f(unsigned k) { return (k & 0x80000000u) ? __uint_as_float(k & 0x7FFFFFFFu) : __uint_as_float(~k); }

__device__ __forceinline__ void tile_partial(const bf16x8 (&af)[4], const bf16x8 (&bfr)[4], const float (&w)[16], float (&p)[4]) {
    f32x16 acc = {};
#pragma unroll
    for (int s = 0; s < 4; ++s) acc = __builtin_amdgcn_mfma_f32_32x32x16_bf16(af[s], bfr[s], acc, 0, 0, 0);
#pragma unroll
    for (int T = 0; T < 4; ++T) {
        float x = w[4 * T] * fmaxf(acc[4 * T], 0.f);
        x = fmaf(w[4 * T + 1], fmaxf(acc[4 * T + 1], 0.f), x);
        x = fmaf(w[4 * T + 2], fmaxf(acc[4 * T + 2], 0.f), x);
        x = fmaf(w[4 * T + 3], fmaxf(acc[4 * T + 3], 0.f), x);
        p[T] = x;
    }
}
__device__ __forceinline__ float pair_combine(float pa, float pb) {
    auto rr = __builtin_amdgcn_permlane32_swap(__float_as_uint(pa), __float_as_uint(pb), false, false);
    return __uint_as_float(rr[0]) + __uint_as_float(rr[1]);
}
__device__ __forceinline__ void load_af_w(const bf16_t* P1, const float* IW, int m0, int r, int hh, bf16x8 (&af)[4], float (&w)[16]) {
    const bf16_t* ap = P1 + (size_t)(m0 + (r >> 3)) * mk::N1P + mk::CIQ + (r & 7) * 64 + 8 * hh;
#pragma unroll
    for (int s = 0; s < 4; ++s) af[s] = *(const bf16x8*)(ap + 16 * s);
#pragma unroll
    for (int i = 0; i < 16; ++i) w[i] = IW[(size_t)(m0 + (i >> 2)) * 8 + (i & 3) + 4 * hh];
}

template <int NA, int NR, int MI = 0, class F> __device__ __forceinline__ void topk_select(const float (&sc)[NA], F&& emit) {
    unsigned lo = 0x007FFFFFu, hi = 0xFF800001u;
    float tau = NEGINF; bool exact = false;
    auto count_ge = [&](float tf) __attribute__((always_inline)) -> int {
        int c = 0;
#pragma unroll
        for (int k0 = 0; k0 < NR; k0 += 8) {
            unsigned long long bm[8];
#pragma unroll
            for (int q = 0; q < 8; ++q) bm[q] = (k0 + q < NR) ? __builtin_amdgcn_ballot_w64(sc[k0 + q < NR ? k0 + q : 0] >= tf) : 0ull;
            __builtin_amdgcn_sched_barrier(0);
#pragma unroll
            for (int q = 0; q < 8; ++q) c += __builtin_popcountll(bm[q]);
            __builtin_amdgcn_sched_barrier(0);
        }
        return c;
    };
    if (MI) {
        float mx = sc[0];
#pragma unroll
        for (int k = 1; k < NR; ++k) mx = fmaxf(mx, sc[k]);
        mx = fmaxf(mx, __int_as_float(__builtin_amdgcn_update_dpp(0, __float_as_int(mx), 0xB1, 0xF, 0xF, false)));
        mx = fmaxf(mx, __int_as_float(__builtin_amdgcn_update_dpp(0, __float_as_int(mx), 0x4E, 0xF, 0xF, false)));
        mx = fmaxf(mx, __int_as_float(__builtin_amdgcn_update_dpp(0, __float_as_int(mx), 0x124, 0xF, 0xF, false)));
        mx = fmaxf(mx, __int_as_float(__builtin_amdgcn_update_dpp(0, __float_as_int(mx), 0x128, 0xF, 0xF, false)));
        const int mi = __float_as_int(mx);
        const float m4 = fmaxf(fmaxf(__int_as_float(__builtin_amdgcn_readlane(mi, 0)), __int_as_float(__builtin_amdgcn_readlane(mi, 16))),
                               fmaxf(__int_as_float(__builtin_amdgcn_readlane(mi, 32)), __int_as_float(__builtin_amdgcn_readlane(mi, 48))));
        if (m4 > 1e-30f) {
            hi = (__float_as_uint(m4) | 0x80000000u) + 1u;
            const float tf = m4 * 0.0625f; const unsigned kf = __float_as_uint(tf) | 0x80000000u;
            const int c = count_ge(tf);
            if (c >= TOPK) { lo = kf; tau = tf; if (c == TOPK) { exact = true; hi = lo + 1u; } } else hi = kf;
        }
    }
    while (hi - lo > 1u) {
        const unsigned mid = lo + ((hi - lo) >> 1);
        const float tf = key2f(mid);
        const int c = count_ge(tf);
        if (c >= TOPK) { lo = mid; tau = tf; if (c == TOPK) { exact = true; break; } } else hi = mid;
    }
    if (exact) {
#pragma unroll
        for (int k = 0; k < NA; ++k) emit(k, k < NR ? __builtin_amdgcn_ballot_w64(sc[k] >= tau) : 0ull);
        return;
    }
    int cgt = 0;
#pragma unroll
    for (int k = 0; k < NR; ++k) cgt += __builtin_popcountll(__builtin_amdgcn_ballot_w64(sc[k] > tau));
    int need = TOPK - cgt;
#pragma unroll
    for (int k = 0; k < NA; ++k) {
        unsigned long long bm = 0ull;
        if (k < NR) {
            const unsigned long long gt = __builtin_amdgcn_ballot_w64(sc[k] > tau);
            unsigned long long eq = __builtin_amdgcn_ballot_w64(sc[k] == tau);
            int pc = __builtin_popcountll(eq);
            while (pc > need) { eq &= ~(1ull << (63 - __builtin_clzll(eq))); --pc; }
            need -= pc;
            bm = gt | eq;
        }
        emit(k, bm);
    }
}

__device__ __forceinline__ void index_prompt_block(int b, int gi, char* lds, const bf16_t* P1, const bf16_t* IKB, const float* IW, unsigned* MASK) {
    const int tid = mk::ltid(), w = __builtin_amdgcn_readfirstlane(tid >> 6), l = tid & 63, r = l & 31, hh = l >> 5;
    const int t0 = 32 * gi + 4 * w, m0 = b * mk::SEQ + t0;
    if (gi < 8) {
#pragma unroll
        for (int T = 0; T < 4; ++T) { const int nb = t0 + T + 1 - 32 * l; MASK[(size_t)(m0 + T) * 64 + l] = nb >= 32 ? 0xFFFFFFFFu : (nb <= 0 ? 0u : ((1u << nb) - 1u)); }
        return;
    }
    bf16x8 af[4]; float wt[16];
    load_af_w(P1, IW, m0, r, hh, af, wt);
    const int JP = (32 * gi + 31) / 64 + 1;
    const int skey = tid >> 3, sch = tid & 7;
    const bf16_t* gsrc = IKB + (size_t)(b * mk::SEQ + skey) * 64 + 8 * sch;
    const int sdst = (skey * 8 + (sch ^ ((skey >> 1) & 7))) * 16;
    const int rd0 = r * 128 + ((hh ^ ((r >> 1) & 1)) << 4), rda = ((r >> 1) & 6) << 4;
#define RDO(s) (rd0 + ((32 * (s)) ^ rda))
    float sc[4][32];
    uint4 stA, stB = make_uint4(0u, 0u, 0u, 0u);
    stA = *(const uint4*)gsrc;
    if (1 < JP) stB = *(const uint4*)(gsrc + (size_t)1 * 64 * 64);
    *(uint4*)(lds + sdst) = stA;
    __syncthreads();
#pragma unroll
    for (int jp = 0; jp < 32; ++jp) {
        if (jp < JP) {
            if (jp + 2 < JP) { if (jp & 1) stB = *(const uint4*)(gsrc + (size_t)(jp + 2) * 64 * 64); else stA = *(const uint4*)(gsrc + (size_t)(jp + 2) * 64 * 64); }
            const char* buf = lds + (jp & 1) * 8192;
            if (jp * 64 <= t0 + 3) {
                float pa[4], pb[4];
                { bf16x8 bfr[4];
#pragma unroll
                  for (int s = 0; s < 4; ++s) bfr[s] = *(const bf16x8*)(buf + RDO(s));
                  tile_partial(af, bfr, wt, pa); }
                { bf16x8 bfr[4];
#pragma unroll
                  for (int s = 0; s < 4; ++s) bfr[s] = *(const bf16x8*)(buf + RDO(s) + 4096);
                  tile_partial(af, bfr, wt, pb); }
#pragma unroll
                for (int T = 0; T < 4; ++T) {
                    float s = pair_combine(pa[T], pb[T]);
                    if (jp * 64 + 63 > t0) { if (jp * 64 + l > t0 + T) s = NEGINF; }
                    sc[T][jp] = s;
                }
            } else {
#pragma unroll
                for (int T = 0; T < 4; ++T) sc[T][jp] = NEGINF;
            }
            if (jp + 1 < JP) *(uint4*)(lds + ((jp + 1) & 1) * 8192 + sdst) = ((jp + 1) & 1) ? stB : stA;
            mk::lds_barrier();
        } else {
#pragma unroll
            for (int T = 0; T < 4; ++T) sc[T][jp] = NEGINF;
        }
    }
#define IX_SELECT(T) do { \
        unsigned wv = 0u; \
        auto put = [&](int k, unsigned long long bm) { const unsigned mine = (l & 1) ? (unsigned)(bm >> 32) : (unsigned)bm; wv = ((l >> 1) == k) ? mine : wv; }; \
        const int nreg = (t0 + (T)) / 64 + 1;                                    \
        if (nreg <= 8) topk_select<32, 8, 1>(sc[T], put); else if (nreg <= 16) topk_select<32, 16, 1>(sc[T], put); else if (nreg <= 24) topk_select<32, 24, 1>(sc[T], put); else topk_select<32, 32, 1>(sc[T], put); \
        MASK[(size_t)(m0 + (T)) * 64 + l] = wv; \
    } while (0)
    IX_SELECT(0); IX_SELECT(1); IX_SELECT(2); IX_SELECT(3);
#undef IX_SELECT
}

constexpr int SCR_BYTES = 8 * 2048 * 4, SCX_OFF = SCR_BYTES;
__device__ __forceinline__ void index_sample_block(int b, int kc, char* lds, const bf16_t* P1, const bf16_t* IKB, const float* IW, const float* cache_ik, const int* page_table, float* CS, int* CI) {
    const int tid = mk::ltid(), w = __builtin_amdgcn_readfirstlane(tid >> 6), l = tid & 63, r = l & 31, hh = l >> 5;
    const int m0 = mk::MP + b * mk::DS;
    float* scr = (float*)lds; float* scx = (float*)(lds + SCX_OFF);
    bf16x8 afA[4], afB[4]; float wtA[16], wtB[16];
    load_af_w(P1, IW, m0, r, hh, afA, wtA);
    load_af_w(P1, IW, m0 + 4, r, hh, afB, wtB);
    const int kbase = 2048 * kc + 256 * w;
    const int pg0 = __builtin_amdgcn_readfirstlane(page_table[b * mk::NPG + (kbase >> 7)]), pg1 = __builtin_amdgcn_readfirstlane(page_table[b * mk::NPG + (kbase >> 7) + 1]);
    const float* kp0 = cache_ik + ((size_t)pg0 * mk::PAGE + r) * 64 + 8 * hh;
    const float* kp1 = cache_ik + ((size_t)pg1 * mk::PAGE + r) * 64 + 8 * hh;
    float4 ring[3][8];
#define SI_LOAD(slot, tl_) do { const float* p_ = (((tl_) >> 2) ? kp1 : kp0) + ((tl_) & 3) * 32 * 64; _Pragma("unroll") for (int s = 0; s < 4; ++s) { ring[slot][2 * s] = *(const float4*)(p_ + 16 * s); ring[slot][2 * s + 1] = *(const float4*)(p_ + 16 * s + 4); } } while (0)
    SI_LOAD(0, 0); SI_LOAD(1, 1); SI_LOAD(2, 2);
    float pA[4] = {0.f, 0.f, 0.f, 0.f}, pB[4] = {0.f, 0.f, 0.f, 0.f};
#pragma unroll
    for (int tl = 0; tl < 8; ++tl) {
        bf16x8 bfr[4];
#pragma unroll
        for (int s = 0; s < 4; ++s) { const float4 x = ring[tl % 3][2 * s], y = ring[tl % 3][2 * s + 1];
            mk::u32x4_t u = {mk::cvtpk_native(x.x, x.y), mk::cvtpk_native(x.z, x.w), mk::cvtpk_native(y.x, y.y), mk::cvtpk_native(y.z, y.w)}; bfr[s] = *reinterpret_cast<bf16x8*>(&u); }
        if (tl + 3 < 8) SI_LOAD(tl % 3, tl + 3);
        float qa[4], qb[4];
        tile_partial(afA, bfr, wtA, qa);
        tile_partial(afB, bfr, wtB, qb);
        if (tl & 1) {
#pragma unroll
            for (int T = 0; T < 4; ++T) { scr[T * 2048 + 256 * w + 32 * (tl - 1) + l] = pair_combine(pA[T], qa[T]); scr[(4 + T) * 2048 + 256 * w + 32 * (tl - 1) + l] = pair_combine(pB[T], qb[T]); }
        } else {
#pragma unroll
            for (int T = 0; T < 4; ++T) { pA[T] = qa[T]; pB[T] = qb[T]; }
        }
    }
#undef SI_LOAD
    if (kc == 7 && w < 2) {
        bf16x8 bfr[4];
#pragma unroll
        for (int s = 0; s < 4; ++s) { bfr[s] = bf16x8{}; if (r < mk::DS) bfr[s] = *(const bf16x8*)(IKB + (size_t)(mk::MP + b * mk::DS + r) * 64 + 16 * s + 8 * hh); }
        float p[4];
        if (w == 0) tile_partial(afA, bfr, wtA, p); else tile_partial(afB, bfr, wtB, p);
#pragma unroll
        for (int T = 0; T < 4; ++T) { const float s = pair_combine(p[T], p[T]); if (l < mk::DS) scx[(4 * w + T) * 8 + l] = (l <= 4 * w + T) ? s : NEGINF; }
    }
    __syncthreads();
    {
        const int tok = w;
        float sc[33];
#pragma unroll
        for (int k = 0; k < 32; ++k) sc[k] = scr[tok * 2048 + 64 * k + l];
        sc[32] = (kc == 7 && l < mk::DS) ? scx[tok * 8 + l] : NEGINF;
        float* cs = CS + ((size_t)(b * mk::DS + tok) * 8 + kc) * TOPK; int* ci = CI + ((size_t)(b * mk::DS + tok) * 8 + kc) * TOPK;
        int run = 0;
        topk_select<33, 33>(sc, [&](int k, unsigned long long bm) {
            const bool mine = (bm >> l) & 1ull;
            const int pos = run + __builtin_popcountll(bm & ((1ull << l) - 1ull));
            if (mine) { cs[pos] = sc[k]; ci[pos] = (k < 32) ? 2048 * kc + 64 * k + l : mk::PAST + l; }
            run += __builtin_popcountll(bm);
        });
    }
    __syncthreads();
}

__device__ __forceinline__ void merge_sample_row(int r, const float* CS, const int* CI, const int* page_table, int* rowi) {
    const int l = mk::ltid() & 63, b = r / mk::DS;
    float sc[32];
    const float* cs = CS + (size_t)r * 8 * TOPK; const int* ci = CI + (size_t)r * 8 * TOPK;
#pragma unroll
    for (int k = 0; k < 32; ++k) sc[k] = cs[64 * k + l];
    int run = 0;
    topk_select<32, 32>(sc, [&](int k, unsigned long long bm) {
        const bool mine = (bm >> l) & 1ull;
        const int pos = run + __builtin_popcountll(bm & ((1ull << l) - 1ull));
        if (mine) { const int idx = ci[64 * k + l];
            rowi[pos] = idx < mk::PAST ? page_table[b * mk::NPG + idx / mk::PAGE] * mk::PAGE + (idx % mk::PAGE) : -(b * mk::DS + (idx - mk::PAST)) - 1; }
        run += __builtin_popcountll(bm);
    });
}
}

namespace dsa {
using mk::bf16_t;
typedef short bf16x8 __attribute__((ext_vector_type(8)));
typedef short s16x4 __attribute__((ext_vector_type(4)));
typedef float f32x16 __attribute__((ext_vector_type(16)));
typedef float f32x4 __attribute__((ext_vector_type(4)));
typedef unsigned u32x4 __attribute__((ext_vector_type(4)));
constexpr float SCALE = 0.08838834764831845f;
constexpr float THR = 8.f;
constexpr int NW = 8, QBLK = 32, KVBLK = 64, HDIM = 128;
constexpr int SHM_V = KVBLK * HDIM * 2, SHM_K = KVBLK * HDIM * 2;
constexpr int LDS_BYTES = 2 * SHM_V + 2 * SHM_K + NW * 64 * 4;

#define KSWZ(row, colB) ((row) * 256 + ((colB) ^ (((row) & 7) << 4)))
#define SBAR() __builtin_amdgcn_sched_barrier(0)
__device__ __forceinline__ int v_st(int k, int c) { const int kk = (k & ~0xC) | ((k & 4) << 1) | ((k & 8) >> 1); return ((kk >> 3) * 4 + (c >> 5)) * 512 + ((kk & 7) * 32 + (c & 31)) * 2; }
__device__ __forceinline__ int v_rd_base(int lane) { return ((lane & 3) << 3) | (((lane >> 2) & 3) << 6) | (((lane >> 4) & 1) << 5) | (((lane >> 5) & 1) << 8); }
constexpr int v_rd_off(int d0, int ks, int half) { return d0 * 512 + ks * 4096 + half * 2048; }
__device__ __forceinline__ int crow(int r, int hi) { return (r & 3) + 8 * (r >> 2) + 4 * hi; }
__device__ __forceinline__ unsigned cvtpk(float lo, float hi) { return mk::cvtpk_native(lo, hi); }

__device__ __forceinline__ void partialSM(f32x16& p0, f32x16& p1, float& m_reg, float& mn, float& alpha) {
    float pmax = p0[0]; for (int r = 1; r < 16; ++r) pmax = fmaxf(pmax, p0[r]); for (int r = 0; r < 16; ++r) pmax = fmaxf(pmax, p1[r]);
    { auto rr = __builtin_amdgcn_permlane32_swap(__float_as_uint(pmax), __float_as_uint(pmax), false, false);
      pmax = fmaxf(__uint_as_float(rr[0]), __uint_as_float(rr[1])); }
    constexpr float C2 = 1.4426950408889634f * SCALE;
    if (__builtin_expect(__all((pmax - m_reg) * SCALE <= THR), 1)) { mn = m_reg; alpha = 1.f; }
    else { mn = fmaxf(m_reg, pmax); alpha = __builtin_amdgcn_exp2f((m_reg - mn) * C2); m_reg = mn; }
    const float mnL = -mn * C2;
    for (int r = 0; r < 16; ++r) p0[r] = fmaf(p0[r], C2, mnL); for (int r = 0; r < 16; ++r) p1[r] = fmaf(p1[r], C2, mnL);
    for (int r = 0; r < 16; ++r) p0[r] = __builtin_amdgcn_exp2f(p0[r]);
}
__device__ __forceinline__ void finishSM(f32x16& p0, f32x16& p1, float alpha, float& l_reg, uint2 mw, int hi, bf16x8& pa0, bf16x8& pa1, bf16x8& pa2, bf16x8& pa3) {
    for (int r = 0; r < 16; ++r) p1[r] = __builtin_amdgcn_exp2f(p1[r]);
    const int w0 = (int)(mw.x >> (4 * hi)), w1 = (int)(mw.y >> (4 * hi));
#pragma unroll
    for (int r = 0; r < 16; ++r) {
        const int c = (r & 3) + 8 * (r >> 2);
        int b0 = __builtin_amdgcn_sbfe(w0, c, 1), b1 = __builtin_amdgcn_sbfe(w1, c, 1);
        asm volatile("" : "+v"(b0), "+v"(b1));
        p0[r] = __uint_as_float(__float_as_uint(p0[r]) & (unsigned)b0);
        p1[r] = __uint_as_float(__float_as_uint(p1[r]) & (unsigned)b1);
    }
    float ps = 0; for (int r = 0; r < 16; ++r) ps += p0[r]; for (int r = 0; r < 16; ++r) ps += p1[r];
    { auto rr = __builtin_amdgcn_permlane32_swap(__float_as_uint(ps), __float_as_uint(ps), false, false);
      ps = __uint_as_float(rr[0]) + __uint_as_float(rr[1]); }
    l_reg = l_reg * alpha + ps;
#define PK4(P, B_, OUT) do { unsigned a0 = cvtpk(P[B_+0], P[B_+1]), a1 = cvtpk(P[B_+2], P[B_+3]);                          \
        unsigned b0 = cvtpk(P[B_+4], P[B_+5]), b1 = cvtpk(P[B_+6], P[B_+7]);                                             \
        auto r0 = __builtin_amdgcn_permlane32_swap(a0, b0, false, false); auto r1 = __builtin_amdgcn_permlane32_swap(a1, b1, false, false); \
        u32x4 w = {r0[0], r1[0], r0[1], r1[1]}; OUT = *reinterpret_cast<bf16x8*>(&w); } while (0)
    PK4(p0, 0, pa0); PK4(p0, 8, pa1); PK4(p1, 0, pa2); PK4(p1, 8, pa3);
#undef PK4
}
template <int KB>
__device__ __forceinline__ void qkt(f32x16& p0, f32x16& p1, const char* K_lds, int r32, int hi, const bf16x8* qr) {
    p0 = f32x16{}; p1 = f32x16{};
    const char* kb[4];
#pragma unroll
    for (int dd = 0; dd < 4; ++dd) kb[dd] = K_lds + KB * SHM_K + KSWZ(r32, (dd * 16 + hi * 8) * 2);
#pragma unroll
    for (int d0 = 0; d0 < 8; ++d0) { const char* a = kb[d0 & 3] + (d0 >> 2) * 128;
        bf16x8 b0 = *reinterpret_cast<const bf16x8*>(a);
        bf16x8 b1 = *reinterpret_cast<const bf16x8*>(a + 32 * 256);
        p0 = __builtin_amdgcn_mfma_f32_32x32x16_bf16(b0, qr[d0], p0, 0, 0, 0);
        p1 = __builtin_amdgcn_mfma_f32_32x32x16_bf16(b1, qr[d0], p1, 0, 0, 0); }
}
template <int VB>
__device__ __forceinline__ void pv_tile(f32x16* o, int vb0, bf16x8 pa0, bf16x8 pa1, bf16x8 pa2, bf16x8 pa3) {
#define TRRD(dst, off) asm volatile("ds_read_b64_tr_b16 %0, %1 offset:%2" : "=&v"(dst) : "v"(vb0), "i"(off) : "memory")
#define PV_D0(d0) do { s16x4 l0, l1, l2, l3, h0, h1, h2, h3; constexpr int b_ = VB * SHM_V + v_rd_off(d0, 0, 0);   \
        TRRD(l0, b_); TRRD(h0, b_ + 2048); TRRD(l1, b_ + 4096); TRRD(h1, b_ + 6144); TRRD(l2, b_ + 8192); TRRD(h2, b_ + 10240); TRRD(l3, b_ + 12288); TRRD(h3, b_ + 14336); \
        asm volatile("s_waitcnt lgkmcnt(0)" ::: "memory"); SBAR();   \
        o[d0] = __builtin_amdgcn_mfma_f32_32x32x16_bf16(pa0, (bf16x8){l0[0], l0[1], l0[2], l0[3], h0[0], h0[1], h0[2], h0[3]}, o[d0], 0, 0, 0);   \
        o[d0] = __builtin_amdgcn_mfma_f32_32x32x16_bf16(pa1, (bf16x8){l1[0], l1[1], l1[2], l1[3], h1[0], h1[1], h1[2], h1[3]}, o[d0], 0, 0, 0);   \
        o[d0] = __builtin_amdgcn_mfma_f32_32x32x16_bf16(pa2, (bf16x8){l2[0], l2[1], l2[2], l2[3], h2[0], h2[1], h2[2], h2[3]}, o[d0], 0, 0, 0);   \
        o[d0] = __builtin_amdgcn_mfma_f32_32x32x16_bf16(pa3, (bf16x8){l3[0], l3[1], l3[2], l3[3], h3[0], h3[1], h3[2], h3[3]}, o[d0], 0, 0, 0); } while (0)
    PV_D0(0); PV_D0(1); PV_D0(2); PV_D0(3);
#undef PV_D0
#undef TRRD
}

struct Tensors { const float* QSS; const bf16_t* KB; const bf16_t* P1; const unsigned* MASK; bf16_t* AO; };
struct Blk { int b, g, qc; };
struct Seam { bf16x8 qr[8]; bf16x8 st_v0, st_v1, st_k0, st_k1; float qss; };
__device__ __forceinline__ const bf16_t* q_row(const Tensors& T, const Blk& k, int wid, int r32) { return T.P1 + (size_t)(k.b * mk::SEQ + k.qc * 64 + (wid & 1) * 32 + r32) * mk::N1P + mk::CQ + (4 * k.g + (wid >> 1)) * 128; }
__device__ __forceinline__ const float* qss_ptr(const Tensors& T, const Blk& k, int wid, int r32) { return T.QSS + (size_t)(k.b * mk::SEQ + k.qc * 64 + (wid & 1) * 32 + r32) * 8 + (4 * k.g + (wid >> 1)); }
__device__ __forceinline__ const bf16_t* k_row(const Tensors& T, const Blk& k, int key) { return T.KB + (size_t)(k.b * mk::SEQ + key) * 256 + k.g * 128; }
__device__ __forceinline__ const bf16_t* v_row(const Tensors& T, const Blk& k, int key) { return T.P1 + (size_t)(k.b * mk::SEQ + key) * mk::N1P + mk::CV + k.g * 128; }

#define VMW() asm volatile("s_waitcnt vmcnt(0)" ::: "memory")
#define VMWN(n) asm volatile("s_waitcnt vmcnt(%0)" :: "i"(n) : "memory")
#define SLOAD_H(blk, k0) do { S.st_v0 = *(const bf16x8*)(v_row(T, blk, (k0) + sr) + sc); S.st_v1 = *(const bf16x8*)(v_row(T, blk, (k0) + 32 + sr) + sc);   \
                              S.st_k0 = *(const bf16x8*)(k_row(T, blk, (k0) + sr) + sc); S.st_k1 = *(const bf16x8*)(k_row(T, blk, (k0) + 32 + sr) + sc); } while (0)
#define SWRITE_HK(bf) do { *(bf16x8*)(K_lds + (bf) * SHM_K + kws) = S.st_k0; *(bf16x8*)(K_lds + (bf) * SHM_K + kws + 32 * 256) = S.st_k1; } while (0)
#define SWRITE_HV(bf) do { *(bf16x8*)(V_lds + (bf) * SHM_V + vst0) = S.st_v0; *(bf16x8*)(V_lds + (bf) * SHM_V + vst0 + VST1) = S.st_v1; } while (0)
#define SWRITE_H(bf) do { SWRITE_HV(bf); SWRITE_HK(bf); } while (0)

__device__ __forceinline__ void dsa_prime(const Tensors& T, const Blk& cur, char* lds, Seam& S) {
    const int tid = mk::ltid(), wid = __builtin_amdgcn_readfirstlane(tid >> 6), lane = tid & 63, r32 = lane & 31, hi = lane >> 5;
    const int sr = tid >> 4, sc = (tid & 15) * 8, kws = KSWZ(sr, sc * 2); char* K_lds = lds + 2 * SHM_V;
    const bf16_t* qp = q_row(T, cur, wid, r32) + hi * 8;
    for (int d0 = 0; d0 < 8; ++d0) S.qr[d0] = *(const bf16x8*)(qp + d0 * 16);
    S.qss = *qss_ptr(T, cur, wid, r32);
    SLOAD_H(cur, 0); VMW(); SWRITE_HK(0);
    __syncthreads();
}
__device__ __forceinline__ void dsa_block(const Tensors& T, const Blk& cur, const Blk& nxt, char* lds, Seam& S) {
    const int tid = mk::ltid(), wid = __builtin_amdgcn_readfirstlane(tid >> 6), lane = tid & 63, r32 = lane & 31, hi = lane >> 5;
    const int NT = cur.qc + 1;
    char* V_lds = lds; char* K_lds = lds + 2 * SHM_V;
    float* ws = (float*)(lds + 2 * SHM_V + 2 * SHM_K) + wid * 64; float* li_l = ws, * al_l = ws + 32;
    float m_reg = -1e30f, l_reg = 0; f32x16 o[4] = {};
    const int sr = tid >> 4, sc = (tid & 15) * 8, vst0 = v_st(sr, sc), kws = KSWZ(sr, sc * 2);
    constexpr int VST1 = 8192;
    const int vb0 = (int)(uintptr_t)V_lds + v_rd_base(lane);
    const int qtok = cur.b * mk::SEQ + cur.qc * 64 + (wid & 1) * 32;
    const int moff = (qtok + r32) * 64;
#define LDMASK(t) (*(const uint2*)(T.MASK + (moff + 2 * (t))))
#define RESC(a) do { if (__any((a) < 1.f)) { if (hi == 0) al_l[r32] = (a); asm volatile("s_waitcnt lgkmcnt(0)" ::: "memory");              \
                     for (int d_ = 0; d_ < 4; ++d_) for (int r = 0; r < 16; ++r) o[d_][r] *= al_l[crow(r, hi)]; } } while (0)
#define KBASE(t) ((t) * KVBLK)
    constexpr int NQL = 9;
#define SEAM_K0() do { VMWN(NQL); SWRITE_HK(0); SBAR(); } while (0)
    f32x16 pA0, pA1, pB0, pB1; float mnA, mnB, alA, alB; bf16x8 pa0, pa1, pa2, pa3; uint2 mcur;
    {
        const float rs = rsqrtf(S.qss * (1.0f / 128) + mk::EPS);
#pragma unroll
        for (int d0 = 0; d0 < 8; ++d0) { u32x4 u = *reinterpret_cast<u32x4*>(&S.qr[d0]);
#pragma unroll
            for (int e = 0; e < 4; ++e) u[e] = cvtpk(__uint_as_float(u[e] << 16) * rs, __uint_as_float(u[e] & 0xFFFF0000u) * rs);
            S.qr[d0] = *reinterpret_cast<bf16x8*>(&u); }
    }
    SWRITE_HV(0); SBAR();
    if (NT > 1) { SLOAD_H(cur, KBASE(1)); }
    SBAR(); qkt<0>(pA0, pA1, K_lds, r32, hi, S.qr); mcur = LDMASK(0);
    partialSM(pA0, pA1, m_reg, mnA, alA);
    if (NT > 1) { VMW(); SWRITE_H(1); }
    __syncthreads();
#define HALF_STEP(PX0, PX1, mnX, alX, PY0, PY1, alY, t, KB, VB, SB) do {                                             \
        SBAR(); qkt<KB>(PX0, PX1, K_lds, r32, hi, S.qr);                                                                       \
        finishSM(PY0, PY1, alY, l_reg, mcur, hi, pa0, pa1, pa2, pa3); mcur = LDMASK(t); SBAR();                                                   \
        if ((t) + 1 < NT) { SLOAD_H(cur, KBASE((t) + 1)); SBAR(); }                                                           \
        pv_tile<VB>(o, vb0, pa0, pa1, pa2, pa3); partialSM(PX0, PX1, m_reg, mnX, alX);                                        \
        __syncthreads();                                                                                                      \
        if ((t) + 1 < NT) { VMW(); SWRITE_H(SB); }                                                                            \
        RESC(alX); __syncthreads(); } while (0)
    for (int t = 1; t + 1 < NT; t += 2) {
        HALF_STEP(pB0, pB1, mnB, alB, pA0, pA1, alA, t, 1, 0, 0);
        HALF_STEP(pA0, pA1, mnA, alA, pB0, pB1, alB, t + 1, 0, 1, 1);
    }
    const bool even = (NT & 1) == 0;
    if (even) { SBAR(); qkt<1>(pB0, pB1, K_lds, r32, hi, S.qr); SBAR(); }
    SLOAD_H(nxt, 0); SBAR();
    { const bf16_t* qp = q_row(T, nxt, wid, r32) + hi * 8;
#pragma unroll
      for (int d0 = 0; d0 < 8; ++d0) S.qr[d0] = *(const bf16x8*)(qp + d0 * 16);
      S.qss = *qss_ptr(T, nxt, wid, r32); }
    SBAR();
    finishSM(pA0, pA1, alA, l_reg, mcur, hi, pa0, pa1, pa2, pa3); if (even) mcur = LDMASK(NT - 1); SBAR();
    pv_tile<0>(o, vb0, pa0, pa1, pa2, pa3);
    if (even) { partialSM(pB0, pB1, m_reg, mnB, alB); __syncthreads(); RESC(alB);
        finishSM(pB0, pB1, alB, l_reg, mcur, hi, pa0, pa1, pa2, pa3); SBAR(); pv_tile<1>(o, vb0, pa0, pa1, pa2, pa3); }
    SBAR(); SEAM_K0();
    if (hi == 0) li_l[r32] = l_reg; asm volatile("s_waitcnt lgkmcnt(0)" ::: "memory");
    { const int le = mk::ltid() & 63, re = le & 31, he = le >> 5;
      const int hq = 4 * cur.g + (wid >> 1);
#pragma unroll
      for (int r = 0; r < 16; ++r) { const int orow = crow(r, he); const size_t tok = (size_t)(qtok + orow);
        const float rl = __builtin_amdgcn_rcpf(li_l[orow]);
        const bf16_t* gp = T.P1 + tok * mk::N1P + mk::CG + hq * 128 + re;
        bf16_t* op = T.AO + tok * mk::D + hq * 128 + re;
#pragma unroll
        for (int d0 = 0; d0 < 4; ++d0) { const float gt = mk::bf2f(gp[d0 * 32]);
            const float v = o[d0][r] * rl * (gt * __builtin_amdgcn_rcpf(1.0f + __builtin_amdgcn_exp2f(-1.4426950408889634f * gt)));
            const float vn = __int_as_float(__builtin_amdgcn_update_dpp(0, __float_as_int(v), 0xB1, 0xF, 0xF, false));
            if ((re & 1) == 0) *(unsigned*)(op + d0 * 32) = cvtpk(v, vn); } } }
    __syncthreads();
#undef LDMASK
#undef RESC
#undef KBASE
#undef SEAM_K0
#undef HALF_STEP
}
#undef VMW
#undef VMWN
#undef SLOAD_H
#undef SWRITE_HK
#undef SWRITE_HV
#undef SWRITE_H

__device__ __forceinline__ void attn_prompt_phase(const Tensors& T, char* lds, int bid, int nblk) {
    constexpr int NITEM = 256;
    if (bid >= NITEM) return;
    int id = bid, pass = 0;
    Blk cur{id & 7, (id >> 3) & 1, 31 - (id >> 4)};
    Seam S;
    dsa_prime(T, cur, lds, S);
    for (;;) {
        const bool more_pass = pass == 0, more_item = id + nblk < NITEM, last = !more_pass && !more_item;
        int idn = id, passn = pass + 1;
        if (!more_pass) { passn = 0; idn = more_item ? id + nblk : id; }
        Blk nxt = cur;
        if (!last) { nxt.b = idn & 7; nxt.g = (idn >> 3) & 1; nxt.qc = passn ? (idn >> 4) : 31 - (idn >> 4); }
        dsa_block(T, cur, nxt, lds, S);
        if (last) break;
        cur = nxt; id = idn; pass = passn;
    }
}
}

namespace dn {
using mk::bf16_t;
typedef short bf16x8 __attribute__((ext_vector_type(8)));
typedef float f32x16 __attribute__((ext_vector_type(16)));
constexpr int NITEM = mk::NB * 8 * 32;
constexpr size_t IT_W = 0, IT_QD = 16384, IT_KDT = 32768, IT_U0T = 49152, IT_QKD = 65536, IT_BYTES = 73728;
constexpr int L_KR = 0, L_QR = 17408, L_KT = 34816, L_VT = 53248, L_AM = 71680, L_TW = 89088, L_TU = 98304, L_SC = 107520, L_END = 108032;
constexpr int RS = 272;
constexpr int TS = 144;
constexpr int L_SK = 108032, L_SU = L_SK + 128 * 144, L_SEND = L_SU + 128 * 136, L_SW = L_AM;
static_assert(L_SEND <= 147456 - 16, "pre-phase LDS map");

__device__ __forceinline__ int crow(int r, int hi) { return (r & 3) + 8 * (r >> 2) + 4 * hi; }
__device__ __forceinline__ unsigned cvtpk(float lo, float hi) { return mk::cvtpk_native(lo, hi); }
__device__ __forceinline__ float silu_f(float x) { return x * __builtin_amdgcn_rcpf(1.0f + __builtin_amdgcn_exp2f(-1.4426950408889634f * x)); }
__device__ __forceinline__ float quad_sum(float v) {
    v += __int_as_float(__builtin_amdgcn_update_dpp(0, __float_as_int(v), 0xB1, 0xF, 0xF, false));
    v += __int_as_float(__builtin_amdgcn_update_dpp(0, __float_as_int(v), 0x4E, 0xF, 0xF, false));
    return v;
}

struct PreArgs { const bf16_t* P2; const float* BA; const float* conv_w; const float* A_log; const float* dt_bias; unsigned char* CH; float* EG; float* out; };

struct PreRaw { unsigned x[3][11]; float wc[3][4][2]; float bv, av; };
__device__ __forceinline__ void pre_load(const PreArgs& a, int item, PreRaw& R) {
    const int tid = mk::ltid(), w = __builtin_amdgcn_readfirstlane(tid >> 6), l = tid & 63;
    const int c = item & 31, h = (item >> 5) & 7, b = item >> 8;
    const int m0 = b * mk::SEQ + c * 64;
    R.bv = a.BA[(size_t)(m0 + l) * 16 + h]; R.av = a.BA[(size_t)(m0 + l) * 16 + 8 + h];
#pragma unroll
    for (int part = 0; part < 3; ++part) {
        const int colb = part * 1024 + h * 128 + 2 * l;
#pragma unroll
        for (int i = 0; i < 4; ++i) { const float2 t = *(const float2*)(a.conv_w + (size_t)i * mk::CONV + colb); R.wc[part][i][0] = t.x; R.wc[part][i][1] = t.y; }
#pragma unroll
        for (int k = 0; k < 11; ++k) {
            const int rl = 8 * w + k - 3;
            unsigned u = 0u;
            if (rl >= 0 || c > 0) u = __builtin_nontemporal_load((const unsigned*)(a.P2 + (size_t)(m0 + rl) * mk::N3P + colb));
            R.x[part][k] = u;
        }
    }
}
__device__ __forceinline__ void pre_item(const PreArgs& a, int item, int next, char* lds, PreRaw& R) {
    const int tid = mk::ltid(), w = __builtin_amdgcn_readfirstlane(tid >> 6), l = tid & 63, r32 = l & 31, hh = l >> 5;
    const int c = item & 31, h = (item >> 5) & 7, b = item >> 8;
    const int m0 = b * mk::SEQ + c * 64;
    unsigned char* ch = a.CH + (size_t)item * IT_BYTES;
    float* sc_beta = (float*)(lds + L_SC); float* sc_gc = sc_beta + 64;
    float beta_l, gc_l;
    {
        const float bv = R.bv, av = R.av;
        beta_l = __builtin_amdgcn_rcpf(1.0f + __expf(-bv));
        const float x = av + a.dt_bias[h];
        const float sp = x > 20.f ? x : log1pf(__expf(x));
        float g = -__expf(a.A_log[h]) * sp;
#pragma unroll
        for (int o = 1; o < 64; o <<= 1) { const float t = __shfl_up(g, o); if (l >= o) g += t; }
        gc_l = g;
    }
    const float gc_last = __shfl(gc_l, 63);
    if (w == 0) { sc_beta[l] = beta_l; sc_gc[l] = gc_l; if (l == 0) a.EG[item] = __expf(gc_last); }
    {
        float sq[8][2], sk[8][2], sv[8][2];
#pragma unroll
        for (int part = 0; part < 3; ++part) {
            const int colb = part * 1024 + h * 128 + 2 * l;
            float wc[4][2];
#pragma unroll
            for (int i = 0; i < 4; ++i) { wc[i][0] = R.wc[part][i][0]; wc[i][1] = R.wc[part][i][1]; }
            float x[11][2];
#pragma unroll
            for (int k = 0; k < 11; ++k) { const unsigned u = R.x[part][k]; x[k][0] = __uint_as_float(u << 16); x[k][1] = __uint_as_float(u & 0xFFFF0000u); }
            if (c == 31 && w == 7) {
#pragma unroll
                for (int j = 0; j < 3; ++j) *(float2*)(a.out + mk::O_CP + ((size_t)b * 3 + j) * mk::CONV + colb) = make_float2(x[8 + j][0], x[8 + j][1]);
            }
#pragma unroll
            for (int rr = 0; rr < 8; ++rr) {
#pragma unroll
                for (int e = 0; e < 2; ++e) {
                    float y = wc[0][e] * x[rr][e]; y = fmaf(wc[1][e], x[rr + 1][e], y); y = fmaf(wc[2][e], x[rr + 2][e], y); y = fmaf(wc[3][e], x[rr + 3][e], y);
                    const float s = silu_f(y);
                    if (part == 0) sq[rr][e] = s; else if (part == 1) sk[rr][e] = s; else sv[rr][e] = s;
                }
            }
        }
        if (next >= 0) pre_load(a, next, R);
        float nq[8], nk[8];
#pragma unroll
        for (int rr = 0; rr < 8; ++rr) { nq[rr] = sq[rr][0] * sq[rr][0] + sq[rr][1] * sq[rr][1]; nk[rr] = sk[rr][0] * sk[rr][0] + sk[rr][1] * sk[rr][1]; }
        mk::wave_sum_n<8>(nq); mk::wave_sum_n<8>(nk);
        unsigned ktp[2][4], vtp[2][4], kdp[2][4];
#pragma unroll
        for (int rr = 0; rr < 8; ++rr) {
            const int i = 8 * w + rr;
            const float rq = rsqrtf(nq[rr] + mk::EPS) * 0.08838834764831845f;
            const float rk = rsqrtf(nk[rr] + mk::EPS);
            const float gci = __shfl(gc_l, i);
            const float eg = __expf(gci), egl = __expf(gc_last - gci);
            const float q0 = sq[rr][0] * rq, q1 = sq[rr][1] * rq, k0 = sk[rr][0] * rk, k1 = sk[rr][1] * rk;
            *(unsigned*)(lds + L_QR + i * RS + 4 * l) = cvtpk(q0, q1);
            *(unsigned*)(lds + L_KR + i * RS + 4 * l) = cvtpk(k0, k1);
            *(unsigned*)(ch + IT_QD + (size_t)i * 256 + 4 * l) = cvtpk(q0 * eg, q1 * eg);
            if ((rr & 1) == 0) { sq[rr][0] = k0; sq[rr][1] = k1; }
            else {
                ktp[0][rr >> 1] = cvtpk(sq[rr - 1][0], k0); ktp[1][rr >> 1] = cvtpk(sq[rr - 1][1], k1);
                vtp[0][rr >> 1] = cvtpk(sv[rr - 1][0], sv[rr][0]); vtp[1][rr >> 1] = cvtpk(sv[rr - 1][1], sv[rr][1]);
                const float gcp = __shfl(gc_l, i - 1); const float eglp = __expf(gc_last - gcp);
                kdp[0][rr >> 1] = cvtpk(sq[rr - 1][0] * eglp, k0 * egl); kdp[1][rr >> 1] = cvtpk(sq[rr - 1][1] * eglp, k1 * egl);
            }
        }
#pragma unroll
        for (int e = 0; e < 2; ++e) {
            *(uint4*)(lds + L_KT + (2 * l + e) * TS + 16 * w) = make_uint4(ktp[e][0], ktp[e][1], ktp[e][2], ktp[e][3]);
            *(uint4*)(lds + L_VT + (2 * l + e) * TS + 16 * w) = make_uint4(vtp[e][0], vtp[e][1], vtp[e][2], vtp[e][3]);
            *(uint4*)(lds + L_SK + (2 * l + e) * 144 + 16 * w) = make_uint4(kdp[e][0], kdp[e][1], kdp[e][2], kdp[e][3]);
        }
    }
    mk::lds_barrier();
#pragma unroll
    for (int j = 0; j < 2; ++j) { const int pc = tid + 512 * j;
        *(uint4*)(ch + IT_KDT + (size_t)16 * pc) = *(const uint4*)(lds + L_SK + (pc >> 3) * 144 + 16 * (pc & 7)); }
    if (w < 6) {
        const int kind = w >= 3, tix = kind ? w - 3 : w, ti = tix > 0, tj = tix > 1;
        const char* ap = lds + (kind ? L_QR : L_KR) + (32 * ti + r32) * RS + 16 * hh;
        const char* bp = lds + L_KR + (32 * tj + r32) * RS + 16 * hh;
        f32x16 acc = {};
#pragma unroll
        for (int s = 0; s < 8; ++s) acc = __builtin_amdgcn_mfma_f32_32x32x16_bf16(*(const bf16x8*)(ap + 32 * s), *(const bf16x8*)(bp + 32 * s), acc, 0, 0, 0);
        const int j = 32 * tj + r32; const float gcj = sc_gc[j];
#pragma unroll
        for (int r = 0; r < 16; ++r) {
            const int i = 32 * ti + crow(r, hh);
            const float dec = __expf(sc_gc[i] - gcj);
            if (!kind) { const float v = (i > j) ? sc_beta[i] * acc[r] * dec : 0.f; *(float*)(lds + L_AM + i * RS + 4 * j) = v; }
            else { const float v = (i >= j) ? acc[r] * dec : 0.f; const float vn = __shfl_xor(v, 1);
                   if ((r32 & 1) == 0) *(unsigned*)(ch + IT_QKD + (size_t)i * 128 + 2 * j) = cvtpk(v, vn); }
        }
    } else if (w == 6) {
#pragma unroll
        for (int k = 0; k < 16; ++k) { const int e = l + 64 * k; *(float*)(lds + L_AM + (e >> 5) * RS + 4 * (32 + (e & 31))) = 0.f; }
    }
    mk::lds_barrier();
    constexpr int L_T1T = L_KR, L_TBR = L_KR + 2560, L_P3T = L_KR + 5120;
    if (w < 2) {
        const int blk = w, ccl = l >> 1, q = l & 1, cc = 32 * blk + ccl;
        float x[16];
#pragma unroll
        for (int k = 0; k < 16; ++k) x[k] = 0.f;
        const char* arow = lds + L_AM + (32 * blk) * RS + 4 * (32 * blk) + 16 * q;
#pragma unroll
        for (int ib = 0; ib < 8; ++ib) {
            const int i0 = 4 * ib, aS = ib >> 1, qS = ib & 1;
            float p[4] = {0.f, 0.f, 0.f, 0.f};
#pragma unroll
            for (int rr = 0; rr < 4; ++rr)
#pragma unroll
                for (int a4 = 0; a4 <= aS; ++a4) { const float4 av = *(const float4*)(arow + (i0 + rr) * RS + 32 * a4);
                    p[rr] = fmaf(av.x, x[4 * a4], p[rr]); p[rr] = fmaf(av.y, x[4 * a4 + 1], p[rr]); p[rr] = fmaf(av.z, x[4 * a4 + 2], p[rr]); p[rr] = fmaf(av.w, x[4 * a4 + 3], p[rr]); }
#pragma unroll
            for (int rr = 0; rr < 4; ++rr) p[rr] += __int_as_float(__builtin_amdgcn_update_dpp(0, __float_as_int(p[rr]), 0xB1, 0xF, 0xF, false));
            const char* rb = lds + L_AM + (32 * blk + i0) * RS + 4 * (32 * blk + i0);
            const float4 r1 = *(const float4*)(rb + RS), r2 = *(const float4*)(rb + 2 * RS), r3 = *(const float4*)(rb + 3 * RS);
            const float x0 = ((i0 == ccl) ? 1.f : 0.f) - p[0];
            const float x1 = ((i0 + 1 == ccl) ? 1.f : 0.f) - p[1] - r1.x * x0;
            const float x2 = ((i0 + 2 == ccl) ? 1.f : 0.f) - p[2] - r2.x * x0 - r2.y * x1;
            const float x3 = ((i0 + 3 == ccl) ? 1.f : 0.f) - p[3] - r3.x * x0 - r3.y * x1 - r3.z * x2;
            if (q == qS) { x[4 * aS] = x0; x[4 * aS + 1] = x1; x[4 * aS + 2] = x2; x[4 * aS + 3] = x3; }
        }
        const float bc = sc_beta[cc], bw = bc * __expf(sc_gc[cc]);
#pragma unroll
        for (int k = 0; k < 16; ++k) { const int j = 8 * (k >> 2) + 4 * q + (k & 3);
            *(bf16_t*)(lds + L_TW + (32 * blk + j) * TS + 2 * cc) = mk::f2bf(x[k] * bw);
            *(bf16_t*)(lds + L_TU + (32 * blk + j) * TS + 2 * cc) = mk::f2bf(x[k] * bc);
            if (blk == 1) *(bf16_t*)(lds + L_TBR + j * 80 + 2 * ccl) = mk::f2bf(x[k]); }
        if (blk == 0) {
#pragma unroll
            for (int a4 = 0; a4 < 4; ++a4) *(uint2*)(lds + L_T1T + ccl * 80 + 2 * (8 * a4 + 4 * q)) = make_uint2(cvtpk(x[4 * a4], x[4 * a4 + 1]), cvtpk(x[4 * a4 + 2], x[4 * a4 + 3]));
        }
    }
    mk::lds_barrier();
    if (w == 0) {
        f32x16 a3 = {};
#pragma unroll
        for (int s = 0; s < 2; ++s) {
            const float4 f0 = *(const float4*)(lds + L_AM + (32 + r32) * RS + 4 * (16 * s + 8 * hh)), f1 = *(const float4*)(lds + L_AM + (32 + r32) * RS + 4 * (16 * s + 8 * hh) + 16);
            mk::u32x4_t au_ = {cvtpk(f0.x, f0.y), cvtpk(f0.z, f0.w), cvtpk(f1.x, f1.y), cvtpk(f1.z, f1.w)};
            a3 = __builtin_amdgcn_mfma_f32_32x32x16_bf16(*reinterpret_cast<bf16x8*>(&au_), *(const bf16x8*)(lds + L_T1T + r32 * 80 + 2 * (16 * s + 8 * hh)), a3, 0, 0, 0);
        }
#pragma unroll
        for (int g = 0; g < 4; ++g) *(uint2*)(lds + L_P3T + r32 * 80 + 2 * (8 * g + 4 * hh)) = make_uint2(cvtpk(a3[4 * g], a3[4 * g + 1]), cvtpk(a3[4 * g + 2], a3[4 * g + 3]));
        asm volatile("s_waitcnt lgkmcnt(0)" ::: "memory");
        f32x16 a4 = {};
#pragma unroll
        for (int s = 0; s < 2; ++s)
            a4 = __builtin_amdgcn_mfma_f32_32x32x16_bf16(*(const bf16x8*)(lds + L_TBR + r32 * 80 + 2 * (16 * s + 8 * hh)), *(const bf16x8*)(lds + L_P3T + r32 * 80 + 2 * (16 * s + 8 * hh)), a4, 0, 0, 0);
        const float bc = sc_beta[r32], bw = bc * __expf(sc_gc[r32]);
#pragma unroll
        for (int r = 0; r < 16; ++r) { const int i = 32 + crow(r, hh);
            *(bf16_t*)(lds + L_TW + i * TS + 2 * r32) = mk::f2bf(-a4[r] * bw);
            *(bf16_t*)(lds + L_TU + i * TS + 2 * r32) = mk::f2bf(-a4[r] * bc); }
    }
    mk::lds_barrier();
    {
        const int it = w >> 2, dt = w & 3, ns = it ? 4 : 2;
        f32x16 aw = {}, au = {};
        const char* kt = lds + L_KT + (32 * dt + r32) * TS + 16 * hh;
        const char* vt = lds + L_VT + (32 * dt + r32) * TS + 16 * hh;
        const char* tw = lds + L_TW + (32 * it + r32) * TS + 16 * hh;
        const char* tu = lds + L_TU + (32 * it + r32) * TS + 16 * hh;
#pragma unroll
        for (int s = 0; s < 4; ++s) if (s < ns) {
            aw = __builtin_amdgcn_mfma_f32_32x32x16_bf16(*(const bf16x8*)(kt + 32 * s), *(const bf16x8*)(tw + 32 * s), aw, 0, 0, 0);
            au = __builtin_amdgcn_mfma_f32_32x32x16_bf16(*(const bf16x8*)(tu + 32 * s), *(const bf16x8*)(vt + 32 * s), au, 0, 0, 0);
        }
#pragma unroll
        for (int g = 0; g < 4; ++g) {
            *(uint2*)(lds + L_SW + (32 * it + r32) * RS + 2 * (32 * dt + 8 * g + 4 * hh)) = make_uint2(cvtpk(aw[4 * g], aw[4 * g + 1]), cvtpk(aw[4 * g + 2], aw[4 * g + 3]));
            *(uint2*)(lds + L_SU + (32 * dt + r32) * 136 + 2 * (32 * it + 8 * g + 4 * hh)) = make_uint2(cvtpk(au[4 * g], au[4 * g + 1]), cvtpk(au[4 * g + 2], au[4 * g + 3]));
        }
    }
    mk::lds_barrier();
#pragma unroll
    for (int j = 0; j < 2; ++j) { const int pc = tid + 512 * j;
        *(uint4*)(ch + IT_W + (size_t)16 * pc) = *(const uint4*)(lds + L_SW + (pc >> 4) * RS + 16 * (pc & 15)); }
#pragma unroll
    for (int j = 0; j < 4; ++j) { const int pc = tid + 512 * j;
        *(uint2*)(ch + IT_U0T + (size_t)8 * pc) = *(const uint2*)(lds + L_SU + (pc >> 4) * 136 + 8 * (pc & 15)); }
}

constexpr int SL_ST = 0, SL_UT = 8704, SL_END = 8704 + 4608;
struct ScanArgs { const unsigned char* CH; const float* EG; bf16_t* ORAW; float* out; };

__device__ __forceinline__ void scan_item(const ScanArgs& a, int bh, int sl, char* lds) {
    const int tid = mk::ltid(), w = __builtin_amdgcn_readfirstlane(tid >> 6), l = tid & 63, r32 = l & 31, hh = l >> 5;
    const int b = bh >> 3, h = bh & 7;
    const unsigned char* chb = a.CH + (size_t)bh * 32 * IT_BYTES;
    for (int k = tid; k < SL_END / 4; k += 512) ((unsigned*)lds)[k] = 0u;
    __syncthreads();
    const char* stp = lds + SL_ST + r32 * RS + 16 * hh;
    const char* utp = lds + SL_UT + r32 * TS + 16 * hh;
    if (w < 2) {
        const int tt = w;
        bf16x8 wf[4][8]; uint2 u0[4][4];
#define LD_W(dst, dstu, cix) do { const unsigned char* cb = chb + (size_t)(cix) * IT_BYTES; \
        _Pragma("unroll") for (int s = 0; s < 8; ++s) dst[s] = *(const bf16x8*)(cb + IT_W + (size_t)(32 * tt + r32) * 256 + 32 * s + 16 * hh); \
        _Pragma("unroll") for (int g = 0; g < 4; ++g) dstu[g] = *(const uint2*)(cb + IT_U0T + (size_t)(32 * sl + r32) * 128 + 2 * (32 * tt + 8 * g + 4 * hh)); } while (0)
        LD_W(wf[0], u0[0], 0); LD_W(wf[1], u0[1], 1); LD_W(wf[2], u0[2], 2);
        for (int c0 = 0; c0 < 32; c0 += 4) {
#pragma unroll
            for (int k = 0; k < 4; ++k) {
                const int c = c0 + k;
                if (c + 3 < 32) LD_W(wf[(k + 3) & 3], u0[(k + 3) & 3], c + 3);
                f32x16 acc = {};
#pragma unroll
                for (int s = 0; s < 8; ++s) acc = __builtin_amdgcn_mfma_f32_32x32x16_bf16(wf[k][s], *(const bf16x8*)(stp + 32 * s), acc, 0, 0, 0);
#pragma unroll
                for (int g = 0; g < 4; ++g) {
                    const float a0 = __uint_as_float(u0[k][g].x << 16) - acc[4 * g], a1 = __uint_as_float(u0[k][g].x & 0xFFFF0000u) - acc[4 * g + 1];
                    const float a2 = __uint_as_float(u0[k][g].y << 16) - acc[4 * g + 2], a3 = __uint_as_float(u0[k][g].y & 0xFFFF0000u) - acc[4 * g + 3];
                    *(uint2*)(lds + SL_UT + r32 * TS + 2 * (32 * tt + 8 * g + 4 * hh)) = make_uint2(cvtpk(a0, a1), cvtpk(a2, a3));
                }
                mk::lds_barrier();
                mk::lds_barrier();
            }
        }
#undef LD_W
    } else if (w < 4) {
        const int tt = w - 2;
        bf16x8 qf[4][8], pf[4][4];
#pragma unroll
        for (int k = 0; k < 4; ++k)
#pragma unroll
            for (int s = 0; s < 4; ++s) pf[k][s] = bf16x8{};
#define LD_Q(dq, dp, cix) do { const unsigned char* cb = chb + (size_t)(cix) * IT_BYTES; \
        _Pragma("unroll") for (int s = 0; s < 8; ++s) dq[s] = *(const bf16x8*)(cb + IT_QD + (size_t)(32 * tt + r32) * 256 + 32 * s + 16 * hh); \
        _Pragma("unroll") for (int s = 0; s < 4; ++s) if (s < 2 * (tt + 1)) dp[s] = *(const bf16x8*)(cb + IT_QKD + (size_t)(32 * tt + r32) * 128 + 32 * s + 16 * hh); } while (0)
        LD_Q(qf[0], pf[0], 0); LD_Q(qf[1], pf[1], 1); LD_Q(qf[2], pf[2], 2);
        const size_t orow0 = (size_t)(b * mk::SEQ + 32 * tt) * mk::D + h * 128 + 32 * sl + r32;
        for (int c0 = 0; c0 < 32; c0 += 4) {
#pragma unroll
            for (int k = 0; k < 4; ++k) {
                const int c = c0 + k;
                if (c + 3 < 32) LD_Q(qf[(k + 3) & 3], pf[(k + 3) & 3], c + 3);
                f32x16 acc = {};
#pragma unroll
                for (int s = 0; s < 8; ++s) acc = __builtin_amdgcn_mfma_f32_32x32x16_bf16(qf[k][s], *(const bf16x8*)(stp + 32 * s), acc, 0, 0, 0);
                mk::lds_barrier();
#pragma unroll
                for (int s = 0; s < 4; ++s) if (s < 2 * (tt + 1)) acc = __builtin_amdgcn_mfma_f32_32x32x16_bf16(pf[k][s], *(const bf16x8*)(utp + 32 * s), acc, 0, 0, 0);
#pragma unroll
                for (int r = 0; r < 16; ++r) { const float v = acc[r]; const float vn = __shfl_xor(v, 1);
                    if ((r32 & 1) == 0) *(unsigned*)(a.ORAW + orow0 + (size_t)(64 * c + crow(r, hh)) * mk::D) = cvtpk(v, vn); }
                mk::lds_barrier();
            }
        }
#undef LD_Q
    } else {
        const int dt = w - 4;
        bf16x8 kf[4][4]; float eg[4];
#define LD_S(dk_, deg, cix) do { const unsigned char* cb = chb + (size_t)(cix) * IT_BYTES; \
        _Pragma("unroll") for (int s = 0; s < 4; ++s) dk_[s] = *(const bf16x8*)(cb + IT_KDT + (size_t)(32 * dt + r32) * 128 + 32 * s + 16 * hh); \
        deg = a.EG[bh * 32 + (cix)]; } while (0)
        LD_S(kf[0], eg[0], 0); LD_S(kf[1], eg[1], 1); LD_S(kf[2], eg[2], 2);
        f32x16 S = {};
        for (int c0 = 0; c0 < 32; c0 += 4) {
#pragma unroll
            for (int k = 0; k < 4; ++k) {
                const int c = c0 + k;
                if (c + 3 < 32) LD_S(kf[(k + 3) & 3], eg[(k + 3) & 3], c + 3);
#pragma unroll
                for (int r = 0; r < 16; ++r) S[r] *= eg[k];
                mk::lds_barrier();
#pragma unroll
                for (int s = 0; s < 4; ++s) S = __builtin_amdgcn_mfma_f32_32x32x16_bf16(kf[k][s], *(const bf16x8*)(utp + 32 * s), S, 0, 0, 0);
#pragma unroll
                for (int g = 0; g < 4; ++g)
                    *(uint2*)(lds + SL_ST + r32 * RS + 2 * (32 * dt + 8 * g + 4 * hh)) = make_uint2(cvtpk(S[4 * g], S[4 * g + 1]), cvtpk(S[4 * g + 2], S[4 * g + 3]));
                mk::lds_barrier();
            }
        }
#undef LD_S
        float* so = a.out + mk::O_SP + ((size_t)bh * 128) * 128 + 32 * sl + r32;
#pragma unroll
        for (int r = 0; r < 16; ++r) so[(size_t)(32 * dt + crow(r, hh)) * 128] = S[r];
    }
    __syncthreads();
}
}

namespace mk {
__device__ __forceinline__ unsigned f2key(float f) { f += 0.0f; unsigned u = __float_as_uint(f); return (u & 0x80000000u) ? ~u : (u | 0x80000000u); }
__device__ __forceinline__ int block_sum_i512(int c, int* red) {
    c += __shfl_xor(c, 32); c += __shfl_xor(c, 16); c += __shfl_xor(c, 8); c += __shfl_xor(c, 4); c += __shfl_xor(c, 2); c += __shfl_xor(c, 1);
    __syncthreads();
    if ((mk::ltid() & 63) == 0) red[mk::ltid() >> 6] = c;
    __syncthreads();
    return red[0] + red[1] + red[2] + red[3] + red[4] + red[5] + red[6] + red[7];
}
__device__ __forceinline__ void attend_sample_row(int r, char* lds, const float* QSS, const float* qg, const bf16_t* P1, const float* CS, const int* CI, const float* out, const float* cache_k, const float* cache_v, const int* page_table, bf16_t* AO) {
    float* lg = (float*)lds;
    int* rowi = (int*)(lg + 2048);
    int* pt = rowi + 256;
    float* red = (float*)(pt + 128);
    bf16_t* qs = (bf16_t*)(red + 64);
    float* part = (float*)(qs + 1024);
    const int m = MP + r, b = r / DS, t = mk::ltid(), w = __builtin_amdgcn_readfirstlane(t >> 6), l = t & 63;
    {
        const unsigned u = ((const unsigned*)(P1 + (size_t)m * N1P + CQ))[t];
        const float rs = rsqrtf(QSS[(size_t)m * 8 + (t >> 6)] * (1.0f / 128) + EPS);
        ((unsigned*)qs)[t] = pk2bf(__uint_as_float(u << 16) * rs * qg[(2 * t) & 127], __uint_as_float(u & 0xFFFF0000u) * rs * qg[(2 * t + 1) & 127]);
    }
    if (t >= 64 && t < 64 + NPG) pt[t - 64] = page_table[b * NPG + t - 64];
    if (w == 0) {
        float sc[32]; int ci[32];
        const float* cs = CS + (size_t)r * 8 * ix::TOPK; const int* cip = CI + (size_t)r * 8 * ix::TOPK;
#pragma unroll
        for (int k = 0; k < 32; ++k) { sc[k] = cs[64 * k + l]; ci[k] = cip[64 * k + l]; }
        __syncthreads();
        int run = 0;
        ix::topk_select<32, 32>(sc, [&](int k, unsigned long long bm) {
            const bool mine = (bm >> l) & 1ull;
            const int pos = run + __builtin_popcountll(bm & ((1ull << l) - 1ull));
            if (mine) { const int idx = ci[k]; rowi[pos] = idx < PAST ? pt[idx >> 7] * PAGE + (idx & (PAGE - 1)) : -(b * DS + (idx - PAST)) - 1; }
            run += __builtin_popcountll(bm);
        });
    } else __syncthreads();
    __syncthreads();
    const int rr = l & 31, hh = l >> 5;
    f32x16 acc0 = {}, acc1 = {};
    {
        const int ri = rowi[32 * w + rr];
        const float* kr = (ri >= 0 ? cache_k + (size_t)ri * 256 : out + O_KS + (size_t)(-ri - 1) * 256) + 8 * hh;
        float4 kf[2][8][2];
#pragma unroll
        for (int g = 0; g < 2; ++g)
#pragma unroll
            for (int s = 0; s < 8; ++s) { kf[g][s][0] = *(const float4*)(kr + g * 128 + 16 * s); kf[g][s][1] = *(const float4*)(kr + g * 128 + 16 * s + 4); }
        const bf16_t* qa = qs + (rr & 3) * 128 + 8 * hh;
#pragma unroll
        for (int s = 0; s < 8; ++s) {
            bf16x8 a0 = *(const bf16x8*)(qa + 16 * s), a1 = *(const bf16x8*)(qa + 512 + 16 * s);
            if (rr >= 4) { a0 = bf16x8{}; a1 = bf16x8{}; }
            { const float4 x = kf[0][s][0], y = kf[0][s][1];
              u32x4_t u = {cvtpk_native(x.x, x.y), cvtpk_native(x.z, x.w), cvtpk_native(y.x, y.y), cvtpk_native(y.z, y.w)};
              acc0 = __builtin_amdgcn_mfma_f32_32x32x16_bf16(a0, *reinterpret_cast<bf16x8*>(&u), acc0, 0, 0, 0); }
            { const float4 x = kf[1][s][0], y = kf[1][s][1];
              u32x4_t u = {cvtpk_native(x.x, x.y), cvtpk_native(x.z, x.w), cvtpk_native(y.x, y.y), cvtpk_native(y.z, y.w)};
              acc1 = __builtin_amdgcn_mfma_f32_32x32x16_bf16(a1, *reinterpret_cast<bf16x8*>(&u), acc1, 0, 0, 0); }
        }
    }
    __builtin_amdgcn_sched_barrier(0);
    float4 vf[32];
#pragma unroll
    for (int jj = 0; jj < 32; ++jj) { const int ri = rowi[32 * w + jj];
        vf[jj] = *(const float4*)((ri >= 0 ? cache_v + (size_t)ri * 256 : out + O_VS + (size_t)(-ri - 1) * 256) + 4 * l); }
    if (hh == 0) {
        *(float4*)(lg + (32 * w + rr) * 8) = make_float4(acc0[0] * 0.08838834764831845f, acc0[1] * 0.08838834764831845f, acc0[2] * 0.08838834764831845f, acc0[3] * 0.08838834764831845f);
        *(float4*)(lg + (32 * w + rr) * 8 + 4) = make_float4(acc1[0] * 0.08838834764831845f, acc1[1] * 0.08838834764831845f, acc1[2] * 0.08838834764831845f, acc1[3] * 0.08838834764831845f);
    }
    mk::lds_barrier();
    {
        float x[4], mx = -INFINITY;
#pragma unroll
        for (int i = 0; i < 4; ++i) { x[i] = lg[(l + 64 * i) * 8 + w]; mx = fmaxf(mx, x[i]); }
#pragma unroll
        for (int o = 32; o > 0; o >>= 1) mx = fmaxf(mx, __shfl_xor(mx, o));
        float s = 0.f;
#pragma unroll
        for (int i = 0; i < 4; ++i) { x[i] = __expf(x[i] - mx); s += x[i]; lg[(l + 64 * i) * 8 + w] = x[i]; }
        s = wave_sum(s);
        if (l == 0) red[w] = 1.0f / s;
    }
    mk::lds_barrier();
    {
        float4 o0 = make_float4(0.f, 0.f, 0.f, 0.f), o1 = o0, o2 = o0, o3 = o0;
#pragma unroll
        for (int jj = 0; jj < 32; ++jj) {
            const float4 p4 = *(const float4*)(lg + (32 * w + jj) * 8 + 4 * hh); const float4 v = vf[jj];
            o0.x = fmaf(p4.x, v.x, o0.x); o0.y = fmaf(p4.x, v.y, o0.y); o0.z = fmaf(p4.x, v.z, o0.z); o0.w = fmaf(p4.x, v.w, o0.w);
            o1.x = fmaf(p4.y, v.x, o1.x); o1.y = fmaf(p4.y, v.y, o1.y); o1.z = fmaf(p4.y, v.z, o1.z); o1.w = fmaf(p4.y, v.w, o1.w);
            o2.x = fmaf(p4.z, v.x, o2.x); o2.y = fmaf(p4.z, v.y, o2.y); o2.z = fmaf(p4.z, v.z, o2.z); o2.w = fmaf(p4.z, v.w, o2.w);
            o3.x = fmaf(p4.w, v.x, o3.x); o3.y = fmaf(p4.w, v.y, o3.y); o3.z = fmaf(p4.w, v.z, o3.z); o3.w = fmaf(p4.w, v.w, o3.w);
        }
        float* pp = part + w * 1024 + (4 * hh) * 128 + 4 * rr;
        *(float4*)(pp) = o0; *(float4*)(pp + 128) = o1; *(float4*)(pp + 256) = o2; *(float4*)(pp + 384) = o3;
    }
    __syncthreads();
    {
        const int c0 = 2 * t, h = c0 >> 7;
        float o0 = 0.f, o1 = 0.f;
#pragma unroll
        for (int ww = 0; ww < 8; ++ww) { const float2 x = *(const float2*)(part + ww * 1024 + c0); o0 += x.x; o1 += x.y; }
        const float rinv = red[h];
        const bf16_t* gate = P1 + (size_t)m * N1P + CG + c0;
        *(unsigned*)(AO + (size_t)m * D + c0) = pk2bf(o0 * rinv * silu(bf2f(gate[0])), o1 * rinv * silu(bf2f(gate[1])));
    }
    __syncthreads();
}

__device__ __forceinline__ void dn_post_row(int m, char* lds, const bf16_t* P2, const float* BA, const float* conv_w, const float* conv_state, const float* A_log, const float* dt_bias,
                                            float* QC, float* KC, float* VC, float* BETA, float* G, float* out) {
    float* y = (float*)lds;
    const int t = mk::ltid();
    const int b = (m - MP) / DS, tt = (m - MP) % DS;
    {
        float xv[6][4], wv[6][4];
#pragma unroll
        for (int k = 0; k < 6; ++k) { const int c = t + 512 * k;
#pragma unroll
            for (int i = 0; i < 4; ++i) { const int j = tt + i;
                xv[k][i] = (j < 3) ? conv_state[((size_t)b * 3 + j) * CONV + c] : bf2f(P2[(size_t)(m - tt + (j - 3)) * N3P + c]);
                wv[k][i] = conv_w[i * CONV + c]; } }
#pragma unroll
        for (int k = 0; k < 6; ++k) { const int c = t + 512 * k;
            float acc = wv[k][0] * xv[k][0]; acc += wv[k][1] * xv[k][1]; acc += wv[k][2] * xv[k][2]; acc += wv[k][3] * xv[k][3];
            y[c] = silu(acc);
            if (tt >= DS - 3) out[O_CS + ((size_t)b * 3 + (tt - (DS - 3))) * CONV + c] = xv[k][3]; }
    }
    __syncthreads();
    const int w = t >> 6, l = t & 63;
    for (int hh = w; hh < 16; hh += 8) {
        const float a = y[hh * 128 + l], bb = y[hh * 128 + 64 + l];
        const float ss = wave_sum(a * a + bb * bb);
        float r = rsqrtf(ss + EPS);
        if (hh < 8) { r *= 0.08838834764831845f; QC[(size_t)m * D + hh * 128 + l] = a * r; QC[(size_t)m * D + hh * 128 + 64 + l] = bb * r; }
        else { KC[(size_t)m * D + (hh - 8) * 128 + l] = a * r; KC[(size_t)m * D + (hh - 8) * 128 + 64 + l] = bb * r; }
    }
    for (int c = t; c < 1024; c += 512) VC[(size_t)m * D + c] = y[2048 + c];
    if (t < 8) {
        const float bv = BA[(size_t)m * 16 + t], av = BA[(size_t)m * 16 + 8 + t];
        BETA[(size_t)m * 8 + t] = 1.0f / (1.0f + expf(-bv));
        const float x = av + dt_bias[t];
        const float sp = x > 20.f ? x : log1pf(expf(x));
        G[(size_t)m * 8 + t] = -expf(A_log[t]) * sp;
    }
    __syncthreads();
}

__device__ __forceinline__ void dn_scan_sample(int it, char* lds, const float* QC, const float* KC, const float* VC, const float* BETA, const float* G, const float* S0, bf16_t* ORAW, float* out) {
    const int t = mk::ltid(), v = t & 127, hq = __builtin_amdgcn_readfirstlane(t >> 7);
    float* qs = (float*)lds; float* ks = qs + DS * 128; float* ex = ks + DS * 128;
    const int b = it >> 3, h = it & 7, m0 = MP + b * DS;
    float S[32], vv[DS], beta[DS], alpha[DS];
    const float* sp = S0 + (((size_t)b * 8 + h) * 128 + hq * 32) * 128 + v;
#pragma unroll
    for (int d = 0; d < 32; ++d) S[d] = ldnt1(sp + (size_t)d * 128);
#pragma unroll
    for (int j = 0; j < 2; ++j) { const int tt = hq + 4 * j;
        qs[tt * 128 + v] = QC[(size_t)(m0 + tt) * D + h * 128 + v]; ks[tt * 128 + v] = KC[(size_t)(m0 + tt) * D + h * 128 + v]; }
#pragma unroll
    for (int tt = 0; tt < DS; ++tt) { vv[tt] = VC[(size_t)(m0 + tt) * D + h * 128 + v]; beta[tt] = BETA[(size_t)(m0 + tt) * 8 + h]; alpha[tt] = expf(G[(size_t)(m0 + tt) * 8 + h]); }
    __syncthreads();
#pragma unroll
    for (int tt = 0; tt < DS; ++tt) {
        const float4* k4 = (const float4*)(ks + tt * 128 + hq * 32); const float4* q4 = (const float4*)(qs + tt * 128 + hq * 32);
        float kS = 0.f;
#pragma unroll
        for (int d = 0; d < 8; ++d) { const float4 kk = k4[d]; kS = fmaf(kk.x, S[4 * d], kS); kS = fmaf(kk.y, S[4 * d + 1], kS); kS = fmaf(kk.z, S[4 * d + 2], kS); kS = fmaf(kk.w, S[4 * d + 3], kS); }
        ex[hq * 128 + v] = kS;
        mk::lds_barrier();
        const float u = beta[tt] * (vv[tt] - alpha[tt] * ((ex[v] + ex[128 + v]) + (ex[256 + v] + ex[384 + v])));
        float o = 0.f;
#pragma unroll
        for (int d = 0; d < 8; ++d) { const float4 kk = k4[d], qq = q4[d];
            S[4 * d] = fmaf(alpha[tt], S[4 * d], kk.x * u); o = fmaf(qq.x, S[4 * d], o);
            S[4 * d + 1] = fmaf(alpha[tt], S[4 * d + 1], kk.y * u); o = fmaf(qq.y, S[4 * d + 1], o);
            S[4 * d + 2] = fmaf(alpha[tt], S[4 * d + 2], kk.z * u); o = fmaf(qq.z, S[4 * d + 2], o);
            S[4 * d + 3] = fmaf(alpha[tt], S[4 * d + 3], kk.w * u); o = fmaf(qq.w, S[4 * d + 3], o); }
        ex[512 + hq * 128 + v] = o;
        mk::lds_barrier();
        if (hq == 0) ORAW[(size_t)(m0 + tt) * D + h * 128 + v] = f2bf((ex[512 + v] + ex[512 + 128 + v]) + (ex[512 + 256 + v] + ex[512 + 384 + v]));
    }
    float* so_ = out + O_SS + (((size_t)b * 8 + h) * 128 + hq * 32) * 128 + v;
#pragma unroll
    for (int d = 0; d < 32; ++d) so_[(size_t)d * 128] = S[d];
    __syncthreads();
}

struct GateRegs { unsigned o[8], z[8]; };
__device__ __forceinline__ void dn_gate_load(int m, const bf16_t* ORAW, const bf16_t* P2, GateRegs& R) {
    const int l = mk::ltid() & 63;
#pragma unroll
    for (int h = 0; h < 8; ++h) { R.o[h] = *(const unsigned*)(ORAW + (size_t)m * D + h * 128 + 2 * l); R.z[h] = __builtin_nontemporal_load((const unsigned*)(P2 + (size_t)m * N3P + CZ + h * 128 + 2 * l)); }
}
__device__ __forceinline__ void dn_gate_finish(int m, const GateRegs& R, const float* og, bf16_t* AO2) {
    const int l = mk::ltid() & 63;
    const float g0 = og[2 * l], g1 = og[2 * l + 1];
    float oa[8], ob[8], ss[8];
#pragma unroll
    for (int h = 0; h < 8; ++h) { oa[h] = __uint_as_float(R.o[h] << 16); ob[h] = __uint_as_float(R.o[h] & 0xFFFF0000u); ss[h] = oa[h] * oa[h] + ob[h] * ob[h]; }
    wave_sum_n<8>(ss);
#pragma unroll
    for (int h = 0; h < 8; ++h) {
        const float r = rsqrtf(ss[h] * (1.0f / 128) + EPS);
        const float z0 = __uint_as_float(R.z[h] << 16), z1 = __uint_as_float(R.z[h] & 0xFFFF0000u);
        *(unsigned*)(AO2 + (size_t)m * D + h * 128 + 2 * l) = pk2bf(oa[h] * r * g0 * silu(z0), ob[h] * r * g1 * silu(z1));
    }
}
__device__ __forceinline__ int dn_gate_rowmap(int j) { return j < MS ? MP + j : ((j - MS) & (NB - 1)) * SEQ + (SEQ - 1 - ((j - MS) >> 3)); }
__device__ __forceinline__ void dn_gate_rows(int gw, int nw, const bf16_t* ORAW, const bf16_t* P2, const float* og, bf16_t* AO2) {
    GateRegs R0, R1, R2;
    int m = gw;
#define RM(j) dn_gate_rowmap(j)
    if (m < M) dn_gate_load(RM(m), ORAW, P2, R0);
    if (m + nw < M) dn_gate_load(RM(m + nw), ORAW, P2, R1);
    for (; m < M; m += 3 * nw) {
        if (m + 2 * nw < M) dn_gate_load(RM(m + 2 * nw), ORAW, P2, R2);
        dn_gate_finish(RM(m), R0, og, AO2);
        if (m + nw < M) { if (m + 3 * nw < M) dn_gate_load(RM(m + 3 * nw), ORAW, P2, R0); dn_gate_finish(RM(m + nw), R1, og, AO2); }
        if (m + 2 * nw < M) { if (m + 4 * nw < M) dn_gate_load(RM(m + 4 * nw), ORAW, P2, R1); dn_gate_finish(RM(m + 2 * nw), R2, og, AO2); }
    }
#undef RM
}
}

namespace mk {
constexpr size_t al256(size_t x) { return (x + 255) & ~(size_t)255; }
constexpr size_t W_BAR = 0, W_WT1 = al256(W_BAR + (size_t)12 * XCD_BAR_WORDS * 4), W_WT2 = al256(W_WT1 + (size_t)N1P * D * 2), W_WT3 = al256(W_WT2 + (size_t)D * D * 2), W_WT4 = al256(W_WT3 + (size_t)N3P * D * 2),
    W_XA = al256(W_WT4 + (size_t)D * D * 2), W_P1 = al256(W_XA + (size_t)M * D * 2), W_P2 = al256(W_P1 + (size_t)M * N1P * 2), W_AO = al256(W_P2 + (size_t)M * N3P * 2), W_QN = al256(W_AO + (size_t)M * D * 2),
    W_KB = al256(W_QN + (size_t)M * D * 2), W_IKB = al256(W_KB + (size_t)M * 256 * 2), W_BA = al256(W_IKB + (size_t)M * 64 * 2), W_IW = al256(W_BA + (size_t)M * 16 * 4), W_Y1 = al256(W_IW + (size_t)M * 8 * 4),
    W_QC = al256(W_Y1 + (size_t)M * D * 4), W_KC = al256(W_QC + (size_t)M * D * 4), W_VC = al256(W_KC + (size_t)M * D * 4), W_BETA = al256(W_VC + (size_t)M * D * 4), W_G = al256(W_BETA + (size_t)M * 8 * 4),
    W_ORAW = al256(W_G + (size_t)M * 8 * 4), W_CH = al256(W_ORAW + (size_t)M * D * 2), W_EG = al256(W_CH + (size_t)dn::NITEM * dn::IT_BYTES), W_CS = al256(W_EG + (size_t)dn::NITEM * 4), W_CI = al256(W_CS + (size_t)MS * 8 * 256 * 4), W_MASK = al256(W_CI + (size_t)MS * 8 * 256 * 4), W_SS = al256(W_MASK + (size_t)MP * 64 * 4), W_END = al256(W_SS + (size_t)M * 4);
struct WsMap {
    unsigned char* base;
#define WSP(name, T, off) __device__ __forceinline__ T* name() const { return (T*)(base + (off)); }
    WSP(bar, unsigned, W_BAR) WSP(Wt1, bf16_t, W_WT1) WSP(Wt2, bf16_t, W_WT2) WSP(Wt3, bf16_t, W_WT3) WSP(Wt4, bf16_t, W_WT4) WSP(XA, bf16_t, W_XA) WSP(P1, bf16_t, W_P1) WSP(P2, bf16_t, W_P2)
    WSP(AO, bf16_t, W_AO) WSP(QNb, bf16_t, W_QN) WSP(KB, bf16_t, W_KB) WSP(IKB, bf16_t, W_IKB) WSP(BA, float, W_BA) WSP(IW, float, W_IW) WSP(Y1, float, W_Y1) WSP(QC, float, W_QC) WSP(KC, float, W_KC)
    WSP(VC, float, W_VC) WSP(BETA, float, W_BETA) WSP(G, float, W_G) WSP(ORAW, bf16_t, W_ORAW) WSP(CH, unsigned char, W_CH) WSP(EG, float, W_EG) WSP(CS, float, W_CS) WSP(CI, int, W_CI) WSP(SS, float, W_SS) WSP(MASK, unsigned, W_MASK)
#undef WSP
};
struct Params {
    const float *x_prompt, *x_sample, *cache_k, *cache_v, *cache_ik, *state_S, *state_conv; const int* page_table;
    const float *att_norm, *att_w_in, *qg, *kg, *ikg, *att_w_out, *dn_norm, *dn_w_in, *conv_w, *A_log, *dt_bias, *og, *dn_w_out;
    float* out; WsMap w; int ph_lo, ph_hi, li, pad_;
};
constexpr int LDS_TOTAL = 147456;
constexpr int NPHASE = 12;
#ifndef MK_NLAUNCH
#define MK_NLAUNCH 1
#endif

__global__ void __launch_bounds__(512, 2) mega(Params p) {
    extern __shared__ __attribute__((aligned(16))) unsigned char lds[];
    const int bid = blockIdx.x, nblk = gridDim.x;
#define wave (mk::ltid() >> 6)
    uint4* xbw = (uint4*)(lds + LDS_TOTAL - 16);
    if (threadIdx.x == 0) *xbw = make_uint4(0u, 0u, 0u, 0u);
    __syncthreads();
    XcdBarrier bar = xcd_barrier_post(p.w.bar() + (size_t)p.li * XCD_BAR_WORDS, (volatile LAS unsigned*)xbw);
    const int lo = p.ph_lo, hi = p.ph_hi;
#define IN(k) (lo <= (k) && (k) < hi)
#define SEAM(k) do { if (IN(k) && IN((k) + 1)) xcd_barrier(bar); } while (0)
    const WsMap& w = p.w;
    if (IN(0)) {
        float* tile = (float*)lds;
        { float* qss = (float*)w.QNb(); for (int i = bid * 512 + mk::ltid(); i < M * 8; i += nblk * 512) qss[i] = 0.f; }
        wconv_waves<1>(p.att_w_in, ATT_IN, p.att_norm, w.Wt1(), D, N1P, bid * 8 + wave, nblk * 8);
        wconv_waves<0>(p.att_w_out, D, nullptr, w.Wt2(), D, D, (bid * 8 + wave + nblk * 8 - 1664 % (nblk * 8)) % (nblk * 8), nblk * 8);
        wconv_waves<3>(p.dn_w_in, DN_IN, p.dn_norm, w.Wt3(), D, N3P, (bid * 8 + wave + nblk * 8 - 2176 % (nblk * 8)) % (nblk * 8), nblk * 8);
        wconv_waves<0>(p.dn_w_out, D, nullptr, w.Wt4(), D, D, (bid * 8 + wave + nblk * 8 - 4352 % (nblk * 8)) % (nblk * 8), nblk * 8);
        { const int gw = bid * 8 + wave, nw = nblk * 8;
          if (nw >= 2048) { float4 v[9][4];
#pragma unroll
              for (int k = 0; k < 9; ++k) { const int m = gw + k * nw; if (m < M) xnorm_load(xrow(p.x_prompt, p.x_sample, m), v[k]); }
#pragma unroll
              for (int k = 0; k < 9; ++k) { const int m = gw + k * nw; if (m < M) xnorm_finish(v[k], w.XA() + (size_t)m * D, w.Y1() + m); } }
          else { float4 v[4]; for (int m = gw; m < M; m += nw) { xnorm_load(xrow(p.x_prompt, p.x_sample, m), v); xnorm_finish(v, w.XA() + (size_t)m * D, w.Y1() + m); } } }
    }
    SEAM(0);
    if (IN(1)) { pg8::Gemm g{w.XA(), w.Wt1(), M, N1P, D, 0}; EpiBf16Tail E{w.P1(), N1P, N1P / 256, nullptr, nullptr, (float*)w.QNb()}; pg8::StaticOrder S; S.init(M, N1P, nblk, bid);
        pg8::gemm_phase<EpiBf16Tail, pg8::StaticOrder, false>((PG8_LAS unsigned char*)lds, g, S, E, nullptr);
    }
    SEAM(1);
    if (IN(2)) { for (int i = bid * 512 + mk::ltid(); i < M; i += nblk * 512) w.SS()[i] = 0.f;
        att_post_rows(bid * 8 + wave, nblk * 8, w.P1(), p.qg, p.kg, p.ikg, w.KB(), w.IKB(), w.IW(), p.out); }
    SEAM(2);
    if (IN(3)) {
        const int pos = (bid >> 3) % 3;
        for (int id = bid; id < 256; id += nblk) { const int b = id & 7, pr = id >> 3;
#pragma nounroll
            for (int s = 0; s < 3; ++s) {
                if (s == pos) ix::index_sample_block(id >> 3, id & 7, (char*)lds, w.P1(), w.IKB(), w.IW(), p.cache_ik, p.page_table, w.CS(), w.CI());
                else { const int k = s - (s > pos ? 1 : 0);
                    ix::index_prompt_block(b, k ? pr : 63 - pr, (char*)lds, w.P1(), w.IKB(), w.IW(), w.MASK());
                    __syncthreads(); } } }
    }
    SEAM(3);
    if (IN(4)) {
        dsa::Tensors T{(const float*)w.QNb(), w.KB(), w.P1(), w.MASK(), w.AO()};
        const bool sfirst = (bid >> 3) & 1;
        if (sfirst) { for (int r = bid; r < MS; r += nblk) attend_sample_row(r, (char*)lds, (const float*)w.QNb(), p.qg, w.P1(), w.CS(), w.CI(), p.out, p.cache_k, p.cache_v, p.page_table, w.AO()); }
        dsa::attn_prompt_phase(T, (char*)lds, bid, nblk);
        __syncthreads();
        if (!sfirst) { for (int r = bid; r < MS; r += nblk) attend_sample_row(r, (char*)lds, (const float*)w.QNb(), p.qg, w.P1(), w.CS(), w.CI(), p.out, p.cache_k, p.cache_v, p.page_table, w.AO()); }
    }
    SEAM(4);
    if (IN(5)) {
        auto small5 = [&]() __attribute__((always_inline)) { const float* INV = w.Y1(); bf16_t* XB = w.XA(); float* SS = w.SS();
          for (int u = bid; u < 256; u += nblk) gemm_small_unit<1>((char*)lds, w.AO(), w.Wt2(), MP + 32 * (u >> 5), 32 * (u & 31), [&](int r_, int c_) { return bf2f(XB[(size_t)r_ * D + c_]) * INV[r_]; }, [&](int r_, int c_, float v, float res) {
              const float y = v + res; XB[(size_t)r_ * D + c_] = f2bf(y);
              float ss = y * y; ss += __shfl_xor(ss, 1); ss += __shfl_xor(ss, 2); ss += __shfl_xor(ss, 4); ss += __shfl_xor(ss, 8); ss += __shfl_xor(ss, 16);
              if ((ltid() & 31) == 0) atomicAdd(SS + r_, ss); }); };
        const bool sf5 = (bid >> 3) & 1;
        if (sf5) small5();
        pg8::Gemm g{w.AO(), w.Wt2(), MP, D, D, 0}; EpiY1 E{w.XA(), w.Y1(), w.SS(), D, 0}; pg8::StaticOrder S; S.init(MP, D, nblk, bid);
        pg8::gemm_phase<EpiY1, pg8::StaticOrder, false>((PG8_LAS unsigned char*)lds, g, S, E, nullptr);
        if (!sf5) { __syncthreads(); small5(); } }
    SEAM(5);
    if (IN(7)) { pg8::Gemm g{w.XA(), w.Wt3(), M, N3P, D, 0}; EpiBf16Tail E{w.P2(), N3P, 16, w.BA(), w.SS(), nullptr}; pg8::StaticOrder S; S.init(M, N3P, nblk, bid);
        pg8::gemm_phase<EpiBf16Tail, pg8::StaticOrder, false>((PG8_LAS unsigned char*)lds, g, S, E, nullptr); }
    SEAM(7);
    if (IN(8)) {
        dn::PreArgs pa{w.P2(), w.BA(), p.conv_w, p.A_log, p.dt_bias, w.CH(), w.EG(), p.out};
        { dn::PreRaw R;
          if (nblk == 256) {
              const int bh = bid & 63, cq = bid >> 6;
              dn::pre_load(pa, bh * 32 + 31 - cq, R);
              for (int k = 0; k < 8; ++k) dn::pre_item(pa, bh * 32 + 31 - (4 * k + cq), k + 1 < 8 ? bh * 32 + 31 - (4 * (k + 1) + cq) : -1, (char*)lds, R);
          } else {
              int item = bid;
              if (item < dn::NITEM) dn::pre_load(pa, item, R);
              for (; item < dn::NITEM; item += nblk) dn::pre_item(pa, item, item + nblk < dn::NITEM ? item + nblk : -1, (char*)lds, R);
          }
          __syncthreads(); }
        for (int m = MP + bid; m < M; m += nblk) dn_post_row(m, (char*)lds, w.P2(), w.BA(), p.conv_w, p.state_conv, p.A_log, p.dt_bias, w.QC(), w.KC(), w.VC(), w.BETA(), w.G(), p.out);
    }
    SEAM(8);
    if (IN(9)) {
        dn::ScanArgs sa{w.CH(), w.EG(), w.ORAW(), p.out};
        for (int it = bid; it < 256; it += nblk) { const int xcd = it & 7, slot = it >> 3; dn::scan_item(sa, xcd * 8 + (slot >> 2), slot & 3, (char*)lds); }
        for (int it = bid; it < DB * 8; it += nblk) dn_scan_sample(it, (char*)lds, w.QC(), w.KC(), w.VC(), w.BETA(), w.G(), p.state_S, w.ORAW(), p.out);
    }
    SEAM(9);
    if (IN(10)) { dn_gate_rows(bid * 8 + wave, nblk * 8, w.ORAW(), w.P2(), p.og, w.AO()); }
    SEAM(10);
    if (IN(11)) {
        auto small11 = [&]() __attribute__((always_inline)) { float* yo = p.out + O_Y; const bf16_t* Y1b = w.XA();
          for (int u = bid; u < 256; u += nblk) gemm_small_unit<1>((char*)lds, w.AO(), w.Wt4(), MP + 32 * (u >> 5), 32 * (u & 31), [&](int r_, int c_) { return bf2f(Y1b[(size_t)r_ * D + c_]); }, [&](int r_, int c_, float v, float res) { yo[(size_t)r_ * D + c_] = v + res; }); };
        const bool sf11 = (bid >> 3) & 1;
        if (sf11) small11();
        pg8::Gemm g{w.AO(), w.Wt4(), MP, D, D, 0}; EpiF32ResBf E{p.out + O_Y, w.XA(), D, 0}; pg8::StaticOrder S; S.init(MP, D, nblk, bid);
        pg8::gemm_phase<EpiF32ResBf, pg8::StaticOrder, false>((PG8_LAS unsigned char*)lds, g, S, E, nullptr);
        if (!sf11) { __syncthreads(); small11(); } }
#undef IN
#undef SEAM
}
}

extern "C" void kernel_launch(void* const* d_in, const int* in_sizes, int n_in, void* d_out, int out_size, void* d_ws, size_t ws_size, hipStream_t stream) {
    using namespace mk;
    static int grid = 0;
    if (!grid) {
        int dev = 0, cus = 0, per_cu = 0;
        (void)hipGetDevice(&dev);
        (void)hipDeviceGetAttribute(&cus, hipDeviceAttributeMultiprocessorCount, dev);
        (void)hipFuncSetAttribute((const void*)mega, hipFuncAttributeMaxDynamicSharedMemorySize, LDS_TOTAL);
        (void)hipOccupancyMaxActiveBlocksPerMultiprocessor(&per_cu, (const void*)mega, 512, LDS_TOTAL);
        (void)hipGetLastError();
        grid = cus > 0 ? cus : 256;
        fprintf(stderr, "mega: cus %d occupancy %d grid %d\n", cus, per_cu, grid);
    }
    Params p; memset(&p, 0, sizeof(p));
    p.x_prompt = (const float*)d_in[0]; p.x_sample = (const float*)d_in[1]; p.cache_k = (const float*)d_in[2]; p.cache_v = (const float*)d_in[3]; p.cache_ik = (const float*)d_in[4];
    p.state_S = (const float*)d_in[5]; p.state_conv = (const float*)d_in[6]; p.page_table = (const int*)d_in[7];
    p.att_norm = (const float*)d_in[8]; p.att_w_in = (const float*)d_in[9]; p.qg = (const float*)d_in[10]; p.kg = (const float*)d_in[11];
    p.ikg = (const float*)d_in[12]; p.att_w_out = (const float*)d_in[13]; p.dn_norm = (const float*)d_in[14]; p.dn_w_in = (const float*)d_in[15];
    p.conv_w = (const float*)d_in[16]; p.A_log = (const float*)d_in[17]; p.dt_bias = (const float*)d_in[18]; p.og = (const float*)d_in[19]; p.dn_w_out = (const float*)d_in[20];
    p.out = (float*)d_out;
    p.w.base = (unsigned char*)d_ws;
    if (W_END > ws_size) { fprintf(stderr, "ws too small\n"); return; }
    (void)hipMemsetAsync(d_ws, 0, (size_t)NPHASE * XCD_BAR_WORDS * 4, stream);
    constexpr int NL = MK_NLAUNCH;
    for (int li = 0; li < NL; ++li) {
        p.ph_lo = (NL == 1) ? 0 : li; p.ph_hi = (NL == 1) ? NPHASE : li + 1; p.li = li;
        hipLaunchKernelGGL(mega, dim3(grid), dim3(512), LDS_TOTAL, stream, p);
    }
}
```
